# Optimizing an MI355X kernel written in HIP

```python
import math
import jax, jax.numpy as jnp
from jax import lax
import numpy as np

D_MODEL = 1024
BATCH = 2
SEQ = 8192
DEPTH = 1

GRID_W = 64
CTX_LEN = 256
N_HEADS_M = 4
D_MLSTM = 1024
HEAD_DIM_M = D_MLSTM // N_HEADS_M
MLSTM_CHUNK = 128
CONV_W = 3
N_GROUPS_S = 4
D_SGU = 1024
GROUP_DIM_S = D_SGU // N_GROUPS_S
SGU_CHUNK = 128
D_FF = 2816
N_MOD = 9
POS_BASE = 10000.0
F_BIAS_LO = 3.0
F_BIAS_HI = 6.0
EPS = 1e-6
PROJ_SIZES = (D_MLSTM, D_MLSTM, D_MLSTM, 4 * N_HEADS_M, D_MLSTM, D_SGU, D_SGU, D_MODEL, D_MODEL)
N_STATE_PIECES = 4
D_PROJ = sum(PROJ_SIZES)

kernel_name = 'hybrid_mlstm_sgu_macaron_block'


def rmsnorm(x, g):
    x32 = x.astype(jnp.float32)
    y = x32 * lax.rsqrt(jnp.mean(x32 * x32, axis=-1, keepdims=True) + EPS)
    return (y * g.astype(jnp.float32)).astype(x.dtype)


def modulate(x, shift, scale):
    return x * (1.0 + scale[:, None, :]) + shift[:, None, :]


def ffn_sublayer(h, shift, scale, gate, g, w_in, w_out):
    hn = modulate(rmsnorm(h, g), shift, scale)
    a, b = jnp.split(hn @ w_in, 2, axis=-1)
    y = (jax.nn.silu(a) * b) @ w_out
    return h + 0.5 * gate[:, None, :] * y


def grid_pos_emb(rows):
    t = jnp.arange(rows * GRID_W)
    r = (t // GRID_W).astype(jnp.float32)
    col = (t % GRID_W).astype(jnp.float32)
    quarter = D_MODEL // 4
    freqs = jnp.exp(-math.log(POS_BASE) * jnp.arange(quarter, dtype=jnp.float32) / quarter)
    ar = r[:, None] * freqs
    ac = col[:, None] * freqs
    return jnp.concatenate([jnp.sin(ar), jnp.cos(ar), jnp.sin(ac), jnp.cos(ac)], axis=-1)


def split_cols(p, sizes):
    out = []
    off = 0
    for s in sizes:
        out.append(p[..., off:off + s])
        off += s
    return out


def project(h, shift, scale, g, w_in, sizes):
    hn = modulate(rmsnorm(h, g), shift, scale)
    return split_cols(hn @ w_in[:, :sum(sizes)], sizes)


def short_conv(x, w, b):
    pad = CONV_W // 2
    s = x.shape[1]
    xp = jnp.pad(x, ((0, 0), (pad, pad), (0, 0)))
    return sum(xp[:, j:j + s] * w[j] for j in range(CONV_W)) + b


def to_heads(t):
    b, s, _ = t.shape
    return t.reshape(b, s, N_HEADS_M, HEAD_DIM_M).transpose(0, 2, 1, 3).astype(jnp.float32)


def mlstm_prep(q, k, v, gates, conv_w, conv_b, b_gates):
    qk = jax.nn.silu(short_conv(jnp.concatenate([q, k], axis=-1), conv_w, conv_b))
    q, k = jnp.split(qk, 2, axis=-1)
    q = to_heads(q) * HEAD_DIM_M ** -0.5
    k = to_heads(k)
    v = to_heads(v)
    gt = jnp.moveaxis((gates + b_gates).astype(jnp.float32), -1, 1)
    nh = N_HEADS_M
    fwd = (gt[:, :nh], jax.nn.log_sigmoid(gt[:, nh:2 * nh]))
    bwd = (gt[:, 2 * nh:3 * nh], jax.nn.log_sigmoid(gt[:, 3 * nh:]))
    return q, k, v, fwd, bwd


def zero_state(bsz):
    return (jnp.zeros((bsz, N_HEADS_M, HEAD_DIM_M, HEAD_DIM_M), jnp.float32),
            jnp.zeros((bsz, N_HEADS_M, HEAD_DIM_M), jnp.float32),
            jnp.zeros((bsz, N_HEADS_M), jnp.float32))


def mlstm_scan(q, k, v, li, lf, state, reverse, emit):
    if reverse:
        q, k, v = jnp.flip(q, 2), jnp.flip(k, 2), jnp.flip(v, 2)
        li, lf = jnp.flip(li, 2), jnp.flip(lf, 2)
    bsz, nh, s, dh = q.shape
    nc = s // MLSTM_CHUNK

    def to_chunks(t):
        return jnp.moveaxis(t.reshape(t.shape[:2] + (nc, MLSTM_CHUNK) + t.shape[3:]), 2, 0)

    tri = jnp.tril(jnp.ones((MLSTM_CHUNK, MLSTM_CHUNK), dtype=bool))

    def body(carry, xs):
        c_st, n_st, m_st = carry
        qc, kc, vc, lic, lfc = xs
        b = jnp.cumsum(lfc, axis=-1)
        g = b[..., -1]
        w = g[..., None] - b + lic
        m_new = jnp.maximum(g + m_st, jnp.max(w, axis=-1))
        ws = jnp.exp(w - m_new[..., None])
        decay = jnp.exp(g + m_st - m_new)
        c_new = decay[..., None, None] * c_st + jnp.einsum('bhsv,bhsk->bhvk', vc * ws[..., None], kc)
        n_new = decay[..., None] * n_st + jnp.einsum('bhs,bhsk->bhk', ws, kc)
        if not emit:
            return (c_new, n_new, m_new), None
        dm = b[..., :, None] - b[..., None, :] + lic[..., None, :]
        dm = jnp.where(tri, dm, -jnp.inf)
        a = b + m_st[..., None]
        m_t = jnp.maximum(a, jnp.max(dm, axis=-1))
        s_ts = jnp.einsum('bhtk,bhsk->bhts', qc, kc) * jnp.exp(dm - m_t[..., None])
        inter = jnp.exp(a - m_t)
        num = jnp.einsum('bhts,bhsv->bhtv', s_ts, vc) + inter[..., None] * jnp.einsum('bhvk,bhtk->bhtv', c_st, qc)
        den = jnp.sum(s_ts, axis=-1) + inter * jnp.einsum('bhk,bhtk->bht', n_st, qc)
        h = num / jnp.maximum(jnp.abs(den), jnp.exp(-m_t))[..., None]
        return (c_new, n_new, m_new), h

    state, hs = lax.scan(body, state, (to_chunks(q), to_chunks(k), to_chunks(v), to_chunks(li), to_chunks(lf)))
    if not emit:
        return None, state
    h = jnp.moveaxis(hs, 0, 2).reshape(bsz, nh, s, dh)
    if reverse:
        h = jnp.flip(h, 2)
    return h, state


def head_layernorm(h, g):
    mu = jnp.mean(h, axis=-1, keepdims=True)
    hc = h - mu
    y = hc * lax.rsqrt(jnp.mean(hc * hc, axis=-1, keepdims=True) + EPS)
    bsz, nh, s, dh = h.shape
    return y.transpose(0, 2, 1, 3).reshape(bsz, s, nh * dh) * g.astype(jnp.float32)


def spatial_gating(u, v, g, w_s, b_s):
    bsz, s, _ = v.shape
    nc = s // SGU_CHUNK
    vn = rmsnorm(v, g).reshape(bsz, nc, SGU_CHUNK, N_GROUPS_S, GROUP_DIM_S)
    mixed = jnp.einsum('gts,bnsgc->bntgc', w_s, vn) + jnp.swapaxes(b_s, 0, 1)[:, :, None]
    return u * mixed.reshape(bsz, s, D_SGU)


def merge_branches(pieces, h_m, g_head, g_sgu, w_s, b_s, w_a, w_b, w_o):
    o, u, vs, ga, gb = pieces
    y_a = jax.nn.sigmoid(o) * head_layernorm(h_m, g_head).astype(o.dtype)
    y_b = spatial_gating(jax.nn.gelu(u), jax.nn.gelu(vs), g_sgu, w_s, b_s)
    mixed = jax.nn.sigmoid(ga) * (y_a @ w_a) + jax.nn.sigmoid(gb) * (y_b @ w_b)
    return mixed @ w_o


def setup_inputs(seed: int = 0) -> dict:
    key = jax.random.key(seed)
    ks = jax.random.split(key, 28)
    f32 = jnp.float32
    L = DEPTH

    def nrm(k, shape, s):
        return jax.random.normal(k, shape, f32) * s

    def gain(k, shape):
        return 1.0 + 0.05 * jax.random.normal(k, shape, f32)

    i_bias = nrm(ks[10], (L, 2, N_HEADS_M), 0.1)
    f_bias = jnp.linspace(F_BIAS_LO, F_BIAS_HI, N_HEADS_M, dtype=f32) + nrm(ks[11], (L, 2, N_HEADS_M), 0.1)
    return {
        'x': nrm(ks[0], (BATCH, SEQ, D_MODEL), 1.0),
        'c': nrm(ks[1], (BATCH, D_MODEL), 1.0),
        'ctx': nrm(ks[2], (BATCH, CTX_LEN, D_MODEL), 1.0),
        'c_ctx': nrm(ks[3], (D_MODEL,), 1.0),
        'w_ada': nrm(ks[4], (L, D_MODEL, N_MOD * D_MODEL), 0.5 * D_MODEL ** -0.5),
        'b_ada': nrm(ks[5], (L, N_MOD * D_MODEL), 0.01),
        'g_ffn1': gain(ks[6], (L, D_MODEL)),
        'w_ffn1_in': nrm(ks[7], (L, D_MODEL, 2 * D_FF), D_MODEL ** -0.5),
        'w_ffn1_out': nrm(ks[8], (L, D_FF, D_MODEL), D_FF ** -0.5),
        'g_mix': gain(ks[9], (L, D_MODEL)),
        'w_in': nrm(ks[12], (L, D_MODEL, D_PROJ), D_MODEL ** -0.5),
        'b_gates': jnp.stack([i_bias, f_bias], axis=2).reshape(L, 4 * N_HEADS_M),
        'conv_qk_w': nrm(ks[13], (L, CONV_W, 2 * D_MLSTM), CONV_W ** -0.5),
        'conv_qk_b': nrm(ks[14], (L, 2 * D_MLSTM), 0.01),
        'g_head': gain(ks[15], (L, D_MLSTM)),
        'g_sgu': gain(ks[16], (L, D_SGU)),
        'w_s': nrm(ks[17], (L, N_GROUPS_S, SGU_CHUNK, SGU_CHUNK), SGU_CHUNK ** -0.5),
        'b_s': 1.0 + nrm(ks[18], (L, N_GROUPS_S, SGU_CHUNK), 0.1),
        'w_branch_a': nrm(ks[19], (L, D_MLSTM, D_MODEL), D_MLSTM ** -0.5),
        'w_branch_b': nrm(ks[20], (L, D_SGU, D_MODEL), D_SGU ** -0.5),
        'w_out': nrm(ks[21], (L, D_MODEL, D_MODEL), D_MODEL ** -0.5),
        'g_ffn2': gain(ks[22], (L, D_MODEL)),
        'w_ffn2_in': nrm(ks[23], (L, D_MODEL, 2 * D_FF), D_MODEL ** -0.5),
        'w_ffn2_out': nrm(ks[24], (L, D_FF, D_MODEL), D_FF ** -0.5),
        'g_final': gain(ks[25], (D_MODEL,)),
    }


def reference(x, c, ctx, c_ctx, w_ada, b_ada, g_ffn1, w_ffn1_in, w_ffn1_out, g_mix, w_in, b_gates,
              conv_qk_w, conv_qk_b, g_head, g_sgu, w_s, b_s, w_branch_a, w_branch_b, w_out,
              g_ffn2, w_ffn2_in, w_ffn2_out, g_final):
    rows = x.shape[1] // GRID_W
    bsz = x.shape[0]
    h = x + grid_pos_emb(rows).astype(x.dtype)[None]
    hc = ctx
    for layer in range(DEPTH):
        is_last = layer == DEPTH - 1
        mods = jnp.split(jax.nn.silu(c) @ w_ada[layer] + b_ada[layer], N_MOD, axis=-1)
        mods_c = jnp.split(jax.nn.silu(c_ctx)[None] @ w_ada[layer] + b_ada[layer], N_MOD, axis=-1)

        h = ffn_sublayer(h, mods[0], mods[1], mods[2], g_ffn1[layer], w_ffn1_in[layer], w_ffn1_out[layer])
        hc = ffn_sublayer(hc, mods_c[0], mods_c[1], mods_c[2], g_ffn1[layer], w_ffn1_in[layer], w_ffn1_out[layer])

        p_lat = project(h, mods[3], mods[4], g_mix[layer], w_in[layer], PROJ_SIZES)
        ctx_sizes = PROJ_SIZES[:N_STATE_PIECES] if is_last else PROJ_SIZES
        p_ctx = project(hc, mods_c[3], mods_c[4], g_mix[layer], w_in[layer], ctx_sizes)
        q_l, k_l, v_l, gf_l, gb_l = mlstm_prep(*p_lat[:N_STATE_PIECES], conv_qk_w[layer], conv_qk_b[layer], b_gates[layer])
        q_c, k_c, v_c, gf_c, gb_c = mlstm_prep(*p_ctx[:N_STATE_PIECES], conv_qk_w[layer], conv_qk_b[layer], b_gates[layer])

        state0 = zero_state(bsz)
        hcf, st_f = mlstm_scan(q_c, k_c, v_c, gf_c[0], gf_c[1], state0, False, not is_last)
        hcb, st_b = mlstm_scan(q_c, k_c, v_c, gb_c[0], gb_c[1], state0, True, not is_last)
        hlf, _ = mlstm_scan(q_l, k_l, v_l, gf_l[0], gf_l[1], st_f, False, True)
        hlb, _ = mlstm_scan(q_l, k_l, v_l, gb_l[0], gb_l[1], st_b, True, True)

        y_lat = merge_branches(p_lat[N_STATE_PIECES:], hlf + hlb, g_head[layer], g_sgu[layer], w_s[layer], b_s[layer],
                               w_branch_a[layer], w_branch_b[layer], w_out[layer])
        h = h + mods[5][:, None, :] * y_lat
        if not is_last:
            y_ctx = merge_branches(p_ctx[N_STATE_PIECES:], hcf + hcb, g_head[layer], g_sgu[layer], w_s[layer], b_s[layer],
                                   w_branch_a[layer], w_branch_b[layer], w_out[layer])
            hc = hc + mods_c[5][:, None, :] * y_ctx
            hc = ffn_sublayer(hc, mods_c[6], mods_c[7], mods_c[8], g_ffn2[layer], w_ffn2_in[layer], w_ffn2_out[layer])

        h = ffn_sublayer(h, mods[6], mods[7], mods[8], g_ffn2[layer], w_ffn2_in[layer], w_ffn2_out[layer])
    return rmsnorm(h, g_final)
```

```cpp
#include <hip/hip_runtime.h>
#include <hip/hip_cooperative_groups.h>
#include <cstdio>
#include <cstdint>
namespace cg = cooperative_groups;

#ifndef MULTI_LAUNCH
#define MULTI_LAUNCH 1
#endif

typedef unsigned short bfraw;
typedef __attribute__((ext_vector_type(8))) short bf16x8;
typedef __attribute__((ext_vector_type(4))) float f32x4;
#define DEVI __device__ __forceinline__

constexpr int NTHR = 512;
constexpr int GBM = 128;
constexpr int LROW = 40;
constexpr int LDS_BYTES = 143360;
constexpr float EPS = 1e-6f;

enum { I_X, I_C, I_CTX, I_CCTX, I_WADA, I_BADA, I_GFFN1, I_W1IN, I_W1OUT, I_GMIX, I_WIN, I_BGATES, I_CONVW, I_CONVB,
       I_GHEAD, I_GSGU, I_WS, I_BS, I_WA, I_WB, I_WO, I_GFFN2, I_W2IN, I_W2OUT, I_GFINAL };

struct P { const float* in[25]; float* out; unsigned char* ws; };

constexpr size_t O_W1IN  = 0;
constexpr size_t O_W1OUT = O_W1IN  + 5632ull * 1024 * 2;
constexpr size_t O_WTA   = O_W1OUT + 1024ull * 2816 * 2;
constexpr size_t O_WTB   = O_WTA   + 4096ull * 1024 * 2;
constexpr size_t O_WA    = O_WTB   + 4096ull * 1024 * 2;
constexpr size_t O_WB    = O_WA    + 1024ull * 1024 * 2;
constexpr size_t O_WO    = O_WB    + 1024ull * 1024 * 2;
constexpr size_t O_W2IN  = O_WO    + 1024ull * 1024 * 2;
constexpr size_t O_W2OUT = O_W2IN  + 5632ull * 1024 * 2;
constexpr size_t O_WSB   = O_W2OUT + 1024ull * 2816 * 2;
constexpr size_t O_MODSP = O_WSB   + 4ull * 128 * 128 * 2;
constexpr size_t O_MODS  = O_MODSP + 16ull * 3 * 9216 * 4;
constexpr size_t O_HCTX  = O_MODS  + 3ull * 9216 * 4;
constexpr size_t O_HN    = O_HCTX  + 512ull * 1024 * 4;
constexpr size_t O_GATES = O_HN    + 16896ull * 1024 * 2;
constexpr size_t O_CTXRAW= O_GATES + 16896ull * 16 * 4;
constexpr size_t O_BIG   = O_CTXRAW+ 2ull * 256 * 3072 * 2;
constexpr size_t O_ACT   = O_BIG;
constexpr size_t O_ST    = O_BIG;
constexpr size_t O_QRAW  = O_BIG;
constexpr size_t O_KRAW  = O_QRAW  + 8448ull * 1024 * 2;
constexpr size_t O_V     = O_ST    + 8ull * 66 * 131072;
constexpr size_t O_GVS   = O_V     + 8448ull * 1024 * 2;
constexpr size_t O_QC    = O_GVS   + 8192ull * 1024 * 2;
constexpr size_t O_KC    = O_QC    + 8448ull * 1024 * 2;
constexpr size_t O_NLOC  = O_KC    + 8448ull * 1024 * 2;
constexpr size_t O_NENT  = O_NLOC  + 8ull * 66 * 256 * 4;
constexpr size_t O_MG    = O_NENT  + 8ull * 66 * 256 * 4;
constexpr size_t O_RS    = O_MG    + 8192;
constexpr size_t O_HPARK = O_RS    + 8192ull * 4;
constexpr size_t O_END   = O_HPARK + 8192ull * 1024 * 2;
static_assert(O_ACT + 16896ull * 2816 * 2 <= 268435456ull, "ws");
static_assert(O_END <= 268435456ull, "ws");
static_assert(O_KRAW + 8448ull * 1024 * 2 <= O_V, "overlay");

DEVI int ltid() { int t = __builtin_amdgcn_workitem_id_x(); asm volatile("" : "+v"(t)); return t; }
DEVI bfraw f2bf(float f) { unsigned u = __float_as_uint(f); u += 0x7fffu + ((u >> 16) & 1u); return (bfraw)(u >> 16); }
DEVI float bf2f(bfraw h) { return __uint_as_float(((unsigned)h) << 16); }
DEVI float sigmoidf_(float x) { return 1.f / (1.f + expf(-x)); }
DEVI float siluf_(float x) { return x / (1.f + expf(-x)); }
DEVI float geluf_(float x) { float u = 0.7978845608028654f * (x + 0.044715f * x * x * x); return 0.5f * x * (1.f + tanhf(u)); }
DEVI float logsigf_(float x) { return fminf(x, 0.f) - log1pf(expf(-fabsf(x))); }
DEVI float wave_sum(float v) {
#pragma unroll
  for (int o = 32; o > 0; o >>= 1) v += __shfl_xor(v, o, 64);
  return v;
}
DEVI float red16(float v) {
  v += __shfl_xor(v, 1, 64); v += __shfl_xor(v, 2, 64); v += __shfl_xor(v, 4, 64); v += __shfl_xor(v, 8, 64);
  return v;
}
DEVI float redsin(float a, bool cosine) {
  float k = rintf(a * 0.15915494309189535f);
  float r = fmaf(-k, 6.2831854820251465f, a);
  r = fmaf(-k, -1.7484555e-7f, r);
  return cosine ? __cosf(r) : __sinf(r);
}

template <int BM, int BN, bool ATR, bool BTR, bool ALDS>
DEVI void gemm_tile(const bfraw* __restrict__ A, int lda, const bfraw* __restrict__ B, int ldb, int K,
                    const float* kscale, f32x4 (&acc)[BM / 32][BN / 64], bfraw* st, const bfraw* sAres, int ldres) {
  constexpr int MI = BM / 32, NJ = BN / 64, CA = BM / 128, CB = BN / 128, WM = BM / 2, WN = BN / 4;
  constexpr int STAGE = (ALDS ? BN : (BM + BN)) * LROW;
  int tid_ = ltid();
  const int tid = tid_, lane = tid & 63, wid = tid >> 6, wm = wid >> 2, wn = wid & 3;
  const int fr = lane & 15, fq = lane >> 4;
  uint4 ra[CA], rb[CB];
  const int nk = K >> 5;

  auto gload = [&](int kt) {
    const int k0 = kt << 5;
    if (!ALDS) {
#pragma unroll
      for (int i = 0; i < CA; ++i) {
        int c = tid + i * NTHR;
        if (!ATR) { int row = c >> 2, kc = (c & 3) * 8; ra[i] = *(const uint4*)(A + (size_t)row * lda + k0 + kc); }
        else { int krow = c / (BM / 8), m0 = (c % (BM / 8)) * 8; ra[i] = *(const uint4*)(A + (size_t)(k0 + krow) * lda + m0); }
      }
    }
#pragma unroll
    for (int i = 0; i < CB; ++i) {
      int c = tid + i * NTHR;
      if (!BTR) { int row = c >> 2, kc = (c & 3) * 8; rb[i] = *(const uint4*)(B + (size_t)row * ldb + k0 + kc); }
      else { int krow = c / (BN / 8), n0 = (c % (BN / 8)) * 8; rb[i] = *(const uint4*)(B + (size_t)(k0 + krow) * ldb + n0); }
    }
  };
  auto scatter = [&](bfraw* s, int m0, int krow, uint4 r, float sc, bool scaled) {
    unsigned w0 = r.x, w1 = r.y, w2 = r.z, w3 = r.w;
    bfraw e0 = w0 & 0xffff, e1 = w0 >> 16, e2 = w1 & 0xffff, e3 = w1 >> 16, e4 = w2 & 0xffff, e5 = w2 >> 16, e6 = w3 & 0xffff, e7 = w3 >> 16;
    if (scaled) {
      e0 = f2bf(bf2f(e0) * sc); e1 = f2bf(bf2f(e1) * sc); e2 = f2bf(bf2f(e2) * sc); e3 = f2bf(bf2f(e3) * sc);
      e4 = f2bf(bf2f(e4) * sc); e5 = f2bf(bf2f(e5) * sc); e6 = f2bf(bf2f(e6) * sc); e7 = f2bf(bf2f(e7) * sc);
    }
    bfraw* d = s + m0 * LROW + krow;
    d[0] = e0; d[LROW] = e1; d[2 * LROW] = e2; d[3 * LROW] = e3; d[4 * LROW] = e4; d[5 * LROW] = e5; d[6 * LROW] = e6; d[7 * LROW] = e7;
  };
  auto lstore = [&](int buf, int kt) {
    bfraw* sA = st + buf * STAGE;
    bfraw* sB = sA + (ALDS ? 0 : BM * LROW);
    if (!ALDS) {
#pragma unroll
      for (int i = 0; i < CA; ++i) {
        int c = tid + i * NTHR;
        if (!ATR) { int row = c >> 2, kc = (c & 3) * 8; *(uint4*)(sA + row * LROW + kc) = ra[i]; }
        else { int krow = c / (BM / 8), m0 = (c % (BM / 8)) * 8; scatter(sA, m0, krow, ra[i], 1.f, false); }
      }
    }
#pragma unroll
    for (int i = 0; i < CB; ++i) {
      int c = tid + i * NTHR;
      if (!BTR) { int row = c >> 2, kc = (c & 3) * 8; *(uint4*)(sB + row * LROW + kc) = rb[i]; }
      else {
        int krow = c / (BN / 8), n0 = (c % (BN / 8)) * 8;
        float sc = kscale ? kscale[(kt << 5) + krow] : 1.f;
        scatter(sB, n0, krow, rb[i], sc, kscale != nullptr);
      }
    }
  };
  auto compute = [&](int buf, int kt) {
    const bfraw* sA = st + buf * STAGE;
    const bfraw* sB = sA + (ALDS ? 0 : BM * LROW);
    bf16x8 af[MI], bfr[NJ];
#pragma unroll
    for (int i = 0; i < MI; ++i) {
      if (ALDS) af[i] = *(const bf16x8*)(sAres + (wm * WM + i * 16 + fr) * ldres + (kt << 5) + fq * 8);
      else af[i] = *(const bf16x8*)(sA + (wm * WM + i * 16 + fr) * LROW + fq * 8);
    }
#pragma unroll
    for (int j = 0; j < NJ; ++j) bfr[j] = *(const bf16x8*)(sB + (wn * WN + j * 16 + fr) * LROW + fq * 8);
#pragma unroll
    for (int i = 0; i < MI; ++i)
#pragma unroll
      for (int j = 0; j < NJ; ++j) acc[i][j] = __builtin_amdgcn_mfma_f32_16x16x32_bf16(af[i], bfr[j], acc[i][j], 0, 0, 0);
  };

  __syncthreads();
  gload(0); lstore(0, 0);
  __syncthreads();
  for (int kt = 0; kt < nk; ++kt) {
    if (kt + 1 < nk) gload(kt + 1);
    compute(kt & 1, kt);
    if (kt + 1 < nk) lstore((kt + 1) & 1, kt + 1);
    __syncthreads();
  }
}

#define ZERO_ACC(acc, MI, NJ) _Pragma("unroll") for (int _i = 0; _i < (MI); ++_i) _Pragma("unroll") for (int _j = 0; _j < (NJ); ++_j) acc[_i][_j] = f32x4{0.f, 0.f, 0.f, 0.f};
#define EPI_BEGIN(BM, BN) { int _t = ltid(); const int _l = _t & 63, _w = _t >> 6; \
    const int _rb = (_w >> 2) * ((BM) / 2) + (_l >> 4) * 4, _cb = (_w & 3) * ((BN) / 4) + (_l & 15); \
    _Pragma("unroll") for (int i = 0; i < (BM) / 32; ++i) _Pragma("unroll") for (int j = 0; j < (BN) / 64; ++j) _Pragma("unroll") for (int r = 0; r < 4; ++r) { \
      const int row = _rb + i * 16 + r, col = _cb + j * 16;
#define EPI_END }}
#define EPIR_BEGIN(BM, BN) { int _t = ltid(); const int _l = _t & 63, _w = _t >> 6; \
    const int _rb = (_w >> 2) * ((BM) / 2) + (_l >> 4) * 4, _cb = (_w & 3) * ((BN) / 4) + (_l & 15); \
    _Pragma("unroll") for (int i = 0; i < (BM) / 32; ++i) _Pragma("unroll") for (int r = 0; r < 4; ++r) { \
      const int row = _rb + i * 16 + r;
#define EPIR_COLS(BN) _Pragma("unroll") for (int j = 0; j < (BN) / 64; ++j) { const int col = _cb + j * 16;
#define EPIR_END }}}

DEVI void tr_tile(const float* __restrict__ src, int ldw, int col0, int kt, int nt, bfraw* dst, int K, int drow0, int mode, float* t) {
  const int tid = ltid();
  __syncthreads();
#pragma unroll
  for (int i = 0; i < 8; ++i) { int e = tid + i * NTHR; int kk = e >> 6, nn = e & 63; t[kk * 65 + nn] = src[(size_t)(kt * 64 + kk) * ldw + col0 + nt * 64 + nn]; }
  __syncthreads();
#pragma unroll
  for (int i = 0; i < 8; ++i) {
    int e = tid + i * NTHR; int nn = e >> 6, kk = e & 63;
    int n = nt * 64 + nn, dr;
    if (mode == 1) { int isb = n >= 2816; int f = n - isb * 2816; dr = (f >> 4) * 32 + isb * 16 + (f & 15); } else dr = drow0 + n;
    dst[(size_t)dr * K + kt * 64 + kk] = f2bf(t[kk * 65 + nn]);
  }
}

DEVI void phase_p0(const P& p, unsigned char* lds) {
  float* sf = (float*)lds;
  const int tid = ltid();
  for (int i = tid; i < 3072; i += NTHR) { float v = i < 2048 ? p.in[I_C][i] : p.in[I_CCTX][i - 2048]; sf[i] = siluf_(v); }
  __syncthreads();
  {
    const float* w = p.in[I_WADA];
    float* mp = (float*)(p.ws + O_MODSP);
    for (int id = blockIdx.x * NTHR + tid; id < 16 * 9216; id += gridDim.x * NTHR) {
      int s = id / 9216, j = id - s * 9216;
      float a0 = 0, a1 = 0, a2 = 0;
#pragma unroll 8
      for (int k = s * 64; k < s * 64 + 64; ++k) { float wv = w[(size_t)k * 9216 + j]; a0 += sf[k] * wv; a1 += sf[1024 + k] * wv; a2 += sf[2048 + k] * wv; }
      mp[(s * 3 + 0) * 9216 + j] = a0; mp[(s * 3 + 1) * 9216 + j] = a1; mp[(s * 3 + 2) * 9216 + j] = a2;
    }
  }
  __syncthreads();
  for (int t = blockIdx.x; t < 7040; t += gridDim.x) {
    int u = t;
    if (u < 1408) { tr_tile(p.in[I_W1IN], 5632, 0, u / 88, u % 88, (bfraw*)(p.ws + O_W1IN), 1024, 0, 1, sf); continue; }
    u -= 1408;
    if (u < 704) { tr_tile(p.in[I_W1OUT], 1024, 0, u / 16, u % 16, (bfraw*)(p.ws + O_W1OUT), 2816, 0, 0, sf); continue; }
    u -= 704;
    if (u < 2048) {
      int pc = u >> 8; u &= 255;
      const int c0[8] = {0, 1024, 2048, 5136, 3088, 4112, 6160, 7184};
      int col0 = pc == 0 ? 0 : pc == 1 ? 1024 : pc == 2 ? 2048 : pc == 3 ? 5136 : pc == 4 ? 3088 : pc == 5 ? 4112 : pc == 6 ? 6160 : 7184;
      (void)c0;
      tr_tile(p.in[I_WIN], 8208, col0, u >> 4, u & 15, (bfraw*)(p.ws + (pc < 4 ? O_WTA : O_WTB)), 1024, (pc & 3) * 1024, 0, sf); continue;
    }
    u -= 2048;
    if (u < 768) { int m = u >> 8; u &= 255; tr_tile(p.in[m == 0 ? I_WA : m == 1 ? I_WB : I_WO], 1024, 0, u >> 4, u & 15, (bfraw*)(p.ws + (m == 0 ? O_WA : m == 1 ? O_WB : O_WO)), 1024, 0, 0, sf); continue; }
    u -= 768;
    if (u < 1408) { tr_tile(p.in[I_W2IN], 5632, 0, u / 88, u % 88, (bfraw*)(p.ws + O_W2IN), 1024, 0, 1, sf); continue; }
    u -= 1408;
    tr_tile(p.in[I_W2OUT], 1024, 0, u / 16, u % 16, (bfraw*)(p.ws + O_W2OUT), 2816, 0, 0, sf);
  }
  { bfraw* d = (bfraw*)(p.ws + O_WSB); for (int id = blockIdx.x * NTHR + tid; id < 65536; id += gridDim.x * NTHR) d[id] = f2bf(p.in[I_WS][id]); }
}

DEVI void phase_p0b(const P& p) {
  const float* mp = (const float*)(p.ws + O_MODSP);
  float* m = (float*)(p.ws + O_MODS);
  for (int id = blockIdx.x * NTHR + ltid(); id < 3 * 9216; id += gridDim.x * NTHR) {
    int j = id % 9216;
    float a = p.in[I_BADA][j];
    for (int s = 0; s < 16; ++s) a += mp[s * 3 * 9216 + id];
    m[id] = a;
  }
}

template <int MODE>
DEVI void phase_rows(const P& p, unsigned char* lds) {
  const int tid = ltid(), lane = tid & 63, wid = tid >> 6;
  const float* mods = (const float*)(p.ws + O_MODS);
  float* hctx = (float*)(p.ws + O_HCTX);
  bfraw* hn = (bfraw*)(p.ws + O_HN);
  float* wg = (float*)lds;
  if (MODE == 2) {
    __syncthreads();
    for (int i = tid; i < 16384; i += NTHR) { int k = i >> 4, g = i & 15; wg[g * 1024 + k] = p.in[I_WIN][(size_t)k * 8208 + 3072 + g]; }
    __syncthreads();
  }
  const int nrows = (MODE == 1 || MODE == 2) ? 16896 : 16384;
  const float* gvec = p.in[MODE == 1 ? I_GFFN1 : MODE == 2 ? I_GMIX : MODE == 3 ? I_GFFN2 : I_GFINAL];
  const int msh = MODE == 1 ? 0 : MODE == 2 ? 3 : 6;
  for (int row = blockIdx.x * 8 + wid; row < nrows; row += gridDim.x * 8) {
    const bool lat = row < 16384;
    const int mrow = lat ? (row >> 13) : 2;
    float4 v[4];
    if (MODE == 1) {
      const float* src = lat ? p.in[I_X] + (size_t)row * 1024 : p.in[I_CTX] + (size_t)(row - 16384) * 1024;
#pragma unroll
      for (int i = 0; i < 4; ++i) v[i] = *(const float4*)(src + i * 256 + lane * 4);
      if (lat) {
        int ts = row & 8191; float rr = (float)(ts >> 6), cc = (float)(ts & 63);
        float fqv[4];
#pragma unroll
        for (int e = 0; e < 4; ++e) fqv[e] = expf((-9.210340371976184f * (float)(lane * 4 + e)) / 256.f);
        v[0].x += redsin(rr * fqv[0], false); v[0].y += redsin(rr * fqv[1], false); v[0].z += redsin(rr * fqv[2], false); v[0].w += redsin(rr * fqv[3], false);
        v[1].x += redsin(rr * fqv[0], true);  v[1].y += redsin(rr * fqv[1], true);  v[1].z += redsin(rr * fqv[2], true);  v[1].w += redsin(rr * fqv[3], true);
        v[2].x += redsin(cc * fqv[0], false); v[2].y += redsin(cc * fqv[1], false); v[2].z += redsin(cc * fqv[2], false); v[2].w += redsin(cc * fqv[3], false);
        v[3].x += redsin(cc * fqv[0], true);  v[3].y += redsin(cc * fqv[1], true);  v[3].z += redsin(cc * fqv[2], true);  v[3].w += redsin(cc * fqv[3], true);
      }
      float* dsth = lat ? p.out + (size_t)row * 1024 : hctx + (size_t)(row - 16384) * 1024;
#pragma unroll
      for (int i = 0; i < 4; ++i) *(float4*)(dsth + i * 256 + lane * 4) = v[i];
    } else {
      const float* src = lat ? p.out + (size_t)row * 1024 : hctx + (size_t)(row - 16384) * 1024;
#pragma unroll
      for (int i = 0; i < 4; ++i) v[i] = *(const float4*)(src + i * 256 + lane * 4);
    }
    float ss = 0;
#pragma unroll
    for (int i = 0; i < 4; ++i) ss += v[i].x * v[i].x + v[i].y * v[i].y + v[i].z * v[i].z + v[i].w * v[i].w;
    ss = wave_sum(ss);
    const float rs = rsqrtf(ss * (1.f / 1024.f) + EPS);
    if (MODE == 4) {
#pragma unroll
      for (int i = 0; i < 4; ++i) {
        float4 g = *(const float4*)(gvec + i * 256 + lane * 4);
        float4 o = {v[i].x * rs * g.x, v[i].y * rs * g.y, v[i].z * rs * g.z, v[i].w * rs * g.w};
        *(float4*)(p.out + (size_t)row * 1024 + i * 256 + lane * 4) = o;
      }
    } else {
      const float* sh = mods + (size_t)(mrow * 9216 + msh * 1024);
      const float* scp = sh + 1024;
      float y[16];
#pragma unroll
      for (int i = 0; i < 4; ++i) {
        const int c = i * 256 + lane * 4;
        float4 g = *(const float4*)(gvec + c), s4 = *(const float4*)(sh + c), c4 = *(const float4*)(scp + c);
        y[i * 4 + 0] = v[i].x * rs * g.x * (1.f + c4.x) + s4.x; y[i * 4 + 1] = v[i].y * rs * g.y * (1.f + c4.y) + s4.y;
        y[i * 4 + 2] = v[i].z * rs * g.z * (1.f + c4.z) + s4.z; y[i * 4 + 3] = v[i].w * rs * g.w * (1.f + c4.w) + s4.w;
        uint2 pk; pk.x = (unsigned)f2bf(y[i * 4]) | ((unsigned)f2bf(y[i * 4 + 1]) << 16); pk.y = (unsigned)f2bf(y[i * 4 + 2]) | ((unsigned)f2bf(y[i * 4 + 3]) << 16);
        *(uint2*)(hn + (size_t)row * 1024 + c) = pk;
      }
      if (MODE == 2) {
        float mine = 0.f;
#pragma unroll 2
        for (int g2 = 0; g2 < 16; ++g2) {
          float a = 0.f;
#pragma unroll
          for (int i = 0; i < 4; ++i) { float4 w4 = *(const float4*)(wg + g2 * 1024 + i * 256 + lane * 4); a += y[i * 4] * w4.x + y[i * 4 + 1] * w4.y + y[i * 4 + 2] * w4.z + y[i * 4 + 3] * w4.w; }
          a = wave_sum(a);
          if (lane == g2) mine = a;
        }
        if (lane < 16) ((float*)(p.ws + O_GATES))[(size_t)row * 16 + lane] = mine;
      }
    }
  }
}

template <int BM>
DEVI void phase_ffn_in(const P& p, unsigned char* lds, size_t o_w, int nrows) {
  const int nTM = nrows / BM;
  const bfraw* hn = (const bfraw*)(p.ws + O_HN);
  const bfraw* W = (const bfraw*)(p.ws + o_w);
  bfraw* act = (bfraw*)(p.ws + O_ACT);
  const int lane = ltid() & 63, wid = ltid() >> 6, wm = wid >> 2, wn = wid & 3, fr = lane & 15, fq = lane >> 4;
  for (int t = blockIdx.x; t < nTM * 22; t += gridDim.x) {
    const int tm = t / 22, tn = t % 22;
    f32x4 acc[BM / 32][4]; ZERO_ACC(acc, BM / 32, 4);
    gemm_tile<BM, 256, false, false, false>(hn + (size_t)tm * BM * 1024, 1024, W + (size_t)tn * 256 * 1024, 1024, 1024, nullptr, acc, (bfraw*)lds, nullptr, 0);
#pragma unroll
    for (int i = 0; i < BM / 32; ++i)
#pragma unroll
      for (int jj = 0; jj < 2; ++jj)
#pragma unroll
        for (int r = 0; r < 4; ++r) {
          float a = acc[i][2 * jj][r], b = acc[i][2 * jj + 1][r];
          int row = tm * BM + wm * (BM / 2) + i * 16 + fq * 4 + r;
          int f = ((tn * 256 + wn * 64) / 32 + jj) * 16 + fr;
          act[(size_t)row * 2816 + f] = f2bf(siluf_(a) * b);
        }
  }
}

template <int BM>
DEVI void phase_ffn_out(const P& p, unsigned char* lds, size_t o_w, int nrows, int gidx) {
  const bfraw* act = (const bfraw*)(p.ws + O_ACT);
  const bfraw* W = (const bfraw*)(p.ws + o_w);
  const float* mods = (const float*)(p.ws + O_MODS);
  float* hctx = (float*)(p.ws + O_HCTX);
  const int nTM = nrows / BM;
  for (int t = blockIdx.x; t < nTM * 4; t += gridDim.x) {
    const int tm = t >> 2, tn = t & 3;
    f32x4 acc[BM / 32][4]; ZERO_ACC(acc, BM / 32, 4);
    gemm_tile<BM, 256, false, false, false>(act + (size_t)tm * BM * 2816, 2816, W + (size_t)tn * 256 * 2816, 2816, 2816, nullptr, acc, (bfraw*)lds, nullptr, 0);
    EPI_BEGIN(BM, 256)
      const int grow = tm * BM + row, gcol = tn * 256 + col;
      const bool lat = grow < 16384;
      float* hp = lat ? p.out + (size_t)grow * 1024 + gcol : hctx + (size_t)(grow - 16384) * 1024 + gcol;
      const float gate = mods[(lat ? (grow >> 13) : 2) * 9216 + gidx * 1024 + gcol];
      *hp = *hp + 0.5f * gate * acc[i][j][r];
    EPI_END
  }
}

DEVI void phase_g3c(const P& p, unsigned char* lds) {
  const bfraw* hn = (const bfraw*)(p.ws + O_HN) + (size_t)16384 * 1024;
  const bfraw* W = (const bfraw*)(p.ws + O_WTA);
  bfraw* dst = (bfraw*)(p.ws + O_CTXRAW);
  for (int t = blockIdx.x; t < 4 * 24; t += gridDim.x) {
    const int tm = t / 24, tn = t % 24;
    f32x4 acc[4][2]; ZERO_ACC(acc, 4, 2);
    gemm_tile<128, 128, false, false, false>(hn + (size_t)tm * 128 * 1024, 1024, W + (size_t)tn * 128 * 1024, 1024, 1024, nullptr, acc, (bfraw*)lds, nullptr, 0);
    EPI_BEGIN(128, 128)
      dst[(size_t)(tm * 128 + row) * 3072 + tn * 128 + col] = f2bf(acc[i][j][r]);
    EPI_END
  }
}

DEVI void phase_g3a(const P& p, unsigned char* lds, int hb) {
  const bfraw* hn = (const bfraw*)(p.ws + O_HN) + (size_t)hb * 8192 * 1024;
  const bfraw* W = (const bfraw*)(p.ws + O_WTA);
  for (int t = blockIdx.x; t < (8192 / GBM) * 16; t += gridDim.x) {
    const int tm = t >> 4, tn = t & 15;
    f32x4 acc[GBM / 32][4]; ZERO_ACC(acc, GBM / 32, 4);
    gemm_tile<GBM, 256, false, false, false>(hn + (size_t)tm * GBM * 1024, 1024, W + (size_t)tn * 256 * 1024, 1024, 1024, nullptr, acc, (bfraw*)lds, nullptr, 0);
    const int pc = tn >> 2;
    bfraw* dst = (bfraw*)(p.ws + (pc == 0 ? O_QRAW : pc == 1 ? O_KRAW : pc == 2 ? O_V : O_GVS));
    EPI_BEGIN(GBM, 256)
      float v = acc[i][j][r];
      if (pc == 3) v = geluf_(v);
      dst[(size_t)(tm * GBM + row) * 1024 + (tn & 3) * 256 + col] = f2bf(v);
    EPI_END
  }
}

DEVI void phase_g3b(const P& p, unsigned char* lds, int hb) {
  const bfraw* hn = (const bfraw*)(p.ws + O_HN) + (size_t)hb * 8192 * 1024;
  const bfraw* W = (const bfraw*)(p.ws + O_WTB);
  for (int t = blockIdx.x; t < (8192 / GBM) * 16; t += gridDim.x) {
    const int tm = t >> 4, tn = t & 15;
    f32x4 acc[GBM / 32][4]; ZERO_ACC(acc, GBM / 32, 4);
    gemm_tile<GBM, 256, false, false, false>(hn + (size_t)tm * GBM * 1024, 1024, W + (size_t)tn * 256 * 1024, 1024, 1024, nullptr, acc, (bfraw*)lds, nullptr, 0);
    const int pc = tn >> 2;
    bfraw* dst = (bfraw*)(p.ws + (pc == 0 ? O_V : pc == 1 ? O_GVS : pc == 2 ? O_QC : O_KC));
    EPI_BEGIN(GBM, 256)
      float v = acc[i][j][r];
      bfraw* d = dst + (size_t)(tm * GBM + row) * 1024 + (tn & 3) * 256 + col;
      if (pc == 0) v = sigmoidf_(v) * bf2f(*d);
      else if (pc == 1) v = geluf_(v) * bf2f(*d);
      else v = sigmoidf_(v);
      *d = f2bf(v);
    EPI_END
  }
}

DEVI void phase_g4(const P& p, unsigned char* lds) {
  const bfraw* ya = (const bfraw*)(p.ws + O_V);
  const bfraw* yb = (const bfraw*)(p.ws + O_GVS);
  bfraw* sga = (bfraw*)(p.ws + O_QC);
  bfraw* sgb = (bfraw*)(p.ws + O_KC);
  for (int t = blockIdx.x; t < 64 * 4; t += gridDim.x) {
    const int tm = t >> 2, tn = t & 3;
    f32x4 acc[4][4]; ZERO_ACC(acc, 4, 4);
    gemm_tile<128, 256, false, false, false>(ya + (size_t)tm * 128 * 1024, 1024, (const bfraw*)(p.ws + O_WA) + (size_t)tn * 256 * 1024, 1024, 1024, nullptr, acc, (bfraw*)lds, nullptr, 0);
    EPI_BEGIN(128, 256)
      const size_t o = (size_t)(tm * 128 + row) * 1024 + tn * 256 + col;
      sga[o] = f2bf(acc[i][j][r] * bf2f(sga[o]));
    EPI_END
    ZERO_ACC(acc, 4, 4);
    gemm_tile<128, 256, false, false, false>(yb + (size_t)tm * 128 * 1024, 1024, (const bfraw*)(p.ws + O_WB) + (size_t)tn * 256 * 1024, 1024, 1024, nullptr, acc, (bfraw*)lds, nullptr, 0);
    EPI_BEGIN(128, 256)
      const size_t o = (size_t)(tm * 128 + row) * 1024 + tn * 256 + col;
      sgb[o] = f2bf(bf2f(sga[o]) + bf2f(sgb[o]) * acc[i][j][r]);
    EPI_END
  }
}

DEVI void phase_g5(const P& p, unsigned char* lds, int hb) {
  const bfraw* mx = (const bfraw*)(p.ws + O_KC);
  const float* mods = (const float*)(p.ws + O_MODS);
  for (int t = blockIdx.x; t < 64 * 4; t += gridDim.x) {
    const int tm = t >> 2, tn = t & 3;
    f32x4 acc[4][4]; ZERO_ACC(acc, 4, 4);
    gemm_tile<128, 256, false, false, false>(mx + (size_t)tm * 128 * 1024, 1024, (const bfraw*)(p.ws + O_WO) + (size_t)tn * 256 * 1024, 1024, 1024, nullptr, acc, (bfraw*)lds, nullptr, 0);
    EPI_BEGIN(128, 256)
      const int gcol = tn * 256 + col;
      float* hp = p.out + (size_t)(hb * 8192 + tm * 128 + row) * 1024 + gcol;
      *hp = *hp + mods[hb * 9216 + 5 * 1024 + gcol] * acc[i][j][r];
    EPI_END
  }
}

DEVI uint4 conv8(uint4 a, uint4 b, uint4 c, const float* w, const float* bias, int ch, float scale) {
  unsigned av[4] = {a.x, a.y, a.z, a.w}, bv[4] = {b.x, b.y, b.z, b.w}, cv[4] = {c.x, c.y, c.z, c.w}, ov[4];
#pragma unroll
  for (int e = 0; e < 4; ++e) {
    float r[2];
#pragma unroll
    for (int h = 0; h < 2; ++h) {
      int cc = ch + e * 2 + h;
      float xa = bf2f((bfraw)(h ? av[e] >> 16 : av[e] & 0xffff)), xb = bf2f((bfraw)(h ? bv[e] >> 16 : bv[e] & 0xffff)), xc = bf2f((bfraw)(h ? cv[e] >> 16 : cv[e] & 0xffff));
      float y = xa * w[cc] + xb * w[2048 + cc] + xc * w[4096 + cc] + bias[cc];
      r[h] = siluf_(y) * scale;
    }
    ov[e] = (unsigned)f2bf(r[0]) | ((unsigned)f2bf(r[1]) << 16);
  }
  return uint4{ov[0], ov[1], ov[2], ov[3]};
}

DEVI void phase_cv(const P& p, int hb) {
  const int lane = ltid() & 63, wid = ltid() >> 6;
  const bfraw* qraw = (const bfraw*)(p.ws + O_QRAW);
  const bfraw* kraw = (const bfraw*)(p.ws + O_KRAW);
  const bfraw* craw = (const bfraw*)(p.ws + O_CTXRAW) + (size_t)hb * 256 * 3072;
  bfraw* qc = (bfraw*)(p.ws + O_QC);
  bfraw* kc = (bfraw*)(p.ws + O_KC);
  bfraw* vv = (bfraw*)(p.ws + O_V);
  const bfraw* gvs = (const bfraw*)(p.ws + O_GVS);
  float* rsb = (float*)(p.ws + O_RS);
  const float* cw = p.in[I_CONVW];
  const float* cb = p.in[I_CONVB];
  const uint4 z = {0, 0, 0, 0};
  for (int row = blockIdx.x * 8 + wid; row < 8448; row += gridDim.x * 8) {
    const bool lat = row < 8192;
    const int lr = lat ? row : row - 8192, len = lat ? 8192 : 256;
    const bfraw* qb = lat ? qraw : craw;
    const bfraw* kb = lat ? kraw : craw + 1024;
    const size_t ld = lat ? 1024 : 3072;
#pragma unroll
    for (int hlf = 0; hlf < 2; ++hlf) {
      const int ch = hlf * 512 + lane * 8;
      uint4 qa = lr > 0 ? *(const uint4*)(qb + (size_t)(lr - 1) * ld + ch) : z;
      uint4 qm = *(const uint4*)(qb + (size_t)lr * ld + ch);
      uint4 qn = lr < len - 1 ? *(const uint4*)(qb + (size_t)(lr + 1) * ld + ch) : z;
      *(uint4*)(qc + (size_t)row * 1024 + ch) = conv8(qa, qm, qn, cw, cb, ch, 0.0625f);
      uint4 ka = lr > 0 ? *(const uint4*)(kb + (size_t)(lr - 1) * ld + ch) : z;
      uint4 km = *(const uint4*)(kb + (size_t)lr * ld + ch);
      uint4 kn = lr < len - 1 ? *(const uint4*)(kb + (size_t)(lr + 1) * ld + ch) : z;
      *(uint4*)(kc + (size_t)row * 1024 + ch) = conv8(ka, km, kn, cw, cb, 1024 + ch, 1.f);
      if (!lat) *(uint4*)(vv + (size_t)row * 1024 + ch) = *(const uint4*)(craw + 2048 + (size_t)lr * 3072 + ch);
    }
    if (lat) {
      float ss = 0;
#pragma unroll
      for (int hlf = 0; hlf < 2; ++hlf) {
        uint4 g = *(const uint4*)(gvs + (size_t)row * 1024 + hlf * 512 + lane * 8);
        unsigned gv[4] = {g.x, g.y, g.z, g.w};
#pragma unroll
        for (int e = 0; e < 4; ++e) { float a = bf2f((bfraw)(gv[e] & 0xffff)), b = bf2f((bfraw)(gv[e] >> 16)); ss += a * a + b * b; }
      }
      ss = wave_sum(ss);
      if (lane == 0) rsb[row] = rsqrtf(ss * (1.f / 1024.f) + EPS);
    }
  }
}

DEVI void phase_ma(const P& p, unsigned char* lds, int hb) {
  const int tid = ltid();
  bfraw* st = (bfraw*)lds;
  float* sc = (float*)(lds + 131072);
  float* s_lf = sc, *s_w = sc + 128, *s_ws = sc + 256, *s_red = sc + 384;
  const float* gates = (const float*)(p.ws + O_GATES);
  const float* bg = p.in[I_BGATES];
  const bfraw* kc = (const bfraw*)(p.ws + O_KC);
  const bfraw* vv = (const bfraw*)(p.ws + O_V);
  bfraw* states = (bfraw*)(p.ws + O_ST);
  float* nloc = (float*)(p.ws + O_NLOC);
  float* mg = (float*)(p.ws + O_MG);
  for (int item = blockIdx.x; item < 528 + 256; item += gridDim.x) {
    if (item < 528) {
      const int seq = item / 66, j = item % 66, d = seq >> 2, h = seq & 3;
      int rbase, grow;
      if (j < 2) { int cc = d == 0 ? j : 1 - j; rbase = 8192 + cc * 128; grow = 16384 + hb * 256 + cc * 128; }
      else { int c = d == 0 ? j - 2 : 65 - j; rbase = c * 128; grow = hb * 8192 + c * 128; }
      __syncthreads();
      if (tid < 128) {
        float li = gates[(size_t)(grow + tid) * 16 + d * 8 + h] + bg[d * 8 + h];
        float lf = logsigf_(gates[(size_t)(grow + tid) * 16 + d * 8 + 4 + h] + bg[d * 8 + 4 + h]);
        s_lf[tid] = lf; s_w[tid] = li;
      }
      __syncthreads();
      if (tid < 128) {
        float b = 0, g = 0;
        if (d == 0) { for (int s = 0; s < 128; ++s) { g += s_lf[s]; if (s == tid) b = g; } }
        else { for (int s = 127; s >= 0; --s) { g += s_lf[s]; if (s == tid) b = g; } }
        float w = g - b + s_w[tid];
        s_ws[tid] = w;
        if (tid == 0) s_red[1] = g;
      }
      __syncthreads();
      if (tid < 64) {
        float m = fmaxf(s_ws[tid], s_ws[tid + 64]);
#pragma unroll
        for (int o = 32; o > 0; o >>= 1) m = fmaxf(m, __shfl_xor(m, o, 64));
        if (tid == 0) s_red[0] = m;
      }
      __syncthreads();
      const float mloc = s_red[0];
      if (tid < 128) s_ws[tid] = expf(s_ws[tid] - mloc);
      if (tid == 0) { mg[seq * 66 + j] = mloc; mg[528 + seq * 66 + j] = s_red[1]; }
      __syncthreads();
      bfraw* dst = states + (size_t)(seq * 66 + j) * 65536;
#pragma unroll 1
      for (int vh = 0; vh < 2; ++vh) {
        f32x4 acc[4][4]; ZERO_ACC(acc, 4, 4);
        gemm_tile<128, 256, true, true, false>(vv + (size_t)rbase * 1024 + h * 256 + vh * 128, 1024, kc + (size_t)rbase * 1024 + h * 256, 1024, 128, s_ws, acc, st, nullptr, 0);
        EPI_BEGIN(128, 256)
          dst[(vh * 128 + row) * 256 + col] = f2bf(acc[i][j][r]);
        EPI_END
      }
      if (tid < 256) {
        float n = 0;
        for (int t = 0; t < 128; ++t) n += s_ws[t] * bf2f(kc[(size_t)(rbase + t) * 1024 + h * 256 + tid]);
        nloc[(size_t)(seq * 66 + j) * 256 + tid] = n;
      }
    } else {
      const int it = item - 528, c = it >> 2, g = it & 3;
      bfraw* gvs = (bfraw*)(p.ws + O_GVS);
      const float* rsb = (const float*)(p.ws + O_RS);
      f32x4 acc[4][4]; ZERO_ACC(acc, 4, 4);
      gemm_tile<128, 256, false, true, false>((const bfraw*)(p.ws + O_WSB) + g * 16384, 128, gvs + (size_t)c * 128 * 1024 + g * 256, 1024, 128, rsb + c * 128, acc, st, nullptr, 0);
      const float* gs = p.in[I_GSGU] + g * 256;
      const float* bs = p.in[I_BS] + g * 128;
      EPI_BEGIN(128, 256)
        gvs[(size_t)(c * 128 + row) * 1024 + g * 256 + col] = f2bf(gs[col] * acc[i][j][r] + bs[row]);
      EPI_END
    }
  }
}

DEVI void phase_mb(const P& p) {
  bfraw* states = (bfraw*)(p.ws + O_ST);
  const float* mg = (const float*)(p.ws + O_MG);
  float* ment = (float*)(p.ws + O_MG) + 1056;
  const float* nloc = (const float*)(p.ws + O_NLOC);
  float* nent = (float*)(p.ws + O_NENT);
  const int gid = blockIdx.x * NTHR + ltid(), gsz = gridDim.x * NTHR;
  for (int id = gid; id < 8 * 16384; id += gsz) {
    const int seq = id >> 14, e = (id & 16383) * 4;
    float s0 = 0, s1 = 0, s2 = 0, s3 = 0, m = 0;
    bfraw* base = states + (size_t)seq * 66 * 65536 + e;
    uint2 nx = *(const uint2*)base;
    for (int j = 0; j < 66; ++j) {
      uint2 cur = nx;
      if (j + 1 < 66) nx = *(const uint2*)(base + (size_t)(j + 1) * 65536);
      const float mloc = mg[seq * 66 + j], g = mg[528 + seq * 66 + j];
      const float mnew = fmaxf(g + m, mloc);
      const float dec = expf(g + m - mnew), scl = expf(mloc - mnew);
      if (e == 0) ment[seq * 66 + j] = m;
      uint2 o; o.x = (unsigned)f2bf(s0) | ((unsigned)f2bf(s1) << 16); o.y = (unsigned)f2bf(s2) | ((unsigned)f2bf(s3) << 16);
      *(uint2*)(base + (size_t)j * 65536) = o;
      s0 = dec * s0 + scl * bf2f((bfraw)(cur.x & 0xffff)); s1 = dec * s1 + scl * bf2f((bfraw)(cur.x >> 16));
      s2 = dec * s2 + scl * bf2f((bfraw)(cur.y & 0xffff)); s3 = dec * s3 + scl * bf2f((bfraw)(cur.y >> 16));
      m = mnew;
    }
  }
  for (int id = gid; id < 8 * 256; id += gsz) {
    const int seq = id >> 8, k = id & 255;
    float n = 0, m = 0;
    for (int j = 0; j < 66; ++j) {
      const float mloc = mg[seq * 66 + j], g = mg[528 + seq * 66 + j];
      const float mnew = fmaxf(g + m, mloc);
      const float dec = expf(g + m - mnew), scl = expf(mloc - mnew);
      nent[(size_t)(seq * 66 + j) * 256 + k] = n;
      n = dec * n + scl * nloc[(size_t)(seq * 66 + j) * 256 + k];
      m = mnew;
    }
  }
}

DEVI void phase_mc(const P& p, unsigned char* lds, int hb) {
  const int tid = ltid(), lane = tid & 63, wid = tid >> 6, wm = wid >> 2, wn = wid & 3, fr = lane & 15, fq = lane >> 4;
  bfraw* st = (bfraw*)lds;
  bfraw* sS = (bfraw*)(lds + 61440);
  float* sc = (float*)(lds + 131072);
  float* s_b = sc, *s_u = sc + 256, *s_mt = sc + 512, *s_in = sc + 768, *s_den = sc + 1024, *s_dq = sc + 1280, *s_tmp = sc + 1536;
  float* s_sum = sc + 1792, *s_sq = sc + 1920;
  const float* gates = (const float*)(p.ws + O_GATES);
  const float* bg = p.in[I_BGATES];
  const bfraw* qc = (const bfraw*)(p.ws + O_QC);
  const bfraw* kc = (const bfraw*)(p.ws + O_KC);
  bfraw* vv = (bfraw*)(p.ws + O_V);
  const bfraw* states = (const bfraw*)(p.ws + O_ST);
  const float* ment = (const float*)(p.ws + O_MG) + 1056;
  const float* nent = (const float*)(p.ws + O_NENT);
  for (int item = blockIdx.x; item < 256; item += gridDim.x) {
    const int c = item >> 2, h = item & 3, R0 = c * 128;
    const bfraw* qp = qc + (size_t)R0 * 1024 + h * 256;
    const bfraw* kp = kc + (size_t)R0 * 1024 + h * 256;
    __syncthreads();
    if (tid < 256) {
      const int d = tid >> 7, t = tid & 127; const size_t grow = (size_t)hb * 8192 + R0 + t;
      float li = gates[grow * 16 + d * 8 + h] + bg[d * 8 + h];
      float lf = logsigf_(gates[grow * 16 + d * 8 + 4 + h] + bg[d * 8 + 4 + h]);
      s_tmp[tid] = lf; s_u[tid] = li; s_den[tid] = 0.f;
      if (tid < 128) { s_sum[tid] = 0.f; s_sq[tid] = 0.f; }
    }
    __syncthreads();
    if (tid < 256) {
      const int d = tid >> 7, t = tid & 127;
      float b = 0;
      if (d == 0) { for (int s = 0; s <= t; ++s) b += s_tmp[s]; }
      else { for (int s = 127; s >= t; --s) b += s_tmp[128 + s]; }
      s_b[tid] = b;
      s_u[tid] = s_u[tid] - b;
    }
    __syncthreads();
    if (tid < 256) {
      const int d = tid >> 7, t = tid & 127;
      float pm = -INFINITY;
      if (d == 0) { for (int s = 0; s <= t; ++s) pm = fmaxf(pm, s_u[s]); }
      else { for (int s = 127; s >= t; --s) pm = fmaxf(pm, s_u[128 + s]); }
      const int seq = d * 4 + h, j = d == 0 ? c + 2 : 65 - c;
      const float mst = ment[seq * 66 + j];
      const float b = s_b[tid], a = b + mst;
      const float mt = fmaxf(a, b + pm);
      s_mt[tid] = mt; s_in[tid] = expf(a - mt);
    }
    {
      const int row = tid >> 2, part = tid & 3;
      const bfraw* q1 = qp + (size_t)row * 1024 + part * 64;
      const float* nf = nent + (size_t)((0 + h) * 66 + (c + 2)) * 256 + part * 64;
      const float* nb = nent + (size_t)((4 + h) * 66 + (65 - c)) * 256 + part * 64;
      float af = 0, ab = 0;
#pragma unroll 4
      for (int k = 0; k < 64; ++k) { float q = bf2f(q1[k]); af += q * nf[k]; ab += q * nb[k]; }
      af += __shfl_xor(af, 1, 64); af += __shfl_xor(af, 2, 64);
      ab += __shfl_xor(ab, 1, 64); ab += __shfl_xor(ab, 2, 64);
      if (part == 0) { s_dq[row] = af; s_dq[128 + row] = ab; }
    }
    __syncthreads();
    {
      f32x4 S[4][2]; ZERO_ACC(S, 4, 2);
      gemm_tile<128, 128, false, false, false>(qp, 1024, kp, 1024, 256, nullptr, S, st, nullptr, 0);
#pragma unroll 1
      for (int d = 0; d < 2; ++d)
#pragma unroll
        for (int i = 0; i < 4; ++i)
#pragma unroll
          for (int r = 0; r < 4; ++r) {
            const int row = wm * 64 + i * 16 + fq * 4 + r;
            const float bt = s_b[d * 128 + row] - s_mt[d * 128 + row];
            float rs = 0;
#pragma unroll
            for (int j = 0; j < 2; ++j) {
              const int col = wn * 32 + j * 16 + fr;
              const bool valid = d == 0 ? (col <= row) : (col >= row);
              const float val = valid ? S[i][j][r] * expf(bt + s_u[d * 128 + col]) : 0.f;
              rs += val;
              sS[(d * 128 + row) * 136 + col] = f2bf(val);
            }
            rs = red16(rs);
            if (fr == 0) atomicAdd(&s_den[d * 128 + row], rs);
          }
    }
    __syncthreads();
    f32x4 hs[4][4];
    bfraw* hpark = (bfraw*)(p.ws + O_HPARK) + (size_t)R0 * 1024 + h * 256;
#pragma unroll 1
    for (int d = 0; d < 2; ++d) {
      f32x4 (&acc)[4][4] = hs; ZERO_ACC(acc, 4, 4);
      const int seq = d * 4 + h, j2 = d == 0 ? c + 2 : 65 - c;
      gemm_tile<128, 256, false, false, false>(qp, 1024, states + (size_t)(seq * 66 + j2) * 65536, 256, 256, nullptr, acc, st, nullptr, 0);
      EPIR_BEGIN(128, 256)
        const float sin_ = s_in[d * 128 + row];
        EPIR_COLS(256) acc[i][j][r] *= sin_; (void)col;
      EPIR_END
      gemm_tile<128, 256, false, true, true>(nullptr, 0, vv + (size_t)R0 * 1024 + h * 256, 1024, 128, nullptr, acc, st, sS + d * 128 * 136, 136);
      EPIR_BEGIN(128, 256)
        const float den = s_den[d * 128 + row] + s_in[d * 128 + row] * s_dq[d * 128 + row];
        const float inv = 1.f / fmaxf(fabsf(den), expf(-s_mt[d * 128 + row]));
        EPIR_COLS(256)
          const float hv = acc[i][j][r] * inv;
          if (d == 0) hpark[(size_t)row * 1024 + col] = f2bf(hv);
          else hs[i][j][r] = hv + bf2f(hpark[(size_t)row * 1024 + col]);
      EPIR_END
    }
#pragma unroll
    for (int i = 0; i < 4; ++i)
#pragma unroll
      for (int r = 0; r < 4; ++r) {
        float ps = hs[i][0][r] + hs[i][1][r] + hs[i][2][r] + hs[i][3][r];
        ps = red16(ps);
        if (fr == 0) atomicAdd(&s_sum[wm * 64 + i * 16 + fq * 4 + r], ps);
      }
    __syncthreads();
#pragma unroll
    for (int i = 0; i < 4; ++i)
#pragma unroll
      for (int r = 0; r < 4; ++r) {
        const float mu = s_sum[wm * 64 + i * 16 + fq * 4 + r] * (1.f / 256.f);
        float ps = 0;
#pragma unroll
        for (int j = 0; j < 4; ++j) { float dlt = hs[i][j][r] - mu; ps += dlt * dlt; }
        ps = red16(ps);
        if (fr == 0) atomicAdd(&s_sq[wm * 64 + i * 16 + fq * 4 + r], ps);
      }
    __syncthreads();
    const float* gh = p.in[I_GHEAD] + h * 256;
    EPIR_BEGIN(128, 256)
      const float mu = s_sum[row] * (1.f / 256.f);
      const float rstd = rsqrtf(s_sq[row] * (1.f / 256.f) + EPS);
      EPIR_COLS(256)
        vv[(size_t)(R0 + row) * 1024 + h * 256 + col] = f2bf((hs[i][j][r] - mu) * rstd * gh[col]);
    EPIR_END
  }
}

constexpr int NPH = 27;
#define PHASE_PROGRAM \
  PHASE(0, phase_p0(p, lds)) \
  PHASE(1, phase_p0b(p)) \
  PHASE(2, phase_rows<1>(p, lds)) \
  PHASE(3, phase_ffn_in<GBM>(p, lds, O_W1IN, 16896)) \
  PHASE(4, phase_ffn_out<128>(p, lds, O_W1OUT, 16896, 2)) \
  PHASE(5, phase_rows<2>(p, lds)) \
  PHASE(6, phase_g3c(p, lds)) \
  PHASE(7, phase_g3a(p, lds, 0)) \
  PHASE(8, phase_cv(p, 0)) \
  PHASE(9, phase_ma(p, lds, 0)) \
  PHASE(10, phase_mb(p)) \
  PHASE(11, phase_mc(p, lds, 0)) \
  PHASE(12, phase_g3b(p, lds, 0)) \
  PHASE(13, phase_g4(p, lds)) \
  PHASE(14, phase_g5(p, lds, 0)) \
  PHASE(15, phase_g3a(p, lds, 1)) \
  PHASE(16, phase_cv(p, 1)) \
  PHASE(17, phase_ma(p, lds, 1)) \
  PHASE(18, phase_mb(p)) \
  PHASE(19, phase_mc(p, lds, 1)) \
  PHASE(20, phase_g3b(p, lds, 1)) \
  PHASE(21, phase_g4(p, lds)) \
  PHASE(22, phase_g5(p, lds, 1)) \
  PHASE(23, phase_rows<3>(p, lds)) \
  PHASE(24, phase_ffn_in<GBM>(p, lds, O_W2IN, 16384)) \
  PHASE(25, phase_ffn_out<128>(p, lds, O_W2OUT, 16384, 8)) \
  PHASE(26, phase_rows<4>(p, lds))

#if !MULTI_LAUNCH
#define PHASE(n, call) if (lo <= (n) && (n) < hi) { if ((n) > lo) grid.sync(); call; }
__global__ void __launch_bounds__(512) mk(P p, int lo, int hi) {
  extern __shared__ __attribute__((aligned(16))) unsigned char lds[];
  cg::grid_group grid = cg::this_grid();
  PHASE_PROGRAM
}
#undef PHASE
#else
#define PHASE(n, call) if constexpr (PH == (n)) { call; }
template <int PH>
__global__ void __launch_bounds__(512) mkp(P p) {
  extern __shared__ __attribute__((aligned(16))) unsigned char lds[];
  PHASE_PROGRAM
}
#undef PHASE
template <int PH> static void launch_all(const P& p, int grid, hipStream_t stream) {
  if constexpr (PH < NPH) {
    (void)hipFuncSetAttribute((const void*)mkp<PH>, hipFuncAttributeMaxDynamicSharedMemorySize, LDS_BYTES);
    hipLaunchKernelGGL(mkp<PH>, dim3(grid), dim3(NTHR), LDS_BYTES, stream, p);
    launch_all<PH + 1>(p, grid, stream);
  }
}
#endif

extern "C" void kernel_launch(void* const* d_in, const int* in_sizes, int n_in, void* d_out, int out_size, void* d_ws, size_t ws_size, hipStream_t stream) {
  static int grid_blocks = 0;
  if (!grid_blocks) {
    if (n_in != 25 || ws_size < O_END || ws_size < O_ACT + 16896ull * 2816 * 2) { fprintf(stderr, "kernel_launch: unexpected n_in %d / ws %zu\n", n_in, ws_size); grid_blocks = -1; return; }
    int dev = 0, cus = 0, per_cu = 0;
    (void)hipGetDevice(&dev);
    (void)hipDeviceGetAttribute(&cus, hipDeviceAttributeMultiprocessorCount, dev);
#if !MULTI_LAUNCH
    if (hipFuncSetAttribute((const void*)mk, hipFuncAttributeMaxDynamicSharedMemorySize, LDS_BYTES) != hipSuccess) { fprintf(stderr, "hipFuncSetAttribute failed\n"); grid_blocks = -1; return; }
    if (hipOccupancyMaxActiveBlocksPerMultiprocessor(&per_cu, (const void*)mk, NTHR, LDS_BYTES) != hipSuccess || per_cu < 1) { fprintf(stderr, "occupancy query failed (%d)\n", per_cu); grid_blocks = -1; return; }
#endif
    grid_blocks = cus * 1;
    fprintf(stderr, "kernel_launch: cus %d per_cu %d grid %d\n", cus, per_cu, grid_blocks);
  }
  if (grid_blocks < 0) return;
  P p{};
  for (int i = 0; i < 25; ++i) p.in[i] = (const float*)d_in[i];
  p.out = (float*)d_out; p.ws = (unsigned char*)d_ws;
#if MULTI_LAUNCH
  launch_all<0>(p, grid_blocks, stream);
#else
  int lo = 0, hi = NPH;
  void* args[] = {&p, &lo, &hi};
  hipError_t e = hipLaunchCooperativeKernel((const void*)mk, dim3(grid_blocks), dim3(NTHR), args, LDS_BYTES, stream);
  if (e != hipSuccess) fprintf(stderr, "cooperative launch failed: %s (grid %d)\n", hipGetErrorString(e), grid_blocks);
#endif
}
```

```cpp
#include <hip/hip_runtime.h>
#include <hip/hip_cooperative_groups.h>
#include <cstdio>
#include <cstdint>
namespace cg = cooperative_groups;

#ifndef MULTI_LAUNCH
#define MULTI_LAUNCH 0
#endif

typedef unsigned short bfraw;
typedef __attribute__((ext_vector_type(8))) short bf16x8;
typedef __attribute__((ext_vector_type(4))) float f32x4;
#define DEVI __device__ __forceinline__

constexpr int NTHR = 512;
constexpr int GBM = 128;
constexpr int LROW = 40;
constexpr int LDS_BYTES = 143360;
constexpr float EPS = 1e-6f;

enum { I_X, I_C, I_CTX, I_CCTX, I_WADA, I_BADA, I_GFFN1, I_W1IN, I_W1OUT, I_GMIX, I_WIN, I_BGATES, I_CONVW, I_CONVB,
       I_GHEAD, I_GSGU, I_WS, I_BS, I_WA, I_WB, I_WO, I_GFFN2, I_W2IN, I_W2OUT, I_GFINAL };

struct P { const float* in[25]; float* out; unsigned char* ws; };

constexpr size_t O_W1IN  = 0;
constexpr size_t O_W1OUT = O_W1IN  + 5632ull * 1024 * 2;
constexpr size_t O_WTA   = O_W1OUT + 1024ull * 2816 * 2;
constexpr size_t O_WTB   = O_WTA   + 4096ull * 1024 * 2;
constexpr size_t O_WA    = O_WTB   + 4096ull * 1024 * 2;
constexpr size_t O_WB    = O_WA    + 1024ull * 1024 * 2;
constexpr size_t O_WO    = O_WB    + 1024ull * 1024 * 2;
constexpr size_t O_W2IN  = O_WO    + 1024ull * 1024 * 2;
constexpr size_t O_W2OUT = O_W2IN  + 5632ull * 1024 * 2;
constexpr size_t O_WSB   = O_W2OUT + 1024ull * 2816 * 2;
constexpr size_t O_MODSP = O_WSB   + 4ull * 128 * 128 * 2;
constexpr size_t O_MODS  = O_MODSP + 16ull * 3 * 9216 * 4;
constexpr size_t O_HCTX  = O_MODS  + 3ull * 9216 * 4;
constexpr size_t O_HN    = O_HCTX  + 512ull * 1024 * 4;
constexpr size_t O_GATES = O_HN    + 16896ull * 1024 * 2;
constexpr size_t O_CTXRAW= O_GATES + 16896ull * 16 * 4;
constexpr size_t O_BIG   = O_CTXRAW+ 2ull * 256 * 3072 * 2;
constexpr size_t O_ACT   = O_BIG;
constexpr size_t O_ST    = O_BIG;
constexpr size_t O_QRAW  = O_BIG;
constexpr size_t O_KRAW  = O_QRAW  + 8448ull * 1024 * 2;
constexpr size_t O_V     = O_ST    + 8ull * 66 * 131072;
constexpr size_t O_GVS   = O_V     + 8448ull * 1024 * 2;
constexpr size_t O_QC    = O_GVS   + 8192ull * 1024 * 2;
constexpr size_t O_KC    = O_QC    + 8448ull * 1024 * 2;
constexpr size_t O_NLOC  = O_KC    + 8448ull * 1024 * 2;
constexpr size_t O_NENT  = O_NLOC  + 8ull * 66 * 256 * 4;
constexpr size_t O_MG    = O_NENT  + 8ull * 66 * 256 * 4;
constexpr size_t O_RS    = O_MG    + 8192;
constexpr size_t O_HPARK = O_RS    + 8192ull * 4;
constexpr size_t O_END   = O_HPARK + 8192ull * 1024 * 2;
static_assert(O_ACT + 16896ull * 2816 * 2 <= 268435456ull, "ws");
static_assert(O_END <= 268435456ull, "ws");
static_assert(O_KRAW + 8448ull * 1024 * 2 <= O_V, "overlay");

DEVI int ltid() { int t = __builtin_amdgcn_workitem_id_x(); asm volatile("" : "+v"(t)); return t; }
DEVI unsigned char* lws(unsigned char* w) { asm volatile("" : "+s"(w)); return w; }
DEVI bfraw f2bf(float f) { unsigned u = __float_as_uint(f); u += 0x7fffu + ((u >> 16) & 1u); return (bfraw)(u >> 16); }
DEVI float bf2f(bfraw h) { return __uint_as_float(((unsigned)h) << 16); }
DEVI float sigmoidf_(float x) { return 1.f / (1.f + expf(-x)); }
DEVI float siluf_(float x) { return x / (1.f + expf(-x)); }
DEVI float geluf_(float x) { float u = 0.7978845608028654f * (x + 0.044715f * x * x * x); return 0.5f * x * (1.f + tanhf(u)); }
DEVI float logsigf_(float x) { return fminf(x, 0.f) - log1pf(expf(-fabsf(x))); }
DEVI float wave_sum(float v) {
#pragma unroll
  for (int o = 32; o > 0; o >>= 1) v += __shfl_xor(v, o, 64);
  return v;
}
DEVI float red16(float v) {
  v += __shfl_xor(v, 1, 64); v += __shfl_xor(v, 2, 64); v += __shfl_xor(v, 4, 64); v += __shfl_xor(v, 8, 64);
  return v;
}
DEVI float redsin(float a, bool cosine) {
  float k = rintf(a * 0.15915494309189535f);
  float r = fmaf(-k, 6.2831854820251465f, a);
  r = fmaf(-k, -1.7484555e-7f, r);
  return cosine ? __cosf(r) : __sinf(r);
}

template <int BM, int BN, bool ATR, bool BTR, bool ALDS>
DEVI void gemm_tile(const bfraw* __restrict__ A, int lda, const bfraw* __restrict__ B, int ldb, int K,
                    const float* kscale, f32x4 (&acc)[BM / 32][BN / 64], bfraw* st, const bfraw* sAres, int ldres) {
  constexpr int MI = BM / 32, NJ = BN / 64, CA = BM / 128, CB = BN / 128, WM = BM / 2, WN = BN / 4;
  constexpr int STAGE = (ALDS ? BN : (BM + BN)) * LROW;
  int tid_ = ltid();
  const int tid = tid_, lane = tid & 63, wid = tid >> 6, wm = wid >> 2, wn = wid & 3;
  const int fr = lane & 15, fq = lane >> 4;
  uint4 ra0 = {0, 0, 0, 0}, ra1 = {0, 0, 0, 0}, rb0 = {0, 0, 0, 0}, rb1 = {0, 0, 0, 0};
  const int nk = K >> 5;

  auto gla = [&](int c, int k0) -> uint4 {
    if (!ATR) { int row = c >> 2, kc = (c & 3) * 8; return *(const uint4*)(A + (size_t)row * lda + k0 + kc); }
    else { int krow = c / (BM / 8), m0 = (c % (BM / 8)) * 8; return *(const uint4*)(A + (size_t)(k0 + krow) * lda + m0); }
  };
  auto glb = [&](int c, int k0) -> uint4 {
    if (!BTR) { int row = c >> 2, kc = (c & 3) * 8; return *(const uint4*)(B + (size_t)row * ldb + k0 + kc); }
    else { int krow = c / (BN / 8), n0 = (c % (BN / 8)) * 8; return *(const uint4*)(B + (size_t)(k0 + krow) * ldb + n0); }
  };
  auto gload = [&](int kt) {
    const int k0 = kt << 5;
    if (!ALDS) { ra0 = gla(tid, k0); if (CA > 1) ra1 = gla(tid + NTHR, k0); }
    rb0 = glb(tid, k0); if (CB > 1) rb1 = glb(tid + NTHR, k0);
  };
  auto scatter = [&](bfraw* s, int m0, int krow, uint4 r, float sc, bool scaled) {
    unsigned w0 = r.x, w1 = r.y, w2 = r.z, w3 = r.w;
    bfraw e0 = w0 & 0xffff, e1 = w0 >> 16, e2 = w1 & 0xffff, e3 = w1 >> 16, e4 = w2 & 0xffff, e5 = w2 >> 16, e6 = w3 & 0xffff, e7 = w3 >> 16;
    if (scaled) {
      e0 = f2bf(bf2f(e0) * sc); e1 = f2bf(bf2f(e1) * sc); e2 = f2bf(bf2f(e2) * sc); e3 = f2bf(bf2f(e3) * sc);
      e4 = f2bf(bf2f(e4) * sc); e5 = f2bf(bf2f(e5) * sc); e6 = f2bf(bf2f(e6) * sc); e7 = f2bf(bf2f(e7) * sc);
    }
    bfraw* d = s + m0 * LROW + krow;
    d[0] = e0; d[LROW] = e1; d[2 * LROW] = e2; d[3 * LROW] = e3; d[4 * LROW] = e4; d[5 * LROW] = e5; d[6 * LROW] = e6; d[7 * LROW] = e7;
  };
  auto lstore = [&](int buf, int kt) {
    bfraw* sA = st + buf * STAGE;
    bfraw* sB = sA + (ALDS ? 0 : BM * LROW);
    auto sta = [&](int c, uint4 v) {
      if (!ATR) { int row = c >> 2, kc = (c & 3) * 8; *(uint4*)(sA + row * LROW + kc) = v; }
      else { int krow = c / (BM / 8), m0 = (c % (BM / 8)) * 8; scatter(sA, m0, krow, v, 1.f, false); }
    };
    auto stb = [&](int c, uint4 v) {
      if (!BTR) { int row = c >> 2, kc = (c & 3) * 8; *(uint4*)(sB + row * LROW + kc) = v; }
      else {
        int krow = c / (BN / 8), n0 = (c % (BN / 8)) * 8;
        float sc = kscale ? kscale[(kt << 5) + krow] : 1.f;
        scatter(sB, n0, krow, v, sc, kscale != nullptr);
      }
    };
    if (!ALDS) { sta(tid, ra0); if (CA > 1) sta(tid + NTHR, ra1); }
    stb(tid, rb0); if (CB > 1) stb(tid + NTHR, rb1);
  };
  auto compute = [&](int buf, int kt) {
    const bfraw* sA = st + buf * STAGE;
    const bfraw* sB = sA + (ALDS ? 0 : BM * LROW);
    bf16x8 af[MI], bfr[NJ];
#pragma unroll
    for (int i = 0; i < MI; ++i) {
      if (ALDS) af[i] = *(const bf16x8*)(sAres + (wm * WM + i * 16 + fr) * ldres + (kt << 5) + fq * 8);
      else af[i] = *(const bf16x8*)(sA + (wm * WM + i * 16 + fr) * LROW + fq * 8);
    }
#pragma unroll
    for (int j = 0; j < NJ; ++j) bfr[j] = *(const bf16x8*)(sB + (wn * WN + j * 16 + fr) * LROW + fq * 8);
#pragma unroll
    for (int i = 0; i < MI; ++i)
#pragma unroll
      for (int j = 0; j < NJ; ++j) acc[i][j] = __builtin_amdgcn_mfma_f32_16x16x32_bf16(af[i], bfr[j], acc[i][j], 0, 0, 0);
  };

  __syncthreads();
  gload(0); lstore(0, 0);
  __syncthreads();
  for (int kt = 0; kt < nk; ++kt) {
    if (kt + 1 < nk) gload(kt + 1);
    compute(kt & 1, kt);
    if (kt + 1 < nk) lstore((kt + 1) & 1, kt + 1);
    __syncthreads();
  }
}

#define ZERO_ACC(acc, MI, NJ) _Pragma("unroll") for (int _i = 0; _i < (MI); ++_i) _Pragma("unroll") for (int _j = 0; _j < (NJ); ++_j) acc[_i][_j] = f32x4{0.f, 0.f, 0.f, 0.f};
#define EPI_BEGIN(BM, BN) { int _t = ltid(); const int _l = _t & 63, _w = _t >> 6; \
    const int _rb = (_w >> 2) * ((BM) / 2) + (_l >> 4) * 4, _cb = (_w & 3) * ((BN) / 4) + (_l & 15); \
    _Pragma("unroll") for (int i = 0; i < (BM) / 32; ++i) _Pragma("unroll") for (int j = 0; j < (BN) / 64; ++j) _Pragma("unroll") for (int r = 0; r < 4; ++r) { \
      const int row = _rb + i * 16 + r, col = _cb + j * 16;
#define EPI_END }}
#define EPIR_BEGIN(BM, BN) { int _t = ltid(); const int _l = _t & 63, _w = _t >> 6; \
    const int _rb = (_w >> 2) * ((BM) / 2) + (_l >> 4) * 4, _cb = (_w & 3) * ((BN) / 4) + (_l & 15); \
    _Pragma("unroll") for (int i = 0; i < (BM) / 32; ++i) _Pragma("unroll") for (int r = 0; r < 4; ++r) { \
      const int row = _rb + i * 16 + r;
#define EPIR_COLS(BN) _Pragma("unroll") for (int j = 0; j < (BN) / 64; ++j) { const int col = _cb + j * 16;
#define EPIR_END }}}

DEVI void tr_tile(const float* __restrict__ src, int ldw, int col0, int kt, int nt, bfraw* dst, int K, int drow0, int mode, float* t) {
  const int tid = ltid();
  __syncthreads();
#pragma unroll
  for (int i = 0; i < 8; ++i) { int e = tid + i * NTHR; int kk = e >> 6, nn = e & 63; t[kk * 65 + nn] = src[(size_t)(kt * 64 + kk) * ldw + col0 + nt * 64 + nn]; }
  __syncthreads();
#pragma unroll
  for (int i = 0; i < 8; ++i) {
    int e = tid + i * NTHR; int nn = e >> 6, kk = e & 63;
    int n = nt * 64 + nn, dr;
    if (mode == 1) { int isb = n >= 2816; int f = n - isb * 2816; dr = (f >> 4) * 32 + isb * 16 + (f & 15); } else dr = drow0 + n;
    dst[(size_t)dr * K + kt * 64 + kk] = f2bf(t[kk * 65 + nn]);
  }
}

DEVI void phase_p0(const P& p, unsigned char* lds) {
  float* sf = (float*)lds;
  const int tid = ltid();
  for (int i = tid; i < 3072; i += NTHR) { float v = i < 2048 ? p.in[I_C][i] : p.in[I_CCTX][i - 2048]; sf[i] = siluf_(v); }
  __syncthreads();
  {
    const float* w = p.in[I_WADA];
    float* mp = (float*)(p.ws + O_MODSP);
    for (int id = blockIdx.x * NTHR + tid; id < 16 * 9216; id += gridDim.x * NTHR) {
      int s = id / 9216, j = id - s * 9216;
      float a0 = 0, a1 = 0, a2 = 0;
#pragma unroll 8
      for (int k = s * 64; k < s * 64 + 64; ++k) { float wv = w[(size_t)k * 9216 + j]; a0 += sf[k] * wv; a1 += sf[1024 + k] * wv; a2 += sf[2048 + k] * wv; }
      mp[(s * 3 + 0) * 9216 + j] = a0; mp[(s * 3 + 1) * 9216 + j] = a1; mp[(s * 3 + 2) * 9216 + j] = a2;
    }
  }
  __syncthreads();
  for (int t = blockIdx.x; t < 7040; t += gridDim.x) {
    int u = t;
    if (u < 1408) { tr_tile(p.in[I_W1IN], 5632, 0, u / 88, u % 88, (bfraw*)(p.ws + O_W1IN), 1024, 0, 1, sf); continue; }
    u -= 1408;
    if (u < 704) { tr_tile(p.in[I_W1OUT], 1024, 0, u / 16, u % 16, (bfraw*)(p.ws + O_W1OUT), 2816, 0, 0, sf); continue; }
    u -= 704;
    if (u < 2048) {
      int pc = u >> 8; u &= 255;
      const int c0[8] = {0, 1024, 2048, 5136, 3088, 4112, 6160, 7184};
      int col0 = pc == 0 ? 0 : pc == 1 ? 1024 : pc == 2 ? 2048 : pc == 3 ? 5136 : pc == 4 ? 3088 : pc == 5 ? 4112 : pc == 6 ? 6160 : 7184;
      (void)c0;
      tr_tile(p.in[I_WIN], 8208, col0, u >> 4, u & 15, (bfraw*)(p.ws + (pc < 4 ? O_WTA : O_WTB)), 1024, (pc & 3) * 1024, 0, sf); continue;
    }
    u -= 2048;
    if (u < 768) { int m = u >> 8; u &= 255; tr_tile(p.in[m == 0 ? I_WA : m == 1 ? I_WB : I_WO], 1024, 0, u >> 4, u & 15, (bfraw*)(p.ws + (m == 0 ? O_WA : m == 1 ? O_WB : O_WO)), 1024, 0, 0, sf); continue; }
    u -= 768;
    if (u < 1408) { tr_tile(p.in[I_W2IN], 5632, 0, u / 88, u % 88, (bfraw*)(p.ws + O_W2IN), 1024, 0, 1, sf); continue; }
    u -= 1408;
    tr_tile(p.in[I_W2OUT], 1024, 0, u / 16, u % 16, (bfraw*)(p.ws + O_W2OUT), 2816, 0, 0, sf);
  }
  { bfraw* d = (bfraw*)(p.ws + O_WSB); for (int id = blockIdx.x * NTHR + tid; id < 65536; id += gridDim.x * NTHR) d[id] = f2bf(p.in[I_WS][id]); }
}

DEVI void phase_p0b(const P& p) {
  const float* mp = (const float*)(p.ws + O_MODSP);
  float* m = (float*)(p.ws + O_MODS);
  for (int id = blockIdx.x * NTHR + ltid(); id < 3 * 9216; id += gridDim.x * NTHR) {
    int j = id % 9216;
    float a = p.in[I_BADA][j];
    for (int s = 0; s < 16; ++s) a += mp[s * 3 * 9216 + id];
    m[id] = a;
  }
}

template <int MODE>
DEVI void phase_rows(const P& p, unsigned char* lds) {
  const int tid = ltid(), lane = tid & 63, wid = tid >> 6;
  const float* mods = (const float*)(p.ws + O_MODS);
  float* hctx = (float*)(p.ws + O_HCTX);
  bfraw* hn = (bfraw*)(p.ws + O_HN);
  float* wg = (float*)lds;
  if (MODE == 2) {
    __syncthreads();
    for (int i = tid; i < 16384; i += NTHR) { int k = i >> 4, g = i & 15; wg[g * 1024 + k] = p.in[I_WIN][(size_t)k * 8208 + 3072 + g]; }
    __syncthreads();
  }
  const int nrows = (MODE == 1 || MODE == 2) ? 16896 : 16384;
  const float* gvec = p.in[MODE == 1 ? I_GFFN1 : MODE == 2 ? I_GMIX : MODE == 3 ? I_GFFN2 : I_GFINAL];
  const int msh = MODE == 1 ? 0 : MODE == 2 ? 3 : 6;
  for (int row = blockIdx.x * 8 + wid; row < nrows; row += gridDim.x * 8) {
    const bool lat = row < 16384;
    const int mrow = lat ? (row >> 13) : 2;
    float4 v[4];
    if (MODE == 1) {
      const float* src = lat ? p.in[I_X] + (size_t)row * 1024 : p.in[I_CTX] + (size_t)(row - 16384) * 1024;
#pragma unroll
      for (int i = 0; i < 4; ++i) v[i] = *(const float4*)(src + i * 256 + lane * 4);
      if (lat) {
        int ts = row & 8191; float rr = (float)(ts >> 6), cc = (float)(ts & 63);
        float fqv[4];
#pragma unroll
        for (int e = 0; e < 4; ++e) fqv[e] = expf((-9.210340371976184f * (float)(lane * 4 + e)) / 256.f);
        v[0].x += redsin(rr * fqv[0], false); v[0].y += redsin(rr * fqv[1], false); v[0].z += redsin(rr * fqv[2], false); v[0].w += redsin(rr * fqv[3], false);
        v[1].x += redsin(rr * fqv[0], true);  v[1].y += redsin(rr * fqv[1], true);  v[1].z += redsin(rr * fqv[2], true);  v[1].w += redsin(rr * fqv[3], true);
        v[2].x += redsin(cc * fqv[0], false); v[2].y += redsin(cc * fqv[1], false); v[2].z += redsin(cc * fqv[2], false); v[2].w += redsin(cc * fqv[3], false);
        v[3].x += redsin(cc * fqv[0], true);  v[3].y += redsin(cc * fqv[1], true);  v[3].z += redsin(cc * fqv[2], true);  v[3].w += redsin(cc * fqv[3], true);
      }
      float* dsth = lat ? p.out + (size_t)row * 1024 : hctx + (size_t)(row - 16384) * 1024;
#pragma unroll
      for (int i = 0; i < 4; ++i) *(float4*)(dsth + i * 256 + lane * 4) = v[i];
    } else {
      const float* src = lat ? p.out + (size_t)row * 1024 : hctx + (size_t)(row - 16384) * 1024;
#pragma unroll
      for (int i = 0; i < 4; ++i) v[i] = *(const float4*)(src + i * 256 + lane * 4);
    }
    float ss = 0;
#pragma unroll
    for (int i = 0; i < 4; ++i) ss += v[i].x * v[i].x + v[i].y * v[i].y + v[i].z * v[i].z + v[i].w * v[i].w;
    ss = wave_sum(ss);
    const float rs = rsqrtf(ss * (1.f / 1024.f) + EPS);
    if (MODE == 4) {
#pragma unroll
      for (int i = 0; i < 4; ++i) {
        float4 g = *(const float4*)(gvec + i * 256 + lane * 4);
        float4 o = {v[i].x * rs * g.x, v[i].y * rs * g.y, v[i].z * rs * g.z, v[i].w * rs * g.w};
        *(float4*)(p.out + (size_t)row * 1024 + i * 256 + lane * 4) = o;
      }
    } else {
      const float* sh = mods + (size_t)(mrow * 9216 + msh * 1024);
      const float* scp = sh + 1024;
      float y[16];
#pragma unroll
      for (int i = 0; i < 4; ++i) {
        const int c = i * 256 + lane * 4;
        float4 g = *(const float4*)(gvec + c), s4 = *(const float4*)(sh + c), c4 = *(const float4*)(scp + c);
        y[i * 4 + 0] = v[i].x * rs * g.x * (1.f + c4.x) + s4.x; y[i * 4 + 1] = v[i].y * rs * g.y * (1.f + c4.y) + s4.y;
        y[i * 4 + 2] = v[i].z * rs * g.z * (1.f + c4.z) + s4.z; y[i * 4 + 3] = v[i].w * rs * g.w * (1.f + c4.w) + s4.w;
        uint2 pk; pk.x = (unsigned)f2bf(y[i * 4]) | ((unsigned)f2bf(y[i * 4 + 1]) << 16); pk.y = (unsigned)f2bf(y[i * 4 + 2]) | ((unsigned)f2bf(y[i * 4 + 3]) << 16);
        *(uint2*)(hn + (size_t)row * 1024 + c) = pk;
      }
      if (MODE == 2) {
        float mine = 0.f;
#pragma unroll 2
        for (int g2 = 0; g2 < 16; ++g2) {
          float a = 0.f;
#pragma unroll
          for (int i = 0; i < 4; ++i) { float4 w4 = *(const float4*)(wg + g2 * 1024 + i * 256 + lane * 4); a += y[i * 4] * w4.x + y[i * 4 + 1] * w4.y + y[i * 4 + 2] * w4.z + y[i * 4 + 3] * w4.w; }
          a = wave_sum(a);
          if (lane == g2) mine = a;
        }
        if (lane < 16) ((float*)(p.ws + O_GATES))[(size_t)row * 16 + lane] = mine;
      }
    }
  }
}

template <int BM>
DEVI void phase_ffn_in(const P& p, unsigned char* lds, size_t o_w, int nrows) {
  const int nTM = nrows / BM;
  const bfraw* hn = (const bfraw*)(p.ws + O_HN);
  const bfraw* W = (const bfraw*)(p.ws + o_w);
  bfraw* act = (bfraw*)(p.ws + O_ACT);
  const int lane = ltid() & 63, wid = ltid() >> 6, wm = wid >> 2, wn = wid & 3, fr = lane & 15, fq = lane >> 4;
  for (int t = blockIdx.x; t < nTM * 22; t += gridDim.x) {
    const int tm = t / 22, tn = t % 22;
    f32x4 acc[BM / 32][4]; ZERO_ACC(acc, BM / 32, 4);
    gemm_tile<BM, 256, false, false, false>(hn + (size_t)tm * BM * 1024, 1024, W + (size_t)tn * 256 * 1024, 1024, 1024, nullptr, acc, (bfraw*)lds, nullptr, 0);
#pragma unroll
    for (int i = 0; i < BM / 32; ++i)
#pragma unroll
      for (int jj = 0; jj < 2; ++jj)
#pragma unroll
        for (int r = 0; r < 4; ++r) {
          float a = acc[i][2 * jj][r], b = acc[i][2 * jj + 1][r];
          int row = tm * BM + wm * (BM / 2) + i * 16 + fq * 4 + r;
          int f = ((tn * 256 + wn * 64) / 32 + jj) * 16 + fr;
          act[(size_t)row * 2816 + f] = f2bf(siluf_(a) * b);
        }
  }
}

template <int BM>
DEVI void phase_ffn_out(const P& p, unsigned char* lds, size_t o_w, int nrows, int gidx) {
  const bfraw* act = (const bfraw*)(p.ws + O_ACT);
  const bfraw* W = (const bfraw*)(p.ws + o_w);
  const float* mods = (const float*)(p.ws + O_MODS);
  float* hctx = (float*)(p.ws + O_HCTX);
  const int nTM = nrows / BM;
  for (int t = blockIdx.x; t < nTM * 4; t += gridDim.x) {
    const int tm = t >> 2, tn = t & 3;
    f32x4 acc[BM / 32][4]; ZERO_ACC(acc, BM / 32, 4);
    gemm_tile<BM, 256, false, false, false>(act + (size_t)tm * BM * 2816, 2816, W + (size_t)tn * 256 * 2816, 2816, 2816, nullptr, acc, (bfraw*)lds, nullptr, 0);
    EPI_BEGIN(BM, 256)
      const int grow = tm * BM + row, gcol = tn * 256 + col;
      const bool lat = grow < 16384;
      float* hp = lat ? p.out + (size_t)grow * 1024 + gcol : hctx + (size_t)(grow - 16384) * 1024 + gcol;
      const float gate = mods[(lat ? (grow >> 13) : 2) * 9216 + gidx * 1024 + gcol];
      *hp = *hp + 0.5f * gate * acc[i][j][r];
    EPI_END
  }
}

DEVI void phase_g3c(const P& p, unsigned char* lds) {
  const bfraw* hn = (const bfraw*)(p.ws + O_HN) + (size_t)16384 * 1024;
  const bfraw* W = (const bfraw*)(p.ws + O_WTA);
  bfraw* dst = (bfraw*)(p.ws + O_CTXRAW);
  for (int t = blockIdx.x; t < 4 * 24; t += gridDim.x) {
    const int tm = t / 24, tn = t % 24;
    f32x4 acc[4][2]; ZERO_ACC(acc, 4, 2);
    gemm_tile<128, 128, false, false, false>(hn + (size_t)tm * 128 * 1024, 1024, W + (size_t)tn * 128 * 1024, 1024, 1024, nullptr, acc, (bfraw*)lds, nullptr, 0);
    EPI_BEGIN(128, 128)
      dst[(size_t)(tm * 128 + row) * 3072 + tn * 128 + col] = f2bf(acc[i][j][r]);
    EPI_END
  }
}

DEVI void phase_g3a(const P& p, unsigned char* lds, int hb) {
  const bfraw* hn = (const bfraw*)(p.ws + O_HN) + (size_t)hb * 8192 * 1024;
  const bfraw* W = (const bfraw*)(p.ws + O_WTA);
  for (int t = blockIdx.x; t < (8192 / GBM) * 16; t += gridDim.x) {
    const int tm = t >> 4, tn = t & 15;
    f32x4 acc[GBM / 32][4]; ZERO_ACC(acc, GBM / 32, 4);
    gemm_tile<GBM, 256, false, false, false>(hn + (size_t)tm * GBM * 1024, 1024, W + (size_t)tn * 256 * 1024, 1024, 1024, nullptr, acc, (bfraw*)lds, nullptr, 0);
    const int pc = tn >> 2;
    bfraw* dst = (bfraw*)(p.ws + (pc == 0 ? O_QRAW : pc == 1 ? O_KRAW : pc == 2 ? O_V : O_GVS));
    EPI_BEGIN(GBM, 256)
      float v = acc[i][j][r];
      if (pc == 3) v = geluf_(v);
      dst[(size_t)(tm * GBM + row) * 1024 + (tn & 3) * 256 + col] = f2bf(v);
    EPI_END
  }
}

DEVI void phase_g3b(const P& p, unsigned char* lds, int hb) {
  const bfraw* hn = (const bfraw*)(p.ws + O_HN) + (size_t)hb * 8192 * 1024;
  const bfraw* W = (const bfraw*)(p.ws + O_WTB);
  for (int t = blockIdx.x; t < (8192 / GBM) * 16; t += gridDim.x) {
    const int tm = t >> 4, tn = t & 15;
    f32x4 acc[GBM / 32][4]; ZERO_ACC(acc, GBM / 32, 4);
    gemm_tile<GBM, 256, false, false, false>(hn + (size_t)tm * GBM * 1024, 1024, W + (size_t)tn * 256 * 1024, 1024, 1024, nullptr, acc, (bfraw*)lds, nullptr, 0);
    const int pc = tn >> 2;
    bfraw* dst = (bfraw*)(p.ws + (pc == 0 ? O_V : pc == 1 ? O_GVS : pc == 2 ? O_QC : O_KC));
    EPI_BEGIN(GBM, 256)
      float v = acc[i][j][r];
      bfraw* d = dst + (size_t)(tm * GBM + row) * 1024 + (tn & 3) * 256 + col;
      if (pc == 0) v = sigmoidf_(v) * bf2f(*d);
      else if (pc == 1) v = geluf_(v) * bf2f(*d);
      else v = sigmoidf_(v);
      *d = f2bf(v);
    EPI_END
  }
}

DEVI void phase_g4(const P& p, unsigned char* lds) {
  const bfraw* ya = (const bfraw*)(p.ws + O_V);
  const bfraw* yb = (const bfraw*)(p.ws + O_GVS);
  bfraw* sga = (bfraw*)(p.ws + O_QC);
  bfraw* sgb = (bfraw*)(p.ws + O_KC);
  for (int t = blockIdx.x; t < 64 * 4; t += gridDim.x) {
    const int tm = t >> 2, tn = t & 3;
    f32x4 acc[4][4]; ZERO_ACC(acc, 4, 4);
    gemm_tile<128, 256, false, false, false>(ya + (size_t)tm * 128 * 1024, 1024, (const bfraw*)(p.ws + O_WA) + (size_t)tn * 256 * 1024, 1024, 1024, nullptr, acc, (bfraw*)lds, nullptr, 0);
    EPI_BEGIN(128, 256)
      const size_t o = (size_t)(tm * 128 + row) * 1024 + tn * 256 + col;
      sga[o] = f2bf(acc[i][j][r] * bf2f(sga[o]));
    EPI_END
    ZERO_ACC(acc, 4, 4);
    gemm_tile<128, 256, false, false, false>(yb + (size_t)tm * 128 * 1024, 1024, (const bfraw*)(p.ws + O_WB) + (size_t)tn * 256 * 1024, 1024, 1024, nullptr, acc, (bfraw*)lds, nullptr, 0);
    EPI_BEGIN(128, 256)
      const size_t o = (size_t)(tm * 128 + row) * 1024 + tn * 256 + col;
      sgb[o] = f2bf(bf2f(sga[o]) + bf2f(sgb[o]) * acc[i][j][r]);
    EPI_END
  }
}

DEVI void phase_g5(const P& p, unsigned char* lds, int hb) {
  const bfraw* mx = (const bfraw*)(p.ws + O_KC);
  const float* mods = (const float*)(p.ws + O_MODS);
  for (int t = blockIdx.x; t < 64 * 4; t += gridDim.x) {
    const int tm = t >> 2, tn = t & 3;
    f32x4 acc[4][4]; ZERO_ACC(acc, 4, 4);
    gemm_tile<128, 256, false, false, false>(mx + (size_t)tm * 128 * 1024, 1024, (const bfraw*)(p.ws + O_WO) + (size_t)tn * 256 * 1024, 1024, 1024, nullptr, acc, (bfraw*)lds, nullptr, 0);
    EPI_BEGIN(128, 256)
      const int gcol = tn * 256 + col;
      float* hp = p.out + (size_t)(hb * 8192 + tm * 128 + row) * 1024 + gcol;
      *hp = *hp + mods[hb * 9216 + 5 * 1024 + gcol] * acc[i][j][r];
    EPI_END
  }
}

DEVI uint4 conv8(uint4 a, uint4 b, uint4 c, const float* w, const float* bias, int ch, float scale) {
  unsigned av[4] = {a.x, a.y, a.z, a.w}, bv[4] = {b.x, b.y, b.z, b.w}, cv[4] = {c.x, c.y, c.z, c.w}, ov[4];
#pragma unroll
  for (int e = 0; e < 4; ++e) {
    float r[2];
#pragma unroll
    for (int h = 0; h < 2; ++h) {
      int cc = ch + e * 2 + h;
      float xa = bf2f((bfraw)(h ? av[e] >> 16 : av[e] & 0xffff)), xb = bf2f((bfraw)(h ? bv[e] >> 16 : bv[e] & 0xffff)), xc = bf2f((bfraw)(h ? cv[e] >> 16 : cv[e] & 0xffff));
      float y = xa * w[cc] + xb * w[2048 + cc] + xc * w[4096 + cc] + bias[cc];
      r[h] = siluf_(y) * scale;
    }
    ov[e] = (unsigned)f2bf(r[0]) | ((unsigned)f2bf(r[1]) << 16);
  }
  return uint4{ov[0], ov[1], ov[2], ov[3]};
}

DEVI void phase_cv(const P& p, int hb) {
  const int lane = ltid() & 63, wid = ltid() >> 6;
  const bfraw* qraw = (const bfraw*)(p.ws + O_QRAW);
  const bfraw* kraw = (const bfraw*)(p.ws + O_KRAW);
  const bfraw* craw = (const bfraw*)(p.ws + O_CTXRAW) + (size_t)hb * 256 * 3072;
  bfraw* qc = (bfraw*)(p.ws + O_QC);
  bfraw* kc = (bfraw*)(p.ws + O_KC);
  bfraw* vv = (bfraw*)(p.ws + O_V);
  const bfraw* gvs = (const bfraw*)(p.ws + O_GVS);
  float* rsb = (float*)(p.ws + O_RS);
  const float* cw = p.in[I_CONVW];
  const float* cb = p.in[I_CONVB];
  const uint4 z = {0, 0, 0, 0};
  for (int row = blockIdx.x * 8 + wid; row < 8448; row += gridDim.x * 8) {
    const bool lat = row < 8192;
    const int lr = lat ? row : row - 8192, len = lat ? 8192 : 256;
    const bfraw* qb = lat ? qraw : craw;
    const bfraw* kb = lat ? kraw : craw + 1024;
    const size_t ld = lat ? 1024 : 3072;
#pragma unroll
    for (int hlf = 0; hlf < 2; ++hlf) {
      const int ch = hlf * 512 + lane * 8;
      uint4 qa = lr > 0 ? *(const uint4*)(qb + (size_t)(lr - 1) * ld + ch) : z;
      uint4 qm = *(const uint4*)(qb + (size_t)lr * ld + ch);
      uint4 qn = lr < len - 1 ? *(const uint4*)(qb + (size_t)(lr + 1) * ld + ch) : z;
      *(uint4*)(qc + (size_t)row * 1024 + ch) = conv8(qa, qm, qn, cw, cb, ch, 0.0625f);
      uint4 ka = lr > 0 ? *(const uint4*)(kb + (size_t)(lr - 1) * ld + ch) : z;
      uint4 km = *(const uint4*)(kb + (size_t)lr * ld + ch);
      uint4 kn = lr < len - 1 ? *(const uint4*)(kb + (size_t)(lr + 1) * ld + ch) : z;
      *(uint4*)(kc + (size_t)row * 1024 + ch) = conv8(ka, km, kn, cw, cb, 1024 + ch, 1.f);
      if (!lat) *(uint4*)(vv + (size_t)row * 1024 + ch) = *(const uint4*)(craw + 2048 + (size_t)lr * 3072 + ch);
    }
    if (lat) {
      float ss = 0;
#pragma unroll
      for (int hlf = 0; hlf < 2; ++hlf) {
        uint4 g = *(const uint4*)(gvs + (size_t)row * 1024 + hlf * 512 + lane * 8);
        unsigned gv[4] = {g.x, g.y, g.z, g.w};
#pragma unroll
        for (int e = 0; e < 4; ++e) { float a = bf2f((bfraw)(gv[e] & 0xffff)), b = bf2f((bfraw)(gv[e] >> 16)); ss += a * a + b * b; }
      }
      ss = wave_sum(ss);
      if (lane == 0) rsb[row] = rsqrtf(ss * (1.f / 1024.f) + EPS);
    }
  }
}

DEVI void phase_ma(const P& p, unsigned char* lds, int hb) {
  const int tid = ltid();
  bfraw* st = (bfraw*)lds;
  float* sc = (float*)(lds + 131072);
  float* s_lf = sc, *s_w = sc + 128, *s_ws = sc + 256, *s_red = sc + 384;
  const float* bg = p.in[I_BGATES];
  for (int item = blockIdx.x; item < 528 + 256; item += gridDim.x) {
    unsigned char* wsb = lws(p.ws);
    const float* gates = (const float*)(wsb + O_GATES);
    const bfraw* kc = (const bfraw*)(wsb + O_KC);
    const bfraw* vv = (const bfraw*)(wsb + O_V);
    bfraw* states = (bfraw*)(wsb + O_ST);
    float* nloc = (float*)(wsb + O_NLOC);
    float* mg = (float*)(wsb + O_MG);
    if (item < 528) {
      const int seq = item / 66, j = item % 66, d = seq >> 2, h = seq & 3;
      int rbase, grow;
      if (j < 2) { int cc = d == 0 ? j : 1 - j; rbase = 8192 + cc * 128; grow = 16384 + hb * 256 + cc * 128; }
      else { int c = d == 0 ? j - 2 : 65 - j; rbase = c * 128; grow = hb * 8192 + c * 128; }
      __syncthreads();
      if (tid < 128) {
        float li = gates[(size_t)(grow + tid) * 16 + d * 8 + h] + bg[d * 8 + h];
        float lf = logsigf_(gates[(size_t)(grow + tid) * 16 + d * 8 + 4 + h] + bg[d * 8 + 4 + h]);
        s_lf[tid] = lf; s_w[tid] = li;
      }
      __syncthreads();
      if (tid < 128) {
        float b = 0;
        if (d == 0) {
#pragma unroll 1
          for (int s = 0; s <= tid; ++s) b += s_lf[s];
        } else {
#pragma unroll 1
          for (int s = 127; s >= tid; --s) b += s_lf[s];
        }
        s_ws[tid] = b;
        if (tid == (d == 0 ? 127 : 0)) s_red[1] = b;
      }
      __syncthreads();
      if (tid < 128) s_ws[tid] = s_red[1] - s_ws[tid] + s_w[tid];
      __syncthreads();
      if (tid < 64) {
        float m = fmaxf(s_ws[tid], s_ws[tid + 64]);
#pragma unroll
        for (int o = 32; o > 0; o >>= 1) m = fmaxf(m, __shfl_xor(m, o, 64));
        if (tid == 0) s_red[0] = m;
      }
      __syncthreads();
      const float mloc = s_red[0];
      if (tid < 128) s_ws[tid] = expf(s_ws[tid] - mloc);
      if (tid == 0) { mg[seq * 66 + j] = mloc; mg[528 + seq * 66 + j] = s_red[1]; }
      __syncthreads();
      bfraw* dst = states + (size_t)(seq * 66 + j) * 65536;
#pragma unroll 1
      for (int vh = 0; vh < 2; ++vh) {
        f32x4 acc[4][4]; ZERO_ACC(acc, 4, 4);
        gemm_tile<128, 256, true, true, false>(vv + (size_t)rbase * 1024 + h * 256 + vh * 128, 1024, kc + (size_t)rbase * 1024 + h * 256, 1024, 128, s_ws, acc, st, nullptr, 0);
        EPI_BEGIN(128, 256)
          dst[(vh * 128 + row) * 256 + col] = f2bf(acc[i][j][r]);
        EPI_END
      }
      if (tid < 256) {
        float n = 0;
        for (int t = 0; t < 128; ++t) n += s_ws[t] * bf2f(kc[(size_t)(rbase + t) * 1024 + h * 256 + tid]);
        nloc[(size_t)(seq * 66 + j) * 256 + tid] = n;
      }
    } else {
      const int it = item - 528, c = it >> 2, g = it & 3;
      bfraw* gvs = (bfraw*)(wsb + O_GVS);
      const float* rsb = (const float*)(wsb + O_RS);
      f32x4 acc[4][4]; ZERO_ACC(acc, 4, 4);
      gemm_tile<128, 256, false, true, false>((const bfraw*)(wsb + O_WSB) + g * 16384, 128, gvs + (size_t)c * 128 * 1024 + g * 256, 1024, 128, rsb + c * 128, acc, st, nullptr, 0);
      const float* gs = p.in[I_GSGU] + g * 256;
      const float* bs = p.in[I_BS] + g * 128;
      EPI_BEGIN(128, 256)
        gvs[(size_t)(c * 128 + row) * 1024 + g * 256 + col] = f2bf(gs[col] * acc[i][j][r] + bs[row]);
      EPI_END
    }
  }
}

DEVI void phase_mb(const P& p) {
  bfraw* states = (bfraw*)(p.ws + O_ST);
  const float* mg = (const float*)(p.ws + O_MG);
  float* ment = (float*)(p.ws + O_MG) + 1056;
  const float* nloc = (const float*)(p.ws + O_NLOC);
  float* nent = (float*)(p.ws + O_NENT);
  const int gid = blockIdx.x * NTHR + ltid(), gsz = gridDim.x * NTHR;
  for (int id = gid; id < 8 * 16384; id += gsz) {
    const int seq = id >> 14, e = (id & 16383) * 4;
    float s0 = 0, s1 = 0, s2 = 0, s3 = 0, m = 0;
    bfraw* base = states + (size_t)seq * 66 * 65536 + e;
    uint2 nx = *(const uint2*)base;
    for (int j = 0; j < 66; ++j) {
      uint2 cur = nx;
      if (j + 1 < 66) nx = *(const uint2*)(base + (size_t)(j + 1) * 65536);
      const float mloc = mg[seq * 66 + j], g = mg[528 + seq * 66 + j];
      const float mnew = fmaxf(g + m, mloc);
      const float dec = expf(g + m - mnew), scl = expf(mloc - mnew);
      if (e == 0) ment[seq * 66 + j] = m;
      uint2 o; o.x = (unsigned)f2bf(s0) | ((unsigned)f2bf(s1) << 16); o.y = (unsigned)f2bf(s2) | ((unsigned)f2bf(s3) << 16);
      *(uint2*)(base + (size_t)j * 65536) = o;
      s0 = dec * s0 + scl * bf2f((bfraw)(cur.x & 0xffff)); s1 = dec * s1 + scl * bf2f((bfraw)(cur.x >> 16));
      s2 = dec * s2 + scl * bf2f((bfraw)(cur.y & 0xffff)); s3 = dec * s3 + scl * bf2f((bfraw)(cur.y >> 16));
      m = mnew;
    }
  }
  for (int id = gid; id < 8 * 256; id += gsz) {
    const int seq = id >> 8, k = id & 255;
    float n = 0, m = 0;
    for (int j = 0; j < 66; ++j) {
      const float mloc = mg[seq * 66 + j], g = mg[528 + seq * 66 + j];
      const float mnew = fmaxf(g + m, mloc);
      const float dec = expf(g + m - mnew), scl = expf(mloc - mnew);
      nent[(size_t)(seq * 66 + j) * 256 + k] = n;
      n = dec * n + scl * nloc[(size_t)(seq * 66 + j) * 256 + k];
      m = mnew;
    }
  }
}

DEVI void phase_mc(const P& p, unsigned char* lds, int hb) {
  const int tid = ltid(), lane = tid & 63, wid = tid >> 6, wm = wid >> 2, wn = wid & 3, fr = lane & 15, fq = lane >> 4;
  bfraw* st = (bfraw*)lds;
  bfraw* sS = (bfraw*)(lds + 61440);
  float* sc = (float*)(lds + 131072);
  float* s_b = sc, *s_u = sc + 256, *s_mt = sc + 512, *s_in = sc + 768, *s_den = sc + 1024, *s_dq = sc + 1280, *s_tmp = sc + 1536;
  float* s_sum = sc + 1792, *s_sq = sc + 1920;
  const float* bg = p.in[I_BGATES];
  for (int item = blockIdx.x; item < 256; item += gridDim.x) {
    unsigned char* wsb = lws(p.ws);
    const float* gates = (const float*)(wsb + O_GATES);
    const bfraw* qc = (const bfraw*)(wsb + O_QC);
    const bfraw* kc = (const bfraw*)(wsb + O_KC);
    bfraw* vv = (bfraw*)(wsb + O_V);
    const bfraw* states = (const bfraw*)(wsb + O_ST);
    const float* ment = (const float*)(wsb + O_MG) + 1056;
    const float* nent = (const float*)(wsb + O_NENT);
    const int c = item >> 2, h = item & 3, R0 = c * 128;
    const bfraw* qp = qc + (size_t)R0 * 1024 + h * 256;
    const bfraw* kp = kc + (size_t)R0 * 1024 + h * 256;
    __syncthreads();
    if (tid < 256) {
      const int d = tid >> 7, t = tid & 127; const size_t grow = (size_t)hb * 8192 + R0 + t;
      float li = gates[grow * 16 + d * 8 + h] + bg[d * 8 + h];
      float lf = logsigf_(gates[grow * 16 + d * 8 + 4 + h] + bg[d * 8 + 4 + h]);
      s_tmp[tid] = lf; s_u[tid] = li; s_den[tid] = 0.f;
      if (tid < 128) { s_sum[tid] = 0.f; s_sq[tid] = 0.f; }
    }
    __syncthreads();
    if (tid < 256) {
      const int d = tid >> 7, t = tid & 127;
      float b = 0;
      if (d == 0) {
#pragma unroll 1
        for (int s = 0; s <= t; ++s) b += s_tmp[s];
      } else {
#pragma unroll 1
        for (int s = 127; s >= t; --s) b += s_tmp[128 + s];
      }
      s_b[tid] = b;
      s_u[tid] = s_u[tid] - b;
    }
    __syncthreads();
    if (tid < 256) {
      const int d = tid >> 7, t = tid & 127;
      float pm = -INFINITY;
      if (d == 0) {
#pragma unroll 1
        for (int s = 0; s <= t; ++s) pm = fmaxf(pm, s_u[s]);
      } else {
#pragma unroll 1
        for (int s = 127; s >= t; --s) pm = fmaxf(pm, s_u[128 + s]);
      }
      const int seq = d * 4 + h, j = d == 0 ? c + 2 : 65 - c;
      const float mst = ment[seq * 66 + j];
      const float b = s_b[tid], a = b + mst;
      const float mt = fmaxf(a, b + pm);
      s_mt[tid] = mt; s_in[tid] = expf(a - mt);
    }
    {
      const int row = tid >> 2, part = tid & 3;
      const bfraw* q1 = qp + (size_t)row * 1024 + part * 64;
      const float* nf = nent + (size_t)((0 + h) * 66 + (c + 2)) * 256 + part * 64;
      const float* nb = nent + (size_t)((4 + h) * 66 + (65 - c)) * 256 + part * 64;
      float af = 0, ab = 0;
#pragma unroll 4
      for (int k = 0; k < 64; ++k) { float q = bf2f(q1[k]); af += q * nf[k]; ab += q * nb[k]; }
      af += __shfl_xor(af, 1, 64); af += __shfl_xor(af, 2, 64);
      ab += __shfl_xor(ab, 1, 64); ab += __shfl_xor(ab, 2, 64);
      if (part == 0) { s_dq[row] = af; s_dq[128 + row] = ab; }
    }
    __syncthreads();
    {
      f32x4 S[4][2]; ZERO_ACC(S, 4, 2);
      gemm_tile<128, 128, false, false, false>(qp, 1024, kp, 1024, 256, nullptr, S, st, nullptr, 0);
#pragma unroll 1
      for (int d = 0; d < 2; ++d)
#pragma unroll
        for (int i = 0; i < 4; ++i)
#pragma unroll
          for (int r = 0; r < 4; ++r) {
            const int row = wm * 64 + i * 16 + fq * 4 + r;
            const float bt = s_b[d * 128 + row] - s_mt[d * 128 + row];
            float rs = 0;
#pragma unroll
            for (int j = 0; j < 2; ++j) {
              const int col = wn * 32 + j * 16 + fr;
              const bool valid = d == 0 ? (col <= row) : (col >= row);
              const float val = valid ? S[i][j][r] * expf(bt + s_u[d * 128 + col]) : 0.f;
              rs += val;
              sS[(d * 128 + row) * 136 + col] = f2bf(val);
            }
            rs = red16(rs);
            if (fr == 0) atomicAdd(&s_den[d * 128 + row], rs);
          }
    }
    __syncthreads();
    f32x4 hs[4][4];
    bfraw* hpark = (bfraw*)(wsb + O_HPARK) + (size_t)R0 * 1024 + h * 256;
#pragma unroll 1
    for (int d = 0; d < 2; ++d) {
      f32x4 (&acc)[4][4] = hs; ZERO_ACC(acc, 4, 4);
      const int seq = d * 4 + h, j2 = d == 0 ? c + 2 : 65 - c;
      gemm_tile<128, 256, false, false, false>(qp, 1024, states + (size_t)(seq * 66 + j2) * 65536, 256, 256, nullptr, acc, st, nullptr, 0);
      EPIR_BEGIN(128, 256)
        const float sin_ = s_in[d * 128 + row];
        EPIR_COLS(256) acc[i][j][r] *= sin_; (void)col;
      EPIR_END
      gemm_tile<128, 256, false, true, true>(nullptr, 0, vv + (size_t)R0 * 1024 + h * 256, 1024, 128, nullptr, acc, st, sS + d * 128 * 136, 136);
      EPIR_BEGIN(128, 256)
        const float den = s_den[d * 128 + row] + s_in[d * 128 + row] * s_dq[d * 128 + row];
        const float inv = 1.f / fmaxf(fabsf(den), expf(-s_mt[d * 128 + row]));
        EPIR_COLS(256)
          const float hv = acc[i][j][r] * inv;
          if (d == 0) hpark[(size_t)row * 1024 + col] = f2bf(hv);
          else hs[i][j][r] = hv + bf2f(hpark[(size_t)row * 1024 + col]);
      EPIR_END
    }
#pragma unroll
    for (int i = 0; i < 4; ++i)
#pragma unroll
      for (int r = 0; r < 4; ++r) {
        float ps = hs[i][0][r] + hs[i][1][r] + hs[i][2][r] + hs[i][3][r];
        ps = red16(ps);
        if (fr == 0) atomicAdd(&s_sum[wm * 64 + i * 16 + fq * 4 + r], ps);
      }
    __syncthreads();
#pragma unroll
    for (int i = 0; i < 4; ++i)
#pragma unroll
      for (int r = 0; r < 4; ++r) {
        const float mu = s_sum[wm * 64 + i * 16 + fq * 4 + r] * (1.f / 256.f);
        float ps = 0;
#pragma unroll
        for (int j = 0; j < 4; ++j) { float dlt = hs[i][j][r] - mu; ps += dlt * dlt; }
        ps = red16(ps);
        if (fr == 0) atomicAdd(&s_sq[wm * 64 + i * 16 + fq * 4 + r], ps);
      }
    __syncthreads();
    const float* gh = p.in[I_GHEAD] + h * 256;
    EPIR_BEGIN(128, 256)
      const float mu = s_sum[row] * (1.f / 256.f);
      const float rstd = rsqrtf(s_sq[row] * (1.f / 256.f) + EPS);
      EPIR_COLS(256)
        vv[(size_t)(R0 + row) * 1024 + h * 256 + col] = f2bf((hs[i][j][r] - mu) * rstd * gh[col]);
    EPIR_END
  }
}

constexpr int NPH = 27;
#define PHASE_PROGRAM \
  PHASE(0, phase_p0(p, lds)) \
  PHASE(1, phase_p0b(p)) \
  PHASE(2, phase_rows<1>(p, lds)) \
  PHASE(3, phase_ffn_in<GBM>(p, lds, O_W1IN, 16896)) \
  PHASE(4, phase_ffn_out<128>(p, lds, O_W1OUT, 16896, 2)) \
  PHASE(5, phase_rows<2>(p, lds)) \
  PHASE(6, phase_g3c(p, lds)) \
  PHASE(7, phase_g3a(p, lds, 0)) \
  PHASE(8, phase_cv(p, 0)) \
  PHASE(9, phase_ma(p, lds, 0)) \
  PHASE(10, phase_mb(p)) \
  PHASE(11, phase_mc(p, lds, 0)) \
  PHASE(12, phase_g3b(p, lds, 0)) \
  PHASE(13, phase_g4(p, lds)) \
  PHASE(14, phase_g5(p, lds, 0)) \
  PHASE(15, phase_g3a(p, lds, 1)) \
  PHASE(16, phase_cv(p, 1)) \
  PHASE(17, phase_ma(p, lds, 1)) \
  PHASE(18, phase_mb(p)) \
  PHASE(19, phase_mc(p, lds, 1)) \
  PHASE(20, phase_g3b(p, lds, 1)) \
  PHASE(21, phase_g4(p, lds)) \
  PHASE(22, phase_g5(p, lds, 1)) \
  PHASE(23, phase_rows<3>(p, lds)) \
  PHASE(24, phase_ffn_in<GBM>(p, lds, O_W2IN, 16384)) \
  PHASE(25, phase_ffn_out<128>(p, lds, O_W2OUT, 16384, 8)) \
  PHASE(26, phase_rows<4>(p, lds))

#if !MULTI_LAUNCH
#define PHASE(n, call) if (lo <= (n) && (n) < hi) { if ((n) > lo) grid.sync(); call; }
__global__ void __launch_bounds__(512) mk(P p, int lo, int hi) {
  extern __shared__ __attribute__((aligned(16))) unsigned char lds[];
  cg::grid_group grid = cg::this_grid();
  PHASE_PROGRAM
}
#undef PHASE
#else
#define PHASE(n, call) if constexpr (PH == (n)) { call; }
template <int PH>
__global__ void __launch_bounds__(512) mkp(P p) {
  extern __shared__ __attribute__((aligned(16))) unsigned char lds[];
  PHASE_PROGRAM
}
#undef PHASE
template <int PH> static void launch_all(const P& p, int grid, hipStream_t stream) {
  if constexpr (PH < NPH) {
    (void)hipFuncSetAttribute((const void*)mkp<PH>, hipFuncAttributeMaxDynamicSharedMemorySize, LDS_BYTES);
    hipLaunchKernelGGL(mkp<PH>, dim3(grid), dim3(NTHR), LDS_BYTES, stream, p);
    launch_all<PH + 1>(p, grid, stream);
  }
}
#endif

extern "C" void kernel_launch(void* const* d_in, const int* in_sizes, int n_in, void* d_out, int out_size, void* d_ws, size_t ws_size, hipStream_t stream) {
  static int grid_blocks = 0;
  if (!grid_blocks) {
    if (n_in != 25 || ws_size < O_END || ws_size < O_ACT + 16896ull * 2816 * 2) { fprintf(stderr, "kernel_launch: unexpected n_in %d / ws %zu\n", n_in, ws_size); grid_blocks = -1; return; }
    int dev = 0, cus = 0, per_cu = 0;
    (void)hipGetDevice(&dev);
    (void)hipDeviceGetAttribute(&cus, hipDeviceAttributeMultiprocessorCount, dev);
#if !MULTI_LAUNCH
    if (hipFuncSetAttribute((const void*)mk, hipFuncAttributeMaxDynamicSharedMemorySize, LDS_BYTES) != hipSuccess) { fprintf(stderr, "hipFuncSetAttribute failed\n"); grid_blocks = -1; return; }
    if (hipOccupancyMaxActiveBlocksPerMultiprocessor(&per_cu, (const void*)mk, NTHR, LDS_BYTES) != hipSuccess || per_cu < 1) { fprintf(stderr, "occupancy query failed (%d)\n", per_cu); grid_blocks = -1; return; }
#endif
    grid_blocks = cus * 1;
    fprintf(stderr, "kernel_launch: cus %d per_cu %d grid %d\n", cus, per_cu, grid_blocks);
  }
  if (grid_blocks < 0) return;
  P p{};
  for (int i = 0; i < 25; ++i) p.in[i] = (const float*)d_in[i];
  p.out = (float*)d_out; p.ws = (unsigned char*)d_ws;
#if MULTI_LAUNCH
  launch_all<0>(p, grid_blocks, stream);
#else
  int lo = 0, hi = NPH;
  void* args[] = {&p, &lo, &hi};
  hipError_t e = hipLaunchCooperativeKernel((const void*)mk, dim3(grid_blocks), dim3(NTHR), args, LDS_BYTES, stream);
  if (e != hipSuccess) fprintf(stderr, "cooperative launch failed: %s (grid %d)\n", hipGetErrorString(e), grid_blocks);
#endif
}
```

```cpp
#include <hip/hip_runtime.h>
#include <hip/hip_cooperative_groups.h>
#include <cstdio>
#include <cstdint>
namespace cg = cooperative_groups;

#ifndef MULTI_LAUNCH
#define MULTI_LAUNCH 0
#endif

typedef unsigned short bfraw;
typedef __attribute__((ext_vector_type(8))) short bf16x8;
typedef __attribute__((ext_vector_type(4))) float f32x4;
#define DEVI __device__ __forceinline__

constexpr int NTHR = 512;
constexpr int GBM = 128;
constexpr int LROW = 40;
constexpr int LDS_BYTES = 143360;
constexpr float EPS = 1e-6f;

enum { I_X, I_C, I_CTX, I_CCTX, I_WADA, I_BADA, I_GFFN1, I_W1IN, I_W1OUT, I_GMIX, I_WIN, I_BGATES, I_CONVW, I_CONVB,
       I_GHEAD, I_GSGU, I_WS, I_BS, I_WA, I_WB, I_WO, I_GFFN2, I_W2IN, I_W2OUT, I_GFINAL };

struct P { const float* in[25]; float* out; unsigned char* ws; };

constexpr size_t O_W1IN  = 0;
constexpr size_t O_W1OUT = O_W1IN  + 5632ull * 1024 * 2;
constexpr size_t O_WTA   = O_W1OUT + 1024ull * 2816 * 2;
constexpr size_t O_WTB   = O_WTA   + 4096ull * 1024 * 2;
constexpr size_t O_WA    = O_WTB   + 4096ull * 1024 * 2;
constexpr size_t O_WB    = O_WA    + 1024ull * 1024 * 2;
constexpr size_t O_WO    = O_WB    + 1024ull * 1024 * 2;
constexpr size_t O_W2IN  = O_WO    + 1024ull * 1024 * 2;
constexpr size_t O_W2OUT = O_W2IN  + 5632ull * 1024 * 2;
constexpr size_t O_WSB   = O_W2OUT + 1024ull * 2816 * 2;
constexpr size_t O_MODSP = O_WSB   + 4ull * 128 * 128 * 2;
constexpr size_t O_MODS  = O_MODSP + 16ull * 3 * 9216 * 4;
constexpr size_t O_HCTX  = O_MODS  + 3ull * 9216 * 4;
constexpr size_t O_HN    = O_HCTX  + 512ull * 1024 * 4;
constexpr size_t O_GATES = O_HN    + 16896ull * 1024 * 2;
constexpr size_t O_CTXRAW= O_GATES + 16896ull * 16 * 4;
constexpr size_t O_BIG   = O_CTXRAW+ 2ull * 256 * 3072 * 2;
constexpr size_t O_ACT   = O_BIG;
constexpr size_t O_ST    = O_BIG;
constexpr size_t O_QRAW  = O_BIG;
constexpr size_t O_KRAW  = O_QRAW  + 8448ull * 1024 * 2;
constexpr size_t O_V     = O_ST    + 8ull * 66 * 131072;
constexpr size_t O_GVS   = O_V     + 8448ull * 1024 * 2;
constexpr size_t O_QC    = O_GVS   + 8192ull * 1024 * 2;
constexpr size_t O_KC    = O_QC    + 8448ull * 1024 * 2;
constexpr size_t O_NLOC  = O_KC    + 8448ull * 1024 * 2;
constexpr size_t O_NENT  = O_NLOC  + 8ull * 66 * 256 * 4;
constexpr size_t O_MG    = O_NENT  + 8ull * 66 * 256 * 4;
constexpr size_t O_RS    = O_MG    + 8192;
constexpr size_t O_HPARK = O_RS    + 8192ull * 4;
constexpr size_t O_BAR   = O_HPARK + 8192ull * 1024 * 2;
constexpr size_t O_END   = O_BAR + 16384;
static_assert(O_ACT + 16896ull * 2816 * 2 <= 268435456ull, "ws");
static_assert(O_END <= 268435456ull, "ws");
static_assert(O_KRAW + 8448ull * 1024 * 2 <= O_V, "overlay");

DEVI int ltid() { int t = __builtin_amdgcn_workitem_id_x(); asm volatile("" : "+v"(t)); return t; }
DEVI unsigned char* lws(unsigned char* w) { asm volatile("" : "+s"(w)); return w; }
DEVI bfraw f2bf(float f) { unsigned u = __float_as_uint(f); u += 0x7fffu + ((u >> 16) & 1u); return (bfraw)(u >> 16); }
DEVI float bf2f(bfraw h) { return __uint_as_float(((unsigned)h) << 16); }
DEVI float sigmoidf_(float x) { return 1.f / (1.f + expf(-x)); }
DEVI float siluf_(float x) { return x / (1.f + expf(-x)); }
DEVI float geluf_(float x) { float u = 0.7978845608028654f * (x + 0.044715f * x * x * x); return 0.5f * x * (1.f + tanhf(u)); }
DEVI float logsigf_(float x) { return fminf(x, 0.f) - log1pf(expf(-fabsf(x))); }
DEVI float wave_sum(float v) {
#pragma unroll
  for (int o = 32; o > 0; o >>= 1) v += __shfl_xor(v, o, 64);
  return v;
}
DEVI float red16(float v) {
  v += __shfl_xor(v, 1, 64); v += __shfl_xor(v, 2, 64); v += __shfl_xor(v, 4, 64); v += __shfl_xor(v, 8, 64);
  return v;
}
DEVI float redsin(float a, bool cosine) {
  float k = rintf(a * 0.15915494309189535f);
  float r = fmaf(-k, 6.2831854820251465f, a);
  r = fmaf(-k, -1.7484555e-7f, r);
  return cosine ? __cosf(r) : __sinf(r);
}


DEVI float seg_scan_sum(float v, int tid, float* s_x) {
  const int lane = tid & 63;
#pragma unroll
  for (int o = 1; o < 64; o <<= 1) { float t = __shfl_up(v, o, 64); if (lane >= o) v += t; }
  if (lane == 63 && tid < 256) s_x[tid >> 6] = v;
  __syncthreads();
  if (tid < 256 && ((tid >> 6) & 1)) v += s_x[(tid >> 6) - 1];
  __syncthreads();
  return v;
}
DEVI float seg_scan_max(float v, int tid, float* s_x) {
  const int lane = tid & 63;
#pragma unroll
  for (int o = 1; o < 64; o <<= 1) { float t = __shfl_up(v, o, 64); if (lane >= o) v = fmaxf(v, t); }
  if (lane == 63 && tid < 256) s_x[tid >> 6] = v;
  __syncthreads();
  if (tid < 256 && ((tid >> 6) & 1)) v = fmaxf(v, s_x[(tid >> 6) - 1]);
  __syncthreads();
  return v;
}

#define XB_TMO      128
#define XB_XCNT(j)  (256  + 64 * (j))
#define XB_XSUB(j)  (1280 + 64 * (j))
#define XB_XGEN(j)  (2304 + 64 * (j))
#define XB_TOP      3328
#define XB_TOPGEN   3392
#define XCD_BAR_WORDS 3456
#define XB_SPIN_CAP (1u << 18)
#define LAS __attribute__((address_space(3)))

__device__ __forceinline__ unsigned xb_ld(unsigned* p)              { return __hip_atomic_load(p, __ATOMIC_RELAXED, __HIP_MEMORY_SCOPE_AGENT); }
__device__ __forceinline__ unsigned xb_add(unsigned* p, unsigned v) { return __hip_atomic_fetch_add(p, v, __ATOMIC_RELAXED, __HIP_MEMORY_SCOPE_AGENT); }
__device__ __forceinline__ unsigned xb_xcc_id() { return (unsigned)__builtin_amdgcn_s_getreg((3 << 11) | 20) & 0xFu; }
#define XB_SPIN(cond, bar) do { unsigned _sp = 0; while (cond) { __builtin_amdgcn_s_sleep(1); \
    if ((++_sp & 255u) == 0u) { if (xb_ld(&(bar)[XB_TMO])) break; if (_sp > XB_SPIN_CAP) { atomicAdd(&(bar)[XB_TMO], 1u); break; } } } } while (0)

struct XcdBarrier {
    unsigned* bar; unsigned x;
    volatile LAS unsigned* st;
};

__device__ __forceinline__ XcdBarrier xcd_barrier_post(unsigned* bar, volatile LAS unsigned* st) {
    XcdBarrier b; b.bar = bar; b.x = xb_xcc_id(); b.st = st;
    if (threadIdx.x == 0) (void)xb_add(&bar[XB_XCNT(b.x)], 1u);
    return b;
}
__device__ __forceinline__ void xcd_barrier_complete(unsigned* bar, unsigned x, unsigned& nloc, unsigned& nx) {
    const unsigned G = gridDim.x * gridDim.y * gridDim.z;
    unsigned sum, cnt, mine, sp = 0u;
    for (;;) {
        sum = 0u; cnt = 0u; mine = 0u;
#pragma unroll
        for (unsigned j = 0; j < 16; ++j) { const unsigned c = xb_ld(&bar[XB_XCNT(j)]); sum += c; cnt += (c > 0u) ? 1u : 0u; mine = (j == x) ? c : mine; }
        if (sum == G) break;
        __builtin_amdgcn_s_sleep(1);
        if ((++sp & 255u) == 0u) { if (xb_ld(&bar[XB_TMO])) break; if (sp > XB_SPIN_CAP) { atomicAdd(&bar[XB_TMO], 1u); break; } }
    }
    nloc = mine > 0u ? mine : 1u; nx = cnt > 0u ? cnt : 1u;
}

__device__ __forceinline__ void xcd_barrier(const XcdBarrier& b) {
    asm volatile("s_waitcnt vmcnt(0)" ::: "memory");
    __syncthreads();
    if (threadIdx.x == 0) {
        unsigned* bar = b.bar;
        __builtin_amdgcn_s_waitcnt(0);
        unsigned nloc = b.st[0], nx = b.st[1];
        if (nloc == 0u) { xcd_barrier_complete(bar, b.x, nloc, nx); b.st[0] = nloc; b.st[1] = nx; }
        const unsigned old = xb_add(&bar[XB_XSUB(b.x)], 1u);
        const unsigned gen = old / nloc;
        if (old + 1u == (gen + 1u) * nloc) {
            __builtin_amdgcn_fence(__ATOMIC_RELEASE, "agent");
            asm volatile("s_waitcnt vmcnt(0)" ::: "memory");
            const unsigned og = xb_add(&bar[XB_TOP], 1u);
            const unsigned tg = og / nx;
            if (og + 1u == (tg + 1u) * nx) xb_add(&bar[XB_TOPGEN], 1u);
            else XB_SPIN(xb_ld(&bar[XB_TOPGEN]) == tg, bar);
            __builtin_amdgcn_fence(__ATOMIC_ACQUIRE, "agent");
            xb_add(&bar[XB_XGEN(b.x)], 1u);
            asm volatile("s_waitcnt vmcnt(0)" ::: "memory");
        } else {
            XB_SPIN(xb_ld(&bar[XB_XGEN(b.x)]) == gen, bar);
            __builtin_amdgcn_fence(__ATOMIC_ACQUIRE, "agent");
            asm volatile("s_waitcnt vmcnt(0)" ::: "memory");
        }
    }
    __syncthreads();
}

template <int BM, int BN, bool ATR, bool BTR, bool ALDS>
DEVI void gemm_tile(const bfraw* __restrict__ A, int lda, const bfraw* __restrict__ B, int ldb, int K,
                    const float* kscale, f32x4 (&acc)[BM / 32][BN / 64], bfraw* st, const bfraw* sAres, int ldres) {
  constexpr int MI = BM / 32, NJ = BN / 64, CA = BM / 128, CB = BN / 128, WM = BM / 2, WN = BN / 4;
  constexpr int STAGE = (ALDS ? BN : (BM + BN)) * LROW;
  int tid_ = ltid();
  const int tid = tid_, lane = tid & 63, wid = tid >> 6, wm = wid >> 2, wn = wid & 3;
  const int fr = lane & 15, fq = lane >> 4;
  uint4 ra0 = {0, 0, 0, 0}, ra1 = {0, 0, 0, 0}, rb0 = {0, 0, 0, 0}, rb1 = {0, 0, 0, 0};
  const int nk = K >> 5;

  auto gla = [&](int c, int k0) -> uint4 {
    if (!ATR) { int row = c >> 2, kc = (c & 3) * 8; return *(const uint4*)(A + (size_t)row * lda + k0 + kc); }
    else { int krow = c / (BM / 8), m0 = (c % (BM / 8)) * 8; return *(const uint4*)(A + (size_t)(k0 + krow) * lda + m0); }
  };
  auto glb = [&](int c, int k0) -> uint4 {
    if (!BTR) { int row = c >> 2, kc = (c & 3) * 8; return *(const uint4*)(B + (size_t)row * ldb + k0 + kc); }
    else { int krow = c / (BN / 8), n0 = (c % (BN / 8)) * 8; return *(const uint4*)(B + (size_t)(k0 + krow) * ldb + n0); }
  };
  auto gload = [&](int kt) {
    const int k0 = kt << 5;
    if (!ALDS) { ra0 = gla(tid, k0); if (CA > 1) ra1 = gla(tid + NTHR, k0); }
    rb0 = glb(tid, k0); if (CB > 1) rb1 = glb(tid + NTHR, k0);
  };
  auto scatter = [&](bfraw* s, int m0, int krow, uint4 r, float sc, bool scaled) {
    unsigned w0 = r.x, w1 = r.y, w2 = r.z, w3 = r.w;
    bfraw e0 = w0 & 0xffff, e1 = w0 >> 16, e2 = w1 & 0xffff, e3 = w1 >> 16, e4 = w2 & 0xffff, e5 = w2 >> 16, e6 = w3 & 0xffff, e7 = w3 >> 16;
    if (scaled) {
      e0 = f2bf(bf2f(e0) * sc); e1 = f2bf(bf2f(e1) * sc); e2 = f2bf(bf2f(e2) * sc); e3 = f2bf(bf2f(e3) * sc);
      e4 = f2bf(bf2f(e4) * sc); e5 = f2bf(bf2f(e5) * sc); e6 = f2bf(bf2f(e6) * sc); e7 = f2bf(bf2f(e7) * sc);
    }
    bfraw* d = s + m0 * LROW + krow;
    d[0] = e0; d[LROW] = e1; d[2 * LROW] = e2; d[3 * LROW] = e3; d[4 * LROW] = e4; d[5 * LROW] = e5; d[6 * LROW] = e6; d[7 * LROW] = e7;
  };
  auto lstore = [&](int buf, int kt) {
    bfraw* sA = st + buf * STAGE;
    bfraw* sB = sA + (ALDS ? 0 : BM * LROW);
    auto sta = [&](int c, uint4 v) {
      if (!ATR) { int row = c >> 2, kc = (c & 3) * 8; *(uint4*)(sA + row * LROW + kc) = v; }
      else { int krow = c / (BM / 8), m0 = (c % (BM / 8)) * 8; scatter(sA, m0, krow, v, 1.f, false); }
    };
    auto stb = [&](int c, uint4 v) {
      if (!BTR) { int row = c >> 2, kc = (c & 3) * 8; *(uint4*)(sB + row * LROW + kc) = v; }
      else {
        int krow = c / (BN / 8), n0 = (c % (BN / 8)) * 8;
        float sc = kscale ? kscale[(kt << 5) + krow] : 1.f;
        scatter(sB, n0, krow, v, sc, kscale != nullptr);
      }
    };
    if (!ALDS) { sta(tid, ra0); if (CA > 1) sta(tid + NTHR, ra1); }
    stb(tid, rb0); if (CB > 1) stb(tid + NTHR, rb1);
  };
  auto compute = [&](int buf, int kt) {
    const bfraw* sA = st + buf * STAGE;
    const bfraw* sB = sA + (ALDS ? 0 : BM * LROW);
    bf16x8 af[MI], bfr[NJ];
#pragma unroll
    for (int i = 0; i < MI; ++i) {
      if (ALDS) af[i] = *(const bf16x8*)(sAres + (wm * WM + i * 16 + fr) * ldres + (kt << 5) + fq * 8);
      else af[i] = *(const bf16x8*)(sA + (wm * WM + i * 16 + fr) * LROW + fq * 8);
    }
#pragma unroll
    for (int j = 0; j < NJ; ++j) bfr[j] = *(const bf16x8*)(sB + (wn * WN + j * 16 + fr) * LROW + fq * 8);
#pragma unroll
    for (int i = 0; i < MI; ++i)
#pragma unroll
      for (int j = 0; j < NJ; ++j) acc[i][j] = __builtin_amdgcn_mfma_f32_16x16x32_bf16(af[i], bfr[j], acc[i][j], 0, 0, 0);
  };

  __syncthreads();
  gload(0); lstore(0, 0);
  __syncthreads();
  for (int kt = 0; kt < nk; ++kt) {
    if (kt + 1 < nk) gload(kt + 1);
    compute(kt & 1, kt);
    if (kt + 1 < nk) lstore((kt + 1) & 1, kt + 1);
    __syncthreads();
  }
}

#define ZERO_ACC(acc, MI, NJ) _Pragma("unroll") for (int _i = 0; _i < (MI); ++_i) _Pragma("unroll") for (int _j = 0; _j < (NJ); ++_j) acc[_i][_j] = f32x4{0.f, 0.f, 0.f, 0.f};
#define EPI_BEGIN(BM, BN) { int _t = ltid(); const int _l = _t & 63, _w = _t >> 6; \
    const int _rb = (_w >> 2) * ((BM) / 2) + (_l >> 4) * 4, _cb = (_w & 3) * ((BN) / 4) + (_l & 15); \
    _Pragma("unroll") for (int i = 0; i < (BM) / 32; ++i) _Pragma("unroll") for (int j = 0; j < (BN) / 64; ++j) _Pragma("unroll") for (int r = 0; r < 4; ++r) { \
      const int row = _rb + i * 16 + r, col = _cb + j * 16;
#define EPI_END }}
#define EPIR_BEGIN(BM, BN) { int _t = ltid(); const int _l = _t & 63, _w = _t >> 6; \
    const int _rb = (_w >> 2) * ((BM) / 2) + (_l >> 4) * 4, _cb = (_w & 3) * ((BN) / 4) + (_l & 15); \
    _Pragma("unroll") for (int i = 0; i < (BM) / 32; ++i) _Pragma("unroll") for (int r = 0; r < 4; ++r) { \
      const int row = _rb + i * 16 + r;
#define EPIR_COLS(BN) _Pragma("unroll") for (int j = 0; j < (BN) / 64; ++j) { const int col = _cb + j * 16;
#define EPIR_END }}}


namespace pg8 {
#define PG8_LAS __attribute__((address_space(3)))
typedef unsigned short bf16_t;
typedef short bf16x8 __attribute__((ext_vector_type(8)));
typedef float f32x4 __attribute__((ext_vector_type(4)));
typedef unsigned u32x4 __attribute__((ext_vector_type(4)));
constexpr int BM = 256, BK = 64, HALF = 128, HTB = HALF * BK * 2  , STAGE_BYTES = 8 * HTB, NXCD = 8, WGM = 8;

__host__ __device__ __forceinline__ int lds_byte(int r, int c) { const int st = (r >> 4) * 2 + (c >> 5), rr = r & 15, cc = c & 31, ob = rr * 64 + cc * 2; return st * 1024 + (ob ^ (((ob >> 9) & 1) << 5)); }
__host__ __device__ __forceinline__ void stage_rc(int b, int& R, int& C) { const int st = b / 1024, sb = b % 1024, swz = sb ^ (((sb >> 9) & 1) << 5); R = (st >> 1) * 16 + swz / 64; C = (st & 1) * 32 + (swz % 64) / 2; }
__host__ __device__ __forceinline__ int perm32(int rho) { const int n = rho >> 4, i = rho & 15; return 8 * (i >> 2) + 4 * n + (i & 3); }

struct Unit { int pm, pn; };
struct Gemm { const bf16_t* A; const bf16_t* Bt; int M, N, K; };
struct StaticOrder {
    int nM, nN, nwg, G, c;
    __host__ __device__ void init(int M, int N, int G_, int c_) { nM = M / BM; nN = N / BM; nwg = nM * nN; G = G_; c = c_; }
    __host__ __device__ bool next(int i, Unit& u) const {
        const long L = (long)i * G + c; if (L >= nwg) return false;
        int wgid = (int)L; { const int q = nwg / NXCD, r = nwg % NXCD, xcd = wgid % NXCD, off = wgid / NXCD; wgid = (xcd < r ? xcd * (q + 1) : r * (q + 1) + (xcd - r) * q) + off; }
        const int nig = WGM * nN, gid = wgid / nig, fm = gid * WGM, gsz = (nM - fm) < WGM ? (nM - fm) : WGM;
        u.pm = fm + ((wgid % nig) % gsz); u.pn = (wgid % nig) / gsz; return true;
    }
    __device__ __forceinline__ void a_ready(const Unit&) const {}
    __device__ __forceinline__ void done(const Unit&) const {}
};
__device__ __forceinline__ unsigned cvt_pk_bf16(float lo, float hi) { unsigned r; asm volatile("v_cvt_pk_bf16_f32 %0, %1, %2" : "=v"(r) : "v"(lo), "v"(hi)); return r; }
template <class Epi, class Sched, bool STAMP = false>
__device__ __forceinline__ void gemm_phase(PG8_LAS unsigned char* lds, const Gemm g, const Sched& S, const Epi& E, unsigned long long* stamps) {
    const int tid = threadIdx.x, wid = __builtin_amdgcn_readfirstlane(tid >> 6), lane = tid & 63, wr = wid >> 2, wc = wid & 3, fr = lane & 15, fq = lane >> 4;
    const int K = g.K, nt = K / BK;
    int ts_lo = 0, ts_hi = 0, nts = 0; const unsigned long long rt_entry = STAMP ? (unsigned long long)wall_clock64() : 0ull;
#define PG8_STAMP() do { if (STAMP && wid == 0 && nts < 64) { const unsigned long long _c = (unsigned long long)clock64(); \
        ts_lo = (lane == nts) ? (int)(unsigned)_c : ts_lo; ts_hi = (lane == nts) ? (int)(unsigned)(_c >> 32) : ts_hi; ++nts; } } while (0)
    PG8_STAMP();
    unsigned voffA[2], voffB[2];
#pragma unroll
    for (int i = 0; i < 2; ++i) { int R, C; stage_rc(tid * 16 + i * 8192, R, C); const int Rb = Epi::PERM ? ((R & ~31) + perm32(R & 31)) : R;
        voffA[i] = (unsigned)(R * K + C) * 2u; voffB[i] = (unsigned)(Rb * K + C) * 2u; }
    const size_t kstep = (size_t)(BK * 2);
    const size_t hstep = (size_t)HALF * K * 2;
    const size_t tstep = 2 * hstep;
    const unsigned ldsw = (unsigned)wid * 1024u;
    const int aoff = lds_byte(wr * 64 + fr, fq * 8), boff = lds_byte(wc * 32 + fr, fq * 8);
#define PG8_SA(b, h) (((b) * 2 + (h)) * HTB)
#define PG8_SB(b, h) ((4 + (b) * 2 + (h)) * HTB)
#define PG8_STAGE(bufoff, gbase, voff) do { _Pragma("unroll") for (int _i = 0; _i < 2; ++_i) \
        __builtin_amdgcn_global_load_lds((const unsigned*)((const char*)(gbase) + (voff)[_i]), (PG8_LAS unsigned*)(lds + (bufoff) + ldsw + _i * 8192), 16, 0, 0); } while (0)
#define PG8_LDA(dst, b, h) do { _Pragma("unroll") for (int m = 0; m < 4; ++m) _Pragma("unroll") for (int k = 0; k < 2; ++k) dst[m][k] = *(const PG8_LAS bf16x8*)(lds + PG8_SA(b, h) + aoff + m * 2048 + k * 1024); } while (0)
#define PG8_LDB(dst, b, h) do { _Pragma("unroll") for (int n = 0; n < 2; ++n) _Pragma("unroll") for (int k = 0; k < 2; ++k) dst[n][k] = *(const PG8_LAS bf16x8*)(lds + PG8_SB(b, h) + boff + n * 2048 + k * 1024); } while (0)
#define PG8_MMA(ai, bj, At, Bt) do { __builtin_amdgcn_s_setprio(1); _Pragma("unroll") for (int m = 0; m < 4; ++m) _Pragma("unroll") for (int n = 0; n < 2; ++n) _Pragma("unroll") for (int k = 0; k < 2; ++k) \
        acc[ai][bj][m][n] = __builtin_amdgcn_mfma_f32_16x16x32_bf16(Bt[n][k], At[m][k], acc[ai][bj][m][n], 0, 0, 0); __builtin_amdgcn_s_setprio(0); } while (0)
#define PG8_WAIT_V(n) asm volatile("s_waitcnt vmcnt(" #n ")" ::: "memory")
#define PG8_WAIT_L(n) asm volatile("s_waitcnt lgkmcnt(" #n ")" ::: "memory")
#define PG8_BAR __builtin_amdgcn_s_barrier()
#define PG8_SCHED __builtin_amdgcn_sched_barrier(0)
    Unit cur, nxt; int ui = 0;
    if (!S.next(0, cur)) return;
    f32x4 acc[2][2][4][2];
#pragma unroll
    for (int a = 0; a < 2; ++a)
#pragma unroll
        for (int b = 0; b < 2; ++b)
#pragma unroll
            for (int m = 0; m < 4; ++m)
#pragma unroll
                for (int n = 0; n < 2; ++n) acc[a][b][m][n] = (f32x4){0.f, 0.f, 0.f, 0.f};
    bf16x8 At[4][2], B0[2][2], B1[2][2];
    const char* cA = (const char*)g.A + (size_t)cur.pm * tstep; const char* cB = (const char*)g.Bt + (size_t)cur.pn * tstep;
    S.a_ready(cur);
    PG8_STAGE(PG8_SB(0, 0), cB, voffB); PG8_STAGE(PG8_SA(0, 0), cA, voffA); PG8_STAGE(PG8_SB(0, 1), cB + hstep, voffB); PG8_STAGE(PG8_SA(0, 1), cA + hstep, voffA);
    if (wr == 1) PG8_BAR;
    PG8_WAIT_V(4); PG8_BAR;
    PG8_STAGE(PG8_SB(1, 0), cB + kstep, voffB); PG8_STAGE(PG8_SA(1, 0), cA + kstep, voffA); PG8_STAGE(PG8_SB(1, 1), cB + hstep + kstep, voffB);
    PG8_WAIT_V(6); PG8_BAR;
    PG8_STAMP();
    for (;;) {
        const bool has_next = S.next(ui + 1, nxt);
        const char* nA = has_next ? (const char*)g.A + (size_t)nxt.pm * tstep : cA; const char* nB = has_next ? (const char*)g.Bt + (size_t)nxt.pn * tstep : cB;
        for (int t = 0; t < nt; t += 2) {
            const bool last = (t == nt - 2);
            const char* a1 = cA + (size_t)(t + 1) * kstep;
            const char* a2 = last ? nA : cA + (size_t)(t + 2) * kstep; const char* b2 = last ? nB : cB + (size_t)(t + 2) * kstep;
            const char* a3 = a2 + kstep; const char* b3 = b2 + kstep;
            if (last && has_next) S.a_ready(nxt);
            PG8_LDB(B0, 0, 0); PG8_SCHED; PG8_LDA(At, 0, 0); PG8_STAGE(PG8_SA(1, 1), a1 + hstep, voffA);
            PG8_WAIT_L(8); PG8_BAR; PG8_WAIT_L(0); PG8_MMA(0, 0, At, B0); PG8_BAR; PG8_SCHED;
            PG8_LDB(B1, 0, 1); PG8_STAGE(PG8_SB(0, 0), b2, voffB);
            PG8_BAR; PG8_WAIT_L(0); PG8_MMA(0, 1, At, B1); PG8_BAR;
            PG8_LDA(At, 0, 1); PG8_STAGE(PG8_SA(0, 0), a2, voffA);
            PG8_BAR; PG8_WAIT_L(0); PG8_MMA(1, 0, At, B0); PG8_BAR; PG8_SCHED;
            PG8_STAGE(PG8_SB(0, 1), b2 + hstep, voffB);
            PG8_WAIT_V(6); PG8_BAR; PG8_MMA(1, 1, At, B1); PG8_BAR;
            PG8_LDB(B0, 1, 0); PG8_SCHED; PG8_LDA(At, 1, 0); PG8_STAGE(PG8_SA(0, 1), a2 + hstep, voffA);
            PG8_WAIT_L(8); PG8_BAR; PG8_WAIT_L(0); PG8_MMA(0, 0, At, B0); PG8_BAR; PG8_SCHED;
            PG8_LDB(B1, 1, 1); PG8_STAGE(PG8_SB(1, 0), b3, voffB);
            PG8_BAR; PG8_WAIT_L(0); PG8_MMA(0, 1, At, B1); PG8_BAR;
            PG8_LDA(At, 1, 1); PG8_STAGE(PG8_SA(1, 0), a3, voffA);
            PG8_BAR; PG8_WAIT_L(0); PG8_MMA(1, 0, At, B0); PG8_BAR; PG8_SCHED;
            PG8_STAGE(PG8_SB(1, 1), b3 + hstep, voffB);
            PG8_WAIT_V(6); PG8_BAR; PG8_MMA(1, 1, At, B1); PG8_BAR;
        }
        PG8_STAMP();
        if constexpr (!Epi::AFTER_DRAIN) { E(acc, cur, wr, wc, fr, fq); S.done(cur); }
        PG8_STAMP();
        if (!has_next) break;
#pragma unroll
        for (int a = 0; a < 2; ++a)
#pragma unroll
            for (int b = 0; b < 2; ++b)
#pragma unroll
                for (int m = 0; m < 4; ++m)
#pragma unroll
                    for (int n = 0; n < 2; ++n) acc[a][b][m][n] = (f32x4){0.f, 0.f, 0.f, 0.f};
        cur = nxt; cA = nA; cB = nB; ++ui;
    }
    PG8_WAIT_V(0);
    if (wr == 0) PG8_BAR;
    PG8_BAR;
    if constexpr (Epi::AFTER_DRAIN) { E.fused(acc, cur, wr, wc, fr, fq, lds, wid, lane); S.done(cur); }
    PG8_STAMP();
    if (STAMP && wid == 0) { stamps[lane] = lane < nts ? (((unsigned long long)(unsigned)ts_hi << 32) | (unsigned)ts_lo) : 0ull;
        if (lane == 62) stamps[62] = rt_entry; if (lane == 63) stamps[63] = (unsigned long long)wall_clock64(); }
#undef PG8_STAMP
#undef PG8_SA
#undef PG8_SB
#undef PG8_STAGE
#undef PG8_LDA
#undef PG8_LDB
#undef PG8_MMA
#undef PG8_WAIT_V
#undef PG8_WAIT_L
#undef PG8_BAR
#undef PG8_SCHED
}
}

typedef pg8::f32x4 pf4;
DEVI float4 ld4(const float* p) { return *(const float4*)p; }
struct EpiFfnIn {
  static constexpr bool PERM = false, AFTER_DRAIN = false;
  bfraw* act;
  DEVI void operator()(const pf4 (&acc)[2][2][4][2], const pg8::Unit& u, int wr, int wc, int fr, int fq) const {
    const int row0 = u.pm * 256 + wr * 64 + fr, f0 = (u.pn * 256 + wc * 32) / 2 + 4 * fq;
#pragma unroll
    for (int ai = 0; ai < 2; ++ai)
#pragma unroll
      for (int m = 0; m < 4; ++m) {
        bfraw* rowp = act + (size_t)(row0 + ai * 128 + m * 16) * 2816 + f0;
#pragma unroll
        for (int bj = 0; bj < 2; ++bj) {
          const pf4 a = acc[ai][bj][m][0], b = acc[ai][bj][m][1];
          uint2 w; w.x = pg8::cvt_pk_bf16(siluf_(a[0]) * b[0], siluf_(a[1]) * b[1]); w.y = pg8::cvt_pk_bf16(siluf_(a[2]) * b[2], siluf_(a[3]) * b[3]);
          *(uint2*)(rowp + bj * 64) = w;
        }
      }
  }
};
struct EpiResid {
  static constexpr bool PERM = false, AFTER_DRAIN = false;
  float* h; const float* mods; int rowoff, gidx; float scale;
  DEVI void operator()(const pf4 (&acc)[2][2][4][2], const pg8::Unit& u, int wr, int wc, int fr, int fq) const {
    const int row0 = rowoff + u.pm * 256 + wr * 64 + fr, col0 = u.pn * 256 + wc * 32 + 4 * fq;
#pragma unroll
    for (int ai = 0; ai < 2; ++ai)
#pragma unroll
      for (int m = 0; m < 4; ++m) {
        const int r = row0 + ai * 128 + m * 16;
        float* rowp = h + (size_t)r * 1024 + col0;
        const float* gp = mods + (r >> 13) * 9216 + gidx * 1024 + col0;
#pragma unroll
        for (int bj = 0; bj < 2; ++bj)
#pragma unroll
          for (int n = 0; n < 2; ++n) {
            float4 hv = ld4(rowp + bj * 128 + n * 16); const float4 g = ld4(gp + bj * 128 + n * 16); const pf4 a = acc[ai][bj][m][n];
            hv.x += scale * g.x * a[0]; hv.y += scale * g.y * a[1]; hv.z += scale * g.z * a[2]; hv.w += scale * g.w * a[3];
            *(float4*)(rowp + bj * 128 + n * 16) = hv;
          }
      }
  }
};
template <int MODE> struct EpiMix {
  static constexpr bool PERM = true, AFTER_DRAIN = false;
  bfraw* d0; bfraw* d1; bfraw* d2; bfraw* d3;
  DEVI void operator()(const pf4 (&acc)[2][2][4][2], const pg8::Unit& u, int wr, int wc, int fr, int fq) const {
    const int row0 = u.pm * 256 + wr * 64 + fr;
    const int pc = u.pn >> 2;
    bfraw* dst = MODE == 0 ? d0 : (MODE == 1 || MODE == 2) ? (pc == 0 ? d0 : pc == 1 ? d1 : pc == 2 ? d2 : d3) : (MODE == 3 ? d0 : d1);
    const int ld = MODE == 0 ? 3072 : 1024;
    const int col0 = (MODE == 1 || MODE == 2 ? (u.pn & 3) : u.pn) * 256 + wc * 32 + 8 * fq;
#pragma unroll
    for (int ai = 0; ai < 2; ++ai)
#pragma unroll
      for (int m = 0; m < 4; ++m) {
        const size_t ro = (size_t)(row0 + ai * 128 + m * 16) * ld + col0;
#pragma unroll
        for (int bj = 0; bj < 2; ++bj) {
          float v[8];
#pragma unroll
          for (int e = 0; e < 4; ++e) { v[e] = acc[ai][bj][m][0][e]; v[4 + e] = acc[ai][bj][m][1][e]; }
          bfraw* dp = dst + ro + bj * 128;
          if (MODE == 1) { if (pc == 3) {
#pragma unroll
            for (int e = 0; e < 8; ++e) v[e] = geluf_(v[e]); } }
          if (MODE == 2 || MODE == 3 || MODE == 4) {
            const uint4 o = *(const uint4*)dp; const unsigned ow[4] = {o.x, o.y, o.z, o.w};
            float p[8];
#pragma unroll
            for (int e = 0; e < 4; ++e) { p[2 * e] = bf2f((bfraw)(ow[e] & 0xffff)); p[2 * e + 1] = bf2f((bfraw)(ow[e] >> 16)); }
            if (MODE == 2) {
#pragma unroll
              for (int e = 0; e < 8; ++e) v[e] = pc == 0 ? sigmoidf_(v[e]) * p[e] : pc == 1 ? geluf_(v[e]) * p[e] : sigmoidf_(v[e]);
            } else if (MODE == 3) {
#pragma unroll
              for (int e = 0; e < 8; ++e) v[e] *= p[e];
            } else {
              const uint4 t = *(const uint4*)(d0 + ro + bj * 128); const unsigned tw[4] = {t.x, t.y, t.z, t.w};
#pragma unroll
              for (int e = 0; e < 4; ++e) { v[2 * e] = bf2f((bfraw)(tw[e] & 0xffff)) + p[2 * e] * v[2 * e]; v[2 * e + 1] = bf2f((bfraw)(tw[e] >> 16)) + p[2 * e + 1] * v[2 * e + 1]; }
            }
          }
          uint4 w; w.x = pg8::cvt_pk_bf16(v[0], v[1]); w.y = pg8::cvt_pk_bf16(v[2], v[3]); w.z = pg8::cvt_pk_bf16(v[4], v[5]); w.w = pg8::cvt_pk_bf16(v[6], v[7]);
          *(uint4*)dp = w;
        }
      }
  }
};
template <class Epi>
DEVI void run8(unsigned char* lds, const bfraw* A, const bfraw* Bt, int M, int N, int K, const Epi& E) {
  pg8::Gemm g{A, Bt, M, N, K};
  pg8::StaticOrder S; S.init(M, N, (int)gridDim.x, (int)blockIdx.x);
  pg8::gemm_phase<Epi, pg8::StaticOrder, false>((PG8_LAS unsigned char*)lds, g, S, E, nullptr);
}

DEVI void tr_tile(const float* __restrict__ src, int ldw, int col0, int kt, int nt, bfraw* dst, int K, int drow0, int mode, float* t) {
  const int tid = ltid();
  __syncthreads();
#pragma unroll
  for (int i = 0; i < 8; ++i) { int e = tid + i * NTHR; int kk = e >> 6, nn = e & 63; t[kk * 65 + nn] = src[(size_t)(kt * 64 + kk) * ldw + col0 + nt * 64 + nn]; }
  __syncthreads();
#pragma unroll
  for (int i = 0; i < 8; ++i) {
    int e = tid + i * NTHR; int nn = e >> 6, kk = e & 63;
    int n = nt * 64 + nn, dr;
    if (mode == 1) { int isb = n >= 2816; int f = n - isb * 2816; dr = (f >> 4) * 32 + isb * 16 + (f & 15); } else dr = drow0 + n;
    dst[(size_t)dr * K + kt * 64 + kk] = f2bf(t[kk * 65 + nn]);
  }
}

DEVI void phase_p0(const P& p, unsigned char* lds) {
  float* sf = (float*)lds;
  const int tid = ltid();
  for (int i = tid; i < 3072; i += NTHR) { float v = i < 2048 ? p.in[I_C][i] : p.in[I_CCTX][i - 2048]; sf[i] = siluf_(v); }
  __syncthreads();
  {
    const float* w = p.in[I_WADA];
    float* mp = (float*)(p.ws + O_MODSP);
    for (int id = blockIdx.x * NTHR + tid; id < 16 * 9216; id += gridDim.x * NTHR) {
      int s = id / 9216, j = id - s * 9216;
      float a0 = 0, a1 = 0, a2 = 0;
#pragma unroll 8
      for (int k = s * 64; k < s * 64 + 64; ++k) { float wv = w[(size_t)k * 9216 + j]; a0 += sf[k] * wv; a1 += sf[1024 + k] * wv; a2 += sf[2048 + k] * wv; }
      mp[(s * 3 + 0) * 9216 + j] = a0; mp[(s * 3 + 1) * 9216 + j] = a1; mp[(s * 3 + 2) * 9216 + j] = a2;
    }
  }
  __syncthreads();
  for (int t = blockIdx.x; t < 7040; t += gridDim.x) {
    int u = t;
    if (u < 1408) { tr_tile(p.in[I_W1IN], 5632, 0, u / 88, u % 88, (bfraw*)(p.ws + O_W1IN), 1024, 0, 1, sf); continue; }
    u -= 1408;
    if (u < 704) { tr_tile(p.in[I_W1OUT], 1024, 0, u / 16, u % 16, (bfraw*)(p.ws + O_W1OUT), 2816, 0, 0, sf); continue; }
    u -= 704;
    if (u < 2048) {
      int pc = u >> 8; u &= 255;
      const int c0[8] = {0, 1024, 2048, 5136, 3088, 4112, 6160, 7184};
      int col0 = pc == 0 ? 0 : pc == 1 ? 1024 : pc == 2 ? 2048 : pc == 3 ? 5136 : pc == 4 ? 3088 : pc == 5 ? 4112 : pc == 6 ? 6160 : 7184;
      (void)c0;
      tr_tile(p.in[I_WIN], 8208, col0, u >> 4, u & 15, (bfraw*)(p.ws + (pc < 4 ? O_WTA : O_WTB)), 1024, (pc & 3) * 1024, 0, sf); continue;
    }
    u -= 2048;
    if (u < 768) { int m = u >> 8; u &= 255; tr_tile(p.in[m == 0 ? I_WA : m == 1 ? I_WB : I_WO], 1024, 0, u >> 4, u & 15, (bfraw*)(p.ws + (m == 0 ? O_WA : m == 1 ? O_WB : O_WO)), 1024, 0, 0, sf); continue; }
    u -= 768;
    if (u < 1408) { tr_tile(p.in[I_W2IN], 5632, 0, u / 88, u % 88, (bfraw*)(p.ws + O_W2IN), 1024, 0, 1, sf); continue; }
    u -= 1408;
    tr_tile(p.in[I_W2OUT], 1024, 0, u / 16, u % 16, (bfraw*)(p.ws + O_W2OUT), 2816, 0, 0, sf);
  }
  { bfraw* d = (bfraw*)(p.ws + O_WSB); for (int id = blockIdx.x * NTHR + tid; id < 65536; id += gridDim.x * NTHR) d[id] = f2bf(p.in[I_WS][id]); }
}

DEVI void phase_p0b(const P& p) {
  const float* mp = (const float*)(p.ws + O_MODSP);
  float* m = (float*)(p.ws + O_MODS);
  for (int id = blockIdx.x * NTHR + ltid(); id < 3 * 9216; id += gridDim.x * NTHR) {
    int j = id % 9216;
    float a = p.in[I_BADA][j];
    for (int s = 0; s < 16; ++s) a += mp[s * 3 * 9216 + id];
    m[id] = a;
  }
}

template <int MODE>
DEVI void phase_rows(const P& p, unsigned char* lds) {
  const int tid = ltid(), lane = tid & 63, wid = tid >> 6;
  const float* mods = (const float*)(p.ws + O_MODS);
  float* hctx = (float*)(p.ws + O_HCTX);
  bfraw* hn = (bfraw*)(p.ws + O_HN);
  float* wg = (float*)lds;
  if (MODE == 2) {
    __syncthreads();
    for (int i = tid; i < 16384; i += NTHR) { int k = i >> 4, g = i & 15; wg[g * 1024 + k] = p.in[I_WIN][(size_t)k * 8208 + 3072 + g]; }
    __syncthreads();
  }
  const int nrows = (MODE == 1 || MODE == 2) ? 16896 : 16384;
  const float* gvec = p.in[MODE == 1 ? I_GFFN1 : MODE == 2 ? I_GMIX : MODE == 3 ? I_GFFN2 : I_GFINAL];
  const int msh = MODE == 1 ? 0 : MODE == 2 ? 3 : 6;
  for (int row = blockIdx.x * 8 + wid; row < nrows; row += gridDim.x * 8) {
    const bool lat = row < 16384;
    const int mrow = lat ? (row >> 13) : 2;
    float4 v[4];
    if (MODE == 1) {
      const float* src = lat ? p.in[I_X] + (size_t)row * 1024 : p.in[I_CTX] + (size_t)(row - 16384) * 1024;
#pragma unroll
      for (int i = 0; i < 4; ++i) v[i] = *(const float4*)(src + i * 256 + lane * 4);
      if (lat) {
        int ts = row & 8191; float rr = (float)(ts >> 6), cc = (float)(ts & 63);
        float fqv[4];
#pragma unroll
        for (int e = 0; e < 4; ++e) fqv[e] = expf((-9.210340371976184f * (float)(lane * 4 + e)) / 256.f);
        v[0].x += redsin(rr * fqv[0], false); v[0].y += redsin(rr * fqv[1], false); v[0].z += redsin(rr * fqv[2], false); v[0].w += redsin(rr * fqv[3], false);
        v[1].x += redsin(rr * fqv[0], true);  v[1].y += redsin(rr * fqv[1], true);  v[1].z += redsin(rr * fqv[2], true);  v[1].w += redsin(rr * fqv[3], true);
        v[2].x += redsin(cc * fqv[0], false); v[2].y += redsin(cc * fqv[1], false); v[2].z += redsin(cc * fqv[2], false); v[2].w += redsin(cc * fqv[3], false);
        v[3].x += redsin(cc * fqv[0], true);  v[3].y += redsin(cc * fqv[1], true);  v[3].z += redsin(cc * fqv[2], true);  v[3].w += redsin(cc * fqv[3], true);
      }
      float* dsth = lat ? p.out + (size_t)row * 1024 : hctx + (size_t)(row - 16384) * 1024;
#pragma unroll
      for (int i = 0; i < 4; ++i) *(float4*)(dsth + i * 256 + lane * 4) = v[i];
    } else {
      const float* src = lat ? p.out + (size_t)row * 1024 : hctx + (size_t)(row - 16384) * 1024;
#pragma unroll
      for (int i = 0; i < 4; ++i) v[i] = *(const float4*)(src + i * 256 + lane * 4);
    }
    float ss = 0;
#pragma unroll
    for (int i = 0; i < 4; ++i) ss += v[i].x * v[i].x + v[i].y * v[i].y + v[i].z * v[i].z + v[i].w * v[i].w;
    ss = wave_sum(ss);
    const float rs = rsqrtf(ss * (1.f / 1024.f) + EPS);
    if (MODE == 4) {
#pragma unroll
      for (int i = 0; i < 4; ++i) {
        float4 g = *(const float4*)(gvec + i * 256 + lane * 4);
        float4 o = {v[i].x * rs * g.x, v[i].y * rs * g.y, v[i].z * rs * g.z, v[i].w * rs * g.w};
        *(float4*)(p.out + (size_t)row * 1024 + i * 256 + lane * 4) = o;
      }
    } else {
      const float* sh = mods + (size_t)(mrow * 9216 + msh * 1024);
      const float* scp = sh + 1024;
      float y[16];
#pragma unroll
      for (int i = 0; i < 4; ++i) {
        const int c = i * 256 + lane * 4;
        float4 g = *(const float4*)(gvec + c), s4 = *(const float4*)(sh + c), c4 = *(const float4*)(scp + c);
        y[i * 4 + 0] = v[i].x * rs * g.x * (1.f + c4.x) + s4.x; y[i * 4 + 1] = v[i].y * rs * g.y * (1.f + c4.y) + s4.y;
        y[i * 4 + 2] = v[i].z * rs * g.z * (1.f + c4.z) + s4.z; y[i * 4 + 3] = v[i].w * rs * g.w * (1.f + c4.w) + s4.w;
        uint2 pk; pk.x = (unsigned)f2bf(y[i * 4]) | ((unsigned)f2bf(y[i * 4 + 1]) << 16); pk.y = (unsigned)f2bf(y[i * 4 + 2]) | ((unsigned)f2bf(y[i * 4 + 3]) << 16);
        *(uint2*)(hn + (size_t)row * 1024 + c) = pk;
      }
      if (MODE == 2) {
        float mine = 0.f;
#pragma unroll 2
        for (int g2 = 0; g2 < 16; ++g2) {
          float a = 0.f;
#pragma unroll
          for (int i = 0; i < 4; ++i) { float4 w4 = *(const float4*)(wg + g2 * 1024 + i * 256 + lane * 4); a += y[i * 4] * w4.x + y[i * 4 + 1] * w4.y + y[i * 4 + 2] * w4.z + y[i * 4 + 3] * w4.w; }
          a = wave_sum(a);
          if (lane == g2) mine = a;
        }
        if (lane < 16) ((float*)(p.ws + O_GATES))[(size_t)row * 16 + lane] = mine;
      }
    }
  }
}

DEVI void phase_ffn_in(const P& p, unsigned char* lds, size_t o_w, int nrows) {
  EpiFfnIn E{(bfraw*)(p.ws + O_ACT)};
  run8(lds, (const bfraw*)(p.ws + O_HN), (const bfraw*)(p.ws + o_w), nrows, 5632, 1024, E);
}

DEVI void phase_ffn_out(const P& p, unsigned char* lds, size_t o_w, int gidx, bool with_ctx) {
  EpiResid E{p.out, (const float*)(p.ws + O_MODS), 0, gidx, 0.5f};
  run8(lds, (const bfraw*)(p.ws + O_ACT), (const bfraw*)(p.ws + o_w), 16384, 1024, 2816, E);
  if (with_ctx) {
    const bfraw* act = (const bfraw*)(p.ws + O_ACT) + (size_t)16384 * 2816;
    const bfraw* W = (const bfraw*)(p.ws + o_w);
    const float* mods = (const float*)(p.ws + O_MODS);
    float* hctx = (float*)(p.ws + O_HCTX);
    __syncthreads();
    for (int t = blockIdx.x; t < 16 * 11; t += gridDim.x) {
      const int ks = t % 11, tt = t / 11, tm = tt >> 2, tn = tt & 3;
      f32x4 acc[4][4]; ZERO_ACC(acc, 4, 4);
      gemm_tile<128, 256, false, false, false>(act + (size_t)tm * 128 * 2816 + ks * 256, 2816, W + (size_t)tn * 256 * 2816 + ks * 256, 2816, 256, nullptr, acc, (bfraw*)lds, nullptr, 0);
      EPI_BEGIN(128, 256)
        const int grow = tm * 128 + row, gcol = tn * 256 + col;
        atomicAdd(hctx + (size_t)grow * 1024 + gcol, 0.5f * mods[2 * 9216 + gidx * 1024 + gcol] * acc[i][j][r]);
      EPI_END
    }
  }
}

DEVI void phase_g3c(const P& p, unsigned char* lds) {
  EpiMix<0> E{(bfraw*)(p.ws + O_CTXRAW), nullptr, nullptr, nullptr};
  run8(lds, (const bfraw*)(p.ws + O_HN) + (size_t)16384 * 1024, (const bfraw*)(p.ws + O_WTA), 512, 3072, 1024, E);
}

DEVI void phase_g3a(const P& p, unsigned char* lds, int hb) {
  EpiMix<1> E{(bfraw*)(p.ws + O_QRAW), (bfraw*)(p.ws + O_KRAW), (bfraw*)(p.ws + O_V), (bfraw*)(p.ws + O_GVS)};
  run8(lds, (const bfraw*)(p.ws + O_HN) + (size_t)hb * 8192 * 1024, (const bfraw*)(p.ws + O_WTA), 8192, 4096, 1024, E);
}

DEVI void phase_g3b(const P& p, unsigned char* lds, int hb) {
  EpiMix<2> E{(bfraw*)(p.ws + O_V), (bfraw*)(p.ws + O_GVS), (bfraw*)(p.ws + O_QC), (bfraw*)(p.ws + O_KC)};
  run8(lds, (const bfraw*)(p.ws + O_HN) + (size_t)hb * 8192 * 1024, (const bfraw*)(p.ws + O_WTB), 8192, 4096, 1024, E);
}

DEVI void phase_g4(const P& p, unsigned char* lds) {
  EpiMix<3> E3{(bfraw*)(p.ws + O_QC), (bfraw*)(p.ws + O_KC), nullptr, nullptr};
  run8(lds, (const bfraw*)(p.ws + O_V), (const bfraw*)(p.ws + O_WA), 8192, 1024, 1024, E3);
  EpiMix<4> E4{(bfraw*)(p.ws + O_QC), (bfraw*)(p.ws + O_KC), nullptr, nullptr};
  run8(lds, (const bfraw*)(p.ws + O_GVS), (const bfraw*)(p.ws + O_WB), 8192, 1024, 1024, E4);
}

DEVI void phase_g5(const P& p, unsigned char* lds, int hb) {
  EpiResid E{p.out, (const float*)(p.ws + O_MODS), hb * 8192, 5, 1.f};
  run8(lds, (const bfraw*)(p.ws + O_KC), (const bfraw*)(p.ws + O_WO), 8192, 1024, 1024, E);
}

DEVI uint4 conv8(uint4 a, uint4 b, uint4 c, const float* w, const float* bias, int ch, float scale) {
  unsigned av[4] = {a.x, a.y, a.z, a.w}, bv[4] = {b.x, b.y, b.z, b.w}, cv[4] = {c.x, c.y, c.z, c.w}, ov[4];
#pragma unroll
  for (int e = 0; e < 4; ++e) {
    float r[2];
#pragma unroll
    for (int h = 0; h < 2; ++h) {
      int cc = ch + e * 2 + h;
      float xa = bf2f((bfraw)(h ? av[e] >> 16 : av[e] & 0xffff)), xb = bf2f((bfraw)(h ? bv[e] >> 16 : bv[e] & 0xffff)), xc = bf2f((bfraw)(h ? cv[e] >> 16 : cv[e] & 0xffff));
      float y = xa * w[cc] + xb * w[2048 + cc] + xc * w[4096 + cc] + bias[cc];
      r[h] = siluf_(y) * scale;
    }
    ov[e] = (unsigned)f2bf(r[0]) | ((unsigned)f2bf(r[1]) << 16);
  }
  return uint4{ov[0], ov[1], ov[2], ov[3]};
}

DEVI void phase_cv(const P& p, int hb) {
  const int lane = ltid() & 63, wid = ltid() >> 6;
  const bfraw* qraw = (const bfraw*)(p.ws + O_QRAW);
  const bfraw* kraw = (const bfraw*)(p.ws + O_KRAW);
  const bfraw* craw = (const bfraw*)(p.ws + O_CTXRAW) + (size_t)hb * 256 * 3072;
  bfraw* qc = (bfraw*)(p.ws + O_QC);
  bfraw* kc = (bfraw*)(p.ws + O_KC);
  bfraw* vv = (bfraw*)(p.ws + O_V);
  const bfraw* gvs = (const bfraw*)(p.ws + O_GVS);
  float* rsb = (float*)(p.ws + O_RS);
  const float* cw = p.in[I_CONVW];
  const float* cb = p.in[I_CONVB];
  const uint4 z = {0, 0, 0, 0};
  for (int row = blockIdx.x * 8 + wid; row < 8448; row += gridDim.x * 8) {
    const bool lat = row < 8192;
    const int lr = lat ? row : row - 8192, len = lat ? 8192 : 256;
    const bfraw* qb = lat ? qraw : craw;
    const bfraw* kb = lat ? kraw : craw + 1024;
    const size_t ld = lat ? 1024 : 3072;
#pragma unroll
    for (int hlf = 0; hlf < 2; ++hlf) {
      const int ch = hlf * 512 + lane * 8;
      uint4 qa = lr > 0 ? *(const uint4*)(qb + (size_t)(lr - 1) * ld + ch) : z;
      uint4 qm = *(const uint4*)(qb + (size_t)lr * ld + ch);
      uint4 qn = lr < len - 1 ? *(const uint4*)(qb + (size_t)(lr + 1) * ld + ch) : z;
      *(uint4*)(qc + (size_t)row * 1024 + ch) = conv8(qa, qm, qn, cw, cb, ch, 0.0625f);
      uint4 ka = lr > 0 ? *(const uint4*)(kb + (size_t)(lr - 1) * ld + ch) : z;
      uint4 km = *(const uint4*)(kb + (size_t)lr * ld + ch);
      uint4 kn = lr < len - 1 ? *(const uint4*)(kb + (size_t)(lr + 1) * ld + ch) : z;
      *(uint4*)(kc + (size_t)row * 1024 + ch) = conv8(ka, km, kn, cw, cb, 1024 + ch, 1.f);
      if (!lat) *(uint4*)(vv + (size_t)row * 1024 + ch) = *(const uint4*)(craw + 2048 + (size_t)lr * 3072 + ch);
    }
    if (lat) {
      float ss = 0;
#pragma unroll
      for (int hlf = 0; hlf < 2; ++hlf) {
        uint4 g = *(const uint4*)(gvs + (size_t)row * 1024 + hlf * 512 + lane * 8);
        unsigned gv[4] = {g.x, g.y, g.z, g.w};
#pragma unroll
        for (int e = 0; e < 4; ++e) { float a = bf2f((bfraw)(gv[e] & 0xffff)), b = bf2f((bfraw)(gv[e] >> 16)); ss += a * a + b * b; }
      }
      ss = wave_sum(ss);
      if (lane == 0) rsb[row] = rsqrtf(ss * (1.f / 1024.f) + EPS);
    }
  }
}

DEVI void phase_ma(const P& p, unsigned char* lds, int hb) {
  const int tid = ltid();
  bfraw* st = (bfraw*)lds;
  float* sc = (float*)(lds + 131072);
  float* s_w = sc + 128, *s_ws = sc + 256, *s_red = sc + 384, *s_part = sc + 512;
  const float* bg = p.in[I_BGATES];
  for (int item = blockIdx.x; item < 528 + 256; item += gridDim.x) {
    unsigned char* wsb = lws(p.ws);
    const float* gates = (const float*)(wsb + O_GATES);
    const bfraw* kc = (const bfraw*)(wsb + O_KC);
    const bfraw* vv = (const bfraw*)(wsb + O_V);
    bfraw* states = (bfraw*)(wsb + O_ST);
    float* nloc = (float*)(wsb + O_NLOC);
    float* mg = (float*)(wsb + O_MG);
    if (item < 528) {
      const int seq = item / 66, j = item % 66, d = seq >> 2, h = seq & 3;
      int rbase, grow;
      if (j < 2) { int cc = d == 0 ? j : 1 - j; rbase = 8192 + cc * 128; grow = 16384 + hb * 256 + cc * 128; }
      else { int c = d == 0 ? j - 2 : 65 - j; rbase = c * 128; grow = hb * 8192 + c * 128; }
      __syncthreads();
      const int el = d == 0 ? (tid & 127) : 127 - (tid & 127);
      float li = 0.f, lf = 0.f;
      if (tid < 128) {
        li = gates[(size_t)(grow + el) * 16 + d * 8 + h] + bg[d * 8 + h];
        lf = logsigf_(gates[(size_t)(grow + el) * 16 + d * 8 + 4 + h] + bg[d * 8 + 4 + h]);
      }
      const float bcum = seg_scan_sum(lf, tid, s_red + 4);
      if (tid == 127) s_red[1] = bcum;
      __syncthreads();
      const float gtot = s_red[1];
      const float wv = gtot - bcum + li;
      if (tid < 128) s_w[el] = wv;
      __syncthreads();
      if (tid < 64) {
        float m = fmaxf(s_w[tid], s_w[tid + 64]);
#pragma unroll
        for (int o = 32; o > 0; o >>= 1) m = fmaxf(m, __shfl_xor(m, o, 64));
        if (tid == 0) s_red[0] = m;
      }
      __syncthreads();
      const float mloc = s_red[0];
      if (tid < 128) s_ws[el] = expf(wv - mloc);
      if (tid == 0) { mg[seq * 66 + j] = mloc; mg[528 + seq * 66 + j] = gtot; }
      __syncthreads();
      {
        const int k = tid & 255, part = tid >> 8;
        const bfraw* kp0 = kc + (size_t)(rbase + part * 64) * 1024 + h * 256 + k;
        float n = 0;
#pragma unroll 16
        for (int t = 0; t < 64; ++t) n += s_ws[part * 64 + t] * bf2f(kp0[(size_t)t * 1024]);
        s_part[tid] = n;
      }
      bfraw* dst = states + (size_t)(seq * 66 + j) * 65536;
#pragma unroll 1
      for (int vh = 0; vh < 2; ++vh) {
        f32x4 acc[4][4]; ZERO_ACC(acc, 4, 4);
        gemm_tile<128, 256, true, true, false>(vv + (size_t)rbase * 1024 + h * 256 + vh * 128, 1024, kc + (size_t)rbase * 1024 + h * 256, 1024, 128, s_ws, acc, st, nullptr, 0);
        EPI_BEGIN(128, 256)
          dst[(vh * 128 + row) * 256 + col] = f2bf(acc[i][j][r]);
        EPI_END
      }
      if (tid < 256) nloc[(size_t)(seq * 66 + j) * 256 + tid] = s_part[tid] + s_part[tid + 256];
    } else {
      const int it = item - 528, c = it >> 2, g = it & 3;
      bfraw* gvs = (bfraw*)(wsb + O_GVS);
      const float* rsb = (const float*)(wsb + O_RS);
      f32x4 acc[4][4]; ZERO_ACC(acc, 4, 4);
      gemm_tile<128, 256, false, true, false>((const bfraw*)(wsb + O_WSB) + g * 16384, 128, gvs + (size_t)c * 128 * 1024 + g * 256, 1024, 128, rsb + c * 128, acc, st, nullptr, 0);
      const float* gs = p.in[I_GSGU] + g * 256;
      const float* bs = p.in[I_BS] + g * 128;
      EPI_BEGIN(128, 256)
        gvs[(size_t)(c * 128 + row) * 1024 + g * 256 + col] = f2bf(gs[col] * acc[i][j][r] + bs[row]);
      EPI_END
    }
  }
}

DEVI void phase_mb(const P& p) {
  bfraw* states = (bfraw*)(p.ws + O_ST);
  const float* mg = (const float*)(p.ws + O_MG);
  float* ment = (float*)(p.ws + O_MG) + 1056;
  const float* nloc = (const float*)(p.ws + O_NLOC);
  float* nent = (float*)(p.ws + O_NENT);
  const int gid = blockIdx.x * NTHR + ltid(), gsz = gridDim.x * NTHR;
  for (int id = gid; id < 8 * 16384; id += gsz) {
    const int seq = id >> 14, e = (id & 16383) * 4;
    float s0 = 0, s1 = 0, s2 = 0, s3 = 0, m = 0;
    bfraw* base = states + (size_t)seq * 66 * 65536 + e;
#pragma unroll 1
    for (int cb = 0; cb < 66; cb += 22) {
      uint2 buf[22];
#pragma unroll
      for (int i = 0; i < 22; ++i) buf[i] = *(const uint2*)(base + (size_t)(cb + i) * 65536);
#pragma unroll
      for (int i = 0; i < 22; ++i) {
        const int j = cb + i;
        const uint2 cur = buf[i];
        const float mloc = mg[seq * 66 + j], g = mg[528 + seq * 66 + j];
        const float mnew = fmaxf(g + m, mloc);
        const float dec = expf(g + m - mnew), scl = expf(mloc - mnew);
        if (e == 0) ment[seq * 66 + j] = m;
        uint2 o; o.x = (unsigned)f2bf(s0) | ((unsigned)f2bf(s1) << 16); o.y = (unsigned)f2bf(s2) | ((unsigned)f2bf(s3) << 16);
        *(uint2*)(base + (size_t)j * 65536) = o;
        s0 = dec * s0 + scl * bf2f((bfraw)(cur.x & 0xffff)); s1 = dec * s1 + scl * bf2f((bfraw)(cur.x >> 16));
        s2 = dec * s2 + scl * bf2f((bfraw)(cur.y & 0xffff)); s3 = dec * s3 + scl * bf2f((bfraw)(cur.y >> 16));
        m = mnew;
      }
    }
  }
  for (int id = gid; id < 8 * 256; id += gsz) {
    const int seq = id >> 8, k = id & 255;
    float n = 0, m = 0;
    for (int j = 0; j < 66; ++j) {
      const float mloc = mg[seq * 66 + j], g = mg[528 + seq * 66 + j];
      const float mnew = fmaxf(g + m, mloc);
      const float dec = expf(g + m - mnew), scl = expf(mloc - mnew);
      nent[(size_t)(seq * 66 + j) * 256 + k] = n;
      n = dec * n + scl * nloc[(size_t)(seq * 66 + j) * 256 + k];
      m = mnew;
    }
  }
}

DEVI void phase_mc(const P& p, unsigned char* lds, int hb) {
  const int tid = ltid(), lane = tid & 63, wid = tid >> 6, wm = wid >> 2, wn = wid & 3, fr = lane & 15, fq = lane >> 4;
  bfraw* st = (bfraw*)lds;
  bfraw* sS = (bfraw*)(lds + 61440);
  float* sc = (float*)(lds + 131072);
  float* s_b = sc, *s_u = sc + 256, *s_mt = sc + 512, *s_in = sc + 768, *s_den = sc + 1024, *s_dq = sc + 1280, *s_tmp = sc + 1536;
  float* s_sum = sc + 1792, *s_sq = sc + 1920;
  const float* bg = p.in[I_BGATES];
  for (int item = blockIdx.x; item < 256; item += gridDim.x) {
    unsigned char* wsb = lws(p.ws);
    const float* gates = (const float*)(wsb + O_GATES);
    const bfraw* qc = (const bfraw*)(wsb + O_QC);
    const bfraw* kc = (const bfraw*)(wsb + O_KC);
    bfraw* vv = (bfraw*)(wsb + O_V);
    const bfraw* states = (const bfraw*)(wsb + O_ST);
    const float* ment = (const float*)(wsb + O_MG) + 1056;
    const float* nent = (const float*)(wsb + O_NENT);
    const int c = item >> 2, h = item & 3, R0 = c * 128;
    const bfraw* qp = qc + (size_t)R0 * 1024 + h * 256;
    const bfraw* kp = kc + (size_t)R0 * 1024 + h * 256;
    __syncthreads();
    {
      const int d = (tid >> 7) & 1, t = tid & 127, el = d == 0 ? t : 127 - t, ix = d * 128 + el;
      float li = 0.f, lf = 0.f;
      if (tid < 256) {
        const size_t grow = (size_t)hb * 8192 + R0 + el;
        li = gates[grow * 16 + d * 8 + h] + bg[d * 8 + h];
        lf = logsigf_(gates[grow * 16 + d * 8 + 4 + h] + bg[d * 8 + 4 + h]);
        s_den[tid] = 0.f;
        if (tid < 128) { s_sum[tid] = 0.f; s_sq[tid] = 0.f; }
      }
      const float b = seg_scan_sum(lf, tid, s_tmp);
      const float uu = li - b;
      const float pm = seg_scan_max(tid < 256 ? uu : -INFINITY, tid, s_tmp);
      if (tid < 256) {
        const int seq = d * 4 + h, j = d == 0 ? c + 2 : 65 - c;
        const float mst = ment[seq * 66 + j];
        const float a = b + mst;
        const float mt = fmaxf(a, b + pm);
        s_b[ix] = b; s_u[ix] = uu; s_mt[ix] = mt; s_in[ix] = expf(a - mt);
      }
    }
    {
      const int row = tid >> 2, part = tid & 3;
      const bfraw* q1 = qp + (size_t)row * 1024 + part * 64;
      const float* nf = nent + (size_t)((0 + h) * 66 + (c + 2)) * 256 + part * 64;
      const float* nb = nent + (size_t)((4 + h) * 66 + (65 - c)) * 256 + part * 64;
      float af = 0, ab = 0;
#pragma unroll 4
      for (int k = 0; k < 64; ++k) { float q = bf2f(q1[k]); af += q * nf[k]; ab += q * nb[k]; }
      af += __shfl_xor(af, 1, 64); af += __shfl_xor(af, 2, 64);
      ab += __shfl_xor(ab, 1, 64); ab += __shfl_xor(ab, 2, 64);
      if (part == 0) { s_dq[row] = af; s_dq[128 + row] = ab; }
    }
    __syncthreads();
    {
      f32x4 S[4][2]; ZERO_ACC(S, 4, 2);
      gemm_tile<128, 128, false, false, false>(qp, 1024, kp, 1024, 256, nullptr, S, st, nullptr, 0);
#pragma unroll 1
      for (int d = 0; d < 2; ++d)
#pragma unroll
        for (int i = 0; i < 4; ++i)
#pragma unroll
          for (int r = 0; r < 4; ++r) {
            const int row = wm * 64 + i * 16 + fq * 4 + r;
            const float bt = s_b[d * 128 + row] - s_mt[d * 128 + row];
            float rs = 0;
#pragma unroll
            for (int j = 0; j < 2; ++j) {
              const int col = wn * 32 + j * 16 + fr;
              const bool valid = d == 0 ? (col <= row) : (col >= row);
              const float val = valid ? S[i][j][r] * expf(bt + s_u[d * 128 + col]) : 0.f;
              rs += val;
              sS[(d * 128 + row) * 136 + col] = f2bf(val);
            }
            rs = red16(rs);
            if (fr == 0) atomicAdd(&s_den[d * 128 + row], rs);
          }
    }
    __syncthreads();
    f32x4 hs[4][4];
    bfraw* hpark = (bfraw*)(wsb + O_HPARK) + (size_t)R0 * 1024 + h * 256;
#pragma unroll 1
    for (int d = 0; d < 2; ++d) {
      f32x4 (&acc)[4][4] = hs; ZERO_ACC(acc, 4, 4);
      const int seq = d * 4 + h, j2 = d == 0 ? c + 2 : 65 - c;
      gemm_tile<128, 256, false, false, false>(qp, 1024, states + (size_t)(seq * 66 + j2) * 65536, 256, 256, nullptr, acc, st, nullptr, 0);
      EPIR_BEGIN(128, 256)
        const float sin_ = s_in[d * 128 + row];
        EPIR_COLS(256) acc[i][j][r] *= sin_; (void)col;
      EPIR_END
      gemm_tile<128, 256, false, true, true>(nullptr, 0, vv + (size_t)R0 * 1024 + h * 256, 1024, 128, nullptr, acc, st, sS + d * 128 * 136, 136);
      EPIR_BEGIN(128, 256)
        const float den = s_den[d * 128 + row] + s_in[d * 128 + row] * s_dq[d * 128 + row];
        const float inv = 1.f / fmaxf(fabsf(den), expf(-s_mt[d * 128 + row]));
        EPIR_COLS(256)
          const float hv = acc[i][j][r] * inv;
          if (d == 0) hpark[(size_t)row * 1024 + col] = f2bf(hv);
          else hs[i][j][r] = hv + bf2f(hpark[(size_t)row * 1024 + col]);
      EPIR_END
    }
#pragma unroll
    for (int i = 0; i < 4; ++i)
#pragma unroll
      for (int r = 0; r < 4; ++r) {
        float ps = hs[i][0][r] + hs[i][1][r] + hs[i][2][r] + hs[i][3][r];
        ps = red16(ps);
        if (fr == 0) atomicAdd(&s_sum[wm * 64 + i * 16 + fq * 4 + r], ps);
      }
    __syncthreads();
#pragma unroll
    for (int i = 0; i < 4; ++i)
#pragma unroll
      for (int r = 0; r < 4; ++r) {
        const float mu = s_sum[wm * 64 + i * 16 + fq * 4 + r] * (1.f / 256.f);
        float ps = 0;
#pragma unroll
        for (int j = 0; j < 4; ++j) { float dlt = hs[i][j][r] - mu; ps += dlt * dlt; }
        ps = red16(ps);
        if (fr == 0) atomicAdd(&s_sq[wm * 64 + i * 16 + fq * 4 + r], ps);
      }
    __syncthreads();
    const float* gh = p.in[I_GHEAD] + h * 256;
    EPIR_BEGIN(128, 256)
      const float mu = s_sum[row] * (1.f / 256.f);
      const float rstd = rsqrtf(s_sq[row] * (1.f / 256.f) + EPS);
      EPIR_COLS(256)
        vv[(size_t)(R0 + row) * 1024 + h * 256 + col] = f2bf((hs[i][j][r] - mu) * rstd * gh[col]);
    EPIR_END
  }
}

constexpr int NPH = 27;
#define PHASE_PROGRAM \
  PHASE(0, phase_p0(p, lds)) \
  PHASE(1, phase_p0b(p)) \
  PHASE(2, phase_rows<1>(p, lds)) \
  PHASE(3, phase_ffn_in(p, lds, O_W1IN, 16896)) \
  PHASE(4, phase_ffn_out(p, lds, O_W1OUT, 2, true)) \
  PHASE(5, phase_rows<2>(p, lds)) \
  PHASE(6, phase_g3c(p, lds)) \
  PHASE(7, phase_g3a(p, lds, 0)) \
  PHASE(8, phase_cv(p, 0)) \
  PHASE(9, phase_ma(p, lds, 0)) \
  PHASE(10, phase_mb(p)) \
  PHASE(11, phase_mc(p, lds, 0)) \
  PHASE(12, phase_g3b(p, lds, 0)) \
  PHASE(13, phase_g4(p, lds)) \
  PHASE(14, phase_g5(p, lds, 0)) \
  PHASE(15, phase_g3a(p, lds, 1)) \
  PHASE(16, phase_cv(p, 1)) \
  PHASE(17, phase_ma(p, lds, 1)) \
  PHASE(18, phase_mb(p)) \
  PHASE(19, phase_mc(p, lds, 1)) \
  PHASE(20, phase_g3b(p, lds, 1)) \
  PHASE(21, phase_g4(p, lds)) \
  PHASE(22, phase_g5(p, lds, 1)) \
  PHASE(23, phase_rows<3>(p, lds)) \
  PHASE(24, phase_ffn_in(p, lds, O_W2IN, 16384)) \
  PHASE(25, phase_ffn_out(p, lds, O_W2OUT, 8, false)) \
  PHASE(26, phase_rows<4>(p, lds))

#if !MULTI_LAUNCH
#define PHASE(n, call) if (lo <= (n) && (n) < hi) { if ((n) > lo) { if ((n) == 1) grid.sync(); else xcd_barrier(xbar); } call; }
__global__ void __launch_bounds__(512) mk(P p, int lo, int hi) {
  extern __shared__ __attribute__((aligned(16))) unsigned char lds[];
  cg::grid_group grid = cg::this_grid();
  volatile LAS unsigned* stw = (volatile LAS unsigned*)(lds + LDS_BYTES - 16);
  if (threadIdx.x == 0) { stw[0] = 0u; stw[1] = 0u; stw[2] = 0u; stw[3] = 0u; }
  __syncthreads();
  XcdBarrier xbar = xcd_barrier_post((unsigned*)(p.ws + O_BAR), stw);
  PHASE_PROGRAM
}
#undef PHASE
#else
#define PHASE(n, call) if constexpr (PH == (n)) { call; }
template <int PH>
__global__ void __launch_bounds__(512) mkp(P p) {
  extern __shared__ __attribute__((aligned(16))) unsigned char lds[];
  PHASE_PROGRAM
}
#undef PHASE
template <int PH> static void launch_all(const P& p, int grid, hipStream_t stream) {
  if constexpr (PH < NPH) {
    (void)hipFuncSetAttribute((const void*)mkp<PH>, hipFuncAttributeMaxDynamicSharedMemorySize, LDS_BYTES);
    hipLaunchKernelGGL(mkp<PH>, dim3(grid), dim3(NTHR), LDS_BYTES, stream, p);
    launch_all<PH + 1>(p, grid, stream);
  }
}
#endif

extern "C" void kernel_launch(void* const* d_in, const int* in_sizes, int n_in, void* d_out, int out_size, void* d_ws, size_t ws_size, hipStream_t stream) {
  static int grid_blocks = 0;
  if (!grid_blocks) {
    if (n_in != 25 || ws_size < O_END || ws_size < O_ACT + 16896ull * 2816 * 2) { fprintf(stderr, "kernel_launch: unexpected n_in %d / ws %zu\n", n_in, ws_size); grid_blocks = -1; return; }
    int dev = 0, cus = 0, per_cu = 0;
    (void)hipGetDevice(&dev);
    (void)hipDeviceGetAttribute(&cus, hipDeviceAttributeMultiprocessorCount, dev);
#if !MULTI_LAUNCH
    if (hipFuncSetAttribute((const void*)mk, hipFuncAttributeMaxDynamicSharedMemorySize, LDS_BYTES) != hipSuccess) { fprintf(stderr, "hipFuncSetAttribute failed\n"); grid_blocks = -1; return; }
    if (hipOccupancyMaxActiveBlocksPerMultiprocessor(&per_cu, (const void*)mk, NTHR, LDS_BYTES) != hipSuccess || per_cu < 1) { fprintf(stderr, "occupancy query failed (%d)\n", per_cu); grid_blocks = -1; return; }
#endif
    grid_blocks = cus * 1;
    fprintf(stderr, "kernel_launch: cus %d per_cu %d grid %d\n", cus, per_cu, grid_blocks);
  }
  if (grid_blocks < 0) return;
  P p{};
  for (int i = 0; i < 25; ++i) p.in[i] = (const float*)d_in[i];
  p.out = (float*)d_out; p.ws = (unsigned char*)d_ws;
#if MULTI_LAUNCH
  launch_all<0>(p, grid_blocks, stream);
#else
  int lo = 0, hi = NPH;
  if (hipMemsetAsync((unsigned char*)d_ws + O_BAR, 0, 16384, stream) != hipSuccess) { fprintf(stderr, "memset of barrier words failed\n"); return; }
  void* args[] = {&p, &lo, &hi};
  hipError_t e = hipLaunchCooperativeKernel((const void*)mk, dim3(grid_blocks), dim3(NTHR), args, LDS_BYTES, stream);
  if (e != hipSuccess) fprintf(stderr, "cooperative launch failed: %s (grid %d)\n", hipGetErrorString(e), grid_blocks);
#endif
}
```

```cpp
#include <hip/hip_runtime.h>
#include <hip/hip_cooperative_groups.h>
#include <cstdio>
#include <cstdint>
namespace cg = cooperative_groups;

#ifndef MULTI_LAUNCH
#define MULTI_LAUNCH 0
#endif

typedef unsigned short bfraw;
typedef __attribute__((ext_vector_type(8))) short bf16x8;
typedef __attribute__((ext_vector_type(4))) float f32x4;
#define DEVI __device__ __forceinline__

constexpr int NTHR = 512;
constexpr int GBM = 128;
constexpr int LROW = 40;
constexpr int LDS_BYTES = 143360;
constexpr float EPS = 1e-6f;

enum { I_X, I_C, I_CTX, I_CCTX, I_WADA, I_BADA, I_GFFN1, I_W1IN, I_W1OUT, I_GMIX, I_WIN, I_BGATES, I_CONVW, I_CONVB,
       I_GHEAD, I_GSGU, I_WS, I_BS, I_WA, I_WB, I_WO, I_GFFN2, I_W2IN, I_W2OUT, I_GFINAL };

struct P { const float* in[25]; float* out; unsigned char* ws; };

constexpr size_t O_W1IN  = 0;
constexpr size_t O_W1OUT = O_W1IN  + 5632ull * 1024 * 2;
constexpr size_t O_WTA   = O_W1OUT + 1024ull * 2816 * 2;
constexpr size_t O_WTB   = O_WTA   + 4096ull * 1024 * 2;
constexpr size_t O_WA    = O_WTB   + 4096ull * 1024 * 2;
constexpr size_t O_WB    = O_WA    + 1024ull * 1024 * 2;
constexpr size_t O_WO    = O_WB    + 1024ull * 1024 * 2;
constexpr size_t O_W2IN  = O_WO    + 1024ull * 1024 * 2;
constexpr size_t O_W2OUT = O_W2IN  + 5632ull * 1024 * 2;
constexpr size_t O_WSB   = O_W2OUT + 1024ull * 2816 * 2;
constexpr size_t O_MODSP = O_WSB   + 4ull * 128 * 128 * 2;
constexpr size_t O_MODS  = O_MODSP + 16ull * 3 * 9216 * 4;
constexpr size_t O_HCTX  = O_MODS  + 3ull * 9216 * 4;
constexpr size_t O_HN    = O_HCTX  + 512ull * 1024 * 4;
constexpr size_t O_GATES = O_HN    + 16896ull * 1024 * 2;
constexpr size_t O_CTXRAW= O_GATES + 16896ull * 16 * 4;
constexpr size_t O_BIG   = O_CTXRAW+ 2ull * 256 * 3072 * 2;
constexpr size_t O_ACT   = O_BIG;
constexpr size_t O_ST    = O_BIG;
constexpr size_t O_QRAW  = O_BIG;
constexpr size_t O_KRAW  = O_QRAW  + 8448ull * 1024 * 2;
constexpr size_t O_V     = O_ST    + 8ull * 66 * 131072;
constexpr size_t O_GVS   = O_V     + 8448ull * 1024 * 2;
constexpr size_t O_QC    = O_GVS   + 8192ull * 1024 * 2;
constexpr size_t O_KC    = O_QC    + 8448ull * 1024 * 2;
constexpr size_t O_NLOC  = O_KC    + 8448ull * 1024 * 2;
constexpr size_t O_NENT  = O_NLOC  + 8ull * 66 * 256 * 4;
constexpr size_t O_MG    = O_NENT  + 8ull * 66 * 256 * 4;
constexpr size_t O_RS    = O_MG    + 8192;
constexpr size_t O_HPARK = O_RS    + 8192ull * 4;
constexpr size_t O_BAR   = O_HPARK + 8192ull * 1024 * 2;
constexpr size_t O_END   = O_BAR + 16384;
static_assert(O_ACT + 16896ull * 2816 * 2 <= 268435456ull, "ws");
static_assert(O_END <= 268435456ull, "ws");
static_assert(O_KRAW + 8448ull * 1024 * 2 <= O_V, "overlay");

DEVI int ltid() { int t = __builtin_amdgcn_workitem_id_x(); asm volatile("" : "+v"(t)); return t; }
DEVI unsigned char* lws(unsigned char* w) { asm volatile("" : "+s"(w)); return w; }
DEVI bfraw f2bf(float f) { unsigned u = __float_as_uint(f); u += 0x7fffu + ((u >> 16) & 1u); return (bfraw)(u >> 16); }
DEVI float bf2f(bfraw h) { return __uint_as_float(((unsigned)h) << 16); }
DEVI float fexp(float x) { return __builtin_amdgcn_exp2f(x * 1.4426950408889634f); }
DEVI float sigmoidf_(float x) { return __builtin_amdgcn_rcpf(1.f + fexp(-x)); }
DEVI float siluf_(float x) { return x * sigmoidf_(x); }
DEVI float geluf_(float x) { return x * sigmoidf_(1.5957691216057308f * (x + 0.044715f * x * x * x)); }
DEVI float logsigf_(float x) { return fminf(x, 0.f) - log1pf(expf(-fabsf(x))); }
DEVI float wave_sum(float v) {
#pragma unroll
  for (int o = 32; o > 0; o >>= 1) v += __shfl_xor(v, o, 64);
  return v;
}
DEVI float red16(float v) {
  v += __shfl_xor(v, 1, 64); v += __shfl_xor(v, 2, 64); v += __shfl_xor(v, 4, 64); v += __shfl_xor(v, 8, 64);
  return v;
}
DEVI float redsin(float a, bool cosine) {
  float k = rintf(a * 0.15915494309189535f);
  float r = fmaf(-k, 6.2831854820251465f, a);
  r = fmaf(-k, -1.7484555e-7f, r);
  return cosine ? __cosf(r) : __sinf(r);
}


DEVI float seg_scan_sum(float v, int tid, float* s_x) {
  const int lane = tid & 63;
#pragma unroll
  for (int o = 1; o < 64; o <<= 1) { float t = __shfl_up(v, o, 64); if (lane >= o) v += t; }
  if (lane == 63 && tid < 256) s_x[tid >> 6] = v;
  __syncthreads();
  if (tid < 256 && ((tid >> 6) & 1)) v += s_x[(tid >> 6) - 1];
  __syncthreads();
  return v;
}
DEVI float seg_scan_max(float v, int tid, float* s_x) {
  const int lane = tid & 63;
#pragma unroll
  for (int o = 1; o < 64; o <<= 1) { float t = __shfl_up(v, o, 64); if (lane >= o) v = fmaxf(v, t); }
  if (lane == 63 && tid < 256) s_x[tid >> 6] = v;
  __syncthreads();
  if (tid < 256 && ((tid >> 6) & 1)) v = fmaxf(v, s_x[(tid >> 6) - 1]);
  __syncthreads();
  return v;
}

#define XB_TMO      128
#define XB_XCNT(j)  (256  + 64 * (j))
#define XB_XSUB(j)  (1280 + 64 * (j))
#define XB_XGEN(j)  (2304 + 64 * (j))
#define XB_TOP      3328
#define XB_TOPGEN   3392
#define XCD_BAR_WORDS 3456
#define XB_SPIN_CAP (1u << 18)
#define LAS __attribute__((address_space(3)))

__device__ __forceinline__ unsigned xb_ld(unsigned* p)              { return __hip_atomic_load(p, __ATOMIC_RELAXED, __HIP_MEMORY_SCOPE_AGENT); }
__device__ __forceinline__ unsigned xb_add(unsigned* p, unsigned v) { return __hip_atomic_fetch_add(p, v, __ATOMIC_RELAXED, __HIP_MEMORY_SCOPE_AGENT); }
__device__ __forceinline__ unsigned xb_xcc_id() { return (unsigned)__builtin_amdgcn_s_getreg((3 << 11) | 20) & 0xFu; }
#define XB_SPIN(cond, bar) do { unsigned _sp = 0; while (cond) { __builtin_amdgcn_s_sleep(1); \
    if ((++_sp & 255u) == 0u) { if (xb_ld(&(bar)[XB_TMO])) break; if (_sp > XB_SPIN_CAP) { atomicAdd(&(bar)[XB_TMO], 1u); break; } } } } while (0)

struct XcdBarrier {
    unsigned* bar; unsigned x;
    volatile LAS unsigned* st;
};

__device__ __forceinline__ XcdBarrier xcd_barrier_post(unsigned* bar, volatile LAS unsigned* st) {
    XcdBarrier b; b.bar = bar; b.x = xb_xcc_id(); b.st = st;
    if (threadIdx.x == 0) (void)xb_add(&bar[XB_XCNT(b.x)], 1u);
    return b;
}
__device__ __forceinline__ void xcd_barrier_complete(unsigned* bar, unsigned x, unsigned& nloc, unsigned& nx) {
    const unsigned G = gridDim.x * gridDim.y * gridDim.z;
    unsigned sum, cnt, mine, sp = 0u;
    for (;;) {
        sum = 0u; cnt = 0u; mine = 0u;
#pragma unroll
        for (unsigned j = 0; j < 16; ++j) { const unsigned c = xb_ld(&bar[XB_XCNT(j)]); sum += c; cnt += (c > 0u) ? 1u : 0u; mine = (j == x) ? c : mine; }
        if (sum == G) break;
        __builtin_amdgcn_s_sleep(1);
        if ((++sp & 255u) == 0u) { if (xb_ld(&bar[XB_TMO])) break; if (sp > XB_SPIN_CAP) { atomicAdd(&bar[XB_TMO], 1u); break; } }
    }
    nloc = mine > 0u ? mine : 1u; nx = cnt > 0u ? cnt : 1u;
}

__device__ __forceinline__ void xcd_barrier(const XcdBarrier& b) {
    asm volatile("s_waitcnt vmcnt(0)" ::: "memory");
    __syncthreads();
    if (threadIdx.x == 0) {
        unsigned* bar = b.bar;
        __builtin_amdgcn_s_waitcnt(0);
        unsigned nloc = b.st[0], nx = b.st[1];
        if (nloc == 0u) { xcd_barrier_complete(bar, b.x, nloc, nx); b.st[0] = nloc; b.st[1] = nx; }
        const unsigned old = xb_add(&bar[XB_XSUB(b.x)], 1u);
        const unsigned gen = old / nloc;
        if (old + 1u == (gen + 1u) * nloc) {
            __builtin_amdgcn_fence(__ATOMIC_RELEASE, "agent");
            asm volatile("s_waitcnt vmcnt(0)" ::: "memory");
            const unsigned og = xb_add(&bar[XB_TOP], 1u);
            const unsigned tg = og / nx;
            if (og + 1u == (tg + 1u) * nx) xb_add(&bar[XB_TOPGEN], 1u);
            else XB_SPIN(xb_ld(&bar[XB_TOPGEN]) == tg, bar);
            __builtin_amdgcn_fence(__ATOMIC_ACQUIRE, "agent");
            xb_add(&bar[XB_XGEN(b.x)], 1u);
            asm volatile("s_waitcnt vmcnt(0)" ::: "memory");
        } else {
            XB_SPIN(xb_ld(&bar[XB_XGEN(b.x)]) == gen, bar);
            __builtin_amdgcn_fence(__ATOMIC_ACQUIRE, "agent");
            asm volatile("s_waitcnt vmcnt(0)" ::: "memory");
        }
    }
    __syncthreads();
}

template <int BM, int BN, bool ATR, bool BTR, bool ALDS>
DEVI void gemm_tile(const bfraw* __restrict__ A, int lda, const bfraw* __restrict__ B, int ldb, int K,
                    const float* kscale, f32x4 (&acc)[BM / 32][BN / 64], bfraw* st, const bfraw* sAres, int ldres) {
  constexpr int MI = BM / 32, NJ = BN / 64, CA = BM / 128, CB = BN / 128, WM = BM / 2, WN = BN / 4;
  constexpr int STAGE = (ALDS ? BN : (BM + BN)) * LROW;
  int tid_ = ltid();
  const int tid = tid_, lane = tid & 63, wid = tid >> 6, wm = wid >> 2, wn = wid & 3;
  const int fr = lane & 15, fq = lane >> 4;
  uint4 ra0 = {0, 0, 0, 0}, ra1 = {0, 0, 0, 0}, rb0 = {0, 0, 0, 0}, rb1 = {0, 0, 0, 0};
  const int nk = K >> 5;

  auto gla = [&](int c, int k0) -> uint4 {
    if (!ATR) { int row = c >> 2, kc = (c & 3) * 8; return *(const uint4*)(A + (size_t)row * lda + k0 + kc); }
    else { int krow = c / (BM / 8), m0 = (c % (BM / 8)) * 8; return *(const uint4*)(A + (size_t)(k0 + krow) * lda + m0); }
  };
  auto glb = [&](int c, int k0) -> uint4 {
    if (!BTR) { int row = c >> 2, kc = (c & 3) * 8; return *(const uint4*)(B + (size_t)row * ldb + k0 + kc); }
    else { int krow = c / (BN / 8), n0 = (c % (BN / 8)) * 8; return *(const uint4*)(B + (size_t)(k0 + krow) * ldb + n0); }
  };
  auto gload = [&](int kt) {
    const int k0 = kt << 5;
    if (!ALDS) { ra0 = gla(tid, k0); if (CA > 1) ra1 = gla(tid + NTHR, k0); }
    rb0 = glb(tid, k0); if (CB > 1) rb1 = glb(tid + NTHR, k0);
  };
  constexpr int TSA = BM + 8, TSB = BN + 8;
  auto scale8 = [&](uint4 r, float sc) -> uint4 {
    unsigned w[4] = {r.x, r.y, r.z, r.w};
#pragma unroll
    for (int e = 0; e < 4; ++e) w[e] = (unsigned)f2bf(bf2f((bfraw)(w[e] & 0xffff)) * sc) | ((unsigned)f2bf(bf2f((bfraw)(w[e] >> 16)) * sc) << 16);
    return uint4{w[0], w[1], w[2], w[3]};
  };
  auto lstore = [&](int buf, int kt) {
    bfraw* sA = st + buf * STAGE;
    bfraw* sB = sA + (ALDS ? 0 : BM * LROW);
    auto sta = [&](int c, uint4 v) {
      if (!ATR) { int row = c >> 2, kc = (c & 3) * 8; *(uint4*)(sA + row * LROW + kc) = v; }
      else { int krow = c / (BM / 8), m0 = (c % (BM / 8)) * 8; *(uint4*)(sA + krow * TSA + m0) = v; }
    };
    auto stb = [&](int c, uint4 v) {
      if (!BTR) { int row = c >> 2, kc = (c & 3) * 8; *(uint4*)(sB + row * LROW + kc) = v; }
      else {
        int krow = c / (BN / 8), n0 = (c % (BN / 8)) * 8;
        if (kscale) v = scale8(v, kscale[(kt << 5) + krow]);
        *(uint4*)(sB + krow * TSB + n0) = v;
      }
    };
    if (!ALDS) { sta(tid, ra0); if (CA > 1) sta(tid + NTHR, ra1); }
    stb(tid, rb0); if (CB > 1) stb(tid + NTHR, rb1);
  };
  typedef short s16x4 __attribute__((ext_vector_type(4)));
  auto trfrag = [&](const bfraw* sT, int TS, int mt) -> bf16x8 {
    const bfraw* a1 = sT + (8 * fq + (fr >> 2)) * TS + mt + (fr & 3) * 4;
    s16x4 r1 = __builtin_amdgcn_ds_read_tr16_b64_v4i16((__attribute__((address_space(3))) s16x4*)a1);
    s16x4 r2 = __builtin_amdgcn_ds_read_tr16_b64_v4i16((__attribute__((address_space(3))) s16x4*)(a1 + 4 * TS));
    return bf16x8{r1[0], r1[1], r1[2], r1[3], r2[0], r2[1], r2[2], r2[3]};
  };
  auto compute = [&](int buf, int kt) {
    const bfraw* sA = st + buf * STAGE;
    const bfraw* sB = sA + (ALDS ? 0 : BM * LROW);
    bf16x8 af[MI], bfr[NJ];
#pragma unroll
    for (int i = 0; i < MI; ++i) {
      if (ALDS) af[i] = *(const bf16x8*)(sAres + (wm * WM + i * 16 + fr) * ldres + (kt << 5) + fq * 8);
      else if (ATR) af[i] = trfrag(sA, TSA, wm * WM + i * 16);
      else af[i] = *(const bf16x8*)(sA + (wm * WM + i * 16 + fr) * LROW + fq * 8);
    }
#pragma unroll
    for (int j = 0; j < NJ; ++j) {
      if (BTR) bfr[j] = trfrag(sB, TSB, wn * WN + j * 16);
      else bfr[j] = *(const bf16x8*)(sB + (wn * WN + j * 16 + fr) * LROW + fq * 8);
    }
#pragma unroll
    for (int i = 0; i < MI; ++i)
#pragma unroll
      for (int j = 0; j < NJ; ++j) acc[i][j] = __builtin_amdgcn_mfma_f32_16x16x32_bf16(af[i], bfr[j], acc[i][j], 0, 0, 0);
  };

  __syncthreads();
  gload(0); lstore(0, 0);
  __syncthreads();
  for (int kt = 0; kt < nk; ++kt) {
    if (kt + 1 < nk) gload(kt + 1);
    compute(kt & 1, kt);
    if (kt + 1 < nk) lstore((kt + 1) & 1, kt + 1);
    __syncthreads();
  }
}

#define ZERO_ACC(acc, MI, NJ) _Pragma("unroll") for (int _i = 0; _i < (MI); ++_i) _Pragma("unroll") for (int _j = 0; _j < (NJ); ++_j) acc[_i][_j] = f32x4{0.f, 0.f, 0.f, 0.f};
#define EPI_BEGIN(BM, BN) { int _t = ltid(); const int _l = _t & 63, _w = _t >> 6; \
    const int _rb = (_w >> 2) * ((BM) / 2) + (_l >> 4) * 4, _cb = (_w & 3) * ((BN) / 4) + (_l & 15); \
    _Pragma("unroll") for (int i = 0; i < (BM) / 32; ++i) _Pragma("unroll") for (int j = 0; j < (BN) / 64; ++j) _Pragma("unroll") for (int r = 0; r < 4; ++r) { \
      const int row = _rb + i * 16 + r, col = _cb + j * 16;
#define EPI_END }}
#define EPIR_BEGIN(BM, BN) { int _t = ltid(); const int _l = _t & 63, _w = _t >> 6; \
    const int _rb = (_w >> 2) * ((BM) / 2) + (_l >> 4) * 4, _cb = (_w & 3) * ((BN) / 4) + (_l & 15); \
    _Pragma("unroll") for (int i = 0; i < (BM) / 32; ++i) _Pragma("unroll") for (int r = 0; r < 4; ++r) { \
      const int row = _rb + i * 16 + r;
#define EPIR_COLS(BN) _Pragma("unroll") for (int j = 0; j < (BN) / 64; ++j) { const int col = _cb + j * 16;
#define EPIR_END }}}


namespace pg8 {
#define PG8_LAS __attribute__((address_space(3)))
typedef unsigned short bf16_t;
typedef short bf16x8 __attribute__((ext_vector_type(8)));
typedef float f32x4 __attribute__((ext_vector_type(4)));
typedef unsigned u32x4 __attribute__((ext_vector_type(4)));
constexpr int BM = 256, BK = 64, HALF = 128, HTB = HALF * BK * 2  , STAGE_BYTES = 8 * HTB, NXCD = 8, WGM = 8;

__host__ __device__ __forceinline__ int lds_byte(int r, int c) { const int st = (r >> 4) * 2 + (c >> 5), rr = r & 15, cc = c & 31, ob = rr * 64 + cc * 2; return st * 1024 + (ob ^ (((ob >> 9) & 1) << 5)); }
__host__ __device__ __forceinline__ void stage_rc(int b, int& R, int& C) { const int st = b / 1024, sb = b % 1024, swz = sb ^ (((sb >> 9) & 1) << 5); R = (st >> 1) * 16 + swz / 64; C = (st & 1) * 32 + (swz % 64) / 2; }
__host__ __device__ __forceinline__ int perm32(int rho) { const int n = rho >> 4, i = rho & 15; return 8 * (i >> 2) + 4 * n + (i & 3); }

struct Unit { int pm, pn; };
struct Gemm { const bf16_t* A; const bf16_t* Bt; int M, N, K; };
struct StaticOrder {
    int nM, nN, nwg, G, c;
    __host__ __device__ void init(int M, int N, int G_, int c_) { nM = M / BM; nN = N / BM; nwg = nM * nN; G = G_; c = c_; }
    __host__ __device__ bool next(int i, Unit& u) const {
        const long L = (long)i * G + c; if (L >= nwg) return false;
        int wgid = (int)L; { const int q = nwg / NXCD, r = nwg % NXCD, xcd = wgid % NXCD, off = wgid / NXCD; wgid = (xcd < r ? xcd * (q + 1) : r * (q + 1) + (xcd - r) * q) + off; }
        const int nig = WGM * nN, gid = wgid / nig, fm = gid * WGM, gsz = (nM - fm) < WGM ? (nM - fm) : WGM;
        u.pm = fm + ((wgid % nig) % gsz); u.pn = (wgid % nig) / gsz; return true;
    }
    __device__ __forceinline__ void a_ready(const Unit&) const {}
    __device__ __forceinline__ void done(const Unit&) const {}
};
__device__ __forceinline__ unsigned cvt_pk_bf16(float lo, float hi) { unsigned r; asm volatile("v_cvt_pk_bf16_f32 %0, %1, %2" : "=v"(r) : "v"(lo), "v"(hi)); return r; }
template <class Epi, class Sched, bool STAMP = false>
__device__ __forceinline__ void gemm_phase(PG8_LAS unsigned char* lds, const Gemm g, const Sched& S, const Epi& E, unsigned long long* stamps) {
    const int tid = threadIdx.x, wid = __builtin_amdgcn_readfirstlane(tid >> 6), lane = tid & 63, wr = wid >> 2, wc = wid & 3, fr = lane & 15, fq = lane >> 4;
    const int K = g.K, nt = K / BK;
    int ts_lo = 0, ts_hi = 0, nts = 0; const unsigned long long rt_entry = STAMP ? (unsigned long long)wall_clock64() : 0ull;
#define PG8_STAMP() do { if (STAMP && wid == 0 && nts < 64) { const unsigned long long _c = (unsigned long long)clock64(); \
        ts_lo = (lane == nts) ? (int)(unsigned)_c : ts_lo; ts_hi = (lane == nts) ? (int)(unsigned)(_c >> 32) : ts_hi; ++nts; } } while (0)
    PG8_STAMP();
    unsigned voffA[2], voffB[2];
#pragma unroll
    for (int i = 0; i < 2; ++i) { int R, C; stage_rc(tid * 16 + i * 8192, R, C); const int Rb = Epi::PERM ? ((R & ~31) + perm32(R & 31)) : R;
        voffA[i] = (unsigned)(R * K + C) * 2u; voffB[i] = (unsigned)(Rb * K + C) * 2u; }
    const size_t kstep = (size_t)(BK * 2);
    const size_t hstep = (size_t)HALF * K * 2;
    const size_t tstep = 2 * hstep;
    const unsigned ldsw = (unsigned)wid * 1024u;
    const int aoff = lds_byte(wr * 64 + fr, fq * 8), boff = lds_byte(wc * 32 + fr, fq * 8);
#define PG8_SA(b, h) (((b) * 2 + (h)) * HTB)
#define PG8_SB(b, h) ((4 + (b) * 2 + (h)) * HTB)
#define PG8_STAGE(bufoff, gbase, voff) do { _Pragma("unroll") for (int _i = 0; _i < 2; ++_i) \
        __builtin_amdgcn_global_load_lds((const unsigned*)((const char*)(gbase) + (voff)[_i]), (PG8_LAS unsigned*)(lds + (bufoff) + ldsw + _i * 8192), 16, 0, 0); } while (0)
#define PG8_LDA(dst, b, h) do { _Pragma("unroll") for (int m = 0; m < 4; ++m) _Pragma("unroll") for (int k = 0; k < 2; ++k) dst[m][k] = *(const PG8_LAS bf16x8*)(lds + PG8_SA(b, h) + aoff + m * 2048 + k * 1024); } while (0)
#define PG8_LDB(dst, b, h) do { _Pragma("unroll") for (int n = 0; n < 2; ++n) _Pragma("unroll") for (int k = 0; k < 2; ++k) dst[n][k] = *(const PG8_LAS bf16x8*)(lds + PG8_SB(b, h) + boff + n * 2048 + k * 1024); } while (0)
#define PG8_MMA(ai, bj, At, Bt) do { __builtin_amdgcn_s_setprio(1); _Pragma("unroll") for (int m = 0; m < 4; ++m) _Pragma("unroll") for (int n = 0; n < 2; ++n) _Pragma("unroll") for (int k = 0; k < 2; ++k) \
        acc[ai][bj][m][n] = __builtin_amdgcn_mfma_f32_16x16x32_bf16(Bt[n][k], At[m][k], acc[ai][bj][m][n], 0, 0, 0); __builtin_amdgcn_s_setprio(0); } while (0)
#define PG8_WAIT_V(n) asm volatile("s_waitcnt vmcnt(" #n ")" ::: "memory")
#define PG8_WAIT_L(n) asm volatile("s_waitcnt lgkmcnt(" #n ")" ::: "memory")
#define PG8_BAR __builtin_amdgcn_s_barrier()
#define PG8_SCHED __builtin_amdgcn_sched_barrier(0)
    Unit cur, nxt; int ui = 0;
    if (!S.next(0, cur)) return;
    f32x4 acc[2][2][4][2];
#pragma unroll
    for (int a = 0; a < 2; ++a)
#pragma unroll
        for (int b = 0; b < 2; ++b)
#pragma unroll
            for (int m = 0; m < 4; ++m)
#pragma unroll
                for (int n = 0; n < 2; ++n) acc[a][b][m][n] = (f32x4){0.f, 0.f, 0.f, 0.f};
    bf16x8 At[4][2], B0[2][2], B1[2][2];
    const char* cA = (const char*)g.A + (size_t)cur.pm * tstep; const char* cB = (const char*)g.Bt + (size_t)cur.pn * tstep;
    S.a_ready(cur);
    PG8_STAGE(PG8_SB(0, 0), cB, voffB); PG8_STAGE(PG8_SA(0, 0), cA, voffA); PG8_STAGE(PG8_SB(0, 1), cB + hstep, voffB); PG8_STAGE(PG8_SA(0, 1), cA + hstep, voffA);
    if (wr == 1) PG8_BAR;
    PG8_WAIT_V(4); PG8_BAR;
    PG8_STAGE(PG8_SB(1, 0), cB + kstep, voffB); PG8_STAGE(PG8_SA(1, 0), cA + kstep, voffA); PG8_STAGE(PG8_SB(1, 1), cB + hstep + kstep, voffB);
    PG8_WAIT_V(6); PG8_BAR;
    PG8_STAMP();
    for (;;) {
        const bool has_next = S.next(ui + 1, nxt);
        const char* nA = has_next ? (const char*)g.A + (size_t)nxt.pm * tstep : cA; const char* nB = has_next ? (const char*)g.Bt + (size_t)nxt.pn * tstep : cB;
        for (int t = 0; t < nt; t += 2) {
            const bool last = (t == nt - 2);
            const char* a1 = cA + (size_t)(t + 1) * kstep;
            const char* a2 = last ? nA : cA + (size_t)(t + 2) * kstep; const char* b2 = last ? nB : cB + (size_t)(t + 2) * kstep;
            const char* a3 = a2 + kstep; const char* b3 = b2 + kstep;
            if (last && has_next) S.a_ready(nxt);
            PG8_LDB(B0, 0, 0); PG8_SCHED; PG8_LDA(At, 0, 0); PG8_STAGE(PG8_SA(1, 1), a1 + hstep, voffA);
            PG8_WAIT_L(8); PG8_BAR; PG8_WAIT_L(0); PG8_MMA(0, 0, At, B0); PG8_BAR; PG8_SCHED;
            PG8_LDB(B1, 0, 1); PG8_STAGE(PG8_SB(0, 0), b2, voffB);
            PG8_BAR; PG8_WAIT_L(0); PG8_MMA(0, 1, At, B1); PG8_BAR;
            PG8_LDA(At, 0, 1); PG8_STAGE(PG8_SA(0, 0), a2, voffA);
            PG8_BAR; PG8_WAIT_L(0); PG8_MMA(1, 0, At, B0); PG8_BAR; PG8_SCHED;
            PG8_STAGE(PG8_SB(0, 1), b2 + hstep, voffB);
            PG8_WAIT_V(6); PG8_BAR; PG8_MMA(1, 1, At, B1); PG8_BAR;
            PG8_LDB(B0, 1, 0); PG8_SCHED; PG8_LDA(At, 1, 0); PG8_STAGE(PG8_SA(0, 1), a2 + hstep, voffA);
            PG8_WAIT_L(8); PG8_BAR; PG8_WAIT_L(0); PG8_MMA(0, 0, At, B0); PG8_BAR; PG8_SCHED;
            PG8_LDB(B1, 1, 1); PG8_STAGE(PG8_SB(1, 0), b3, voffB);
            PG8_BAR; PG8_WAIT_L(0); PG8_MMA(0, 1, At, B1); PG8_BAR;
            PG8_LDA(At, 1, 1); PG8_STAGE(PG8_SA(1, 0), a3, voffA);
            PG8_BAR; PG8_WAIT_L(0); PG8_MMA(1, 0, At, B0); PG8_BAR; PG8_SCHED;
            PG8_STAGE(PG8_SB(1, 1), b3 + hstep, voffB);
            PG8_WAIT_V(6); PG8_BAR; PG8_MMA(1, 1, At, B1); PG8_BAR;
        }
        PG8_STAMP();
        if constexpr (!Epi::AFTER_DRAIN) { E(acc, cur, wr, wc, fr, fq); S.done(cur); }
        PG8_STAMP();
        if (!has_next) break;
#pragma unroll
        for (int a = 0; a < 2; ++a)
#pragma unroll
            for (int b = 0; b < 2; ++b)
#pragma unroll
                for (int m = 0; m < 4; ++m)
#pragma unroll
                    for (int n = 0; n < 2; ++n) acc[a][b][m][n] = (f32x4){0.f, 0.f, 0.f, 0.f};
        cur = nxt; cA = nA; cB = nB; ++ui;
    }
    PG8_WAIT_V(0);
    if (wr == 0) PG8_BAR;
    PG8_BAR;
    if constexpr (Epi::AFTER_DRAIN) { E.fused(acc, cur, wr, wc, fr, fq, lds, wid, lane); S.done(cur); }
    PG8_STAMP();
    if (STAMP && wid == 0) { stamps[lane] = lane < nts ? (((unsigned long long)(unsigned)ts_hi << 32) | (unsigned)ts_lo) : 0ull;
        if (lane == 62) stamps[62] = rt_entry; if (lane == 63) stamps[63] = (unsigned long long)wall_clock64(); }
#undef PG8_STAMP
#undef PG8_SA
#undef PG8_SB
#undef PG8_STAGE
#undef PG8_LDA
#undef PG8_LDB
#undef PG8_MMA
#undef PG8_WAIT_V
#undef PG8_WAIT_L
#undef PG8_BAR
#undef PG8_SCHED
}
}

typedef pg8::f32x4 pf4;
DEVI float4 ld4(const float* p) { return *(const float4*)p; }
struct EpiFfnIn {
  static constexpr bool PERM = false, AFTER_DRAIN = false;
  bfraw* act;
  DEVI void operator()(const pf4 (&acc)[2][2][4][2], const pg8::Unit& u, int wr, int wc, int fr, int fq) const {
    const int row0 = u.pm * 256 + wr * 64 + fr, f0 = (u.pn * 256 + wc * 32) / 2 + 4 * fq;
#pragma unroll
    for (int ai = 0; ai < 2; ++ai)
#pragma unroll
      for (int m = 0; m < 4; ++m) {
        bfraw* rowp = act + (size_t)(row0 + ai * 128 + m * 16) * 2816 + f0;
#pragma unroll
        for (int bj = 0; bj < 2; ++bj) {
          const pf4 a = acc[ai][bj][m][0], b = acc[ai][bj][m][1];
          uint2 w; w.x = pg8::cvt_pk_bf16(siluf_(a[0]) * b[0], siluf_(a[1]) * b[1]); w.y = pg8::cvt_pk_bf16(siluf_(a[2]) * b[2], siluf_(a[3]) * b[3]);
          *(uint2*)(rowp + bj * 64) = w;
        }
      }
  }
};
struct EpiResid {
  static constexpr bool PERM = false, AFTER_DRAIN = false;
  float* h; const float* mods; int rowoff, gidx; float scale;
  DEVI void operator()(const pf4 (&acc)[2][2][4][2], const pg8::Unit& u, int wr, int wc, int fr, int fq) const {
    const int row0 = rowoff + u.pm * 256 + wr * 64 + fr, col0 = u.pn * 256 + wc * 32 + 4 * fq;
#pragma unroll
    for (int ai = 0; ai < 2; ++ai)
#pragma unroll
      for (int m = 0; m < 4; ++m) {
        const int r = row0 + ai * 128 + m * 16;
        float* rowp = h + (size_t)r * 1024 + col0;
        const float* gp = mods + (r >> 13) * 9216 + gidx * 1024 + col0;
#pragma unroll
        for (int bj = 0; bj < 2; ++bj)
#pragma unroll
          for (int n = 0; n < 2; ++n) {
            float4 hv = ld4(rowp + bj * 128 + n * 16); const float4 g = ld4(gp + bj * 128 + n * 16); const pf4 a = acc[ai][bj][m][n];
            hv.x += scale * g.x * a[0]; hv.y += scale * g.y * a[1]; hv.z += scale * g.z * a[2]; hv.w += scale * g.w * a[3];
            *(float4*)(rowp + bj * 128 + n * 16) = hv;
          }
      }
  }
};
struct EpiResidAtomic {
  static constexpr bool PERM = false, AFTER_DRAIN = false;
  float* h; const float* mods; int rowoff, gidx;
  DEVI void operator()(const pf4 (&acc)[2][2][4][2], const pg8::Unit& u, int wr, int wc, int fr, int fq) const {
    const int row0 = rowoff + u.pm * 256 + wr * 64 + fr, col0 = u.pn * 256 + wc * 32 + 4 * fq;
#pragma unroll
    for (int ai = 0; ai < 2; ++ai)
#pragma unroll
      for (int m = 0; m < 4; ++m) {
        const int r = row0 + ai * 128 + m * 16;
        float* rowp = h + (size_t)r * 1024 + col0;
        const float* gp = mods + (r >> 13) * 9216 + gidx * 1024 + col0;
#pragma unroll
        for (int bj = 0; bj < 2; ++bj)
#pragma unroll
          for (int n = 0; n < 2; ++n) {
            const float4 g = ld4(gp + bj * 128 + n * 16); const pf4 a = acc[ai][bj][m][n];
            float* q = rowp + bj * 128 + n * 16;
            atomicAdd(q, g.x * a[0]); atomicAdd(q + 1, g.y * a[1]); atomicAdd(q + 2, g.z * a[2]); atomicAdd(q + 3, g.w * a[3]);
          }
      }
  }
};
template <int MODE> struct EpiMix {
  static constexpr bool PERM = true, AFTER_DRAIN = false;
  bfraw* d0; bfraw* d1; bfraw* d2; bfraw* d3;
  DEVI void operator()(const pf4 (&acc)[2][2][4][2], const pg8::Unit& u, int wr, int wc, int fr, int fq) const {
    const int row0 = u.pm * 256 + wr * 64 + fr;
    const int pc = u.pn >> 2;
    bfraw* dst = MODE == 0 ? d0 : (MODE == 1 || MODE == 2) ? (pc == 0 ? d0 : pc == 1 ? d1 : pc == 2 ? d2 : d3) : (MODE == 3 ? d0 : d1);
    const int ld = MODE == 0 ? 3072 : 1024;
    const int col0 = (MODE == 1 || MODE == 2 ? (u.pn & 3) : u.pn) * 256 + wc * 32 + 8 * fq;
#pragma unroll
    for (int ai = 0; ai < 2; ++ai)
#pragma unroll
      for (int m = 0; m < 4; ++m) {
        const size_t ro = (size_t)(row0 + ai * 128 + m * 16) * ld + col0;
#pragma unroll
        for (int bj = 0; bj < 2; ++bj) {
          float v[8];
#pragma unroll
          for (int e = 0; e < 4; ++e) { v[e] = acc[ai][bj][m][0][e]; v[4 + e] = acc[ai][bj][m][1][e]; }
          bfraw* dp = dst + ro + bj * 128;
          if (MODE == 1) { if (pc == 3) {
#pragma unroll
            for (int e = 0; e < 8; ++e) v[e] = geluf_(v[e]); } }
          if (MODE == 2 || MODE == 3 || MODE == 4) {
            const uint4 o = *(const uint4*)dp; const unsigned ow[4] = {o.x, o.y, o.z, o.w};
            float p[8];
#pragma unroll
            for (int e = 0; e < 4; ++e) { p[2 * e] = bf2f((bfraw)(ow[e] & 0xffff)); p[2 * e + 1] = bf2f((bfraw)(ow[e] >> 16)); }
            if (MODE == 2) {
#pragma unroll
              for (int e = 0; e < 8; ++e) v[e] = pc == 0 ? sigmoidf_(v[e]) * p[e] : pc == 1 ? geluf_(v[e]) * p[e] : sigmoidf_(v[e]);
            } else if (MODE == 3) {
#pragma unroll
              for (int e = 0; e < 8; ++e) v[e] *= p[e];
            } else {
              const uint4 t = *(const uint4*)(d0 + ro + bj * 128); const unsigned tw[4] = {t.x, t.y, t.z, t.w};
#pragma unroll
              for (int e = 0; e < 4; ++e) { v[2 * e] = bf2f((bfraw)(tw[e] & 0xffff)) + p[2 * e] * v[2 * e]; v[2 * e + 1] = bf2f((bfraw)(tw[e] >> 16)) + p[2 * e + 1] * v[2 * e + 1]; }
            }
          }
          uint4 w; w.x = pg8::cvt_pk_bf16(v[0], v[1]); w.y = pg8::cvt_pk_bf16(v[2], v[3]); w.z = pg8::cvt_pk_bf16(v[4], v[5]); w.w = pg8::cvt_pk_bf16(v[6], v[7]);
          *(uint4*)dp = w;
        }
      }
  }
};
template <class Epi>
DEVI void run8(unsigned char* lds, const bfraw* A, const bfraw* Bt, int M, int N, int K, const Epi& E, int G = -1, int c = -1) {
  pg8::Gemm g{A, Bt, M, N, K};
  pg8::StaticOrder S; S.init(M, N, G < 0 ? (int)gridDim.x : G, c < 0 ? (int)blockIdx.x : c);
  pg8::gemm_phase<Epi, pg8::StaticOrder, false>((PG8_LAS unsigned char*)lds, g, S, E, nullptr);
}

struct TrJob { const float* src; bfraw* dst; int ldw, K, kt, nt, drow0, mode; };
DEVI TrJob tr_decode(const P& p, int t) {
  TrJob j; int u = t;
  if (u < 1408) { j = TrJob{p.in[I_W1IN], (bfraw*)(p.ws + O_W1IN), 5632, 1024, u / 88, u % 88, 0, 1}; return j; }
  u -= 1408;
  if (u < 704) { j = TrJob{p.in[I_W1OUT], (bfraw*)(p.ws + O_W1OUT), 1024, 2816, u / 16, u % 16, 0, 0}; return j; }
  u -= 704;
  if (u < 2048) {
    const int pc = u >> 8; u &= 255;
    const int col0 = pc == 0 ? 0 : pc == 1 ? 1024 : pc == 2 ? 2048 : pc == 3 ? 5136 : pc == 4 ? 3088 : pc == 5 ? 4112 : pc == 6 ? 6160 : 7184;
    j = TrJob{p.in[I_WIN] + col0, (bfraw*)(p.ws + (pc < 4 ? O_WTA : O_WTB)), 8208, 1024, u >> 4, u & 15, (pc & 3) * 1024, 0}; return j;
  }
  u -= 2048;
  if (u < 768) { const int m = u >> 8; u &= 255; j = TrJob{p.in[m == 0 ? I_WA : m == 1 ? I_WB : I_WO], (bfraw*)(p.ws + (m == 0 ? O_WA : m == 1 ? O_WB : O_WO)), 1024, 1024, u >> 4, u & 15, 0, 0}; return j; }
  u -= 768;
  if (u < 1408) { j = TrJob{p.in[I_W2IN], (bfraw*)(p.ws + O_W2IN), 5632, 1024, u / 88, u % 88, 0, 1}; return j; }
  u -= 1408;
  j = TrJob{p.in[I_W2OUT], (bfraw*)(p.ws + O_W2OUT), 1024, 2816, u / 16, u % 16, 0, 0}; return j;
}

DEVI void phase_p0(const P& p, unsigned char* lds) {
  float* sf = (float*)lds;
  const int tid = ltid();
  for (int i = tid; i < 3072; i += NTHR) { float v = i < 2048 ? p.in[I_C][i] : p.in[I_CCTX][i - 2048]; sf[i] = v / (1.f + expf(-v)); }
  __syncthreads();
  {
    const float* w = p.in[I_WADA];
    float* mp = (float*)(p.ws + O_MODSP);
    for (int id = blockIdx.x * NTHR + tid; id < 16 * 9216; id += gridDim.x * NTHR) {
      int s = id / 9216, j = id - s * 9216;
      float a0 = 0, a1 = 0, a2 = 0;
#pragma unroll 16
      for (int k = s * 64; k < s * 64 + 64; ++k) { float wv = w[(size_t)k * 9216 + j]; a0 += sf[k] * wv; a1 += sf[1024 + k] * wv; a2 += sf[2048 + k] * wv; }
      mp[(s * 3 + 0) * 9216 + j] = a0; mp[(s * 3 + 1) * 9216 + j] = a1; mp[(s * 3 + 2) * 9216 + j] = a2;
    }
  }
  __syncthreads();
  {
    float rg[8];
    int t = blockIdx.x;
    TrJob jb = tr_decode(p, t < 7040 ? t : 0);
    if (t < 7040) {
#pragma unroll
      for (int i = 0; i < 8; ++i) { int e = tid + i * NTHR; int kk = e >> 6, nn = e & 63; rg[i] = jb.src[(size_t)(jb.kt * 64 + kk) * jb.ldw + jb.nt * 64 + nn]; }
    }
    for (; t < 7040; t += gridDim.x) {
#pragma unroll
      for (int i = 0; i < 8; ++i) { int e = tid + i * NTHR; int kk = e >> 6, nn = e & 63; sf[kk * 65 + nn] = rg[i]; }
      __syncthreads();
      const TrJob cj = jb;
      const int tn = t + gridDim.x;
      if (tn < 7040) {
        jb = tr_decode(p, tn);
#pragma unroll
        for (int i = 0; i < 8; ++i) { int e = tid + i * NTHR; int kk = e >> 6, nn = e & 63; rg[i] = jb.src[(size_t)(jb.kt * 64 + kk) * jb.ldw + jb.nt * 64 + nn]; }
      }
#pragma unroll
      for (int i = 0; i < 8; ++i) {
        int e = tid + i * NTHR; int nn = e >> 6, kk = e & 63;
        int n = cj.nt * 64 + nn, dr;
        if (cj.mode == 1) { int isb = n >= 2816; int f = n - isb * 2816; dr = (f >> 4) * 32 + isb * 16 + (f & 15); } else dr = cj.drow0 + n;
        cj.dst[(size_t)dr * cj.K + cj.kt * 64 + kk] = f2bf(sf[kk * 65 + nn]);
      }
      __syncthreads();
    }
  }
  { bfraw* d = (bfraw*)(p.ws + O_WSB); for (int id = blockIdx.x * NTHR + tid; id < 65536; id += gridDim.x * NTHR) d[id] = f2bf(p.in[I_WS][id]); }
}

DEVI void phase_p0b(const P& p) {
  const float* mp = (const float*)(p.ws + O_MODSP);
  float* m = (float*)(p.ws + O_MODS);
  for (int id = blockIdx.x * NTHR + ltid(); id < 3 * 9216; id += gridDim.x * NTHR) {
    int j = id % 9216;
    float a = p.in[I_BADA][j];
    for (int s = 0; s < 16; ++s) a += mp[s * 3 * 9216 + id];
    m[id] = a;
  }
}

template <int MODE>
DEVI void phase_rows(const P& p, unsigned char* lds) {
  const int tid = ltid(), lane = tid & 63, wid = tid >> 6;
  const float* mods = (const float*)(p.ws + O_MODS);
  float* hctx = (float*)(p.ws + O_HCTX);
  bfraw* hn = (bfraw*)(p.ws + O_HN);
  float* wg = (float*)lds;
  if (MODE == 2) {
    __syncthreads();
    for (int i = tid; i < 16384; i += NTHR) { int k = i >> 4, g = i & 15; wg[g * 1024 + k] = p.in[I_WIN][(size_t)k * 8208 + 3072 + g]; }
    __syncthreads();
  }
  const int nrows = (MODE == 1 || MODE == 2) ? 16896 : 16384;
  const float* gvec = p.in[MODE == 1 ? I_GFFN1 : MODE == 2 ? I_GMIX : MODE == 3 ? I_GFFN2 : I_GFINAL];
  const int msh = MODE == 1 ? 0 : MODE == 2 ? 3 : 6;
  for (int row = blockIdx.x * 8 + wid; row < nrows; row += gridDim.x * 8) {
    const bool lat = row < 16384;
    const int mrow = lat ? (row >> 13) : 2;
    float4 v[4];
    if (MODE == 1) {
      const float* src = lat ? p.in[I_X] + (size_t)row * 1024 : p.in[I_CTX] + (size_t)(row - 16384) * 1024;
#pragma unroll
      for (int i = 0; i < 4; ++i) v[i] = *(const float4*)(src + i * 256 + lane * 4);
      if (lat) {
        int ts = row & 8191; float rr = (float)(ts >> 6), cc = (float)(ts & 63);
        float fqv[4];
#pragma unroll
        for (int e = 0; e < 4; ++e) fqv[e] = expf((-9.210340371976184f * (float)(lane * 4 + e)) / 256.f);
        v[0].x += redsin(rr * fqv[0], false); v[0].y += redsin(rr * fqv[1], false); v[0].z += redsin(rr * fqv[2], false); v[0].w += redsin(rr * fqv[3], false);
        v[1].x += redsin(rr * fqv[0], true);  v[1].y += redsin(rr * fqv[1], true);  v[1].z += redsin(rr * fqv[2], true);  v[1].w += redsin(rr * fqv[3], true);
        v[2].x += redsin(cc * fqv[0], false); v[2].y += redsin(cc * fqv[1], false); v[2].z += redsin(cc * fqv[2], false); v[2].w += redsin(cc * fqv[3], false);
        v[3].x += redsin(cc * fqv[0], true);  v[3].y += redsin(cc * fqv[1], true);  v[3].z += redsin(cc * fqv[2], true);  v[3].w += redsin(cc * fqv[3], true);
      }
      float* dsth = lat ? p.out + (size_t)row * 1024 : hctx + (size_t)(row - 16384) * 1024;
#pragma unroll
      for (int i = 0; i < 4; ++i) *(float4*)(dsth + i * 256 + lane * 4) = v[i];
    } else {
      const float* src = lat ? p.out + (size_t)row * 1024 : hctx + (size_t)(row - 16384) * 1024;
#pragma unroll
      for (int i = 0; i < 4; ++i) v[i] = *(const float4*)(src + i * 256 + lane * 4);
    }
    float ss = 0;
#pragma unroll
    for (int i = 0; i < 4; ++i) ss += v[i].x * v[i].x + v[i].y * v[i].y + v[i].z * v[i].z + v[i].w * v[i].w;
    ss = wave_sum(ss);
    const float rs = rsqrtf(ss * (1.f / 1024.f) + EPS);
    if (MODE == 4) {
#pragma unroll
      for (int i = 0; i < 4; ++i) {
        float4 g = *(const float4*)(gvec + i * 256 + lane * 4);
        float4 o = {v[i].x * rs * g.x, v[i].y * rs * g.y, v[i].z * rs * g.z, v[i].w * rs * g.w};
        *(float4*)(p.out + (size_t)row * 1024 + i * 256 + lane * 4) = o;
      }
    } else {
      const float* sh = mods + (size_t)(mrow * 9216 + msh * 1024);
      const float* scp = sh + 1024;
      float y[16];
#pragma unroll
      for (int i = 0; i < 4; ++i) {
        const int c = i * 256 + lane * 4;
        float4 g = *(const float4*)(gvec + c), s4 = *(const float4*)(sh + c), c4 = *(const float4*)(scp + c);
        y[i * 4 + 0] = v[i].x * rs * g.x * (1.f + c4.x) + s4.x; y[i * 4 + 1] = v[i].y * rs * g.y * (1.f + c4.y) + s4.y;
        y[i * 4 + 2] = v[i].z * rs * g.z * (1.f + c4.z) + s4.z; y[i * 4 + 3] = v[i].w * rs * g.w * (1.f + c4.w) + s4.w;
        uint2 pk; pk.x = (unsigned)f2bf(y[i * 4]) | ((unsigned)f2bf(y[i * 4 + 1]) << 16); pk.y = (unsigned)f2bf(y[i * 4 + 2]) | ((unsigned)f2bf(y[i * 4 + 3]) << 16);
        *(uint2*)(hn + (size_t)row * 1024 + c) = pk;
      }
      if (MODE == 2) {
        float mine = 0.f;
#pragma unroll 2
        for (int g2 = 0; g2 < 16; ++g2) {
          float a = 0.f;
#pragma unroll
          for (int i = 0; i < 4; ++i) { float4 w4 = *(const float4*)(wg + g2 * 1024 + i * 256 + lane * 4); a += y[i * 4] * w4.x + y[i * 4 + 1] * w4.y + y[i * 4 + 2] * w4.z + y[i * 4 + 3] * w4.w; }
          a = wave_sum(a);
          if (lane == g2) mine = a;
        }
        if (lane < 16) ((float*)(p.ws + O_GATES))[(size_t)row * 16 + lane] = mine;
      }
    }
  }
}

DEVI void phase_ffn_in(const P& p, unsigned char* lds, size_t o_w, int nrows) {
  EpiFfnIn E{(bfraw*)(p.ws + O_ACT)};
  run8(lds, (const bfraw*)(p.ws + O_HN), (const bfraw*)(p.ws + o_w), nrows, 5632, 1024, E);
}

DEVI void phase_ffn_out(const P& p, unsigned char* lds, size_t o_w, int gidx, bool with_ctx) {
  EpiResid E{p.out, (const float*)(p.ws + O_MODS), 0, gidx, 0.5f};
  run8(lds, (const bfraw*)(p.ws + O_ACT), (const bfraw*)(p.ws + o_w), 16384, 1024, 2816, E);
  if (with_ctx) {
    const bfraw* act = (const bfraw*)(p.ws + O_ACT) + (size_t)16384 * 2816;
    const bfraw* W = (const bfraw*)(p.ws + o_w);
    const float* mods = (const float*)(p.ws + O_MODS);
    float* hctx = (float*)(p.ws + O_HCTX);
    __syncthreads();
    for (int t = blockIdx.x; t < 16 * 11; t += gridDim.x) {
      const int ks = t % 11, tt = t / 11, tm = tt >> 2, tn = tt & 3;
      f32x4 acc[4][4]; ZERO_ACC(acc, 4, 4);
      gemm_tile<128, 256, false, false, false>(act + (size_t)tm * 128 * 2816 + ks * 256, 2816, W + (size_t)tn * 256 * 2816 + ks * 256, 2816, 256, nullptr, acc, (bfraw*)lds, nullptr, 0);
      EPI_BEGIN(128, 256)
        const int grow = tm * 128 + row, gcol = tn * 256 + col;
        atomicAdd(hctx + (size_t)grow * 1024 + gcol, 0.5f * mods[2 * 9216 + gidx * 1024 + gcol] * acc[i][j][r]);
      EPI_END
    }
  }
}

DEVI void phase_g3c(const P& p, unsigned char* lds) {
  EpiMix<0> E{(bfraw*)(p.ws + O_CTXRAW), nullptr, nullptr, nullptr};
  run8(lds, (const bfraw*)(p.ws + O_HN) + (size_t)16384 * 1024, (const bfraw*)(p.ws + O_WTA), 512, 3072, 1024, E);
}

DEVI void phase_g3a(const P& p, unsigned char* lds, int hb) {
  EpiMix<1> E{(bfraw*)(p.ws + O_QRAW), (bfraw*)(p.ws + O_KRAW), (bfraw*)(p.ws + O_V), (bfraw*)(p.ws + O_GVS)};
  run8(lds, (const bfraw*)(p.ws + O_HN) + (size_t)hb * 8192 * 1024, (const bfraw*)(p.ws + O_WTA), 8192, 4096, 1024, E);
}

DEVI void phase_g3b(const P& p, unsigned char* lds, int hb) {
  EpiMix<2> E{(bfraw*)(p.ws + O_V), (bfraw*)(p.ws + O_GVS), (bfraw*)(p.ws + O_QC), (bfraw*)(p.ws + O_KC)};
  run8(lds, (const bfraw*)(p.ws + O_HN) + (size_t)hb * 8192 * 1024, (const bfraw*)(p.ws + O_WTB), 8192, 4096, 1024, E);
}

DEVI void phase_g4(const P& p, unsigned char* lds) {
  const int Gh = (int)gridDim.x >> 1, grp = (int)blockIdx.x / Gh, c = (int)blockIdx.x % Gh;
  if (grp == 0) { EpiMix<3> E{(bfraw*)(p.ws + O_QC), nullptr, nullptr, nullptr}; run8(lds, (const bfraw*)(p.ws + O_V), (const bfraw*)(p.ws + O_WA), 8192, 1024, 1024, E, Gh, c); }
  else if (grp == 1) { EpiMix<3> E{(bfraw*)(p.ws + O_KC), nullptr, nullptr, nullptr}; run8(lds, (const bfraw*)(p.ws + O_GVS), (const bfraw*)(p.ws + O_WB), 8192, 1024, 1024, E, Gh, c); }
}

DEVI void phase_g5(const P& p, unsigned char* lds, int hb) {
  EpiResid E{p.out, (const float*)(p.ws + O_MODS), hb * 8192, 5, 1.f};
  run8(lds, (const bfraw*)(p.ws + O_QC), (const bfraw*)(p.ws + O_WO), 8192, 1024, 1024, E);
  run8(lds, (const bfraw*)(p.ws + O_KC), (const bfraw*)(p.ws + O_WO), 8192, 1024, 1024, E);
}

DEVI void phase_cv(const P& p, int hb) {
  const int tid = ltid(), lane = tid & 63, wid = tid >> 6;
  const bfraw* qraw = (const bfraw*)(p.ws + O_QRAW);
  const bfraw* kraw = (const bfraw*)(p.ws + O_KRAW);
  const bfraw* craw = (const bfraw*)(p.ws + O_CTXRAW) + (size_t)hb * 256 * 3072;
  bfraw* qc = (bfraw*)(p.ws + O_QC);
  bfraw* kc = (bfraw*)(p.ws + O_KC);
  bfraw* vv = (bfraw*)(p.ws + O_V);
  const bfraw* gvs = (const bfraw*)(p.ws + O_GVS);
  float* rsb = (float*)(p.ws + O_RS);
  const float* cw = p.in[I_CONVW];
  const float* cb = p.in[I_CONVB];
  for (int task = blockIdx.x * 8 + wid; task < 1056 * 4; task += gridDim.x * 8) {
    const int sidx = task >> 2, part = task & 3, isk = part >> 1;
    const bool lat = sidx < 1024;
    const int lr0 = (lat ? sidx : sidx - 1024) * 8, len = lat ? 8192 : 256, orow0 = sidx * 8;
    const bfraw* src = lat ? (isk ? kraw : qraw) : (craw + isk * 1024);
    const size_t ld = lat ? 1024 : 3072;
    const int ch = (part & 1) * 512 + lane * 8, wch = isk * 1024 + ch;
    float w0[8], w1[8], w2[8], bb[8];
#pragma unroll
    for (int e = 0; e < 8; e += 4) {
      float4 a = ld4(cw + wch + e), b = ld4(cw + 2048 + wch + e), c4 = ld4(cw + 4096 + wch + e), d = ld4(cb + wch + e);
      w0[e] = a.x; w0[e + 1] = a.y; w0[e + 2] = a.z; w0[e + 3] = a.w; w1[e] = b.x; w1[e + 1] = b.y; w1[e + 2] = b.z; w1[e + 3] = b.w;
      w2[e] = c4.x; w2[e + 1] = c4.y; w2[e + 2] = c4.z; w2[e + 3] = c4.w; bb[e] = d.x; bb[e + 1] = d.y; bb[e + 2] = d.z; bb[e + 3] = d.w;
    }
    uint4 rw[10];
#pragma unroll
    for (int i = 0; i < 10; ++i) { const int lr = lr0 - 1 + i; uint4 t = {0u, 0u, 0u, 0u}; if (lr >= 0 && lr < len) t = *(const uint4*)(src + (size_t)lr * ld + ch); rw[i] = t; }
    const float osc = isk ? 1.f : 0.0625f;
    bfraw* dst = (isk ? kc : qc) + (size_t)orow0 * 1024 + ch;
#pragma unroll
    for (int i = 0; i < 8; ++i) {
      const unsigned av[4] = {rw[i].x, rw[i].y, rw[i].z, rw[i].w}, bv[4] = {rw[i + 1].x, rw[i + 1].y, rw[i + 1].z, rw[i + 1].w}, cv[4] = {rw[i + 2].x, rw[i + 2].y, rw[i + 2].z, rw[i + 2].w};
      unsigned ov[4];
#pragma unroll
      for (int e = 0; e < 4; ++e) {
        const float y0 = bf2f((bfraw)(av[e] & 0xffff)) * w0[2 * e] + bf2f((bfraw)(bv[e] & 0xffff)) * w1[2 * e] + bf2f((bfraw)(cv[e] & 0xffff)) * w2[2 * e] + bb[2 * e];
        const float y1 = bf2f((bfraw)(av[e] >> 16)) * w0[2 * e + 1] + bf2f((bfraw)(bv[e] >> 16)) * w1[2 * e + 1] + bf2f((bfraw)(cv[e] >> 16)) * w2[2 * e + 1] + bb[2 * e + 1];
        ov[e] = (unsigned)f2bf(siluf_(y0) * osc) | ((unsigned)f2bf(siluf_(y1) * osc) << 16);
      }
      *(uint4*)(dst + (size_t)i * 1024) = uint4{ov[0], ov[1], ov[2], ov[3]};
    }
  }
  for (int row = blockIdx.x * 8 + wid; row < 8448; row += gridDim.x * 8) {
    if (row < 8192) {
      float ss = 0;
#pragma unroll
      for (int hlf = 0; hlf < 2; ++hlf) {
        uint4 g = *(const uint4*)(gvs + (size_t)row * 1024 + hlf * 512 + lane * 8);
        unsigned gv[4] = {g.x, g.y, g.z, g.w};
#pragma unroll
        for (int e = 0; e < 4; ++e) { float a = bf2f((bfraw)(gv[e] & 0xffff)), b = bf2f((bfraw)(gv[e] >> 16)); ss += a * a + b * b; }
      }
      ss = wave_sum(ss);
      if (lane == 0) rsb[row] = rsqrtf(ss * (1.f / 1024.f) + EPS);
    } else {
#pragma unroll
      for (int hlf = 0; hlf < 2; ++hlf)
        *(uint4*)(vv + (size_t)row * 1024 + hlf * 512 + lane * 8) = *(const uint4*)(craw + 2048 + (size_t)(row - 8192) * 3072 + hlf * 512 + lane * 8);
    }
  }
}

DEVI void phase_ma(const P& p, unsigned char* lds, int hb) {
  const int tid = ltid();
  bfraw* st = (bfraw*)lds;
  float* sc = (float*)(lds + 131072);
  float* s_w = sc + 128, *s_ws = sc + 256, *s_red = sc + 384, *s_part = sc + 512;
  const float* bg = p.in[I_BGATES];
  for (int item = blockIdx.x; item < 528 + 256; item += gridDim.x) {
    unsigned char* wsb = lws(p.ws);
    const float* gates = (const float*)(wsb + O_GATES);
    const bfraw* kc = (const bfraw*)(wsb + O_KC);
    const bfraw* vv = (const bfraw*)(wsb + O_V);
    bfraw* states = (bfraw*)(wsb + O_ST);
    float* nloc = (float*)(wsb + O_NLOC);
    float* mg = (float*)(wsb + O_MG);
    if (item < 528) {
      const int seq = item / 66, j = item % 66, d = seq >> 2, h = seq & 3;
      int rbase, grow;
      if (j < 2) { int cc = d == 0 ? j : 1 - j; rbase = 8192 + cc * 128; grow = 16384 + hb * 256 + cc * 128; }
      else { int c = d == 0 ? j - 2 : 65 - j; rbase = c * 128; grow = hb * 8192 + c * 128; }
      __syncthreads();
      const int el = d == 0 ? (tid & 127) : 127 - (tid & 127);
      float li = 0.f, lf = 0.f;
      if (tid < 128) {
        li = gates[(size_t)(grow + el) * 16 + d * 8 + h] + bg[d * 8 + h];
        lf = logsigf_(gates[(size_t)(grow + el) * 16 + d * 8 + 4 + h] + bg[d * 8 + 4 + h]);
      }
      const float bcum = seg_scan_sum(lf, tid, s_red + 4);
      if (tid == 127) s_red[1] = bcum;
      __syncthreads();
      const float gtot = s_red[1];
      const float wv = gtot - bcum + li;
      if (tid < 128) s_w[el] = wv;
      __syncthreads();
      if (tid < 64) {
        float m = fmaxf(s_w[tid], s_w[tid + 64]);
#pragma unroll
        for (int o = 32; o > 0; o >>= 1) m = fmaxf(m, __shfl_xor(m, o, 64));
        if (tid == 0) s_red[0] = m;
      }
      __syncthreads();
      const float mloc = s_red[0];
      if (tid < 128) s_ws[el] = expf(wv - mloc);
      if (tid == 0) { mg[seq * 66 + j] = mloc; mg[528 + seq * 66 + j] = gtot; }
      __syncthreads();
      {
        const int k = tid & 255, part = tid >> 8;
        const bfraw* kp0 = kc + (size_t)(rbase + part * 64) * 1024 + h * 256 + k;
        float n = 0;
#pragma unroll 16
        for (int t = 0; t < 64; ++t) n += s_ws[part * 64 + t] * bf2f(kp0[(size_t)t * 1024]);
        s_part[tid] = n;
      }
      bfraw* dst = states + (size_t)(seq * 66 + j) * 65536;
#pragma unroll 1
      for (int vh = 0; vh < 2; ++vh) {
        f32x4 acc[4][4]; ZERO_ACC(acc, 4, 4);
        gemm_tile<128, 256, true, true, false>(vv + (size_t)rbase * 1024 + h * 256 + vh * 128, 1024, kc + (size_t)rbase * 1024 + h * 256, 1024, 128, s_ws, acc, st, nullptr, 0);
        EPI_BEGIN(128, 256)
          dst[(vh * 128 + row) * 256 + col] = f2bf(acc[i][j][r]);
        EPI_END
      }
      if (tid < 256) nloc[(size_t)(seq * 66 + j) * 256 + tid] = s_part[tid] + s_part[tid + 256];
    } else {
      const int it = item - 528, c = it >> 2, g = it & 3;
      bfraw* gvs = (bfraw*)(wsb + O_GVS);
      const float* rsb = (const float*)(wsb + O_RS);
      f32x4 acc[4][4]; ZERO_ACC(acc, 4, 4);
      gemm_tile<128, 256, false, true, false>((const bfraw*)(wsb + O_WSB) + g * 16384, 128, gvs + (size_t)c * 128 * 1024 + g * 256, 1024, 128, rsb + c * 128, acc, st, nullptr, 0);
      const float* gs = p.in[I_GSGU] + g * 256;
      const float* bs = p.in[I_BS] + g * 128;
      EPI_BEGIN(128, 256)
        gvs[(size_t)(c * 128 + row) * 1024 + g * 256 + col] = f2bf(gs[col] * acc[i][j][r] + bs[row]);
      EPI_END
    }
  }
}

DEVI void phase_mb(const P& p) {
  bfraw* states = (bfraw*)(p.ws + O_ST);
  const float* mg = (const float*)(p.ws + O_MG);
  float* ment = (float*)(p.ws + O_MG) + 1056;
  const float* nloc = (const float*)(p.ws + O_NLOC);
  float* nent = (float*)(p.ws + O_NENT);
  const int gid = blockIdx.x * NTHR + ltid(), gsz = gridDim.x * NTHR;
  for (int id = gid; id < 8 * 16384; id += gsz) {
    const int seq = id >> 14, e = (id & 16383) * 4;
    float s0 = 0, s1 = 0, s2 = 0, s3 = 0, m = 0;
    bfraw* base = states + (size_t)seq * 66 * 65536 + e;
#pragma unroll 1
    for (int cb = 0; cb < 66; cb += 22) {
      uint2 buf[22];
#pragma unroll
      for (int i = 0; i < 22; ++i) buf[i] = *(const uint2*)(base + (size_t)(cb + i) * 65536);
#pragma unroll
      for (int i = 0; i < 22; ++i) {
        const int j = cb + i;
        const uint2 cur = buf[i];
        const float mloc = mg[seq * 66 + j], g = mg[528 + seq * 66 + j];
        const float mnew = fmaxf(g + m, mloc);
        const float dec = expf(g + m - mnew), scl = expf(mloc - mnew);
        if (e == 0) ment[seq * 66 + j] = m;
        uint2 o; o.x = (unsigned)f2bf(s0) | ((unsigned)f2bf(s1) << 16); o.y = (unsigned)f2bf(s2) | ((unsigned)f2bf(s3) << 16);
        *(uint2*)(base + (size_t)j * 65536) = o;
        s0 = dec * s0 + scl * bf2f((bfraw)(cur.x & 0xffff)); s1 = dec * s1 + scl * bf2f((bfraw)(cur.x >> 16));
        s2 = dec * s2 + scl * bf2f((bfraw)(cur.y & 0xffff)); s3 = dec * s3 + scl * bf2f((bfraw)(cur.y >> 16));
        m = mnew;
      }
    }
  }
  for (int id = gid; id < 8 * 256; id += gsz) {
    const int seq = id >> 8, k = id & 255;
    float n = 0, m = 0;
    for (int j = 0; j < 66; ++j) {
      const float mloc = mg[seq * 66 + j], g = mg[528 + seq * 66 + j];
      const float mnew = fmaxf(g + m, mloc);
      const float dec = expf(g + m - mnew), scl = expf(mloc - mnew);
      nent[(size_t)(seq * 66 + j) * 256 + k] = n;
      n = dec * n + scl * nloc[(size_t)(seq * 66 + j) * 256 + k];
      m = mnew;
    }
  }
}

DEVI void phase_mc(const P& p, unsigned char* lds, int hb) {
  const int tid = ltid(), lane = tid & 63, wid = tid >> 6, wm = wid >> 2, wn = wid & 3, fr = lane & 15, fq = lane >> 4;
  bfraw* st = (bfraw*)lds;
  bfraw* sS = (bfraw*)(lds + 61440);
  float* sc = (float*)(lds + 131072);
  float* s_b = sc, *s_u = sc + 256, *s_mt = sc + 512, *s_in = sc + 768, *s_den = sc + 1024, *s_dq = sc + 1280, *s_tmp = sc + 1536;
  float* s_sum = sc + 1792, *s_sq = sc + 1920;
  const float* bg = p.in[I_BGATES];
  for (int item = blockIdx.x; item < 256; item += gridDim.x) {
    unsigned char* wsb = lws(p.ws);
    const float* gates = (const float*)(wsb + O_GATES);
    const bfraw* qc = (const bfraw*)(wsb + O_QC);
    const bfraw* kc = (const bfraw*)(wsb + O_KC);
    bfraw* vv = (bfraw*)(wsb + O_V);
    const bfraw* states = (const bfraw*)(wsb + O_ST);
    const float* ment = (const float*)(wsb + O_MG) + 1056;
    const float* nent = (const float*)(wsb + O_NENT);
    const int c = item >> 2, h = item & 3, R0 = c * 128;
    const bfraw* qp = qc + (size_t)R0 * 1024 + h * 256;
    const bfraw* kp = kc + (size_t)R0 * 1024 + h * 256;
    __syncthreads();
    {
      const int d = (tid >> 7) & 1, t = tid & 127, el = d == 0 ? t : 127 - t, ix = d * 128 + el;
      float li = 0.f, lf = 0.f;
      if (tid < 256) {
        const size_t grow = (size_t)hb * 8192 + R0 + el;
        li = gates[grow * 16 + d * 8 + h] + bg[d * 8 + h];
        lf = logsigf_(gates[grow * 16 + d * 8 + 4 + h] + bg[d * 8 + 4 + h]);
        s_den[tid] = 0.f;
        if (tid < 128) { s_sum[tid] = 0.f; s_sq[tid] = 0.f; }
      }
      const float b = seg_scan_sum(lf, tid, s_tmp);
      const float uu = li - b;
      const float pm = seg_scan_max(tid < 256 ? uu : -INFINITY, tid, s_tmp);
      if (tid < 256) {
        const int seq = d * 4 + h, j = d == 0 ? c + 2 : 65 - c;
        const float mst = ment[seq * 66 + j];
        const float a = b + mst;
        const float mt = fmaxf(a, b + pm);
        s_b[ix] = b; s_u[ix] = uu; s_mt[ix] = mt; s_in[ix] = expf(a - mt);
      }
    }
    {
      const int row = tid >> 2, part = tid & 3;
      const bfraw* q1 = qp + (size_t)row * 1024 + part * 64;
      const float* nf = nent + (size_t)((0 + h) * 66 + (c + 2)) * 256 + part * 64;
      const float* nb = nent + (size_t)((4 + h) * 66 + (65 - c)) * 256 + part * 64;
      float af = 0, ab = 0;
#pragma unroll 4
      for (int k = 0; k < 64; ++k) { float q = bf2f(q1[k]); af += q * nf[k]; ab += q * nb[k]; }
      af += __shfl_xor(af, 1, 64); af += __shfl_xor(af, 2, 64);
      ab += __shfl_xor(ab, 1, 64); ab += __shfl_xor(ab, 2, 64);
      if (part == 0) { s_dq[row] = af; s_dq[128 + row] = ab; }
    }
    __syncthreads();
    {
      f32x4 S[4][2]; ZERO_ACC(S, 4, 2);
      gemm_tile<128, 128, false, false, false>(qp, 1024, kp, 1024, 256, nullptr, S, st, nullptr, 0);
#pragma unroll 1
      for (int d = 0; d < 2; ++d)
#pragma unroll
        for (int i = 0; i < 4; ++i)
#pragma unroll
          for (int r = 0; r < 4; ++r) {
            const int row = wm * 64 + i * 16 + fq * 4 + r;
            const float bt = s_b[d * 128 + row] - s_mt[d * 128 + row];
            float rs = 0;
#pragma unroll
            for (int j = 0; j < 2; ++j) {
              const int col = wn * 32 + j * 16 + fr;
              const bool valid = d == 0 ? (col <= row) : (col >= row);
              const float val = valid ? S[i][j][r] * fexp(bt + s_u[d * 128 + col]) : 0.f;
              rs += val;
              sS[(d * 128 + row) * 136 + col] = f2bf(val);
            }
            rs = red16(rs);
            if (fr == 0) atomicAdd(&s_den[d * 128 + row], rs);
          }
    }
    __syncthreads();
    f32x4 hs[4][4];
    bfraw* hpark = (bfraw*)(wsb + O_HPARK) + (size_t)R0 * 1024 + h * 256;
#pragma unroll 1
    for (int d = 0; d < 2; ++d) {
      f32x4 (&acc)[4][4] = hs; ZERO_ACC(acc, 4, 4);
      const int seq = d * 4 + h, j2 = d == 0 ? c + 2 : 65 - c;
      gemm_tile<128, 256, false, false, false>(qp, 1024, states + (size_t)(seq * 66 + j2) * 65536, 256, 256, nullptr, acc, st, nullptr, 0);
      EPIR_BEGIN(128, 256)
        const float sin_ = s_in[d * 128 + row];
        EPIR_COLS(256) acc[i][j][r] *= sin_; (void)col;
      EPIR_END
      gemm_tile<128, 256, false, true, true>(nullptr, 0, vv + (size_t)R0 * 1024 + h * 256, 1024, 128, nullptr, acc, st, sS + d * 128 * 136, 136);
      EPIR_BEGIN(128, 256)
        const float den = s_den[d * 128 + row] + s_in[d * 128 + row] * s_dq[d * 128 + row];
        const float inv = 1.f / fmaxf(fabsf(den), expf(-s_mt[d * 128 + row]));
        EPIR_COLS(256)
          const float hv = acc[i][j][r] * inv;
          if (d == 0) hpark[(size_t)row * 1024 + col] = f2bf(hv);
          else hs[i][j][r] = hv + bf2f(hpark[(size_t)row * 1024 + col]);
      EPIR_END
    }
#pragma unroll
    for (int i = 0; i < 4; ++i)
#pragma unroll
      for (int r = 0; r < 4; ++r) {
        float ps = hs[i][0][r] + hs[i][1][r] + hs[i][2][r] + hs[i][3][r];
        ps = red16(ps);
        if (fr == 0) atomicAdd(&s_sum[wm * 64 + i * 16 + fq * 4 + r], ps);
      }
    __syncthreads();
#pragma unroll
    for (int i = 0; i < 4; ++i)
#pragma unroll
      for (int r = 0; r < 4; ++r) {
        const float mu = s_sum[wm * 64 + i * 16 + fq * 4 + r] * (1.f / 256.f);
        float ps = 0;
#pragma unroll
        for (int j = 0; j < 4; ++j) { float dlt = hs[i][j][r] - mu; ps += dlt * dlt; }
        ps = red16(ps);
        if (fr == 0) atomicAdd(&s_sq[wm * 64 + i * 16 + fq * 4 + r], ps);
      }
    __syncthreads();
    const float* gh = p.in[I_GHEAD] + h * 256;
    EPIR_BEGIN(128, 256)
      const float mu = s_sum[row] * (1.f / 256.f);
      const float rstd = rsqrtf(s_sq[row] * (1.f / 256.f) + EPS);
      EPIR_COLS(256)
        vv[(size_t)(R0 + row) * 1024 + h * 256 + col] = f2bf((hs[i][j][r] - mu) * rstd * gh[col]);
    EPIR_END
  }
}

constexpr int NPH = 27;
#define PHASE_PROGRAM \
  PHASE(0, phase_p0(p, lds)) \
  PHASE(1, phase_p0b(p)) \
  PHASE(2, phase_rows<1>(p, lds)) \
  PHASE(3, phase_ffn_in(p, lds, O_W1IN, 16896)) \
  PHASE(4, phase_ffn_out(p, lds, O_W1OUT, 2, true)) \
  PHASE(5, phase_rows<2>(p, lds)) \
  PHASE(6, phase_g3c(p, lds)) \
  PHASE(7, phase_g3a(p, lds, 0)) \
  PHASE(8, phase_cv(p, 0)) \
  PHASE(9, phase_ma(p, lds, 0)) \
  PHASE(10, phase_mb(p)) \
  PHASE(11, phase_mc(p, lds, 0)) \
  PHASE(12, phase_g3b(p, lds, 0)) \
  PHASE(13, phase_g4(p, lds)) \
  PHASE(14, phase_g5(p, lds, 0)) \
  PHASE(15, phase_g3a(p, lds, 1)) \
  PHASE(16, phase_cv(p, 1)) \
  PHASE(17, phase_ma(p, lds, 1)) \
  PHASE(18, phase_mb(p)) \
  PHASE(19, phase_mc(p, lds, 1)) \
  PHASE(20, phase_g3b(p, lds, 1)) \
  PHASE(21, phase_g4(p, lds)) \
  PHASE(22, phase_g5(p, lds, 1)) \
  PHASE(23, phase_rows<3>(p, lds)) \
  PHASE(24, phase_ffn_in(p, lds, O_W2IN, 16384)) \
  PHASE(25, phase_ffn_out(p, lds, O_W2OUT, 8, false)) \
  PHASE(26, phase_rows<4>(p, lds))

#if !MULTI_LAUNCH
#define PHASE(n, call) if (lo <= (n) && (n) < hi) { if ((n) > lo) { if ((n) == 1) grid.sync(); else xcd_barrier(xbar); } call; }
__global__ void __launch_bounds__(512) mk(P p, int lo, int hi) {
  extern __shared__ __attribute__((aligned(16))) unsigned char lds[];
  cg::grid_group grid = cg::this_grid();
  volatile LAS unsigned* stw = (volatile LAS unsigned*)(lds + LDS_BYTES - 16);
  if (threadIdx.x == 0) { stw[0] = 0u; stw[1] = 0u; stw[2] = 0u; stw[3] = 0u; }
  __syncthreads();
  XcdBarrier xbar = xcd_barrier_post((unsigned*)(p.ws + O_BAR), stw);
  PHASE_PROGRAM
}
#undef PHASE
#else
#define PHASE(n, call) if constexpr (PH == (n)) { call; }
template <int PH>
__global__ void __launch_bounds__(512) mkp(P p) {
  extern __shared__ __attribute__((aligned(16))) unsigned char lds[];
  PHASE_PROGRAM
}
#undef PHASE
template <int PH> static void launch_all(const P& p, int grid, hipStream_t stream) {
  if constexpr (PH < NPH) {
    (void)hipFuncSetAttribute((const void*)mkp<PH>, hipFuncAttributeMaxDynamicSharedMemorySize, LDS_BYTES);
    hipLaunchKernelGGL(mkp<PH>, dim3(grid), dim3(NTHR), LDS_BYTES, stream, p);
    launch_all<PH + 1>(p, grid, stream);
  }
}
#endif

extern "C" void kernel_launch(void* const* d_in, const int* in_sizes, int n_in, void* d_out, int out_size, void* d_ws, size_t ws_size, hipStream_t stream) {
  static int grid_blocks = 0;
  if (!grid_blocks) {
    if (n_in != 25 || ws_size < O_END || ws_size < O_ACT + 16896ull * 2816 * 2) { fprintf(stderr, "kernel_launch: unexpected n_in %d / ws %zu\n", n_in, ws_size); grid_blocks = -1; return; }
    int dev = 0, cus = 0, per_cu = 0;
    (void)hipGetDevice(&dev);
    (void)hipDeviceGetAttribute(&cus, hipDeviceAttributeMultiprocessorCount, dev);
#if !MULTI_LAUNCH
    if (hipFuncSetAttribute((const void*)mk, hipFuncAttributeMaxDynamicSharedMemorySize, LDS_BYTES) != hipSuccess) { fprintf(stderr, "hipFuncSetAttribute failed\n"); grid_blocks = -1; return; }
    if (hipOccupancyMaxActiveBlocksPerMultiprocessor(&per_cu, (const void*)mk, NTHR, LDS_BYTES) != hipSuccess || per_cu < 1) { fprintf(stderr, "occupancy query failed (%d)\n", per_cu); grid_blocks = -1; return; }
#endif
    grid_blocks = cus * 1;
    fprintf(stderr, "kernel_launch: cus %d per_cu %d grid %d\n", cus, per_cu, grid_blocks);
  }
  if (grid_blocks < 0) return;
  P p{};
  for (int i = 0; i < 25; ++i) p.in[i] = (const float*)d_in[i];
  p.out = (float*)d_out; p.ws = (unsigned char*)d_ws;
#if MULTI_LAUNCH
  launch_all<0>(p, grid_blocks, stream);
#else
  int lo = 0, hi = NPH;
  if (hipMemsetAsync((unsigned char*)d_ws + O_BAR, 0, 16384, stream) != hipSuccess) { fprintf(stderr, "memset of barrier words failed\n"); return; }
  void* args[] = {&p, &lo, &hi};
#ifdef PROBE_K
  {
    int plo = 0, phi = PROBE_K + 1; void* pargs[] = {&p, &plo, &phi};
    (void)hipLaunchCooperativeKernel((const void*)mk, dim3(grid_blocks), dim3(NTHR), pargs, LDS_BYTES, stream);
    (void)hipMemsetAsync((unsigned char*)d_ws + O_BAR, 0, 16384, stream);
  }
#endif
  hipError_t e = hipLaunchCooperativeKernel((const void*)mk, dim3(grid_blocks), dim3(NTHR), args, LDS_BYTES, stream);
  if (e != hipSuccess) fprintf(stderr, "cooperative launch failed: %s (grid %d)\n", hipGetErrorString(e), grid_blocks);
#endif
}
```

```cpp
#include <hip/hip_runtime.h>
#include <hip/hip_cooperative_groups.h>
#include <cstdio>
#include <cstdint>
namespace cg = cooperative_groups;

#ifndef MULTI_LAUNCH
#define MULTI_LAUNCH 0
#endif

typedef unsigned short bfraw;
typedef __attribute__((ext_vector_type(8))) short bf16x8;
typedef __attribute__((ext_vector_type(4))) float f32x4;
#define DEVI __device__ __forceinline__

constexpr int NTHR = 512;
constexpr int GBM = 128;
constexpr int LROW = 40;
constexpr int LDS_BYTES = 143360;
constexpr float EPS = 1e-6f;

enum { I_X, I_C, I_CTX, I_CCTX, I_WADA, I_BADA, I_GFFN1, I_W1IN, I_W1OUT, I_GMIX, I_WIN, I_BGATES, I_CONVW, I_CONVB,
       I_GHEAD, I_GSGU, I_WS, I_BS, I_WA, I_WB, I_WO, I_GFFN2, I_W2IN, I_W2OUT, I_GFINAL };

struct P { const float* in[25]; float* out; unsigned char* ws; };

constexpr size_t O_W1IN  = 0;
constexpr size_t O_W1OUT = O_W1IN  + 5632ull * 1024 * 2;
constexpr size_t O_WTA   = O_W1OUT + 1024ull * 2816 * 2;
constexpr size_t O_WTB   = O_WTA   + 4096ull * 1024 * 2;
constexpr size_t O_WA    = O_WTB   + 4096ull * 1024 * 2;
constexpr size_t O_WB    = O_WA    + 1024ull * 1024 * 2;
constexpr size_t O_WO    = O_WB    + 1024ull * 1024 * 2;
constexpr size_t O_W2IN  = O_WO    + 1024ull * 1024 * 2;
constexpr size_t O_W2OUT = O_W2IN  + 5632ull * 1024 * 2;
constexpr size_t O_WSB   = O_W2OUT + 1024ull * 2816 * 2;
constexpr size_t O_MODSP = O_WSB   + 4ull * 128 * 128 * 2;
constexpr size_t O_MODS  = O_MODSP + 16ull * 3 * 9216 * 4;
constexpr size_t O_HCTX  = O_MODS  + 3ull * 9216 * 4;
constexpr size_t O_HN    = O_HCTX  + 512ull * 1024 * 4;
constexpr size_t O_GATES = O_HN    + 16896ull * 1024 * 2;
constexpr size_t O_CTXRAW= O_GATES + 16896ull * 16 * 4;
constexpr size_t O_BIG   = O_CTXRAW+ 2ull * 256 * 3072 * 2;
constexpr size_t O_ACT   = O_BIG;
constexpr size_t O_ST    = O_BIG;
constexpr size_t O_QRAW  = O_BIG;
constexpr size_t O_KRAW  = O_QRAW  + 8448ull * 1024 * 2;
constexpr size_t O_V     = O_ST    + 8ull * 66 * 131072;
constexpr size_t O_GVS   = O_V     + 8448ull * 1024 * 2;
constexpr size_t O_QC    = O_GVS   + 8192ull * 1024 * 2;
constexpr size_t O_KC    = O_QC    + 8448ull * 1024 * 2;
constexpr size_t O_NLOC  = O_KC    + 8448ull * 1024 * 2;
constexpr size_t O_NENT  = O_NLOC  + 8ull * 66 * 256 * 4;
constexpr size_t O_MG    = O_NENT  + 8ull * 66 * 256 * 4;
constexpr size_t O_RS    = O_MG    + 8192;
constexpr size_t O_HPARK = O_RS    + 8192ull * 4;
constexpr size_t O_BAR   = O_HPARK + 8192ull * 1024 * 2;
constexpr size_t O_END   = O_BAR + 16384;
static_assert(O_ACT + 16896ull * 2816 * 2 <= 268435456ull, "ws");
static_assert(O_END <= 268435456ull, "ws");
static_assert(O_KRAW + 8448ull * 1024 * 2 <= O_V, "overlay");

DEVI int ltid() { int t = __builtin_amdgcn_workitem_id_x(); asm volatile("" : "+v"(t)); return t; }
DEVI unsigned char* lws(unsigned char* w) { asm volatile("" : "+s"(w)); return w; }
DEVI bfraw f2bf(float f) { unsigned u = __float_as_uint(f); u += 0x7fffu + ((u >> 16) & 1u); return (bfraw)(u >> 16); }
DEVI float bf2f(bfraw h) { return __uint_as_float(((unsigned)h) << 16); }
DEVI float fexp(float x) { return __builtin_amdgcn_exp2f(x * 1.4426950408889634f); }
DEVI float sigmoidf_(float x) { return __builtin_amdgcn_rcpf(1.f + fexp(-x)); }
DEVI float siluf_(float x) { return x * sigmoidf_(x); }
DEVI float geluf_(float x) { return x * sigmoidf_(1.5957691216057308f * (x + 0.044715f * x * x * x)); }
DEVI float logsigf_(float x) { return fminf(x, 0.f) - log1pf(expf(-fabsf(x))); }
DEVI float wave_sum(float v) {
#pragma unroll
  for (int o = 32; o > 0; o >>= 1) v += __shfl_xor(v, o, 64);
  return v;
}
DEVI float red16(float v) {
  v += __shfl_xor(v, 1, 64); v += __shfl_xor(v, 2, 64); v += __shfl_xor(v, 4, 64); v += __shfl_xor(v, 8, 64);
  return v;
}
DEVI float redsin(float a, bool cosine) {
  float k = rintf(a * 0.15915494309189535f);
  float r = fmaf(-k, 6.2831854820251465f, a);
  r = fmaf(-k, -1.7484555e-7f, r);
  return cosine ? __cosf(r) : __sinf(r);
}


DEVI float seg_scan_sum(float v, int tid, float* s_x) {
  const int lane = tid & 63;
#pragma unroll
  for (int o = 1; o < 64; o <<= 1) { float t = __shfl_up(v, o, 64); if (lane >= o) v += t; }
  if (lane == 63 && tid < 256) s_x[tid >> 6] = v;
  __syncthreads();
  if (tid < 256 && ((tid >> 6) & 1)) v += s_x[(tid >> 6) - 1];
  __syncthreads();
  return v;
}
DEVI float seg_scan_max(float v, int tid, float* s_x) {
  const int lane = tid & 63;
#pragma unroll
  for (int o = 1; o < 64; o <<= 1) { float t = __shfl_up(v, o, 64); if (lane >= o) v = fmaxf(v, t); }
  if (lane == 63 && tid < 256) s_x[tid >> 6] = v;
  __syncthreads();
  if (tid < 256 && ((tid >> 6) & 1)) v = fmaxf(v, s_x[(tid >> 6) - 1]);
  __syncthreads();
  return v;
}

#define XB_TMO      128
#define XB_XCNT(j)  (256  + 64 * (j))
#define XB_XSUB(j)  (1280 + 64 * (j))
#define XB_XGEN(j)  (2304 + 64 * (j))
#define XB_TOP      3328
#define XB_TOPGEN   3392
#define XCD_BAR_WORDS 3456
#define XB_SPIN_CAP (1u << 18)
#define LAS __attribute__((address_space(3)))

__device__ __forceinline__ unsigned xb_ld(unsigned* p)              { return __hip_atomic_load(p, __ATOMIC_RELAXED, __HIP_MEMORY_SCOPE_AGENT); }
__device__ __forceinline__ unsigned xb_add(unsigned* p, unsigned v) { return __hip_atomic_fetch_add(p, v, __ATOMIC_RELAXED, __HIP_MEMORY_SCOPE_AGENT); }
__device__ __forceinline__ unsigned xb_xcc_id() { return (unsigned)__builtin_amdgcn_s_getreg((3 << 11) | 20) & 0xFu; }
#define XB_SPIN(cond, bar) do { unsigned _sp = 0; while (cond) { __builtin_amdgcn_s_sleep(1); \
    if ((++_sp & 255u) == 0u) { if (xb_ld(&(bar)[XB_TMO])) break; if (_sp > XB_SPIN_CAP) { atomicAdd(&(bar)[XB_TMO], 1u); break; } } } } while (0)

struct XcdBarrier {
    unsigned* bar; unsigned x;
    volatile LAS unsigned* st;
};

__device__ __forceinline__ XcdBarrier xcd_barrier_post(unsigned* bar, volatile LAS unsigned* st) {
    XcdBarrier b; b.bar = bar; b.x = xb_xcc_id(); b.st = st;
    if (threadIdx.x == 0) (void)xb_add(&bar[XB_XCNT(b.x)], 1u);
    return b;
}
__device__ __forceinline__ void xcd_barrier_complete(unsigned* bar, unsigned x, unsigned& nloc, unsigned& nx) {
    const unsigned G = gridDim.x * gridDim.y * gridDim.z;
    unsigned sum, cnt, mine, sp = 0u;
    for (;;) {
        sum = 0u; cnt = 0u; mine = 0u;
#pragma unroll
        for (unsigned j = 0; j < 16; ++j) { const unsigned c = xb_ld(&bar[XB_XCNT(j)]); sum += c; cnt += (c > 0u) ? 1u : 0u; mine = (j == x) ? c : mine; }
        if (sum == G) break;
        __builtin_amdgcn_s_sleep(1);
        if ((++sp & 255u) == 0u) { if (xb_ld(&bar[XB_TMO])) break; if (sp > XB_SPIN_CAP) { atomicAdd(&bar[XB_TMO], 1u); break; } }
    }
    nloc = mine > 0u ? mine : 1u; nx = cnt > 0u ? cnt : 1u;
}

__device__ __forceinline__ void xcd_barrier(const XcdBarrier& b) {
    asm volatile("s_waitcnt vmcnt(0)" ::: "memory");
    __syncthreads();
    if (threadIdx.x == 0) {
        unsigned* bar = b.bar;
        __builtin_amdgcn_s_waitcnt(0);
        unsigned nloc = b.st[0], nx = b.st[1];
        if (nloc == 0u) { xcd_barrier_complete(bar, b.x, nloc, nx); b.st[0] = nloc; b.st[1] = nx; }
        const unsigned old = xb_add(&bar[XB_XSUB(b.x)], 1u);
        const unsigned gen = old / nloc;
        if (old + 1u == (gen + 1u) * nloc) {
            __builtin_amdgcn_fence(__ATOMIC_RELEASE, "agent");
            asm volatile("s_waitcnt vmcnt(0)" ::: "memory");
            const unsigned og = xb_add(&bar[XB_TOP], 1u);
            const unsigned tg = og / nx;
            if (og + 1u == (tg + 1u) * nx) xb_add(&bar[XB_TOPGEN], 1u);
            else XB_SPIN(xb_ld(&bar[XB_TOPGEN]) == tg, bar);
            __builtin_amdgcn_fence(__ATOMIC_ACQUIRE, "agent");
            xb_add(&bar[XB_XGEN(b.x)], 1u);
            asm volatile("s_waitcnt vmcnt(0)" ::: "memory");
        } else {
            XB_SPIN(xb_ld(&bar[XB_XGEN(b.x)]) == gen, bar);
            __builtin_amdgcn_fence(__ATOMIC_ACQUIRE, "agent");
            asm volatile("s_waitcnt vmcnt(0)" ::: "memory");
        }
    }
    __syncthreads();
}

template <int BM, int BN, bool ATR, bool BTR, bool ALDS>
DEVI void gemm_tile(const bfraw* __restrict__ A, int lda, const bfraw* __restrict__ B, int ldb, int K,
                    const float* kscale, f32x4 (&acc)[BM / 32][BN / 64], bfraw* st, const bfraw* sAres, int ldres) {
  constexpr int MI = BM / 32, NJ = BN / 64, CA = BM / 128, CB = BN / 128, WM = BM / 2, WN = BN / 4;
  constexpr int STAGE = (ALDS ? BN : (BM + BN)) * LROW;
  int tid_ = ltid();
  const int tid = tid_, lane = tid & 63, wid = tid >> 6, wm = wid >> 2, wn = wid & 3;
  const int fr = lane & 15, fq = lane >> 4;
  uint4 ra0 = {0, 0, 0, 0}, ra1 = {0, 0, 0, 0}, rb0 = {0, 0, 0, 0}, rb1 = {0, 0, 0, 0};
  const int nk = K >> 5;

  auto gla = [&](int c, int k0) -> uint4 {
    if (!ATR) { int row = c >> 2, kc = (c & 3) * 8; return *(const uint4*)(A + (size_t)row * lda + k0 + kc); }
    else { int krow = c / (BM / 8), m0 = (c % (BM / 8)) * 8; return *(const uint4*)(A + (size_t)(k0 + krow) * lda + m0); }
  };
  auto glb = [&](int c, int k0) -> uint4 {
    if (!BTR) { int row = c >> 2, kc = (c & 3) * 8; return *(const uint4*)(B + (size_t)row * ldb + k0 + kc); }
    else { int krow = c / (BN / 8), n0 = (c % (BN / 8)) * 8; return *(const uint4*)(B + (size_t)(k0 + krow) * ldb + n0); }
  };
  auto gload = [&](int kt) {
    const int k0 = kt << 5;
    if (!ALDS) { ra0 = gla(tid, k0); if (CA > 1) ra1 = gla(tid + NTHR, k0); }
    rb0 = glb(tid, k0); if (CB > 1) rb1 = glb(tid + NTHR, k0);
  };
  constexpr int TSA = BM + 8, TSB = BN + 8;
  auto scale8 = [&](uint4 r, float sc) -> uint4 {
    unsigned w[4] = {r.x, r.y, r.z, r.w};
#pragma unroll
    for (int e = 0; e < 4; ++e) w[e] = (unsigned)f2bf(bf2f((bfraw)(w[e] & 0xffff)) * sc) | ((unsigned)f2bf(bf2f((bfraw)(w[e] >> 16)) * sc) << 16);
    return uint4{w[0], w[1], w[2], w[3]};
  };
  auto lstore = [&](int buf, int kt) {
    bfraw* sA = st + buf * STAGE;
    bfraw* sB = sA + (ALDS ? 0 : BM * LROW);
    auto sta = [&](int c, uint4 v) {
      if (!ATR) { int row = c >> 2, kc = (c & 3) * 8; *(uint4*)(sA + row * LROW + kc) = v; }
      else { int krow = c / (BM / 8), m0 = (c % (BM / 8)) * 8; *(uint4*)(sA + krow * TSA + m0) = v; }
    };
    auto stb = [&](int c, uint4 v) {
      if (!BTR) { int row = c >> 2, kc = (c & 3) * 8; *(uint4*)(sB + row * LROW + kc) = v; }
      else {
        int krow = c / (BN / 8), n0 = (c % (BN / 8)) * 8;
        if (kscale) v = scale8(v, kscale[(kt << 5) + krow]);
        *(uint4*)(sB + krow * TSB + n0) = v;
      }
    };
    if (!ALDS) { sta(tid, ra0); if (CA > 1) sta(tid + NTHR, ra1); }
    stb(tid, rb0); if (CB > 1) stb(tid + NTHR, rb1);
  };
  typedef short s16x4 __attribute__((ext_vector_type(4)));
  auto trfrag = [&](const bfraw* sT, int TS, int mt) -> bf16x8 {
    const bfraw* a1 = sT + (8 * fq + (fr >> 2)) * TS + mt + (fr & 3) * 4;
    s16x4 r1 = __builtin_amdgcn_ds_read_tr16_b64_v4i16((__attribute__((address_space(3))) s16x4*)a1);
    s16x4 r2 = __builtin_amdgcn_ds_read_tr16_b64_v4i16((__attribute__((address_space(3))) s16x4*)(a1 + 4 * TS));
    return bf16x8{r1[0], r1[1], r1[2], r1[3], r2[0], r2[1], r2[2], r2[3]};
  };
  auto compute = [&](int buf, int kt) {
    const bfraw* sA = st + buf * STAGE;
    const bfraw* sB = sA + (ALDS ? 0 : BM * LROW);
    bf16x8 af[MI], bfr[NJ];
#pragma unroll
    for (int i = 0; i < MI; ++i) {
      if (ALDS) af[i] = *(const bf16x8*)(sAres + (wm * WM + i * 16 + fr) * ldres + (kt << 5) + fq * 8);
      else if (ATR) af[i] = trfrag(sA, TSA, wm * WM + i * 16);
      else af[i] = *(const bf16x8*)(sA + (wm * WM + i * 16 + fr) * LROW + fq * 8);
    }
#pragma unroll
    for (int j = 0; j < NJ; ++j) {
      if (BTR) bfr[j] = trfrag(sB, TSB, wn * WN + j * 16);
      else bfr[j] = *(const bf16x8*)(sB + (wn * WN + j * 16 + fr) * LROW + fq * 8);
    }
#pragma unroll
    for (int i = 0; i < MI; ++i)
#pragma unroll
      for (int j = 0; j < NJ; ++j) acc[i][j] = __builtin_amdgcn_mfma_f32_16x16x32_bf16(af[i], bfr[j], acc[i][j], 0, 0, 0);
  };

  __syncthreads();
  gload(0); lstore(0, 0);
  __syncthreads();
  for (int kt = 0; kt < nk; ++kt) {
    if (kt + 1 < nk) gload(kt + 1);
    compute(kt & 1, kt);
    if (kt + 1 < nk) lstore((kt + 1) & 1, kt + 1);
    __syncthreads();
  }
}

#define ZERO_ACC(acc, MI, NJ) _Pragma("unroll") for (int _i = 0; _i < (MI); ++_i) _Pragma("unroll") for (int _j = 0; _j < (NJ); ++_j) acc[_i][_j] = f32x4{0.f, 0.f, 0.f, 0.f};
#define EPI_BEGIN(BM, BN) { int _t = ltid(); const int _l = _t & 63, _w = _t >> 6; \
    const int _rb = (_w >> 2) * ((BM) / 2) + (_l >> 4) * 4, _cb = (_w & 3) * ((BN) / 4) + (_l & 15); \
    _Pragma("unroll") for (int i = 0; i < (BM) / 32; ++i) _Pragma("unroll") for (int j = 0; j < (BN) / 64; ++j) _Pragma("unroll") for (int r = 0; r < 4; ++r) { \
      const int row = _rb + i * 16 + r, col = _cb + j * 16;
#define EPI_END }}
#define EPIR_BEGIN(BM, BN) { int _t = ltid(); const int _l = _t & 63, _w = _t >> 6; \
    const int _rb = (_w >> 2) * ((BM) / 2) + (_l >> 4) * 4, _cb = (_w & 3) * ((BN) / 4) + (_l & 15); \
    _Pragma("unroll") for (int i = 0; i < (BM) / 32; ++i) _Pragma("unroll") for (int r = 0; r < 4; ++r) { \
      const int row = _rb + i * 16 + r;
#define EPIR_COLS(BN) _Pragma("unroll") for (int j = 0; j < (BN) / 64; ++j) { const int col = _cb + j * 16;
#define EPIR_END }}}


namespace pg8 {
#define PG8_LAS __attribute__((address_space(3)))
typedef unsigned short bf16_t;
typedef short bf16x8 __attribute__((ext_vector_type(8)));
typedef float f32x4 __attribute__((ext_vector_type(4)));
typedef unsigned u32x4 __attribute__((ext_vector_type(4)));
constexpr int BM = 256, BK = 64, HALF = 128, HTB = HALF * BK * 2  , STAGE_BYTES = 8 * HTB, NXCD = 8, WGM = 8;

__host__ __device__ __forceinline__ int lds_byte(int r, int c) { const int st = (r >> 4) * 2 + (c >> 5), rr = r & 15, cc = c & 31, ob = rr * 64 + cc * 2; return st * 1024 + (ob ^ (((ob >> 9) & 1) << 5)); }
__host__ __device__ __forceinline__ void stage_rc(int b, int& R, int& C) { const int st = b / 1024, sb = b % 1024, swz = sb ^ (((sb >> 9) & 1) << 5); R = (st >> 1) * 16 + swz / 64; C = (st & 1) * 32 + (swz % 64) / 2; }
__host__ __device__ __forceinline__ int perm32(int rho) { const int n = rho >> 4, i = rho & 15; return 8 * (i >> 2) + 4 * n + (i & 3); }

struct Unit { int pm, pn; };
struct Gemm { const bf16_t* A; const bf16_t* Bt; int M, N, K; };
struct StaticOrder {
    int nM, nN, nwg, G, c;
    __host__ __device__ void init(int M, int N, int G_, int c_) { nM = M / BM; nN = N / BM; nwg = nM * nN; G = G_; c = c_; }
    __host__ __device__ bool next(int i, Unit& u) const {
        const long L = (long)i * G + c; if (L >= nwg) return false;
        int wgid = (int)L; { const int q = nwg / NXCD, r = nwg % NXCD, xcd = wgid % NXCD, off = wgid / NXCD; wgid = (xcd < r ? xcd * (q + 1) : r * (q + 1) + (xcd - r) * q) + off; }
        const int nig = WGM * nN, gid = wgid / nig, fm = gid * WGM, gsz = (nM - fm) < WGM ? (nM - fm) : WGM;
        u.pm = fm + ((wgid % nig) % gsz); u.pn = (wgid % nig) / gsz; return true;
    }
    __device__ __forceinline__ void a_ready(const Unit&) const {}
    __device__ __forceinline__ void done(const Unit&) const {}
};
__device__ __forceinline__ unsigned cvt_pk_bf16(float lo, float hi) { unsigned r; asm volatile("v_cvt_pk_bf16_f32 %0, %1, %2" : "=v"(r) : "v"(lo), "v"(hi)); return r; }
template <class Epi, class Sched, bool STAMP = false>
__device__ __forceinline__ void gemm_phase(PG8_LAS unsigned char* lds, const Gemm g, const Sched& S, const Epi& E, unsigned long long* stamps) {
    const int tid = threadIdx.x, wid = __builtin_amdgcn_readfirstlane(tid >> 6), lane = tid & 63, wr = wid >> 2, wc = wid & 3, fr = lane & 15, fq = lane >> 4;
    const int K = g.K, nt = K / BK;
    int ts_lo = 0, ts_hi = 0, nts = 0; const unsigned long long rt_entry = STAMP ? (unsigned long long)wall_clock64() : 0ull;
#define PG8_STAMP() do { if (STAMP && wid == 0 && nts < 64) { const unsigned long long _c = (unsigned long long)clock64(); \
        ts_lo = (lane == nts) ? (int)(unsigned)_c : ts_lo; ts_hi = (lane == nts) ? (int)(unsigned)(_c >> 32) : ts_hi; ++nts; } } while (0)
    PG8_STAMP();
    unsigned voffA[2], voffB[2];
#pragma unroll
    for (int i = 0; i < 2; ++i) { int R, C; stage_rc(tid * 16 + i * 8192, R, C); const int Rb = Epi::PERM ? ((R & ~31) + perm32(R & 31)) : R;
        voffA[i] = (unsigned)(R * K + C) * 2u; voffB[i] = (unsigned)(Rb * K + C) * 2u; }
    const size_t kstep = (size_t)(BK * 2);
    const size_t hstep = (size_t)HALF * K * 2;
    const size_t tstep = 2 * hstep;
    const unsigned ldsw = (unsigned)wid * 1024u;
    const int aoff = lds_byte(wr * 64 + fr, fq * 8), boff = lds_byte(wc * 32 + fr, fq * 8);
#define PG8_SA(b, h) (((b) * 2 + (h)) * HTB)
#define PG8_SB(b, h) ((4 + (b) * 2 + (h)) * HTB)
#define PG8_STAGE(bufoff, gbase, voff) do { _Pragma("unroll") for (int _i = 0; _i < 2; ++_i) \
        __builtin_amdgcn_global_load_lds((const unsigned*)((const char*)(gbase) + (voff)[_i]), (PG8_LAS unsigned*)(lds + (bufoff) + ldsw + _i * 8192), 16, 0, 0); } while (0)
#define PG8_LDA(dst, b, h) do { _Pragma("unroll") for (int m = 0; m < 4; ++m) _Pragma("unroll") for (int k = 0; k < 2; ++k) dst[m][k] = *(const PG8_LAS bf16x8*)(lds + PG8_SA(b, h) + aoff + m * 2048 + k * 1024); } while (0)
#define PG8_LDB(dst, b, h) do { _Pragma("unroll") for (int n = 0; n < 2; ++n) _Pragma("unroll") for (int k = 0; k < 2; ++k) dst[n][k] = *(const PG8_LAS bf16x8*)(lds + PG8_SB(b, h) + boff + n * 2048 + k * 1024); } while (0)
#define PG8_MMA(ai, bj, At, Bt) do { __builtin_amdgcn_s_setprio(1); _Pragma("unroll") for (int m = 0; m < 4; ++m) _Pragma("unroll") for (int n = 0; n < 2; ++n) _Pragma("unroll") for (int k = 0; k < 2; ++k) \
        acc[ai][bj][m][n] = __builtin_amdgcn_mfma_f32_16x16x32_bf16(Bt[n][k], At[m][k], acc[ai][bj][m][n], 0, 0, 0); __builtin_amdgcn_s_setprio(0); } while (0)
#define PG8_WAIT_V(n) asm volatile("s_waitcnt vmcnt(" #n ")" ::: "memory")
#define PG8_WAIT_L(n) asm volatile("s_waitcnt lgkmcnt(" #n ")" ::: "memory")
#define PG8_BAR __builtin_amdgcn_s_barrier()
#define PG8_SCHED __builtin_amdgcn_sched_barrier(0)
    Unit cur, nxt; int ui = 0;
    if (!S.next(0, cur)) return;
    f32x4 acc[2][2][4][2];
#pragma unroll
    for (int a = 0; a < 2; ++a)
#pragma unroll
        for (int b = 0; b < 2; ++b)
#pragma unroll
            for (int m = 0; m < 4; ++m)
#pragma unroll
                for (int n = 0; n < 2; ++n) acc[a][b][m][n] = (f32x4){0.f, 0.f, 0.f, 0.f};
    bf16x8 At[4][2], B0[2][2], B1[2][2];
    const char* cA = (const char*)g.A + (size_t)cur.pm * tstep; const char* cB = (const char*)g.Bt + (size_t)cur.pn * tstep;
    S.a_ready(cur);
    PG8_STAGE(PG8_SB(0, 0), cB, voffB); PG8_STAGE(PG8_SA(0, 0), cA, voffA); PG8_STAGE(PG8_SB(0, 1), cB + hstep, voffB); PG8_STAGE(PG8_SA(0, 1), cA + hstep, voffA);
    if (wr == 1) PG8_BAR;
    PG8_WAIT_V(4); PG8_BAR;
    PG8_STAGE(PG8_SB(1, 0), cB + kstep, voffB); PG8_STAGE(PG8_SA(1, 0), cA + kstep, voffA); PG8_STAGE(PG8_SB(1, 1), cB + hstep + kstep, voffB);
    PG8_WAIT_V(6); PG8_BAR;
    PG8_STAMP();
    for (;;) {
        const bool has_next = S.next(ui + 1, nxt);
        const char* nA = has_next ? (const char*)g.A + (size_t)nxt.pm * tstep : cA; const char* nB = has_next ? (const char*)g.Bt + (size_t)nxt.pn * tstep : cB;
        for (int t = 0; t < nt; t += 2) {
            const bool last = (t == nt - 2);
            const char* a1 = cA + (size_t)(t + 1) * kstep;
            const char* a2 = last ? nA : cA + (size_t)(t + 2) * kstep; const char* b2 = last ? nB : cB + (size_t)(t + 2) * kstep;
            const char* a3 = a2 + kstep; const char* b3 = b2 + kstep;
            if (last && has_next) S.a_ready(nxt);
            PG8_LDB(B0, 0, 0); PG8_SCHED; PG8_LDA(At, 0, 0); PG8_STAGE(PG8_SA(1, 1), a1 + hstep, voffA);
            PG8_WAIT_L(8); PG8_BAR; PG8_WAIT_L(0); PG8_MMA(0, 0, At, B0); PG8_BAR; PG8_SCHED;
            PG8_LDB(B1, 0, 1); PG8_STAGE(PG8_SB(0, 0), b2, voffB);
            PG8_BAR; PG8_WAIT_L(0); PG8_MMA(0, 1, At, B1); PG8_BAR;
            PG8_LDA(At, 0, 1); PG8_STAGE(PG8_SA(0, 0), a2, voffA);
            PG8_BAR; PG8_WAIT_L(0); PG8_MMA(1, 0, At, B0); PG8_BAR; PG8_SCHED;
            PG8_STAGE(PG8_SB(0, 1), b2 + hstep, voffB);
            PG8_WAIT_V(6); PG8_BAR; PG8_MMA(1, 1, At, B1); PG8_BAR;
            PG8_LDB(B0, 1, 0); PG8_SCHED; PG8_LDA(At, 1, 0); PG8_STAGE(PG8_SA(0, 1), a2 + hstep, voffA);
            PG8_WAIT_L(8); PG8_BAR; PG8_WAIT_L(0); PG8_MMA(0, 0, At, B0); PG8_BAR; PG8_SCHED;
            PG8_LDB(B1, 1, 1); PG8_STAGE(PG8_SB(1, 0), b3, voffB);
            PG8_BAR; PG8_WAIT_L(0); PG8_MMA(0, 1, At, B1); PG8_BAR;
            PG8_LDA(At, 1, 1); PG8_STAGE(PG8_SA(1, 0), a3, voffA);
            PG8_BAR; PG8_WAIT_L(0); PG8_MMA(1, 0, At, B0); PG8_BAR; PG8_SCHED;
            PG8_STAGE(PG8_SB(1, 1), b3 + hstep, voffB);
            PG8_WAIT_V(6); PG8_BAR; PG8_MMA(1, 1, At, B1); PG8_BAR;
        }
        PG8_STAMP();
        if constexpr (!Epi::AFTER_DRAIN) { E(acc, cur, wr, wc, fr, fq); S.done(cur); }
        PG8_STAMP();
        if (!has_next) break;
#pragma unroll
        for (int a = 0; a < 2; ++a)
#pragma unroll
            for (int b = 0; b < 2; ++b)
#pragma unroll
                for (int m = 0; m < 4; ++m)
#pragma unroll
                    for (int n = 0; n < 2; ++n) acc[a][b][m][n] = (f32x4){0.f, 0.f, 0.f, 0.f};
        cur = nxt; cA = nA; cB = nB; ++ui;
    }
    PG8_WAIT_V(0);
    if (wr == 0) PG8_BAR;
    PG8_BAR;
    if constexpr (Epi::AFTER_DRAIN) { E.fused(acc, cur, wr, wc, fr, fq, lds, wid, lane); S.done(cur); }
    PG8_STAMP();
    if (STAMP && wid == 0) { stamps[lane] = lane < nts ? (((unsigned long long)(unsigned)ts_hi << 32) | (unsigned)ts_lo) : 0ull;
        if (lane == 62) stamps[62] = rt_entry; if (lane == 63) stamps[63] = (unsigned long long)wall_clock64(); }
#undef PG8_STAMP
#undef PG8_SA
#undef PG8_SB
#undef PG8_STAGE
#undef PG8_LDA
#undef PG8_LDB
#undef PG8_MMA
#undef PG8_WAIT_V
#undef PG8_WAIT_L
#undef PG8_BAR
#undef PG8_SCHED
}
}

typedef pg8::f32x4 pf4;
DEVI float4 ld4(const float* p) { return *(const float4*)p; }
struct EpiFfnIn {
  static constexpr bool PERM = false, AFTER_DRAIN = false;
  bfraw* act;
  DEVI void operator()(const pf4 (&acc)[2][2][4][2], const pg8::Unit& u, int wr, int wc, int fr, int fq) const {
    const int row0 = u.pm * 256 + wr * 64 + fr, f0 = (u.pn * 256 + wc * 32) / 2 + 4 * fq;
#pragma unroll
    for (int ai = 0; ai < 2; ++ai)
#pragma unroll
      for (int m = 0; m < 4; ++m) {
        bfraw* rowp = act + (size_t)(row0 + ai * 128 + m * 16) * 2816 + f0;
#pragma unroll
        for (int bj = 0; bj < 2; ++bj) {
          const pf4 a = acc[ai][bj][m][0], b = acc[ai][bj][m][1];
          uint2 w; w.x = pg8::cvt_pk_bf16(siluf_(a[0]) * b[0], siluf_(a[1]) * b[1]); w.y = pg8::cvt_pk_bf16(siluf_(a[2]) * b[2], siluf_(a[3]) * b[3]);
          *(uint2*)(rowp + bj * 64) = w;
        }
      }
  }
};
struct EpiResid {
  static constexpr bool PERM = false, AFTER_DRAIN = false;
  float* h; const float* mods; int rowoff, gidx; float scale;
  DEVI void operator()(const pf4 (&acc)[2][2][4][2], const pg8::Unit& u, int wr, int wc, int fr, int fq) const {
    const int row0 = rowoff + u.pm * 256 + wr * 64 + fr, col0 = u.pn * 256 + wc * 32 + 4 * fq;
#pragma unroll
    for (int ai = 0; ai < 2; ++ai)
#pragma unroll
      for (int m = 0; m < 4; ++m) {
        const int r = row0 + ai * 128 + m * 16;
        float* rowp = h + (size_t)r * 1024 + col0;
        const float* gp = mods + (r >> 13) * 9216 + gidx * 1024 + col0;
#pragma unroll
        for (int bj = 0; bj < 2; ++bj)
#pragma unroll
          for (int n = 0; n < 2; ++n) {
            float4 hv = ld4(rowp + bj * 128 + n * 16); const float4 g = ld4(gp + bj * 128 + n * 16); const pf4 a = acc[ai][bj][m][n];
            hv.x += scale * g.x * a[0]; hv.y += scale * g.y * a[1]; hv.z += scale * g.z * a[2]; hv.w += scale * g.w * a[3];
            *(float4*)(rowp + bj * 128 + n * 16) = hv;
          }
      }
  }
};
struct EpiResidAtomic {
  static constexpr bool PERM = false, AFTER_DRAIN = false;
  float* h; const float* mods; int rowoff, gidx;
  DEVI void operator()(const pf4 (&acc)[2][2][4][2], const pg8::Unit& u, int wr, int wc, int fr, int fq) const {
    const int row0 = rowoff + u.pm * 256 + wr * 64 + fr, col0 = u.pn * 256 + wc * 32 + 4 * fq;
#pragma unroll
    for (int ai = 0; ai < 2; ++ai)
#pragma unroll
      for (int m = 0; m < 4; ++m) {
        const int r = row0 + ai * 128 + m * 16;
        float* rowp = h + (size_t)r * 1024 + col0;
        const float* gp = mods + (r >> 13) * 9216 + gidx * 1024 + col0;
#pragma unroll
        for (int bj = 0; bj < 2; ++bj)
#pragma unroll
          for (int n = 0; n < 2; ++n) {
            const float4 g = ld4(gp + bj * 128 + n * 16); const pf4 a = acc[ai][bj][m][n];
            float* q = rowp + bj * 128 + n * 16;
            atomicAdd(q, g.x * a[0]); atomicAdd(q + 1, g.y * a[1]); atomicAdd(q + 2, g.z * a[2]); atomicAdd(q + 3, g.w * a[3]);
          }
      }
  }
};
template <int MODE> struct EpiMix {
  static constexpr bool PERM = true, AFTER_DRAIN = false;
  bfraw* d0; bfraw* d1; bfraw* d2; bfraw* d3;
  DEVI void operator()(const pf4 (&acc)[2][2][4][2], const pg8::Unit& u, int wr, int wc, int fr, int fq) const {
    const int row0 = u.pm * 256 + wr * 64 + fr;
    const int pc = u.pn >> 2;
    bfraw* dst = MODE == 0 ? d0 : (MODE == 1 || MODE == 2) ? (pc == 0 ? d0 : pc == 1 ? d1 : pc == 2 ? d2 : d3) : (MODE == 3 ? d0 : d1);
    const int ld = MODE == 0 ? 3072 : 1024;
    const int col0 = (MODE == 1 || MODE == 2 ? (u.pn & 3) : u.pn) * 256 + wc * 32 + 8 * fq;
#pragma unroll
    for (int ai = 0; ai < 2; ++ai)
#pragma unroll
      for (int m = 0; m < 4; ++m) {
        const size_t ro = (size_t)(row0 + ai * 128 + m * 16) * ld + col0;
#pragma unroll
        for (int bj = 0; bj < 2; ++bj) {
          float v[8];
#pragma unroll
          for (int e = 0; e < 4; ++e) { v[e] = acc[ai][bj][m][0][e]; v[4 + e] = acc[ai][bj][m][1][e]; }
          bfraw* dp = dst + ro + bj * 128;
          if (MODE == 1) { if (pc == 3) {
#pragma unroll
            for (int e = 0; e < 8; ++e) v[e] = geluf_(v[e]); } }
          if (MODE == 2 || MODE == 3 || MODE == 4) {
            const uint4 o = *(const uint4*)dp; const unsigned ow[4] = {o.x, o.y, o.z, o.w};
            float p[8];
#pragma unroll
            for (int e = 0; e < 4; ++e) { p[2 * e] = bf2f((bfraw)(ow[e] & 0xffff)); p[2 * e + 1] = bf2f((bfraw)(ow[e] >> 16)); }
            if (MODE == 2) {
#pragma unroll
              for (int e = 0; e < 8; ++e) v[e] = pc == 0 ? sigmoidf_(v[e]) * p[e] : pc == 1 ? geluf_(v[e]) * p[e] : sigmoidf_(v[e]);
            } else if (MODE == 3) {
#pragma unroll
              for (int e = 0; e < 8; ++e) v[e] *= p[e];
            } else {
              const uint4 t = *(const uint4*)(d0 + ro + bj * 128); const unsigned tw[4] = {t.x, t.y, t.z, t.w};
#pragma unroll
              for (int e = 0; e < 4; ++e) { v[2 * e] = bf2f((bfraw)(tw[e] & 0xffff)) + p[2 * e] * v[2 * e]; v[2 * e + 1] = bf2f((bfraw)(tw[e] >> 16)) + p[2 * e + 1] * v[2 * e + 1]; }
            }
          }
          uint4 w; w.x = pg8::cvt_pk_bf16(v[0], v[1]); w.y = pg8::cvt_pk_bf16(v[2], v[3]); w.z = pg8::cvt_pk_bf16(v[4], v[5]); w.w = pg8::cvt_pk_bf16(v[6], v[7]);
          *(uint4*)dp = w;
        }
      }
  }
};
template <class Epi>
DEVI void run8(unsigned char* lds, const bfraw* A, const bfraw* Bt, int M, int N, int K, const Epi& E, int G = -1, int c = -1) {
  pg8::Gemm g{A, Bt, M, N, K};
  pg8::StaticOrder S; S.init(M, N, G < 0 ? (int)gridDim.x : G, c < 0 ? (int)blockIdx.x : c);
  pg8::gemm_phase<Epi, pg8::StaticOrder, false>((PG8_LAS unsigned char*)lds, g, S, E, nullptr);
}

struct TrJob { const float* src; bfraw* dst; int ldw, K, kt, nt, drow0, mode; };
DEVI TrJob tr_decode(const P& p, int t) {
  TrJob j; int u = t;
  if (u < 1408) { j = TrJob{p.in[I_W1IN], (bfraw*)(p.ws + O_W1IN), 5632, 1024, u / 88, u % 88, 0, 1}; return j; }
  u -= 1408;
  if (u < 704) { j = TrJob{p.in[I_W1OUT], (bfraw*)(p.ws + O_W1OUT), 1024, 2816, u / 16, u % 16, 0, 0}; return j; }
  u -= 704;
  if (u < 2048) {
    const int pc = u >> 8; u &= 255;
    const int col0 = pc == 0 ? 0 : pc == 1 ? 1024 : pc == 2 ? 2048 : pc == 3 ? 5136 : pc == 4 ? 3088 : pc == 5 ? 4112 : pc == 6 ? 6160 : 7184;
    j = TrJob{p.in[I_WIN] + col0, (bfraw*)(p.ws + (pc < 4 ? O_WTA : O_WTB)), 8208, 1024, u >> 4, u & 15, (pc & 3) * 1024, 0}; return j;
  }
  u -= 2048;
  if (u < 768) { const int m = u >> 8; u &= 255; j = TrJob{p.in[m == 0 ? I_WA : m == 1 ? I_WB : I_WO], (bfraw*)(p.ws + (m == 0 ? O_WA : m == 1 ? O_WB : O_WO)), 1024, 1024, u >> 4, u & 15, 0, 0}; return j; }
  u -= 768;
  if (u < 1408) { j = TrJob{p.in[I_W2IN], (bfraw*)(p.ws + O_W2IN), 5632, 1024, u / 88, u % 88, 0, 1}; return j; }
  u -= 1408;
  j = TrJob{p.in[I_W2OUT], (bfraw*)(p.ws + O_W2OUT), 1024, 2816, u / 16, u % 16, 0, 0}; return j;
}

DEVI void phase_p0(const P& p, unsigned char* lds) {
  float* sf = (float*)lds;
  const int tid = ltid();
  for (int i = tid; i < 3072; i += NTHR) { float v = i < 2048 ? p.in[I_C][i] : p.in[I_CCTX][i - 2048]; sf[i] = v / (1.f + expf(-v)); }
  __syncthreads();
  {
    const float* w = p.in[I_WADA];
    float* mp = (float*)(p.ws + O_MODSP);
    for (int id = blockIdx.x * NTHR + tid; id < 16 * 9216; id += gridDim.x * NTHR) {
      int s = id / 9216, j = id - s * 9216;
      float a0 = 0, a1 = 0, a2 = 0;
#pragma unroll 16
      for (int k = s * 64; k < s * 64 + 64; ++k) { float wv = w[(size_t)k * 9216 + j]; a0 += sf[k] * wv; a1 += sf[1024 + k] * wv; a2 += sf[2048 + k] * wv; }
      mp[(s * 3 + 0) * 9216 + j] = a0; mp[(s * 3 + 1) * 9216 + j] = a1; mp[(s * 3 + 2) * 9216 + j] = a2;
    }
  }
  __syncthreads();
  {
    float rg[8];
    int t = blockIdx.x;
    TrJob jb = tr_decode(p, t < 7040 ? t : 0);
    if (t < 7040) {
#pragma unroll
      for (int i = 0; i < 8; ++i) { int e = tid + i * NTHR; int kk = e >> 6, nn = e & 63; rg[i] = jb.src[(size_t)(jb.kt * 64 + kk) * jb.ldw + jb.nt * 64 + nn]; }
    }
    for (; t < 7040; t += gridDim.x) {
#pragma unroll
      for (int i = 0; i < 8; ++i) { int e = tid + i * NTHR; int kk = e >> 6, nn = e & 63; sf[kk * 65 + nn] = rg[i]; }
      __syncthreads();
      const TrJob cj = jb;
      const int tn = t + gridDim.x;
      if (tn < 7040) {
        jb = tr_decode(p, tn);
#pragma unroll
        for (int i = 0; i < 8; ++i) { int e = tid + i * NTHR; int kk = e >> 6, nn = e & 63; rg[i] = jb.src[(size_t)(jb.kt * 64 + kk) * jb.ldw + jb.nt * 64 + nn]; }
      }
#pragma unroll
      for (int i = 0; i < 8; ++i) {
        int e = tid + i * NTHR; int nn = e >> 6, kk = e & 63;
        int n = cj.nt * 64 + nn, dr;
        if (cj.mode == 1) { int isb = n >= 2816; int f = n - isb * 2816; dr = (f >> 4) * 32 + isb * 16 + (f & 15); } else dr = cj.drow0 + n;
        cj.dst[(size_t)dr * cj.K + cj.kt * 64 + kk] = f2bf(sf[kk * 65 + nn]);
      }
      __syncthreads();
    }
  }
  { bfraw* d = (bfraw*)(p.ws + O_WSB); for (int id = blockIdx.x * NTHR + tid; id < 65536; id += gridDim.x * NTHR) d[id] = f2bf(p.in[I_WS][id]); }
}

DEVI void phase_p0b(const P& p) {
  const float* mp = (const float*)(p.ws + O_MODSP);
  float* m = (float*)(p.ws + O_MODS);
  for (int id = blockIdx.x * NTHR + ltid(); id < 3 * 9216; id += gridDim.x * NTHR) {
    int j = id % 9216;
    float a = p.in[I_BADA][j];
    for (int s = 0; s < 16; ++s) a += mp[s * 3 * 9216 + id];
    m[id] = a;
  }
}

template <int MODE>
DEVI void phase_rows(const P& p, unsigned char* lds) {
  const int tid = ltid(), lane = tid & 63, wid = tid >> 6;
  const float* mods = (const float*)(p.ws + O_MODS);
  float* hctx = (float*)(p.ws + O_HCTX);
  bfraw* hn = (bfraw*)(p.ws + O_HN);
  float* wg = (float*)lds;
  if (MODE == 2) {
    __syncthreads();
    for (int i = tid; i < 16384; i += NTHR) { int k = i >> 4, g = i & 15; wg[g * 1024 + k] = p.in[I_WIN][(size_t)k * 8208 + 3072 + g]; }
    __syncthreads();
  }
  const int nrows = (MODE == 1 || MODE == 2) ? 16896 : 16384;
  const float* gvec = p.in[MODE == 1 ? I_GFFN1 : MODE == 2 ? I_GMIX : MODE == 3 ? I_GFFN2 : I_GFINAL];
  const int msh = MODE == 1 ? 0 : MODE == 2 ? 3 : 6;
  for (int row = blockIdx.x * 8 + wid; row < nrows; row += gridDim.x * 8) {
    const bool lat = row < 16384;
    const int mrow = lat ? (row >> 13) : 2;
    float4 v[4];
    if (MODE == 1) {
      const float* src = lat ? p.in[I_X] + (size_t)row * 1024 : p.in[I_CTX] + (size_t)(row - 16384) * 1024;
#pragma unroll
      for (int i = 0; i < 4; ++i) v[i] = *(const float4*)(src + i * 256 + lane * 4);
      if (lat) {
        int ts = row & 8191; float rr = (float)(ts >> 6), cc = (float)(ts & 63);
        float fqv[4];
#pragma unroll
        for (int e = 0; e < 4; ++e) fqv[e] = expf((-9.210340371976184f * (float)(lane * 4 + e)) / 256.f);
        v[0].x += redsin(rr * fqv[0], false); v[0].y += redsin(rr * fqv[1], false); v[0].z += redsin(rr * fqv[2], false); v[0].w += redsin(rr * fqv[3], false);
        v[1].x += redsin(rr * fqv[0], true);  v[1].y += redsin(rr * fqv[1], true);  v[1].z += redsin(rr * fqv[2], true);  v[1].w += redsin(rr * fqv[3], true);
        v[2].x += redsin(cc * fqv[0], false); v[2].y += redsin(cc * fqv[1], false); v[2].z += redsin(cc * fqv[2], false); v[2].w += redsin(cc * fqv[3], false);
        v[3].x += redsin(cc * fqv[0], true);  v[3].y += redsin(cc * fqv[1], true);  v[3].z += redsin(cc * fqv[2], true);  v[3].w += redsin(cc * fqv[3], true);
      }
      float* dsth = lat ? p.out + (size_t)row * 1024 : hctx + (size_t)(row - 16384) * 1024;
#pragma unroll
      for (int i = 0; i < 4; ++i) *(float4*)(dsth + i * 256 + lane * 4) = v[i];
    } else {
      const float* src = lat ? p.out + (size_t)row * 1024 : hctx + (size_t)(row - 16384) * 1024;
#pragma unroll
      for (int i = 0; i < 4; ++i) v[i] = *(const float4*)(src + i * 256 + lane * 4);
    }
    float ss = 0;
#pragma unroll
    for (int i = 0; i < 4; ++i) ss += v[i].x * v[i].x + v[i].y * v[i].y + v[i].z * v[i].z + v[i].w * v[i].w;
    ss = wave_sum(ss);
    const float rs = rsqrtf(ss * (1.f / 1024.f) + EPS);
    if (MODE == 4) {
#pragma unroll
      for (int i = 0; i < 4; ++i) {
        float4 g = *(const float4*)(gvec + i * 256 + lane * 4);
        float4 o = {v[i].x * rs * g.x, v[i].y * rs * g.y, v[i].z * rs * g.z, v[i].w * rs * g.w};
        *(float4*)(p.out + (size_t)row * 1024 + i * 256 + lane * 4) = o;
      }
    } else {
      const float* sh = mods + (size_t)(mrow * 9216 + msh * 1024);
      const float* scp = sh + 1024;
      float y[16];
#pragma unroll
      for (int i = 0; i < 4; ++i) {
        const int c = i * 256 + lane * 4;
        float4 g = *(const float4*)(gvec + c), s4 = *(const float4*)(sh + c), c4 = *(const float4*)(scp + c);
        y[i * 4 + 0] = v[i].x * rs * g.x * (1.f + c4.x) + s4.x; y[i * 4 + 1] = v[i].y * rs * g.y * (1.f + c4.y) + s4.y;
        y[i * 4 + 2] = v[i].z * rs * g.z * (1.f + c4.z) + s4.z; y[i * 4 + 3] = v[i].w * rs * g.w * (1.f + c4.w) + s4.w;
        uint2 pk; pk.x = (unsigned)f2bf(y[i * 4]) | ((unsigned)f2bf(y[i * 4 + 1]) << 16); pk.y = (unsigned)f2bf(y[i * 4 + 2]) | ((unsigned)f2bf(y[i * 4 + 3]) << 16);
        *(uint2*)(hn + (size_t)row * 1024 + c) = pk;
      }
      if (MODE == 2) {
        float mine = 0.f;
#pragma unroll 2
        for (int g2 = 0; g2 < 16; ++g2) {
          float a = 0.f;
#pragma unroll
          for (int i = 0; i < 4; ++i) { float4 w4 = *(const float4*)(wg + g2 * 1024 + i * 256 + lane * 4); a += y[i * 4] * w4.x + y[i * 4 + 1] * w4.y + y[i * 4 + 2] * w4.z + y[i * 4 + 3] * w4.w; }
          a = wave_sum(a);
          if (lane == g2) mine = a;
        }
        if (lane < 16) ((float*)(p.ws + O_GATES))[(size_t)row * 16 + lane] = mine;
      }
    }
  }
}

DEVI void phase_ffn_in(const P& p, unsigned char* lds, size_t o_w, int nrows) {
  EpiFfnIn E{(bfraw*)(p.ws + O_ACT)};
  run8(lds, (const bfraw*)(p.ws + O_HN), (const bfraw*)(p.ws + o_w), nrows, 5632, 1024, E);
}

DEVI void phase_ffn_out(const P& p, unsigned char* lds, size_t o_w, int gidx, bool with_ctx) {
  EpiResid E{p.out, (const float*)(p.ws + O_MODS), 0, gidx, 0.5f};
  run8(lds, (const bfraw*)(p.ws + O_ACT), (const bfraw*)(p.ws + o_w), 16384, 1024, 2816, E);
  if (with_ctx) {
    const bfraw* act = (const bfraw*)(p.ws + O_ACT) + (size_t)16384 * 2816;
    const bfraw* W = (const bfraw*)(p.ws + o_w);
    const float* mods = (const float*)(p.ws + O_MODS);
    float* hctx = (float*)(p.ws + O_HCTX);
    __syncthreads();
    for (int t = blockIdx.x; t < 16 * 11; t += gridDim.x) {
      const int ks = t % 11, tt = t / 11, tm = tt >> 2, tn = tt & 3;
      f32x4 acc[4][4]; ZERO_ACC(acc, 4, 4);
      gemm_tile<128, 256, false, false, false>(act + (size_t)tm * 128 * 2816 + ks * 256, 2816, W + (size_t)tn * 256 * 2816 + ks * 256, 2816, 256, nullptr, acc, (bfraw*)lds, nullptr, 0);
      EPI_BEGIN(128, 256)
        const int grow = tm * 128 + row, gcol = tn * 256 + col;
        atomicAdd(hctx + (size_t)grow * 1024 + gcol, 0.5f * mods[2 * 9216 + gidx * 1024 + gcol] * acc[i][j][r]);
      EPI_END
    }
  }
}

DEVI void phase_g3c(const P& p, unsigned char* lds) {
  EpiMix<0> E{(bfraw*)(p.ws + O_CTXRAW), nullptr, nullptr, nullptr};
  run8(lds, (const bfraw*)(p.ws + O_HN) + (size_t)16384 * 1024, (const bfraw*)(p.ws + O_WTA), 512, 3072, 1024, E);
}

DEVI void phase_g3a(const P& p, unsigned char* lds, int hb) {
  EpiMix<1> E{(bfraw*)(p.ws + O_QRAW), (bfraw*)(p.ws + O_KRAW), (bfraw*)(p.ws + O_V), (bfraw*)(p.ws + O_GVS)};
  run8(lds, (const bfraw*)(p.ws + O_HN) + (size_t)hb * 8192 * 1024, (const bfraw*)(p.ws + O_WTA), 8192, 4096, 1024, E);
}

DEVI void phase_g3b(const P& p, unsigned char* lds, int hb) {
  EpiMix<2> E{(bfraw*)(p.ws + O_V), (bfraw*)(p.ws + O_GVS), (bfraw*)(p.ws + O_QC), (bfraw*)(p.ws + O_KC)};
  run8(lds, (const bfraw*)(p.ws + O_HN) + (size_t)hb * 8192 * 1024, (const bfraw*)(p.ws + O_WTB), 8192, 4096, 1024, E);
}

DEVI void phase_g4(const P& p, unsigned char* lds) {
  const int Gh = (int)gridDim.x >> 1, grp = (int)blockIdx.x / Gh, c = (int)blockIdx.x % Gh;
  if (grp == 0) { EpiMix<3> E{(bfraw*)(p.ws + O_QC), nullptr, nullptr, nullptr}; run8(lds, (const bfraw*)(p.ws + O_V), (const bfraw*)(p.ws + O_WA), 8192, 1024, 1024, E, Gh, c); }
  else if (grp == 1) { EpiMix<3> E{(bfraw*)(p.ws + O_KC), nullptr, nullptr, nullptr}; run8(lds, (const bfraw*)(p.ws + O_GVS), (const bfraw*)(p.ws + O_WB), 8192, 1024, 1024, E, Gh, c); }
}

DEVI void phase_addmix(const P& p, int hb) {
  const uint4* t1 = (const uint4*)(p.ws + O_QC);
  const uint4* t2 = (const uint4*)(p.ws + O_KC);
  uint4* dst = (uint4*)(p.ws + (hb == 0 ? O_W1IN : O_QC));
  const int tid = ltid();
  for (int i = blockIdx.x * NTHR + tid; i < 8192 * 128; i += gridDim.x * NTHR) {
    const uint4 a = t1[i], b = t2[i];
    const unsigned aw[4] = {a.x, a.y, a.z, a.w}, bw[4] = {b.x, b.y, b.z, b.w}; unsigned o[4];
#pragma unroll
    for (int e = 0; e < 4; ++e) o[e] = (unsigned)f2bf(bf2f((bfraw)(aw[e] & 0xffff)) + bf2f((bfraw)(bw[e] & 0xffff))) | ((unsigned)f2bf(bf2f((bfraw)(aw[e] >> 16)) + bf2f((bfraw)(bw[e] >> 16))) << 16);
    dst[i] = uint4{o[0], o[1], o[2], o[3]};
  }
}

DEVI void phase_g5(const P& p, unsigned char* lds) {
  const int Gh = (int)gridDim.x >> 1, grp = (int)blockIdx.x / Gh, c = (int)blockIdx.x % Gh;
  EpiResid E{p.out, (const float*)(p.ws + O_MODS), grp * 8192, 5, 1.f};
  if (grp < 2) run8(lds, (const bfraw*)(p.ws + (grp == 0 ? O_W1IN : O_QC)), (const bfraw*)(p.ws + O_WO), 8192, 1024, 1024, E, Gh, c);
}

DEVI void phase_cv(const P& p, int hb) {
  const int tid = ltid(), lane = tid & 63, wid = tid >> 6;
  const bfraw* qraw = (const bfraw*)(p.ws + O_QRAW);
  const bfraw* kraw = (const bfraw*)(p.ws + O_KRAW);
  const bfraw* craw = (const bfraw*)(p.ws + O_CTXRAW) + (size_t)hb * 256 * 3072;
  bfraw* qc = (bfraw*)(p.ws + O_QC);
  bfraw* kc = (bfraw*)(p.ws + O_KC);
  bfraw* vv = (bfraw*)(p.ws + O_V);
  const bfraw* gvs = (const bfraw*)(p.ws + O_GVS);
  float* rsb = (float*)(p.ws + O_RS);
  const float* cw = p.in[I_CONVW];
  const float* cb = p.in[I_CONVB];
  for (int task = blockIdx.x * 8 + wid; task < 1056 * 4; task += gridDim.x * 8) {
    const int sidx = task >> 2, part = task & 3, isk = part >> 1;
    const bool lat = sidx < 1024;
    const int lr0 = (lat ? sidx : sidx - 1024) * 8, len = lat ? 8192 : 256, orow0 = sidx * 8;
    const bfraw* src = lat ? (isk ? kraw : qraw) : (craw + isk * 1024);
    const size_t ld = lat ? 1024 : 3072;
    const int ch = (part & 1) * 512 + lane * 8, wch = isk * 1024 + ch;
    float w0[8], w1[8], w2[8], bb[8];
#pragma unroll
    for (int e = 0; e < 8; e += 4) {
      float4 a = ld4(cw + wch + e), b = ld4(cw + 2048 + wch + e), c4 = ld4(cw + 4096 + wch + e), d = ld4(cb + wch + e);
      w0[e] = a.x; w0[e + 1] = a.y; w0[e + 2] = a.z; w0[e + 3] = a.w; w1[e] = b.x; w1[e + 1] = b.y; w1[e + 2] = b.z; w1[e + 3] = b.w;
      w2[e] = c4.x; w2[e + 1] = c4.y; w2[e + 2] = c4.z; w2[e + 3] = c4.w; bb[e] = d.x; bb[e + 1] = d.y; bb[e + 2] = d.z; bb[e + 3] = d.w;
    }
    uint4 rw[10];
#pragma unroll
    for (int i = 0; i < 10; ++i) { const int lr = lr0 - 1 + i; uint4 t = {0u, 0u, 0u, 0u}; if (lr >= 0 && lr < len) t = *(const uint4*)(src + (size_t)lr * ld + ch); rw[i] = t; }
    const float osc = isk ? 1.f : 0.0625f;
    bfraw* dst = (isk ? kc : qc) + (size_t)orow0 * 1024 + ch;
#pragma unroll
    for (int i = 0; i < 8; ++i) {
      const unsigned av[4] = {rw[i].x, rw[i].y, rw[i].z, rw[i].w}, bv[4] = {rw[i + 1].x, rw[i + 1].y, rw[i + 1].z, rw[i + 1].w}, cv[4] = {rw[i + 2].x, rw[i + 2].y, rw[i + 2].z, rw[i + 2].w};
      unsigned ov[4];
#pragma unroll
      for (int e = 0; e < 4; ++e) {
        const float y0 = bf2f((bfraw)(av[e] & 0xffff)) * w0[2 * e] + bf2f((bfraw)(bv[e] & 0xffff)) * w1[2 * e] + bf2f((bfraw)(cv[e] & 0xffff)) * w2[2 * e] + bb[2 * e];
        const float y1 = bf2f((bfraw)(av[e] >> 16)) * w0[2 * e + 1] + bf2f((bfraw)(bv[e] >> 16)) * w1[2 * e + 1] + bf2f((bfraw)(cv[e] >> 16)) * w2[2 * e + 1] + bb[2 * e + 1];
        ov[e] = (unsigned)f2bf(siluf_(y0) * osc) | ((unsigned)f2bf(siluf_(y1) * osc) << 16);
      }
      *(uint4*)(dst + (size_t)i * 1024) = uint4{ov[0], ov[1], ov[2], ov[3]};
    }
  }
  for (int row = blockIdx.x * 8 + wid; row < 8448; row += gridDim.x * 8) {
    if (row < 8192) {
      float ss = 0;
#pragma unroll
      for (int hlf = 0; hlf < 2; ++hlf) {
        uint4 g = *(const uint4*)(gvs + (size_t)row * 1024 + hlf * 512 + lane * 8);
        unsigned gv[4] = {g.x, g.y, g.z, g.w};
#pragma unroll
        for (int e = 0; e < 4; ++e) { float a = bf2f((bfraw)(gv[e] & 0xffff)), b = bf2f((bfraw)(gv[e] >> 16)); ss += a * a + b * b; }
      }
      ss = wave_sum(ss);
      if (lane == 0) rsb[row] = rsqrtf(ss * (1.f / 1024.f) + EPS);
    } else {
#pragma unroll
      for (int hlf = 0; hlf < 2; ++hlf)
        *(uint4*)(vv + (size_t)row * 1024 + hlf * 512 + lane * 8) = *(const uint4*)(craw + 2048 + (size_t)(row - 8192) * 3072 + hlf * 512 + lane * 8);
    }
  }
}

DEVI void phase_ma(const P& p, unsigned char* lds, int hb) {
  const int tid = ltid();
  bfraw* st = (bfraw*)lds;
  float* sc = (float*)(lds + 131072);
  float* s_w = sc + 128, *s_ws = sc + 256, *s_red = sc + 384, *s_part = sc + 512;
  const float* bg = p.in[I_BGATES];
  for (int item = blockIdx.x; item < 528 + 256; item += gridDim.x) {
    unsigned char* wsb = lws(p.ws);
    const float* gates = (const float*)(wsb + O_GATES);
    const bfraw* kc = (const bfraw*)(wsb + O_KC);
    const bfraw* vv = (const bfraw*)(wsb + O_V);
    bfraw* states = (bfraw*)(wsb + O_ST);
    float* nloc = (float*)(wsb + O_NLOC);
    float* mg = (float*)(wsb + O_MG);
    if (item < 528) {
      const int seq = item / 66, j = item % 66, d = seq >> 2, h = seq & 3;
      int rbase, grow;
      if (j < 2) { int cc = d == 0 ? j : 1 - j; rbase = 8192 + cc * 128; grow = 16384 + hb * 256 + cc * 128; }
      else { int c = d == 0 ? j - 2 : 65 - j; rbase = c * 128; grow = hb * 8192 + c * 128; }
      __syncthreads();
      const int el = d == 0 ? (tid & 127) : 127 - (tid & 127);
      float li = 0.f, lf = 0.f;
      if (tid < 128) {
        li = gates[(size_t)(grow + el) * 16 + d * 8 + h] + bg[d * 8 + h];
        lf = logsigf_(gates[(size_t)(grow + el) * 16 + d * 8 + 4 + h] + bg[d * 8 + 4 + h]);
      }
      const float bcum = seg_scan_sum(lf, tid, s_red + 4);
      if (tid == 127) s_red[1] = bcum;
      __syncthreads();
      const float gtot = s_red[1];
      const float wv = gtot - bcum + li;
      if (tid < 128) s_w[el] = wv;
      __syncthreads();
      if (tid < 64) {
        float m = fmaxf(s_w[tid], s_w[tid + 64]);
#pragma unroll
        for (int o = 32; o > 0; o >>= 1) m = fmaxf(m, __shfl_xor(m, o, 64));
        if (tid == 0) s_red[0] = m;
      }
      __syncthreads();
      const float mloc = s_red[0];
      if (tid < 128) s_ws[el] = expf(wv - mloc);
      if (tid == 0) { mg[seq * 66 + j] = mloc; mg[528 + seq * 66 + j] = gtot; }
      __syncthreads();
      {
        const int k = tid & 255, part = tid >> 8;
        const bfraw* kp0 = kc + (size_t)(rbase + part * 64) * 1024 + h * 256 + k;
        float n = 0;
#pragma unroll 16
        for (int t = 0; t < 64; ++t) n += s_ws[part * 64 + t] * bf2f(kp0[(size_t)t * 1024]);
        s_part[tid] = n;
      }
      bfraw* dst = states + (size_t)(seq * 66 + j) * 65536;
#pragma unroll 1
      for (int vh = 0; vh < 2; ++vh) {
        f32x4 acc[4][4]; ZERO_ACC(acc, 4, 4);
        gemm_tile<128, 256, true, true, false>(vv + (size_t)rbase * 1024 + h * 256 + vh * 128, 1024, kc + (size_t)rbase * 1024 + h * 256, 1024, 128, s_ws, acc, st, nullptr, 0);
        EPI_BEGIN(128, 256)
          dst[(vh * 128 + row) * 256 + col] = f2bf(acc[i][j][r]);
        EPI_END
      }
      if (tid < 256) nloc[(size_t)(seq * 66 + j) * 256 + tid] = s_part[tid] + s_part[tid + 256];
    } else {
      const int it = item - 528, c = it >> 2, g = it & 3;
      bfraw* gvs = (bfraw*)(wsb + O_GVS);
      const float* rsb = (const float*)(wsb + O_RS);
      f32x4 acc[4][4]; ZERO_ACC(acc, 4, 4);
      gemm_tile<128, 256, false, true, false>((const bfraw*)(wsb + O_WSB) + g * 16384, 128, gvs + (size_t)c * 128 * 1024 + g * 256, 1024, 128, rsb + c * 128, acc, st, nullptr, 0);
      const float* gs = p.in[I_GSGU] + g * 256;
      const float* bs = p.in[I_BS] + g * 128;
      EPI_BEGIN(128, 256)
        gvs[(size_t)(c * 128 + row) * 1024 + g * 256 + col] = f2bf(gs[col] * acc[i][j][r] + bs[row]);
      EPI_END
    }
  }
}

DEVI void phase_mb(const P& p) {
  bfraw* states = (bfraw*)(p.ws + O_ST);
  const float* mg = (const float*)(p.ws + O_MG);
  float* ment = (float*)(p.ws + O_MG) + 1056;
  const float* nloc = (const float*)(p.ws + O_NLOC);
  float* nent = (float*)(p.ws + O_NENT);
  const int gid = blockIdx.x * NTHR + ltid(), gsz = gridDim.x * NTHR;
  for (int id = gid; id < 8 * 16384; id += gsz) {
    const int seq = id >> 14, e = (id & 16383) * 4;
    float s0 = 0, s1 = 0, s2 = 0, s3 = 0, m = 0;
    bfraw* base = states + (size_t)seq * 66 * 65536 + e;
#pragma unroll 1
    for (int cb = 0; cb < 66; cb += 22) {
      uint2 buf[22];
#pragma unroll
      for (int i = 0; i < 22; ++i) buf[i] = *(const uint2*)(base + (size_t)(cb + i) * 65536);
#pragma unroll
      for (int i = 0; i < 22; ++i) {
        const int j = cb + i;
        const uint2 cur = buf[i];
        const float mloc = mg[seq * 66 + j], g = mg[528 + seq * 66 + j];
        const float mnew = fmaxf(g + m, mloc);
        const float dec = expf(g + m - mnew), scl = expf(mloc - mnew);
        if (e == 0) ment[seq * 66 + j] = m;
        uint2 o; o.x = (unsigned)f2bf(s0) | ((unsigned)f2bf(s1) << 16); o.y = (unsigned)f2bf(s2) | ((unsigned)f2bf(s3) << 16);
        *(uint2*)(base + (size_t)j * 65536) = o;
        s0 = dec * s0 + scl * bf2f((bfraw)(cur.x & 0xffff)); s1 = dec * s1 + scl * bf2f((bfraw)(cur.x >> 16));
        s2 = dec * s2 + scl * bf2f((bfraw)(cur.y & 0xffff)); s3 = dec * s3 + scl * bf2f((bfraw)(cur.y >> 16));
        m = mnew;
      }
    }
  }
  for (int id = gid; id < 8 * 256; id += gsz) {
    const int seq = id >> 8, k = id & 255;
    float n = 0, m = 0;
    for (int j = 0; j < 66; ++j) {
      const float mloc = mg[seq * 66 + j], g = mg[528 + seq * 66 + j];
      const float mnew = fmaxf(g + m, mloc);
      const float dec = expf(g + m - mnew), scl = expf(mloc - mnew);
      nent[(size_t)(seq * 66 + j) * 256 + k] = n;
      n = dec * n + scl * nloc[(size_t)(seq * 66 + j) * 256 + k];
      m = mnew;
    }
  }
}

DEVI void phase_mc(const P& p, unsigned char* lds, int hb) {
  const int tid = ltid(), lane = tid & 63, wid = tid >> 6, wm = wid >> 2, wn = wid & 3, fr = lane & 15, fq = lane >> 4;
  bfraw* st = (bfraw*)lds;
  bfraw* sS = (bfraw*)(lds + 61440);
  float* sc = (float*)(lds + 131072);
  float* s_b = sc, *s_u = sc + 256, *s_mt = sc + 512, *s_in = sc + 768, *s_den = sc + 1024, *s_dq = sc + 1280, *s_tmp = sc + 1536;
  float* s_sum = sc + 1792, *s_sq = sc + 1920;
  const float* bg = p.in[I_BGATES];
  for (int item = blockIdx.x; item < 256; item += gridDim.x) {
    unsigned char* wsb = lws(p.ws);
    const float* gates = (const float*)(wsb + O_GATES);
    const bfraw* qc = (const bfraw*)(wsb + O_QC);
    const bfraw* kc = (const bfraw*)(wsb + O_KC);
    bfraw* vv = (bfraw*)(wsb + O_V);
    const bfraw* states = (const bfraw*)(wsb + O_ST);
    const float* ment = (const float*)(wsb + O_MG) + 1056;
    const float* nent = (const float*)(wsb + O_NENT);
    const int c = item >> 2, h = item & 3, R0 = c * 128;
    const bfraw* qp = qc + (size_t)R0 * 1024 + h * 256;
    const bfraw* kp = kc + (size_t)R0 * 1024 + h * 256;
    __syncthreads();
    {
      const int d = (tid >> 7) & 1, t = tid & 127, el = d == 0 ? t : 127 - t, ix = d * 128 + el;
      float li = 0.f, lf = 0.f;
      if (tid < 256) {
        const size_t grow = (size_t)hb * 8192 + R0 + el;
        li = gates[grow * 16 + d * 8 + h] + bg[d * 8 + h];
        lf = logsigf_(gates[grow * 16 + d * 8 + 4 + h] + bg[d * 8 + 4 + h]);
        s_den[tid] = 0.f;
        if (tid < 128) { s_sum[tid] = 0.f; s_sq[tid] = 0.f; }
      }
      const float b = seg_scan_sum(lf, tid, s_tmp);
      const float uu = li - b;
      const float pm = seg_scan_max(tid < 256 ? uu : -INFINITY, tid, s_tmp);
      if (tid < 256) {
        const int seq = d * 4 + h, j = d == 0 ? c + 2 : 65 - c;
        const float mst = ment[seq * 66 + j];
        const float a = b + mst;
        const float mt = fmaxf(a, b + pm);
        s_b[ix] = b; s_u[ix] = uu; s_mt[ix] = mt; s_in[ix] = expf(a - mt);
      }
    }
    {
      const int row = tid >> 2, part = tid & 3;
      const bfraw* q1 = qp + (size_t)row * 1024 + part * 64;
      const float* nf = nent + (size_t)((0 + h) * 66 + (c + 2)) * 256 + part * 64;
      const float* nb = nent + (size_t)((4 + h) * 66 + (65 - c)) * 256 + part * 64;
      float af = 0, ab = 0;
#pragma unroll 4
      for (int k = 0; k < 64; ++k) { float q = bf2f(q1[k]); af += q * nf[k]; ab += q * nb[k]; }
      af += __shfl_xor(af, 1, 64); af += __shfl_xor(af, 2, 64);
      ab += __shfl_xor(ab, 1, 64); ab += __shfl_xor(ab, 2, 64);
      if (part == 0) { s_dq[row] = af; s_dq[128 + row] = ab; }
    }
    __syncthreads();
    {
      f32x4 S[4][2]; ZERO_ACC(S, 4, 2);
      gemm_tile<128, 128, false, false, false>(qp, 1024, kp, 1024, 256, nullptr, S, st, nullptr, 0);
#pragma unroll 1
      for (int d = 0; d < 2; ++d)
#pragma unroll
        for (int i = 0; i < 4; ++i)
#pragma unroll
          for (int r = 0; r < 4; ++r) {
            const int row = wm * 64 + i * 16 + fq * 4 + r;
            const float bt = s_b[d * 128 + row] - s_mt[d * 128 + row];
            float rs = 0;
#pragma unroll
            for (int j = 0; j < 2; ++j) {
              const int col = wn * 32 + j * 16 + fr;
              const bool valid = d == 0 ? (col <= row) : (col >= row);
              const float val = valid ? S[i][j][r] * fexp(bt + s_u[d * 128 + col]) : 0.f;
              rs += val;
              sS[(d * 128 + row) * 136 + col] = f2bf(val);
            }
            rs = red16(rs);
            if (fr == 0) atomicAdd(&s_den[d * 128 + row], rs);
          }
    }
    __syncthreads();
    f32x4 hs[4][4];
    bfraw* hpark = (bfraw*)(wsb + O_HPARK) + (size_t)R0 * 1024 + h * 256;
#pragma unroll 1
    for (int d = 0; d < 2; ++d) {
      f32x4 (&acc)[4][4] = hs; ZERO_ACC(acc, 4, 4);
      const int seq = d * 4 + h, j2 = d == 0 ? c + 2 : 65 - c;
      gemm_tile<128, 256, false, false, false>(qp, 1024, states + (size_t)(seq * 66 + j2) * 65536, 256, 256, nullptr, acc, st, nullptr, 0);
      EPIR_BEGIN(128, 256)
        const float sin_ = s_in[d * 128 + row];
        EPIR_COLS(256) acc[i][j][r] *= sin_; (void)col;
      EPIR_END
      gemm_tile<128, 256, false, true, true>(nullptr, 0, vv + (size_t)R0 * 1024 + h * 256, 1024, 128, nullptr, acc, st, sS + d * 128 * 136, 136);
      EPIR_BEGIN(128, 256)
        const float den = s_den[d * 128 + row] + s_in[d * 128 + row] * s_dq[d * 128 + row];
        const float inv = 1.f / fmaxf(fabsf(den), expf(-s_mt[d * 128 + row]));
        EPIR_COLS(256)
          const float hv = acc[i][j][r] * inv;
          if (d == 0) hpark[(size_t)row * 1024 + col] = f2bf(hv);
          else hs[i][j][r] = hv + bf2f(hpark[(size_t)row * 1024 + col]);
      EPIR_END
    }
#pragma unroll
    for (int i = 0; i < 4; ++i)
#pragma unroll
      for (int r = 0; r < 4; ++r) {
        float ps = hs[i][0][r] + hs[i][1][r] + hs[i][2][r] + hs[i][3][r];
        ps = red16(ps);
        if (fr == 0) atomicAdd(&s_sum[wm * 64 + i * 16 + fq * 4 + r], ps);
      }
    __syncthreads();
#pragma unroll
    for (int i = 0; i < 4; ++i)
#pragma unroll
      for (int r = 0; r < 4; ++r) {
        const float mu = s_sum[wm * 64 + i * 16 + fq * 4 + r] * (1.f / 256.f);
        float ps = 0;
#pragma unroll
        for (int j = 0; j < 4; ++j) { float dlt = hs[i][j][r] - mu; ps += dlt * dlt; }
        ps = red16(ps);
        if (fr == 0) atomicAdd(&s_sq[wm * 64 + i * 16 + fq * 4 + r], ps);
      }
    __syncthreads();
    const float* gh = p.in[I_GHEAD] + h * 256;
    EPIR_BEGIN(128, 256)
      const float mu = s_sum[row] * (1.f / 256.f);
      const float rstd = rsqrtf(s_sq[row] * (1.f / 256.f) + EPS);
      EPIR_COLS(256)
        vv[(size_t)(R0 + row) * 1024 + h * 256 + col] = f2bf((hs[i][j][r] - mu) * rstd * gh[col]);
    EPIR_END
  }
}

constexpr int NPH = 27;
#define PHASE_PROGRAM \
  PHASE(0, phase_p0(p, lds)) \
  PHASE(1, phase_p0b(p)) \
  PHASE(2, phase_rows<1>(p, lds)) \
  PHASE(3, phase_ffn_in(p, lds, O_W1IN, 16896)) \
  PHASE(4, phase_ffn_out(p, lds, O_W1OUT, 2, true)) \
  PHASE(5, phase_rows<2>(p, lds)) \
  PHASE(6, phase_g3c(p, lds)) \
  PHASE(7, phase_g3a(p, lds, 0)) \
  PHASE(8, phase_cv(p, 0)) \
  PHASE(9, phase_ma(p, lds, 0)) \
  PHASE(10, phase_mb(p)) \
  PHASE(11, phase_mc(p, lds, 0)) \
  PHASE(12, phase_g3b(p, lds, 0)) \
  PHASE(13, phase_g4(p, lds)) \
  PHASE(14, phase_addmix(p, 0); __syncthreads(); phase_g3a(p, lds, 1)) \
  PHASE(15, phase_cv(p, 1)) \
  PHASE(16, phase_ma(p, lds, 1)) \
  PHASE(17, phase_mb(p)) \
  PHASE(18, phase_mc(p, lds, 1)) \
  PHASE(19, phase_g3b(p, lds, 1)) \
  PHASE(20, phase_g4(p, lds)) \
  PHASE(21, phase_addmix(p, 1)) \
  PHASE(22, phase_g5(p, lds)) \
  PHASE(23, phase_rows<3>(p, lds)) \
  PHASE(24, phase_ffn_in(p, lds, O_W2IN, 16384)) \
  PHASE(25, phase_ffn_out(p, lds, O_W2OUT, 8, false)) \
  PHASE(26, phase_rows<4>(p, lds))

#if !MULTI_LAUNCH
#ifndef USE_CG
#define USE_CG 0
#endif
#if USE_CG
#define PHASE(n, call) if (lo <= (n) && (n) < hi) { if ((n) > lo) { if ((n) == 1) grid.sync(); else xcd_barrier(xbar); } call; }
#else
#define PHASE(n, call) if (lo <= (n) && (n) < hi) { if ((n) > lo) xcd_barrier(xbar); call; }
#endif
__global__ void __launch_bounds__(512) mk(P p, int lo, int hi) {
  extern __shared__ __attribute__((aligned(16))) unsigned char lds[];
#if USE_CG
  cg::grid_group grid = cg::this_grid();
#endif
  volatile LAS unsigned* stw = (volatile LAS unsigned*)(lds + LDS_BYTES - 16);
  if (threadIdx.x == 0) { stw[0] = 0u; stw[1] = 0u; stw[2] = 0u; stw[3] = 0u; }
  __syncthreads();
  XcdBarrier xbar = xcd_barrier_post((unsigned*)(p.ws + O_BAR), stw);
  PHASE_PROGRAM
}
#undef PHASE
#else
#define PHASE(n, call) if constexpr (PH == (n)) { call; }
template <int PH>
__global__ void __launch_bounds__(512) mkp(P p) {
  extern __shared__ __attribute__((aligned(16))) unsigned char lds[];
  PHASE_PROGRAM
}
#undef PHASE
template <int PH> static void launch_all(const P& p, int grid, hipStream_t stream) {
  if constexpr (PH < NPH) {
    (void)hipFuncSetAttribute((const void*)mkp<PH>, hipFuncAttributeMaxDynamicSharedMemorySize, LDS_BYTES);
    hipLaunchKernelGGL(mkp<PH>, dim3(grid), dim3(NTHR), LDS_BYTES, stream, p);
    launch_all<PH + 1>(p, grid, stream);
  }
}
#endif

extern "C" void kernel_launch(void* const* d_in, const int* in_sizes, int n_in, void* d_out, int out_size, void* d_ws, size_t ws_size, hipStream_t stream) {
  static int grid_blocks = 0;
  if (!grid_blocks) {
    if (n_in != 25 || ws_size < O_END || ws_size < O_ACT + 16896ull * 2816 * 2) { fprintf(stderr, "kernel_launch: unexpected n_in %d / ws %zu\n", n_in, ws_size); grid_blocks = -1; return; }
    int dev = 0, cus = 0, per_cu = 0;
    (void)hipGetDevice(&dev);
    (void)hipDeviceGetAttribute(&cus, hipDeviceAttributeMultiprocessorCount, dev);
#if !MULTI_LAUNCH
    if (hipFuncSetAttribute((const void*)mk, hipFuncAttributeMaxDynamicSharedMemorySize, LDS_BYTES) != hipSuccess) { fprintf(stderr, "hipFuncSetAttribute failed\n"); grid_blocks = -1; return; }
    if (hipOccupancyMaxActiveBlocksPerMultiprocessor(&per_cu, (const void*)mk, NTHR, LDS_BYTES) != hipSuccess || per_cu < 1) { fprintf(stderr, "occupancy query failed (%d)\n", per_cu); grid_blocks = -1; return; }
#endif
    grid_blocks = cus * 1;
    fprintf(stderr, "kernel_launch: cus %d per_cu %d grid %d\n", cus, per_cu, grid_blocks);
  }
  if (grid_blocks < 0) return;
  P p{};
  for (int i = 0; i < 25; ++i) p.in[i] = (const float*)d_in[i];
  p.out = (float*)d_out; p.ws = (unsigned char*)d_ws;
#if MULTI_LAUNCH
  launch_all<0>(p, grid_blocks, stream);
#else
  int lo = 0, hi = NPH;
  if (hipMemsetAsync((unsigned char*)d_ws + O_BAR, 0, 16384, stream) != hipSuccess) { fprintf(stderr, "memset of barrier words failed\n"); return; }
  void* args[] = {&p, &lo, &hi};
#ifdef PROBE_K
  {
    int plo = 0, phi = PROBE_K + 1; void* pargs[] = {&p, &plo, &phi};
    (void)hipLaunchCooperativeKernel((const void*)mk, dim3(grid_blocks), dim3(NTHR), pargs, LDS_BYTES, stream);
    (void)hipMemsetAsync((unsigned char*)d_ws + O_BAR, 0, 16384, stream);
  }
#endif
#if USE_CG
  hipError_t e = hipLaunchCooperativeKernel((const void*)mk, dim3(grid_blocks), dim3(NTHR), args, LDS_BYTES, stream);
#else
  (void)args;
  hipLaunchKernelGGL(mk, dim3(grid_blocks), dim3(NTHR), LDS_BYTES, stream, p, lo, hi);
  hipError_t e = hipPeekAtLastError();
#endif
  if (e != hipSuccess) fprintf(stderr, "cooperative launch failed: %s (grid %d)\n", hipGetErrorString(e), grid_blocks);
#endif
}
```

```cpp
#include <hip/hip_runtime.h>
#include <hip/hip_cooperative_groups.h>
#include <cstdio>
#include <cstdint>
namespace cg = cooperative_groups;

#ifndef MULTI_LAUNCH
#define MULTI_LAUNCH 0
#endif

typedef unsigned short bfraw;
typedef __attribute__((ext_vector_type(8))) short bf16x8;
typedef __attribute__((ext_vector_type(4))) float f32x4;
#define DEVI __device__ __forceinline__

constexpr int NTHR = 512;
constexpr int GBM = 128;
constexpr int LROW = 40;
constexpr int LDS_BYTES = 143360;
constexpr float EPS = 1e-6f;

enum { I_X, I_C, I_CTX, I_CCTX, I_WADA, I_BADA, I_GFFN1, I_W1IN, I_W1OUT, I_GMIX, I_WIN, I_BGATES, I_CONVW, I_CONVB,
       I_GHEAD, I_GSGU, I_WS, I_BS, I_WA, I_WB, I_WO, I_GFFN2, I_W2IN, I_W2OUT, I_GFINAL };

struct P { const float* in[25]; float* out; unsigned char* ws; };

constexpr size_t O_W1IN  = 0;
constexpr size_t O_W1OUT = O_W1IN  + 5632ull * 1024 * 2;
constexpr size_t O_WTA   = O_W1OUT + 1024ull * 2816 * 2;
constexpr size_t O_WTB   = O_WTA   + 4096ull * 1024 * 2;
constexpr size_t O_WA    = O_WTB   + 4096ull * 1024 * 2;
constexpr size_t O_WB    = O_WA    + 1024ull * 1024 * 2;
constexpr size_t O_WO    = O_WB    + 1024ull * 1024 * 2;
constexpr size_t O_W2IN  = O_WO    + 1024ull * 1024 * 2;
constexpr size_t O_W2OUT = O_W2IN  + 5632ull * 1024 * 2;
constexpr size_t O_WSB   = O_W2OUT + 1024ull * 2816 * 2;
constexpr size_t O_MODSP = O_WSB   + 4ull * 128 * 128 * 2;
constexpr size_t O_MODS  = O_MODSP + 16ull * 3 * 9216 * 4;
constexpr size_t O_HCTX  = O_MODS  + 3ull * 9216 * 4;
constexpr size_t O_HN    = O_HCTX  + 512ull * 1024 * 4;
constexpr size_t O_GATES = O_HN    + 16896ull * 1024 * 2;
constexpr size_t O_CTXRAW= O_GATES + 16896ull * 16 * 4;
constexpr size_t O_BIG   = O_CTXRAW+ 2ull * 256 * 3072 * 2;
constexpr size_t O_ACT   = O_BIG;
constexpr size_t O_ST    = O_BIG;
constexpr size_t O_QRAW  = O_BIG;
constexpr size_t O_KRAW  = O_QRAW  + 8448ull * 1024 * 2;
constexpr size_t O_V     = O_ST    + 8ull * 66 * 131072;
constexpr size_t O_GVS   = O_V     + 8448ull * 1024 * 2;
constexpr size_t O_QC    = O_GVS   + 8192ull * 1024 * 2;
constexpr size_t O_KC    = O_QC    + 8448ull * 1024 * 2;
constexpr size_t O_NLOC  = O_KC    + 8448ull * 1024 * 2;
constexpr size_t O_NENT  = O_NLOC  + 8ull * 66 * 256 * 4;
constexpr size_t O_MG    = O_NENT  + 8ull * 66 * 256 * 4;
constexpr size_t O_RS    = O_MG    + 8192;
constexpr size_t O_HPARK = O_RS    + 8192ull * 4;
constexpr size_t O_BAR   = O_HPARK + 8192ull * 1024 * 2;
constexpr size_t O_END   = O_BAR + 16384;
static_assert(O_ACT + 16896ull * 2816 * 2 <= 268435456ull, "ws");
static_assert(O_END <= 268435456ull, "ws");
static_assert(O_KRAW + 8448ull * 1024 * 2 <= O_V, "overlay");

DEVI int ltid() { int t = __builtin_amdgcn_workitem_id_x(); asm volatile("" : "+v"(t)); return t; }
DEVI unsigned char* lws(unsigned char* w) { asm volatile("" : "+s"(w)); return w; }
DEVI bfraw f2bf(float f) { unsigned u = __float_as_uint(f); u += 0x7fffu + ((u >> 16) & 1u); return (bfraw)(u >> 16); }
DEVI float bf2f(bfraw h) { return __uint_as_float(((unsigned)h) << 16); }
DEVI float fexp(float x) { return __builtin_amdgcn_exp2f(x * 1.4426950408889634f); }
DEVI float sigmoidf_(float x) { return __builtin_amdgcn_rcpf(1.f + fexp(-x)); }
DEVI float siluf_(float x) { return x * sigmoidf_(x); }
DEVI float geluf_(float x) { return x * sigmoidf_(1.5957691216057308f * (x + 0.044715f * x * x * x)); }
DEVI float logsigf_(float x) { return fminf(x, 0.f) - log1pf(expf(-fabsf(x))); }
DEVI float wave_sum(float v) {
#pragma unroll
  for (int o = 32; o > 0; o >>= 1) v += __shfl_xor(v, o, 64);
  return v;
}
DEVI float red16(float v) {
  v += __shfl_xor(v, 1, 64); v += __shfl_xor(v, 2, 64); v += __shfl_xor(v, 4, 64); v += __shfl_xor(v, 8, 64);
  return v;
}
DEVI float redsin(float a, bool cosine) {
  float k = rintf(a * 0.15915494309189535f);
  float r = fmaf(-k, 6.2831854820251465f, a);
  r = fmaf(-k, -1.7484555e-7f, r);
  return cosine ? __cosf(r) : __sinf(r);
}


DEVI float seg_scan_sum(float v, int tid, float* s_x) {
  const int lane = tid & 63;
#pragma unroll
  for (int o = 1; o < 64; o <<= 1) { float t = __shfl_up(v, o, 64); if (lane >= o) v += t; }
  if (lane == 63 && tid < 256) s_x[tid >> 6] = v;
  __syncthreads();
  if (tid < 256 && ((tid >> 6) & 1)) v += s_x[(tid >> 6) - 1];
  __syncthreads();
  return v;
}
DEVI float seg_scan_max(float v, int tid, float* s_x) {
  const int lane = tid & 63;
#pragma unroll
  for (int o = 1; o < 64; o <<= 1) { float t = __shfl_up(v, o, 64); if (lane >= o) v = fmaxf(v, t); }
  if (lane == 63 && tid < 256) s_x[tid >> 6] = v;
  __syncthreads();
  if (tid < 256 && ((tid >> 6) & 1)) v = fmaxf(v, s_x[(tid >> 6) - 1]);
  __syncthreads();
  return v;
}

#define XB_TMO      128
#define XB_XCNT(j)  (256  + 64 * (j))
#define XB_XSUB(j)  (1280 + 64 * (j))
#define XB_XGEN(j)  (2304 + 64 * (j))
#define XB_TOP      3328
#define XB_TOPGEN   3392
#define XCD_BAR_WORDS 3456
#define XB_SPIN_CAP (1u << 18)
#define LAS __attribute__((address_space(3)))

__device__ __forceinline__ unsigned xb_ld(unsigned* p)              { return __hip_atomic_load(p, __ATOMIC_RELAXED, __HIP_MEMORY_SCOPE_AGENT); }
__device__ __forceinline__ unsigned xb_add(unsigned* p, unsigned v) { return __hip_atomic_fetch_add(p, v, __ATOMIC_RELAXED, __HIP_MEMORY_SCOPE_AGENT); }
__device__ __forceinline__ unsigned xb_xcc_id() { return (unsigned)__builtin_amdgcn_s_getreg((3 << 11) | 20) & 0xFu; }
#define XB_SPIN(cond, bar) do { unsigned _sp = 0; while (cond) { __builtin_amdgcn_s_sleep(1); \
    if ((++_sp & 255u) == 0u) { if (xb_ld(&(bar)[XB_TMO])) break; if (_sp > XB_SPIN_CAP) { atomicAdd(&(bar)[XB_TMO], 1u); break; } } } } while (0)

struct XcdBarrier {
    unsigned* bar; unsigned x;
    volatile LAS unsigned* st;
};

__device__ __forceinline__ XcdBarrier xcd_barrier_post(unsigned* bar, volatile LAS unsigned* st) {
    XcdBarrier b; b.bar = bar; b.x = xb_xcc_id(); b.st = st;
    if (threadIdx.x == 0) (void)xb_add(&bar[XB_XCNT(b.x)], 1u);
    return b;
}
__device__ __forceinline__ void xcd_barrier_complete(unsigned* bar, unsigned x, unsigned& nloc, unsigned& nx) {
    const unsigned G = gridDim.x * gridDim.y * gridDim.z;
    unsigned sum, cnt, mine, sp = 0u;
    for (;;) {
        sum = 0u; cnt = 0u; mine = 0u;
#pragma unroll
        for (unsigned j = 0; j < 16; ++j) { const unsigned c = xb_ld(&bar[XB_XCNT(j)]); sum += c; cnt += (c > 0u) ? 1u : 0u; mine = (j == x) ? c : mine; }
        if (sum == G) break;
        __builtin_amdgcn_s_sleep(1);
        if ((++sp & 255u) == 0u) { if (xb_ld(&bar[XB_TMO])) break; if (sp > XB_SPIN_CAP) { atomicAdd(&bar[XB_TMO], 1u); break; } }
    }
    nloc = mine > 0u ? mine : 1u; nx = cnt > 0u ? cnt : 1u;
}

__device__ __forceinline__ void xcd_barrier(const XcdBarrier& b) {
    asm volatile("s_waitcnt vmcnt(0)" ::: "memory");
    __syncthreads();
    if (threadIdx.x == 0) {
        unsigned* bar = b.bar;
        __builtin_amdgcn_s_waitcnt(0);
        unsigned nloc = b.st[0], nx = b.st[1];
        if (nloc == 0u) { xcd_barrier_complete(bar, b.x, nloc, nx); b.st[0] = nloc; b.st[1] = nx; }
        const unsigned old = xb_add(&bar[XB_XSUB(b.x)], 1u);
        const unsigned gen = old / nloc;
        if (old + 1u == (gen + 1u) * nloc) {
            __builtin_amdgcn_fence(__ATOMIC_RELEASE, "agent");
            asm volatile("s_waitcnt vmcnt(0)" ::: "memory");
            const unsigned og = xb_add(&bar[XB_TOP], 1u);
            const unsigned tg = og / nx;
            if (og + 1u == (tg + 1u) * nx) xb_add(&bar[XB_TOPGEN], 1u);
            else XB_SPIN(xb_ld(&bar[XB_TOPGEN]) == tg, bar);
            __builtin_amdgcn_fence(__ATOMIC_ACQUIRE, "agent");
            xb_add(&bar[XB_XGEN(b.x)], 1u);
            asm volatile("s_waitcnt vmcnt(0)" ::: "memory");
        } else {
            XB_SPIN(xb_ld(&bar[XB_XGEN(b.x)]) == gen, bar);
            __builtin_amdgcn_fence(__ATOMIC_ACQUIRE, "agent");
            asm volatile("s_waitcnt vmcnt(0)" ::: "memory");
        }
    }
    __syncthreads();
}

template <int BM, int BN, bool ATR, bool BTR, bool ALDS>
DEVI void gemm_tile(const bfraw* __restrict__ A, int lda, const bfraw* __restrict__ B, int ldb, int K,
                    const float* kscale, f32x4 (&acc)[BM / 32][BN / 64], bfraw* st, const bfraw* sAres, int ldres) {
  constexpr int MI = BM / 32, NJ = BN / 64, CA = BM / 128, CB = BN / 128, WM = BM / 2, WN = BN / 4;
  constexpr int STAGE = (ALDS ? BN : (BM + BN)) * LROW;
  int tid_ = ltid();
  const int tid = tid_, lane = tid & 63, wid = tid >> 6, wm = wid >> 2, wn = wid & 3;
  const int fr = lane & 15, fq = lane >> 4;
  uint4 ra0 = {0, 0, 0, 0}, ra1 = {0, 0, 0, 0}, rb0 = {0, 0, 0, 0}, rb1 = {0, 0, 0, 0};
  const int nk = K >> 5;

  auto gla = [&](int c, int k0) -> uint4 {
    if (!ATR) { int row = c >> 2, kc = (c & 3) * 8; return *(const uint4*)(A + (size_t)row * lda + k0 + kc); }
    else { int krow = c / (BM / 8), m0 = (c % (BM / 8)) * 8; return *(const uint4*)(A + (size_t)(k0 + krow) * lda + m0); }
  };
  auto glb = [&](int c, int k0) -> uint4 {
    if (!BTR) { int row = c >> 2, kc = (c & 3) * 8; return *(const uint4*)(B + (size_t)row * ldb + k0 + kc); }
    else { int krow = c / (BN / 8), n0 = (c % (BN / 8)) * 8; return *(const uint4*)(B + (size_t)(k0 + krow) * ldb + n0); }
  };
  auto gload = [&](int kt) {
    const int k0 = kt << 5;
    if (!ALDS) { ra0 = gla(tid, k0); if (CA > 1) ra1 = gla(tid + NTHR, k0); }
    rb0 = glb(tid, k0); if (CB > 1) rb1 = glb(tid + NTHR, k0);
  };
  constexpr int TSA = BM + 8, TSB = BN + 8;
  auto scale8 = [&](uint4 r, float sc) -> uint4 {
    unsigned w[4] = {r.x, r.y, r.z, r.w};
#pragma unroll
    for (int e = 0; e < 4; ++e) w[e] = (unsigned)f2bf(bf2f((bfraw)(w[e] & 0xffff)) * sc) | ((unsigned)f2bf(bf2f((bfraw)(w[e] >> 16)) * sc) << 16);
    return uint4{w[0], w[1], w[2], w[3]};
  };
  auto lstore = [&](int buf, int kt) {
    bfraw* sA = st + buf * STAGE;
    bfraw* sB = sA + (ALDS ? 0 : BM * LROW);
    auto sta = [&](int c, uint4 v) {
      if (!ATR) { int row = c >> 2, kc = (c & 3) * 8; *(uint4*)(sA + row * LROW + kc) = v; }
      else { int krow = c / (BM / 8), m0 = (c % (BM / 8)) * 8; *(uint4*)(sA + krow * TSA + m0) = v; }
    };
    auto stb = [&](int c, uint4 v) {
      if (!BTR) { int row = c >> 2, kc = (c & 3) * 8; *(uint4*)(sB + row * LROW + kc) = v; }
      else {
        int krow = c / (BN / 8), n0 = (c % (BN / 8)) * 8;
        if (kscale) v = scale8(v, kscale[(kt << 5) + krow]);
        *(uint4*)(sB + krow * TSB + n0) = v;
      }
    };
    if (!ALDS) { sta(tid, ra0); if (CA > 1) sta(tid + NTHR, ra1); }
    stb(tid, rb0); if (CB > 1) stb(tid + NTHR, rb1);
  };
  typedef short s16x4 __attribute__((ext_vector_type(4)));
  auto trfrag = [&](const bfraw* sT, int TS, int mt) -> bf16x8 {
    const bfraw* a1 = sT + (8 * fq + (fr >> 2)) * TS + mt + (fr & 3) * 4;
    s16x4 r1 = __builtin_amdgcn_ds_read_tr16_b64_v4i16((__attribute__((address_space(3))) s16x4*)a1);
    s16x4 r2 = __builtin_amdgcn_ds_read_tr16_b64_v4i16((__attribute__((address_space(3))) s16x4*)(a1 + 4 * TS));
    return bf16x8{r1[0], r1[1], r1[2], r1[3], r2[0], r2[1], r2[2], r2[3]};
  };
  auto compute = [&](int buf, int kt) {
    const bfraw* sA = st + buf * STAGE;
    const bfraw* sB = sA + (ALDS ? 0 : BM * LROW);
    bf16x8 af[MI], bfr[NJ];
#pragma unroll
    for (int i = 0; i < MI; ++i) {
      if (ALDS) af[i] = *(const bf16x8*)(sAres + (wm * WM + i * 16 + fr) * ldres + (kt << 5) + fq * 8);
      else if (ATR) af[i] = trfrag(sA, TSA, wm * WM + i * 16);
      else af[i] = *(const bf16x8*)(sA + (wm * WM + i * 16 + fr) * LROW + fq * 8);
    }
#pragma unroll
    for (int j = 0; j < NJ; ++j) {
      if (BTR) bfr[j] = trfrag(sB, TSB, wn * WN + j * 16);
      else bfr[j] = *(const bf16x8*)(sB + (wn * WN + j * 16 + fr) * LROW + fq * 8);
    }
#pragma unroll
    for (int i = 0; i < MI; ++i)
#pragma unroll
      for (int j = 0; j < NJ; ++j) acc[i][j] = __builtin_amdgcn_mfma_f32_16x16x32_bf16(af[i], bfr[j], acc[i][j], 0, 0, 0);
  };

  uint4 xa0 = {0, 0, 0, 0}, xa1 = {0, 0, 0, 0}, xb0 = {0, 0, 0, 0}, xb1 = {0, 0, 0, 0};
  auto swapsets = [&]() { uint4 t; t = ra0; ra0 = xa0; xa0 = t; t = ra1; ra1 = xa1; xa1 = t; t = rb0; rb0 = xb0; xb0 = t; t = rb1; rb1 = xb1; xb1 = t; };
  __syncthreads();
  gload(0); lstore(0, 0);
  if (nk > 1) gload(1);
  if (nk > 2) { swapsets(); gload(2); swapsets(); }
  __syncthreads();
  for (int kt = 0; kt < nk; kt += 2) {
    compute(0, kt);
    if (kt + 1 < nk) lstore(1, kt + 1);
    if (kt + 3 < nk) gload(kt + 3);
    __syncthreads();
    if (kt + 1 >= nk) break;
    compute(1, kt + 1);
    swapsets();
    if (kt + 2 < nk) lstore(0, kt + 2);
    if (kt + 4 < nk) gload(kt + 4);
    swapsets();
    __syncthreads();
  }
}

#define ZERO_ACC(acc, MI, NJ) _Pragma("unroll") for (int _i = 0; _i < (MI); ++_i) _Pragma("unroll") for (int _j = 0; _j < (NJ); ++_j) acc[_i][_j] = f32x4{0.f, 0.f, 0.f, 0.f};
#define EPI_BEGIN(BM, BN) { int _t = ltid(); const int _l = _t & 63, _w = _t >> 6; \
    const int _rb = (_w >> 2) * ((BM) / 2) + (_l >> 4) * 4, _cb = (_w & 3) * ((BN) / 4) + (_l & 15); \
    _Pragma("unroll") for (int i = 0; i < (BM) / 32; ++i) _Pragma("unroll") for (int j = 0; j < (BN) / 64; ++j) _Pragma("unroll") for (int r = 0; r < 4; ++r) { \
      const int row = _rb + i * 16 + r, col = _cb + j * 16;
#define EPI_END }}
#define EPIR_BEGIN(BM, BN) { int _t = ltid(); const int _l = _t & 63, _w = _t >> 6; \
    const int _rb = (_w >> 2) * ((BM) / 2) + (_l >> 4) * 4, _cb = (_w & 3) * ((BN) / 4) + (_l & 15); \
    _Pragma("unroll") for (int i = 0; i < (BM) / 32; ++i) _Pragma("unroll") for (int r = 0; r < 4; ++r) { \
      const int row = _rb + i * 16 + r;
#define EPIR_COLS(BN) _Pragma("unroll") for (int j = 0; j < (BN) / 64; ++j) { const int col = _cb + j * 16;
#define EPIR_END }}}


namespace pg8 {
#define PG8_LAS __attribute__((address_space(3)))
typedef unsigned short bf16_t;
typedef short bf16x8 __attribute__((ext_vector_type(8)));
typedef float f32x4 __attribute__((ext_vector_type(4)));
typedef unsigned u32x4 __attribute__((ext_vector_type(4)));
constexpr int BM = 256, BK = 64, HALF = 128, HTB = HALF * BK * 2  , STAGE_BYTES = 8 * HTB, NXCD = 8, WGM = 8;

__host__ __device__ __forceinline__ int lds_byte(int r, int c) { const int st = (r >> 4) * 2 + (c >> 5), rr = r & 15, cc = c & 31, ob = rr * 64 + cc * 2; return st * 1024 + (ob ^ (((ob >> 9) & 1) << 5)); }
__host__ __device__ __forceinline__ void stage_rc(int b, int& R, int& C) { const int st = b / 1024, sb = b % 1024, swz = sb ^ (((sb >> 9) & 1) << 5); R = (st >> 1) * 16 + swz / 64; C = (st & 1) * 32 + (swz % 64) / 2; }
__host__ __device__ __forceinline__ int perm32(int rho) { const int n = rho >> 4, i = rho & 15; return 8 * (i >> 2) + 4 * n + (i & 3); }

struct Unit { int pm, pn; };
struct Gemm { const bf16_t* A; const bf16_t* Bt; int M, N, K, ld; };
struct StaticOrder {
    int nM, nN, nwg, G, c;
    __host__ __device__ void init(int M, int N, int G_, int c_) { nM = M / BM; nN = N / BM; nwg = nM * nN; G = G_; c = c_; }
    __host__ __device__ bool next(int i, Unit& u) const {
        const long L = (long)i * G + c; if (L >= nwg) return false;
        int wgid = (int)L; { const int q = nwg / NXCD, r = nwg % NXCD, xcd = wgid % NXCD, off = wgid / NXCD; wgid = (xcd < r ? xcd * (q + 1) : r * (q + 1) + (xcd - r) * q) + off; }
        const int nig = WGM * nN, gid = wgid / nig, fm = gid * WGM, gsz = (nM - fm) < WGM ? (nM - fm) : WGM;
        u.pm = fm + ((wgid % nig) % gsz); u.pn = (wgid % nig) / gsz; return true;
    }
    __device__ __forceinline__ void a_ready(const Unit&) const {}
    __device__ __forceinline__ void done(const Unit&) const {}
};
__device__ __forceinline__ unsigned cvt_pk_bf16(float lo, float hi) { unsigned r; asm volatile("v_cvt_pk_bf16_f32 %0, %1, %2" : "=v"(r) : "v"(lo), "v"(hi)); return r; }
template <class Epi, class Sched, bool STAMP = false>
__device__ __forceinline__ void gemm_phase(PG8_LAS unsigned char* lds, const Gemm g, const Sched& S, const Epi& E, unsigned long long* stamps) {
    const int tid = threadIdx.x, wid = __builtin_amdgcn_readfirstlane(tid >> 6), lane = tid & 63, wr = wid >> 2, wc = wid & 3, fr = lane & 15, fq = lane >> 4;
    const int K = g.K, nt = K / BK;
    int ts_lo = 0, ts_hi = 0, nts = 0; const unsigned long long rt_entry = STAMP ? (unsigned long long)wall_clock64() : 0ull;
#define PG8_STAMP() do { if (STAMP && wid == 0 && nts < 64) { const unsigned long long _c = (unsigned long long)clock64(); \
        ts_lo = (lane == nts) ? (int)(unsigned)_c : ts_lo; ts_hi = (lane == nts) ? (int)(unsigned)(_c >> 32) : ts_hi; ++nts; } } while (0)
    PG8_STAMP();
    unsigned voffA[2], voffB[2];
#pragma unroll
    for (int i = 0; i < 2; ++i) { int R, C; stage_rc(tid * 16 + i * 8192, R, C); const int Rb = Epi::PERM ? ((R & ~31) + perm32(R & 31)) : R;
        voffA[i] = (unsigned)(R * g.ld + C) * 2u; voffB[i] = (unsigned)(Rb * g.ld + C) * 2u; }
    const size_t kstep = (size_t)(BK * 2);
    const size_t hstep = (size_t)HALF * g.ld * 2;
    const size_t tstep = 2 * hstep;
    const unsigned ldsw = (unsigned)wid * 1024u;
    const int aoff = lds_byte(wr * 64 + fr, fq * 8), boff = lds_byte(wc * 32 + fr, fq * 8);
#define PG8_SA(b, h) (((b) * 2 + (h)) * HTB)
#define PG8_SB(b, h) ((4 + (b) * 2 + (h)) * HTB)
#define PG8_STAGE(bufoff, gbase, voff) do { _Pragma("unroll") for (int _i = 0; _i < 2; ++_i) \
        __builtin_amdgcn_global_load_lds((const unsigned*)((const char*)(gbase) + (voff)[_i]), (PG8_LAS unsigned*)(lds + (bufoff) + ldsw + _i * 8192), 16, 0, 0); } while (0)
#define PG8_LDA(dst, b, h) do { _Pragma("unroll") for (int m = 0; m < 4; ++m) _Pragma("unroll") for (int k = 0; k < 2; ++k) dst[m][k] = *(const PG8_LAS bf16x8*)(lds + PG8_SA(b, h) + aoff + m * 2048 + k * 1024); } while (0)
#define PG8_LDB(dst, b, h) do { _Pragma("unroll") for (int n = 0; n < 2; ++n) _Pragma("unroll") for (int k = 0; k < 2; ++k) dst[n][k] = *(const PG8_LAS bf16x8*)(lds + PG8_SB(b, h) + boff + n * 2048 + k * 1024); } while (0)
#define PG8_MMA(ai, bj, At, Bt) do { __builtin_amdgcn_s_setprio(1); _Pragma("unroll") for (int m = 0; m < 4; ++m) _Pragma("unroll") for (int n = 0; n < 2; ++n) _Pragma("unroll") for (int k = 0; k < 2; ++k) \
        acc[ai][bj][m][n] = __builtin_amdgcn_mfma_f32_16x16x32_bf16(Bt[n][k], At[m][k], acc[ai][bj][m][n], 0, 0, 0); __builtin_amdgcn_s_setprio(0); } while (0)
#define PG8_WAIT_V(n) asm volatile("s_waitcnt vmcnt(" #n ")" ::: "memory")
#define PG8_WAIT_L(n) asm volatile("s_waitcnt lgkmcnt(" #n ")" ::: "memory")
#define PG8_BAR __builtin_amdgcn_s_barrier()
#define PG8_SCHED __builtin_amdgcn_sched_barrier(0)
    Unit cur, nxt; int ui = 0;
    if (!S.next(0, cur)) return;
    f32x4 acc[2][2][4][2];
#pragma unroll
    for (int a = 0; a < 2; ++a)
#pragma unroll
        for (int b = 0; b < 2; ++b)
#pragma unroll
            for (int m = 0; m < 4; ++m)
#pragma unroll
                for (int n = 0; n < 2; ++n) acc[a][b][m][n] = (f32x4){0.f, 0.f, 0.f, 0.f};
    bf16x8 At[4][2], B0[2][2], B1[2][2];
    const char* cA = (const char*)g.A + (size_t)cur.pm * tstep; const char* cB = (const char*)g.Bt + (size_t)cur.pn * tstep;
    S.a_ready(cur);
    PG8_STAGE(PG8_SB(0, 0), cB, voffB); PG8_STAGE(PG8_SA(0, 0), cA, voffA); PG8_STAGE(PG8_SB(0, 1), cB + hstep, voffB); PG8_STAGE(PG8_SA(0, 1), cA + hstep, voffA);
    if (wr == 1) PG8_BAR;
    PG8_WAIT_V(4); PG8_BAR;
    PG8_STAGE(PG8_SB(1, 0), cB + kstep, voffB); PG8_STAGE(PG8_SA(1, 0), cA + kstep, voffA); PG8_STAGE(PG8_SB(1, 1), cB + hstep + kstep, voffB);
    PG8_WAIT_V(6); PG8_BAR;
    PG8_STAMP();
    for (;;) {
        const bool has_next = S.next(ui + 1, nxt);
        const char* nA = has_next ? (const char*)g.A + (size_t)nxt.pm * tstep : cA; const char* nB = has_next ? (const char*)g.Bt + (size_t)nxt.pn * tstep : cB;
        for (int t = 0; t < nt; t += 2) {
            const bool last = (t == nt - 2);
            const char* a1 = cA + (size_t)(t + 1) * kstep;
            const char* a2 = last ? nA : cA + (size_t)(t + 2) * kstep; const char* b2 = last ? nB : cB + (size_t)(t + 2) * kstep;
            const char* a3 = a2 + kstep; const char* b3 = b2 + kstep;
            if (last && has_next) S.a_ready(nxt);
            PG8_LDB(B0, 0, 0); PG8_SCHED; PG8_LDA(At, 0, 0); PG8_STAGE(PG8_SA(1, 1), a1 + hstep, voffA);
            PG8_WAIT_L(8); PG8_BAR; PG8_WAIT_L(0); PG8_MMA(0, 0, At, B0); PG8_BAR; PG8_SCHED;
            PG8_LDB(B1, 0, 1); PG8_STAGE(PG8_SB(0, 0), b2, voffB);
            PG8_BAR; PG8_WAIT_L(0); PG8_MMA(0, 1, At, B1); PG8_BAR;
            PG8_LDA(At, 0, 1); PG8_STAGE(PG8_SA(0, 0), a2, voffA);
            PG8_BAR; PG8_WAIT_L(0); PG8_MMA(1, 0, At, B0); PG8_BAR; PG8_SCHED;
            PG8_STAGE(PG8_SB(0, 1), b2 + hstep, voffB);
            PG8_WAIT_V(6); PG8_BAR; PG8_MMA(1, 1, At, B1); PG8_BAR;
            PG8_LDB(B0, 1, 0); PG8_SCHED; PG8_LDA(At, 1, 0); PG8_STAGE(PG8_SA(0, 1), a2 + hstep, voffA);
            PG8_WAIT_L(8); PG8_BAR; PG8_WAIT_L(0); PG8_MMA(0, 0, At, B0); PG8_BAR; PG8_SCHED;
            PG8_LDB(B1, 1, 1); PG8_STAGE(PG8_SB(1, 0), b3, voffB);
            PG8_BAR; PG8_WAIT_L(0); PG8_MMA(0, 1, At, B1); PG8_BAR;
            PG8_LDA(At, 1, 1); PG8_STAGE(PG8_SA(1, 0), a3, voffA);
            PG8_BAR; PG8_WAIT_L(0); PG8_MMA(1, 0, At, B0); PG8_BAR; PG8_SCHED;
            PG8_STAGE(PG8_SB(1, 1), b3 + hstep, voffB);
            PG8_WAIT_V(6); PG8_BAR; PG8_MMA(1, 1, At, B1); PG8_BAR;
        }
        PG8_STAMP();
        if constexpr (!Epi::AFTER_DRAIN) { E(acc, cur, wr, wc, fr, fq); S.done(cur); }
        PG8_STAMP();
        if (!has_next) break;
#pragma unroll
        for (int a = 0; a < 2; ++a)
#pragma unroll
            for (int b = 0; b < 2; ++b)
#pragma unroll
                for (int m = 0; m < 4; ++m)
#pragma unroll
                    for (int n = 0; n < 2; ++n) acc[a][b][m][n] = (f32x4){0.f, 0.f, 0.f, 0.f};
        cur = nxt; cA = nA; cB = nB; ++ui;
    }
    PG8_WAIT_V(0);
    if (wr == 0) PG8_BAR;
    PG8_BAR;
    if constexpr (Epi::AFTER_DRAIN) { E.fused(acc, cur, wr, wc, fr, fq, lds, wid, lane); S.done(cur); }
    PG8_STAMP();
    if (STAMP && wid == 0) { stamps[lane] = lane < nts ? (((unsigned long long)(unsigned)ts_hi << 32) | (unsigned)ts_lo) : 0ull;
        if (lane == 62) stamps[62] = rt_entry; if (lane == 63) stamps[63] = (unsigned long long)wall_clock64(); }
#undef PG8_STAMP
#undef PG8_SA
#undef PG8_SB
#undef PG8_STAGE
#undef PG8_LDA
#undef PG8_LDB
#undef PG8_MMA
#undef PG8_WAIT_V
#undef PG8_WAIT_L
#undef PG8_BAR
#undef PG8_SCHED
}
}

typedef pg8::f32x4 pf4;
DEVI float4 ld4(const float* p) { return *(const float4*)p; }
struct EpiFfnIn {
  static constexpr bool PERM = false, AFTER_DRAIN = false;
  bfraw* act;
  DEVI void operator()(const pf4 (&acc)[2][2][4][2], const pg8::Unit& u, int wr, int wc, int fr, int fq) const {
    const int row0 = u.pm * 256 + wr * 64 + fr, f0 = (u.pn * 256 + wc * 32) / 2 + 4 * fq;
#pragma unroll
    for (int ai = 0; ai < 2; ++ai)
#pragma unroll
      for (int m = 0; m < 4; ++m) {
        bfraw* rowp = act + (size_t)(row0 + ai * 128 + m * 16) * 2816 + f0;
#pragma unroll
        for (int bj = 0; bj < 2; ++bj) {
          const pf4 a = acc[ai][bj][m][0], b = acc[ai][bj][m][1];
          uint2 w; w.x = pg8::cvt_pk_bf16(siluf_(a[0]) * b[0], siluf_(a[1]) * b[1]); w.y = pg8::cvt_pk_bf16(siluf_(a[2]) * b[2], siluf_(a[3]) * b[3]);
          *(uint2*)(rowp + bj * 64) = w;
        }
      }
  }
};
struct EpiResid {
  static constexpr bool PERM = false, AFTER_DRAIN = false;
  float* h; const float* mods; int rowoff, gidx; float scale; int mrow;
  DEVI void operator()(const pf4 (&acc)[2][2][4][2], const pg8::Unit& u, int wr, int wc, int fr, int fq) const {
    const int row0 = rowoff + u.pm * 256 + wr * 64 + fr, col0 = u.pn * 256 + wc * 32 + 4 * fq;
#pragma unroll
    for (int ai = 0; ai < 2; ++ai)
#pragma unroll
      for (int m = 0; m < 4; ++m) {
        const int r = row0 + ai * 128 + m * 16;
        float* rowp = h + (size_t)r * 1024 + col0;
        const float* gp = mods + (mrow >= 0 ? mrow : (r >> 13)) * 9216 + gidx * 1024 + col0;
#pragma unroll
        for (int bj = 0; bj < 2; ++bj)
#pragma unroll
          for (int n = 0; n < 2; ++n) {
            float4 hv = ld4(rowp + bj * 128 + n * 16); const float4 g = ld4(gp + bj * 128 + n * 16); const pf4 a = acc[ai][bj][m][n];
            hv.x += scale * g.x * a[0]; hv.y += scale * g.y * a[1]; hv.z += scale * g.z * a[2]; hv.w += scale * g.w * a[3];
            *(float4*)(rowp + bj * 128 + n * 16) = hv;
          }
      }
  }
};
struct EpiResidAtomic {
  static constexpr bool PERM = false, AFTER_DRAIN = false;
  float* h; const float* mods; int rowoff, gidx; float scale; int mrow;
  DEVI void operator()(const pf4 (&acc)[2][2][4][2], const pg8::Unit& u, int wr, int wc, int fr, int fq) const {
    const int row0 = rowoff + u.pm * 256 + wr * 64 + fr, col0 = u.pn * 256 + wc * 32 + 4 * fq;
#pragma unroll
    for (int ai = 0; ai < 2; ++ai)
#pragma unroll
      for (int m = 0; m < 4; ++m) {
        const int r = row0 + ai * 128 + m * 16;
        float* rowp = h + (size_t)r * 1024 + col0;
        const float* gp = mods + (mrow >= 0 ? mrow : (r >> 13)) * 9216 + gidx * 1024 + col0;
#pragma unroll
        for (int bj = 0; bj < 2; ++bj)
#pragma unroll
          for (int n = 0; n < 2; ++n) {
            const float4 g = ld4(gp + bj * 128 + n * 16); const pf4 a = acc[ai][bj][m][n];
            float* q = rowp + bj * 128 + n * 16;
            atomicAdd(q, scale * g.x * a[0]); atomicAdd(q + 1, scale * g.y * a[1]); atomicAdd(q + 2, scale * g.z * a[2]); atomicAdd(q + 3, scale * g.w * a[3]);
          }
      }
  }
};
template <int MODE> struct EpiMix {
  static constexpr bool PERM = true, AFTER_DRAIN = false;
  bfraw* d0; bfraw* d1; bfraw* d2; bfraw* d3;
  DEVI void operator()(const pf4 (&acc)[2][2][4][2], const pg8::Unit& u, int wr, int wc, int fr, int fq) const {
    const int row0 = u.pm * 256 + wr * 64 + fr;
    const int pc = u.pn >> 2;
    bfraw* dst = MODE == 0 ? d0 : (MODE == 1 || MODE == 2) ? (pc == 0 ? d0 : pc == 1 ? d1 : pc == 2 ? d2 : d3) : (MODE == 3 ? d0 : d1);
    const int ld = MODE == 0 ? 3072 : 1024;
    const int col0 = (MODE == 1 || MODE == 2 ? (u.pn & 3) : u.pn) * 256 + wc * 32 + 8 * fq;
#pragma unroll
    for (int ai = 0; ai < 2; ++ai)
#pragma unroll
      for (int m = 0; m < 4; ++m) {
        const size_t ro = (size_t)(row0 + ai * 128 + m * 16) * ld + col0;
#pragma unroll
        for (int bj = 0; bj < 2; ++bj) {
          float v[8];
#pragma unroll
          for (int e = 0; e < 4; ++e) { v[e] = acc[ai][bj][m][0][e]; v[4 + e] = acc[ai][bj][m][1][e]; }
          bfraw* dp = dst + ro + bj * 128;
          if (MODE == 1) { if (pc == 3) {
#pragma unroll
            for (int e = 0; e < 8; ++e) v[e] = geluf_(v[e]); } }
          if (MODE == 2 && pc >= 2) {
#pragma unroll
            for (int e = 0; e < 8; ++e) v[e] = sigmoidf_(v[e]);
          } else if (MODE == 2 || MODE == 3 || MODE == 4) {
            const uint4 o = *(const uint4*)dp; const unsigned ow[4] = {o.x, o.y, o.z, o.w};
            float p[8];
#pragma unroll
            for (int e = 0; e < 4; ++e) { p[2 * e] = bf2f((bfraw)(ow[e] & 0xffff)); p[2 * e + 1] = bf2f((bfraw)(ow[e] >> 16)); }
            if (MODE == 2) {
#pragma unroll
              for (int e = 0; e < 8; ++e) v[e] = (pc == 0 ? sigmoidf_(v[e]) : geluf_(v[e])) * p[e];
            } else if (MODE == 3) {
#pragma unroll
              for (int e = 0; e < 8; ++e) v[e] *= p[e];
            } else {
              const uint4 t = *(const uint4*)(d0 + ro + bj * 128); const unsigned tw[4] = {t.x, t.y, t.z, t.w};
#pragma unroll
              for (int e = 0; e < 4; ++e) { v[2 * e] = bf2f((bfraw)(tw[e] & 0xffff)) + p[2 * e] * v[2 * e]; v[2 * e + 1] = bf2f((bfraw)(tw[e] >> 16)) + p[2 * e + 1] * v[2 * e + 1]; }
            }
          }
          uint4 w; w.x = pg8::cvt_pk_bf16(v[0], v[1]); w.y = pg8::cvt_pk_bf16(v[2], v[3]); w.z = pg8::cvt_pk_bf16(v[4], v[5]); w.w = pg8::cvt_pk_bf16(v[6], v[7]);
          *(uint4*)dp = w;
        }
      }
  }
};
template <class Epi>
DEVI void run8(unsigned char* lds, const bfraw* A, const bfraw* Bt, int M, int N, int K, const Epi& E, int G = -1, int c = -1, int ld = -1) {
  pg8::Gemm g{A, Bt, M, N, K, ld < 0 ? K : ld};
  pg8::StaticOrder S; S.init(M, N, G < 0 ? (int)gridDim.x : G, c < 0 ? (int)blockIdx.x : c);
  pg8::gemm_phase<Epi, pg8::StaticOrder, false>((PG8_LAS unsigned char*)lds, g, S, E, nullptr);
}

struct TrJob { const float* src; bfraw* dst; int ldw, K, kt, nt, drow0, mode; };
DEVI TrJob tr_decode(const P& p, int t) {
  TrJob j; int u = t;
  if (u < 1408) { j = TrJob{p.in[I_W1IN], (bfraw*)(p.ws + O_W1IN), 5632, 1024, u / 88, u % 88, 0, 1}; return j; }
  u -= 1408;
  if (u < 704) { j = TrJob{p.in[I_W1OUT], (bfraw*)(p.ws + O_W1OUT), 1024, 2816, u / 16, u % 16, 0, 0}; return j; }
  u -= 704;
  if (u < 2048) {
    const int pc = u >> 8; u &= 255;
    const int col0 = pc == 0 ? 0 : pc == 1 ? 1024 : pc == 2 ? 2048 : pc == 3 ? 5136 : pc == 4 ? 3088 : pc == 5 ? 4112 : pc == 6 ? 6160 : 7184;
    j = TrJob{p.in[I_WIN] + col0, (bfraw*)(p.ws + (pc < 4 ? O_WTA : O_WTB)), 8208, 1024, u >> 4, u & 15, (pc & 3) * 1024, 0}; return j;
  }
  u -= 2048;
  if (u < 768) { const int m = u >> 8; u &= 255; j = TrJob{p.in[m == 0 ? I_WA : m == 1 ? I_WB : I_WO], (bfraw*)(p.ws + (m == 0 ? O_WA : m == 1 ? O_WB : O_WO)), 1024, 1024, u >> 4, u & 15, 0, 0}; return j; }
  u -= 768;
  if (u < 1408) { j = TrJob{p.in[I_W2IN], (bfraw*)(p.ws + O_W2IN), 5632, 1024, u / 88, u % 88, 0, 1}; return j; }
  u -= 1408;
  j = TrJob{p.in[I_W2OUT], (bfraw*)(p.ws + O_W2OUT), 1024, 2816, u / 16, u % 16, 0, 0}; return j;
}

DEVI void phase_p0(const P& p, unsigned char* lds) {
  float* sf = (float*)lds;
  const int tid = ltid();
  for (int i = tid; i < 3072; i += NTHR) { float v = i < 2048 ? p.in[I_C][i] : p.in[I_CCTX][i - 2048]; sf[i] = v / (1.f + expf(-v)); }
  __syncthreads();
  {
    const float* w = p.in[I_WADA];
    float* mp = (float*)(p.ws + O_MODSP);
    for (int id = blockIdx.x * NTHR + tid; id < 16 * 9216; id += gridDim.x * NTHR) {
      int s = id / 9216, j = id - s * 9216;
      float a0 = 0, a1 = 0, a2 = 0;
#pragma unroll 16
      for (int k = s * 64; k < s * 64 + 64; ++k) { float wv = w[(size_t)k * 9216 + j]; a0 += sf[k] * wv; a1 += sf[1024 + k] * wv; a2 += sf[2048 + k] * wv; }
      mp[(s * 3 + 0) * 9216 + j] = a0; mp[(s * 3 + 1) * 9216 + j] = a1; mp[(s * 3 + 2) * 9216 + j] = a2;
    }
  }
  __syncthreads();
  {
    float rg[8];
    int t = blockIdx.x;
    TrJob jb = tr_decode(p, t < 7040 ? t : 0);
    if (t < 7040) {
#pragma unroll
      for (int i = 0; i < 8; ++i) { int e = tid + i * NTHR; int kk = e >> 6, nn = e & 63; rg[i] = jb.src[(size_t)(jb.kt * 64 + kk) * jb.ldw + jb.nt * 64 + nn]; }
    }
    for (; t < 7040; t += gridDim.x) {
#pragma unroll
      for (int i = 0; i < 8; ++i) { int e = tid + i * NTHR; int kk = e >> 6, nn = e & 63; sf[kk * 65 + nn] = rg[i]; }
      __syncthreads();
      const TrJob cj = jb;
      const int tn = t + gridDim.x;
      if (tn < 7040) {
        jb = tr_decode(p, tn);
#pragma unroll
        for (int i = 0; i < 8; ++i) { int e = tid + i * NTHR; int kk = e >> 6, nn = e & 63; rg[i] = jb.src[(size_t)(jb.kt * 64 + kk) * jb.ldw + jb.nt * 64 + nn]; }
      }
#pragma unroll
      for (int i = 0; i < 8; ++i) {
        int e = tid + i * NTHR; int nn = e >> 6, kk = e & 63;
        int n = cj.nt * 64 + nn, dr;
        if (cj.mode == 1) { int isb = n >= 2816; int f = n - isb * 2816; dr = (f >> 4) * 32 + isb * 16 + (f & 15); } else dr = cj.drow0 + n;
        cj.dst[(size_t)dr * cj.K + cj.kt * 64 + kk] = f2bf(sf[kk * 65 + nn]);
      }
      __syncthreads();
    }
  }
  { bfraw* d = (bfraw*)(p.ws + O_WSB); for (int id = blockIdx.x * NTHR + tid; id < 65536; id += gridDim.x * NTHR) d[id] = f2bf(p.in[I_WS][id]); }
}

DEVI void phase_p0b(const P& p) {
  const float* mp = (const float*)(p.ws + O_MODSP);
  float* m = (float*)(p.ws + O_MODS);
  for (int id = blockIdx.x * NTHR + ltid(); id < 3 * 9216; id += gridDim.x * NTHR) {
    int j = id % 9216;
    float a = p.in[I_BADA][j];
    for (int s = 0; s < 16; ++s) a += mp[s * 3 * 9216 + id];
    m[id] = a;
  }
}

template <int MODE>
DEVI void phase_rows(const P& p, unsigned char* lds, int row_lo = 0, int row_hi = -1, int vb = -1, int nvb = -1) {
  const int tid = ltid(), lane = tid & 63, wid = tid >> 6;
  const float* mods = (const float*)(p.ws + O_MODS);
  float* hctx = (float*)(p.ws + O_HCTX);
  bfraw* hn = (bfraw*)(p.ws + O_HN);
  float* wg = (float*)lds;
  if (MODE == 2) {
    __syncthreads();
    for (int i = tid; i < 16384; i += NTHR) { int k = i >> 4, g = i & 15; wg[g * 1024 + k] = p.in[I_WIN][(size_t)k * 8208 + 3072 + g]; }
    __syncthreads();
  }
  const int nrows = row_hi >= 0 ? row_hi : ((MODE == 1 || MODE == 2) ? 16896 : 16384);
  if (vb < 0) { vb = (int)blockIdx.x; nvb = (int)gridDim.x; }
  const float* gvec = p.in[MODE == 1 ? I_GFFN1 : MODE == 2 ? I_GMIX : MODE == 3 ? I_GFFN2 : I_GFINAL];
  const int msh = MODE == 1 ? 0 : MODE == 2 ? 3 : 6;
  for (int row = row_lo + vb * 8 + wid; row < nrows; row += nvb * 8) {
    const bool lat = row < 16384;
    const int mrow = lat ? (row >> 13) : 2;
    float4 v[4];
    if (MODE == 1) {
      const float* src = lat ? p.in[I_X] + (size_t)row * 1024 : p.in[I_CTX] + (size_t)(row - 16384) * 1024;
#pragma unroll
      for (int i = 0; i < 4; ++i) v[i] = *(const float4*)(src + i * 256 + lane * 4);
      if (lat) {
        int ts = row & 8191; float rr = (float)(ts >> 6), cc = (float)(ts & 63);
        float fqv[4];
#pragma unroll
        for (int e = 0; e < 4; ++e) fqv[e] = expf((-9.210340371976184f * (float)(lane * 4 + e)) / 256.f);
        v[0].x += redsin(rr * fqv[0], false); v[0].y += redsin(rr * fqv[1], false); v[0].z += redsin(rr * fqv[2], false); v[0].w += redsin(rr * fqv[3], false);
        v[1].x += redsin(rr * fqv[0], true);  v[1].y += redsin(rr * fqv[1], true);  v[1].z += redsin(rr * fqv[2], true);  v[1].w += redsin(rr * fqv[3], true);
        v[2].x += redsin(cc * fqv[0], false); v[2].y += redsin(cc * fqv[1], false); v[2].z += redsin(cc * fqv[2], false); v[2].w += redsin(cc * fqv[3], false);
        v[3].x += redsin(cc * fqv[0], true);  v[3].y += redsin(cc * fqv[1], true);  v[3].z += redsin(cc * fqv[2], true);  v[3].w += redsin(cc * fqv[3], true);
      }
      float* dsth = lat ? p.out + (size_t)row * 1024 : hctx + (size_t)(row - 16384) * 1024;
#pragma unroll
      for (int i = 0; i < 4; ++i) *(float4*)(dsth + i * 256 + lane * 4) = v[i];
    } else {
      const float* src = lat ? p.out + (size_t)row * 1024 : hctx + (size_t)(row - 16384) * 1024;
#pragma unroll
      for (int i = 0; i < 4; ++i) v[i] = *(const float4*)(src + i * 256 + lane * 4);
    }
    float ss = 0;
#pragma unroll
    for (int i = 0; i < 4; ++i) ss += v[i].x * v[i].x + v[i].y * v[i].y + v[i].z * v[i].z + v[i].w * v[i].w;
    ss = wave_sum(ss);
    const float rs = rsqrtf(ss * (1.f / 1024.f) + EPS);
    if (MODE == 4) {
#pragma unroll
      for (int i = 0; i < 4; ++i) {
        float4 g = *(const float4*)(gvec + i * 256 + lane * 4);
        float4 o = {v[i].x * rs * g.x, v[i].y * rs * g.y, v[i].z * rs * g.z, v[i].w * rs * g.w};
        *(float4*)(p.out + (size_t)row * 1024 + i * 256 + lane * 4) = o;
      }
    } else {
      const float* sh = mods + (size_t)(mrow * 9216 + msh * 1024);
      const float* scp = sh + 1024;
      float y[16];
#pragma unroll
      for (int i = 0; i < 4; ++i) {
        const int c = i * 256 + lane * 4;
        float4 g = *(const float4*)(gvec + c), s4 = *(const float4*)(sh + c), c4 = *(const float4*)(scp + c);
        y[i * 4 + 0] = v[i].x * rs * g.x * (1.f + c4.x) + s4.x; y[i * 4 + 1] = v[i].y * rs * g.y * (1.f + c4.y) + s4.y;
        y[i * 4 + 2] = v[i].z * rs * g.z * (1.f + c4.z) + s4.z; y[i * 4 + 3] = v[i].w * rs * g.w * (1.f + c4.w) + s4.w;
        uint2 pk; pk.x = (unsigned)f2bf(y[i * 4]) | ((unsigned)f2bf(y[i * 4 + 1]) << 16); pk.y = (unsigned)f2bf(y[i * 4 + 2]) | ((unsigned)f2bf(y[i * 4 + 3]) << 16);
        *(uint2*)(hn + (size_t)row * 1024 + c) = pk;
      }
      if (MODE == 2) {
        float mine = 0.f;
#pragma unroll 2
        for (int g2 = 0; g2 < 16; ++g2) {
          float a = 0.f;
#pragma unroll
          for (int i = 0; i < 4; ++i) { float4 w4 = *(const float4*)(wg + g2 * 1024 + i * 256 + lane * 4); a += y[i * 4] * w4.x + y[i * 4 + 1] * w4.y + y[i * 4 + 2] * w4.z + y[i * 4 + 3] * w4.w; }
          a = wave_sum(a);
          if (lane == g2) mine = a;
        }
        if (lane < 16) ((float*)(p.ws + O_GATES))[(size_t)row * 16 + lane] = mine;
      }
    }
  }
}

DEVI void phase_ffn_in(const P& p, unsigned char* lds, size_t o_w, int nrows) {
  EpiFfnIn E{(bfraw*)(p.ws + O_ACT)};
  run8(lds, (const bfraw*)(p.ws + O_HN), (const bfraw*)(p.ws + o_w), nrows, 5632, 1024, E);
}

DEVI void phase_ffn_out(const P& p, unsigned char* lds, size_t o_w, int gidx, bool with_ctx) {
  EpiResid E{p.out, (const float*)(p.ws + O_MODS), 0, gidx, 0.5f, -1};
  run8(lds, (const bfraw*)(p.ws + O_ACT), (const bfraw*)(p.ws + o_w), 16384, 1024, 2816, E);
  (void)with_ctx;
}

DEVI void phase_r2_g2c(const P& p, unsigned char* lds) {
  const int G = (int)gridDim.x, nc = G >= 48 ? 24 : 0;
  if (nc == 0) {
    EpiResid E{(float*)(p.ws + O_HCTX), (const float*)(p.ws + O_MODS), 0, 2, 0.5f, 2};
    run8(lds, (const bfraw*)(p.ws + O_ACT) + (size_t)16384 * 2816, (const bfraw*)(p.ws + O_W1OUT), 512, 1024, 2816, E);
    __syncthreads();
  } else if ((int)blockIdx.x < nc) {
    const int sl = (int)blockIdx.x >> 3, k0 = sl * 1024, kl = sl == 2 ? 768 : 1024;
    EpiResidAtomic E{(float*)(p.ws + O_HCTX), (const float*)(p.ws + O_MODS), 0, 2, 0.5f, 2};
    run8(lds, (const bfraw*)(p.ws + O_ACT) + (size_t)16384 * 2816 + k0, (const bfraw*)(p.ws + O_W1OUT) + k0, 512, 1024, kl, E, 8, (int)blockIdx.x & 7, 2816);
    return;
  }
  phase_rows<2>(p, lds, 0, 16384, (int)blockIdx.x - nc, G - nc);
}

DEVI void phase_g3c(const P& p, unsigned char* lds) {
  EpiMix<0> E{(bfraw*)(p.ws + O_CTXRAW), nullptr, nullptr, nullptr};
  run8(lds, (const bfraw*)(p.ws + O_HN) + (size_t)16384 * 1024, (const bfraw*)(p.ws + O_WTA), 512, 3072, 1024, E);
}

DEVI void phase_g3a(const P& p, unsigned char* lds, int hb) {
  EpiMix<1> E{(bfraw*)(p.ws + O_QRAW), (bfraw*)(p.ws + O_KRAW), (bfraw*)(p.ws + O_V), (bfraw*)(p.ws + O_GVS)};
  run8(lds, (const bfraw*)(p.ws + O_HN) + (size_t)hb * 8192 * 1024, (const bfraw*)(p.ws + O_WTA), 8192, 4096, 1024, E);
}

DEVI void phase_g3b(const P& p, unsigned char* lds, int hb) {
  EpiMix<2> E{(bfraw*)(p.ws + O_V), (bfraw*)(p.ws + O_GVS), (bfraw*)(p.ws + O_QC), (bfraw*)(p.ws + O_KC)};
  run8(lds, (const bfraw*)(p.ws + O_HN) + (size_t)hb * 8192 * 1024, (const bfraw*)(p.ws + O_WTB), 8192, 4096, 1024, E);
}

DEVI void phase_g4(const P& p, unsigned char* lds) {
  const int Gh = (int)gridDim.x >> 1, grp = (int)blockIdx.x / Gh, c = (int)blockIdx.x % Gh;
  if (grp == 0) { EpiMix<3> E{(bfraw*)(p.ws + O_QC), nullptr, nullptr, nullptr}; run8(lds, (const bfraw*)(p.ws + O_V), (const bfraw*)(p.ws + O_WA), 8192, 1024, 1024, E, Gh, c); }
  else if (grp == 1) { EpiMix<3> E{(bfraw*)(p.ws + O_KC), nullptr, nullptr, nullptr}; run8(lds, (const bfraw*)(p.ws + O_GVS), (const bfraw*)(p.ws + O_WB), 8192, 1024, 1024, E, Gh, c); }
}

DEVI void phase_addmix(const P& p, int hb) {
  const uint4* t1 = (const uint4*)(p.ws + O_QC);
  const uint4* t2 = (const uint4*)(p.ws + O_KC);
  uint4* dst = (uint4*)(p.ws + (hb == 0 ? O_W1IN : O_QC));
  const int tid = ltid();
  for (int i = blockIdx.x * NTHR + tid; i < 8192 * 128; i += gridDim.x * NTHR) {
    const uint4 a = t1[i], b = t2[i];
    const unsigned aw[4] = {a.x, a.y, a.z, a.w}, bw[4] = {b.x, b.y, b.z, b.w}; unsigned o[4];
#pragma unroll
    for (int e = 0; e < 4; ++e) o[e] = (unsigned)f2bf(bf2f((bfraw)(aw[e] & 0xffff)) + bf2f((bfraw)(bw[e] & 0xffff))) | ((unsigned)f2bf(bf2f((bfraw)(aw[e] >> 16)) + bf2f((bfraw)(bw[e] >> 16))) << 16);
    dst[i] = uint4{o[0], o[1], o[2], o[3]};
  }
}

DEVI void phase_g5(const P& p, unsigned char* lds) {
  const int Gh = (int)gridDim.x >> 1, grp = (int)blockIdx.x / Gh, c = (int)blockIdx.x % Gh;
  EpiResid E{p.out, (const float*)(p.ws + O_MODS), grp * 8192, 5, 1.f, -1};
  if (grp < 2) run8(lds, (const bfraw*)(p.ws + (grp == 0 ? O_W1IN : O_QC)), (const bfraw*)(p.ws + O_WO), 8192, 1024, 1024, E, Gh, c);
}

DEVI void phase_cv(const P& p, int hb) {
  const int tid = ltid(), lane = tid & 63, wid = tid >> 6;
  const bfraw* qraw = (const bfraw*)(p.ws + O_QRAW);
  const bfraw* kraw = (const bfraw*)(p.ws + O_KRAW);
  const bfraw* craw = (const bfraw*)(p.ws + O_CTXRAW) + (size_t)hb * 256 * 3072;
  bfraw* qc = (bfraw*)(p.ws + O_QC);
  bfraw* kc = (bfraw*)(p.ws + O_KC);
  bfraw* vv = (bfraw*)(p.ws + O_V);
  const bfraw* gvs = (const bfraw*)(p.ws + O_GVS);
  float* rsb = (float*)(p.ws + O_RS);
  const float* cw = p.in[I_CONVW];
  const float* cb = p.in[I_CONVB];
  for (int task = blockIdx.x * 8 + wid; task < 1056 * 4; task += gridDim.x * 8) {
    const int sidx = task >> 2, part = task & 3, isk = part >> 1;
    const bool lat = sidx < 1024;
    const int lr0 = (lat ? sidx : sidx - 1024) * 8, len = lat ? 8192 : 256, orow0 = sidx * 8;
    const bfraw* src = lat ? (isk ? kraw : qraw) : (craw + isk * 1024);
    const size_t ld = lat ? 1024 : 3072;
    const int ch = (part & 1) * 512 + lane * 8, wch = isk * 1024 + ch;
    float w0[8], w1[8], w2[8], bb[8];
#pragma unroll
    for (int e = 0; e < 8; e += 4) {
      float4 a = ld4(cw + wch + e), b = ld4(cw + 2048 + wch + e), c4 = ld4(cw + 4096 + wch + e), d = ld4(cb + wch + e);
      w0[e] = a.x; w0[e + 1] = a.y; w0[e + 2] = a.z; w0[e + 3] = a.w; w1[e] = b.x; w1[e + 1] = b.y; w1[e + 2] = b.z; w1[e + 3] = b.w;
      w2[e] = c4.x; w2[e + 1] = c4.y; w2[e + 2] = c4.z; w2[e + 3] = c4.w; bb[e] = d.x; bb[e + 1] = d.y; bb[e + 2] = d.z; bb[e + 3] = d.w;
    }
    uint4 rw[10];
#pragma unroll
    for (int i = 0; i < 10; ++i) { const int lr = lr0 - 1 + i; uint4 t = {0u, 0u, 0u, 0u}; if (lr >= 0 && lr < len) t = *(const uint4*)(src + (size_t)lr * ld + ch); rw[i] = t; }
    const float osc = isk ? 1.f : 0.0625f;
    bfraw* dst = (isk ? kc : qc) + (size_t)orow0 * 1024 + ch;
#pragma unroll
    for (int i = 0; i < 8; ++i) {
      const unsigned av[4] = {rw[i].x, rw[i].y, rw[i].z, rw[i].w}, bv[4] = {rw[i + 1].x, rw[i + 1].y, rw[i + 1].z, rw[i + 1].w}, cv[4] = {rw[i + 2].x, rw[i + 2].y, rw[i + 2].z, rw[i + 2].w};
      unsigned ov[4];
#pragma unroll
      for (int e = 0; e < 4; ++e) {
        const float y0 = bf2f((bfraw)(av[e] & 0xffff)) * w0[2 * e] + bf2f((bfraw)(bv[e] & 0xffff)) * w1[2 * e] + bf2f((bfraw)(cv[e] & 0xffff)) * w2[2 * e] + bb[2 * e];
        const float y1 = bf2f((bfraw)(av[e] >> 16)) * w0[2 * e + 1] + bf2f((bfraw)(bv[e] >> 16)) * w1[2 * e + 1] + bf2f((bfraw)(cv[e] >> 16)) * w2[2 * e + 1] + bb[2 * e + 1];
        ov[e] = (unsigned)f2bf(siluf_(y0) * osc) | ((unsigned)f2bf(siluf_(y1) * osc) << 16);
      }
      *(uint4*)(dst + (size_t)i * 1024) = uint4{ov[0], ov[1], ov[2], ov[3]};
    }
  }
  for (int row = blockIdx.x * 8 + wid; row < 8448; row += gridDim.x * 8) {
    if (row < 8192) {
      float ss = 0;
#pragma unroll
      for (int hlf = 0; hlf < 2; ++hlf) {
        uint4 g = *(const uint4*)(gvs + (size_t)row * 1024 + hlf * 512 + lane * 8);
        unsigned gv[4] = {g.x, g.y, g.z, g.w};
#pragma unroll
        for (int e = 0; e < 4; ++e) { float a = bf2f((bfraw)(gv[e] & 0xffff)), b = bf2f((bfraw)(gv[e] >> 16)); ss += a * a + b * b; }
      }
      ss = wave_sum(ss);
      if (lane == 0) rsb[row] = rsqrtf(ss * (1.f / 1024.f) + EPS);
    } else {
#pragma unroll
      for (int hlf = 0; hlf < 2; ++hlf)
        *(uint4*)(vv + (size_t)row * 1024 + hlf * 512 + lane * 8) = *(const uint4*)(craw + 2048 + (size_t)(row - 8192) * 3072 + hlf * 512 + lane * 8);
    }
  }
}

DEVI void phase_ma(const P& p, unsigned char* lds, int hb) {
  const int tid = ltid();
  bfraw* st = (bfraw*)lds;
  float* sc = (float*)(lds + 131072);
  float* s_w = sc + 128, *s_ws = sc + 256, *s_red = sc + 384, *s_part = sc + 512;
  const float* bg = p.in[I_BGATES];
  for (int item = blockIdx.x; item < 528 + 256; item += gridDim.x) {
    unsigned char* wsb = lws(p.ws);
    const float* gates = (const float*)(wsb + O_GATES);
    const bfraw* kc = (const bfraw*)(wsb + O_KC);
    const bfraw* vv = (const bfraw*)(wsb + O_V);
    bfraw* states = (bfraw*)(wsb + O_ST);
    float* nloc = (float*)(wsb + O_NLOC);
    float* mg = (float*)(wsb + O_MG);
    if (item < 528) {
      const int seq = item / 66, j = item % 66, d = seq >> 2, h = seq & 3;
      int rbase, grow;
      if (j < 2) { int cc = d == 0 ? j : 1 - j; rbase = 8192 + cc * 128; grow = 16384 + hb * 256 + cc * 128; }
      else { int c = d == 0 ? j - 2 : 65 - j; rbase = c * 128; grow = hb * 8192 + c * 128; }
      __syncthreads();
      const int el = d == 0 ? (tid & 127) : 127 - (tid & 127);
      float li = 0.f, lf = 0.f;
      if (tid < 128) {
        li = gates[(size_t)(grow + el) * 16 + d * 8 + h] + bg[d * 8 + h];
        lf = logsigf_(gates[(size_t)(grow + el) * 16 + d * 8 + 4 + h] + bg[d * 8 + 4 + h]);
      }
      const float bcum = seg_scan_sum(lf, tid, s_red + 4);
      if (tid == 127) s_red[1] = bcum;
      __syncthreads();
      const float gtot = s_red[1];
      const float wv = gtot - bcum + li;
      if (tid < 128) s_w[el] = wv;
      __syncthreads();
      if (tid < 64) {
        float m = fmaxf(s_w[tid], s_w[tid + 64]);
#pragma unroll
        for (int o = 32; o > 0; o >>= 1) m = fmaxf(m, __shfl_xor(m, o, 64));
        if (tid == 0) s_red[0] = m;
      }
      __syncthreads();
      const float mloc = s_red[0];
      if (tid < 128) s_ws[el] = expf(wv - mloc);
      if (tid == 0) { mg[seq * 66 + j] = mloc; mg[528 + seq * 66 + j] = gtot; }
      __syncthreads();
      {
        const int k = tid & 255, part = tid >> 8;
        const bfraw* kp0 = kc + (size_t)(rbase + part * 64) * 1024 + h * 256 + k;
        float n = 0;
#pragma unroll 16
        for (int t = 0; t < 64; ++t) n += s_ws[part * 64 + t] * bf2f(kp0[(size_t)t * 1024]);
        s_part[tid] = n;
      }
      bfraw* dst = states + (size_t)(seq * 66 + j) * 65536;
#pragma unroll 1
      for (int vh = 0; vh < 2; ++vh) {
        f32x4 acc[4][4]; ZERO_ACC(acc, 4, 4);
        gemm_tile<128, 256, true, true, false>(vv + (size_t)rbase * 1024 + h * 256 + vh * 128, 1024, kc + (size_t)rbase * 1024 + h * 256, 1024, 128, s_ws, acc, st, nullptr, 0);
        EPI_BEGIN(128, 256)
          dst[(vh * 128 + row) * 256 + col] = f2bf(acc[i][j][r]);
        EPI_END
      }
      if (tid < 256) nloc[(size_t)(seq * 66 + j) * 256 + tid] = s_part[tid] + s_part[tid + 256];
    } else {
      const int it = item - 528, c = it >> 2, g = it & 3;
      bfraw* gvs = (bfraw*)(wsb + O_GVS);
      const float* rsb = (const float*)(wsb + O_RS);
      f32x4 acc[4][4]; ZERO_ACC(acc, 4, 4);
      gemm_tile<128, 256, false, true, false>((const bfraw*)(wsb + O_WSB) + g * 16384, 128, gvs + (size_t)c * 128 * 1024 + g * 256, 1024, 128, rsb + c * 128, acc, st, nullptr, 0);
      const float* gs = p.in[I_GSGU] + g * 256;
      const float* bs = p.in[I_BS] + g * 128;
      EPI_BEGIN(128, 256)
        gvs[(size_t)(c * 128 + row) * 1024 + g * 256 + col] = f2bf(gs[col] * acc[i][j][r] + bs[row]);
      EPI_END
    }
  }
}

DEVI void phase_mb(const P& p, unsigned char* lds) {
  bfraw* states = (bfraw*)(p.ws + O_ST);
  const float* mg = (const float*)(p.ws + O_MG);
  float* ment = (float*)(p.ws + O_MG) + 1056;
  const float* nloc = (const float*)(p.ws + O_NLOC);
  float* nent = (float*)(p.ws + O_NENT);
  const int gid = blockIdx.x * NTHR + ltid(), gsz = gridDim.x * NTHR;
  float* s_dec = (float*)lds, *s_scl = s_dec + 528;
  __syncthreads();
  if (ltid() < 8) {
    const int seq = ltid(); float m = 0;
    for (int j = 0; j < 66; ++j) {
      const float mloc = mg[seq * 66 + j], g = mg[528 + seq * 66 + j];
      const float mnew = fmaxf(g + m, mloc);
      s_dec[seq * 66 + j] = expf(g + m - mnew); s_scl[seq * 66 + j] = expf(mloc - mnew);
      if (blockIdx.x == 0) ment[seq * 66 + j] = m;
      m = mnew;
    }
  }
  __syncthreads();
  for (int id = gid; id < 8 * 16384; id += gsz) {
    const int seq = id >> 14, e = (id & 16383) * 4;
    float s0 = 0, s1 = 0, s2 = 0, s3 = 0;
    bfraw* base = states + (size_t)seq * 66 * 65536 + e;
#pragma unroll 1
    for (int cb = 0; cb < 66; cb += 22) {
      uint2 buf[22];
#pragma unroll
      for (int i = 0; i < 22; ++i) buf[i] = *(const uint2*)(base + (size_t)(cb + i) * 65536);
#pragma unroll
      for (int i = 0; i < 22; ++i) {
        const int j = cb + i; const uint2 cur = buf[i];
        const float dec = s_dec[seq * 66 + j], scl = s_scl[seq * 66 + j];
        if (j >= 2) { uint2 o; o.x = (unsigned)f2bf(s0) | ((unsigned)f2bf(s1) << 16); o.y = (unsigned)f2bf(s2) | ((unsigned)f2bf(s3) << 16);
          *(uint2*)(base + (size_t)j * 65536) = o; }
        s0 = dec * s0 + scl * bf2f((bfraw)(cur.x & 0xffff)); s1 = dec * s1 + scl * bf2f((bfraw)(cur.x >> 16));
        s2 = dec * s2 + scl * bf2f((bfraw)(cur.y & 0xffff)); s3 = dec * s3 + scl * bf2f((bfraw)(cur.y >> 16));
      }
    }
  }
  for (int id = gid; id < 8 * 256; id += gsz) {
    const int seq = id >> 8, k = id & 255;
    float n = 0;
    for (int j = 0; j < 66; ++j) {
      nent[(size_t)(seq * 66 + j) * 256 + k] = n;
      n = s_dec[seq * 66 + j] * n + s_scl[seq * 66 + j] * nloc[(size_t)(seq * 66 + j) * 256 + k];
    }
  }
}

DEVI void phase_mc(const P& p, unsigned char* lds, int hb) {
  const int tid = ltid(), lane = tid & 63, wid = tid >> 6, wm = wid >> 2, wn = wid & 3, fr = lane & 15, fq = lane >> 4;
  bfraw* st = (bfraw*)lds;
  bfraw* sS = (bfraw*)(lds + 61440);
  float* sc = (float*)(lds + 131072);
  float* s_b = sc, *s_u = sc + 256, *s_mt = sc + 512, *s_in = sc + 768, *s_den = sc + 1024, *s_dq = sc + 1280, *s_tmp = sc + 1536;
  float* s_sum = sc + 1792, *s_sq = sc + 1920;
  const float* bg = p.in[I_BGATES];
  for (int item = blockIdx.x; item < 256; item += gridDim.x) {
    unsigned char* wsb = lws(p.ws);
    const float* gates = (const float*)(wsb + O_GATES);
    const bfraw* qc = (const bfraw*)(wsb + O_QC);
    const bfraw* kc = (const bfraw*)(wsb + O_KC);
    bfraw* vv = (bfraw*)(wsb + O_V);
    const bfraw* states = (const bfraw*)(wsb + O_ST);
    const float* ment = (const float*)(wsb + O_MG) + 1056;
    const float* nent = (const float*)(wsb + O_NENT);
    const int c = item >> 2, h = item & 3, R0 = c * 128;
    const bfraw* qp = qc + (size_t)R0 * 1024 + h * 256;
    const bfraw* kp = kc + (size_t)R0 * 1024 + h * 256;
    __syncthreads();
    {
      const int d = (tid >> 7) & 1, t = tid & 127, el = d == 0 ? t : 127 - t, ix = d * 128 + el;
      float li = 0.f, lf = 0.f;
      if (tid < 256) {
        const size_t grow = (size_t)hb * 8192 + R0 + el;
        li = gates[grow * 16 + d * 8 + h] + bg[d * 8 + h];
        lf = logsigf_(gates[grow * 16 + d * 8 + 4 + h] + bg[d * 8 + 4 + h]);
        s_den[tid] = 0.f;
        if (tid < 128) { s_sum[tid] = 0.f; s_sq[tid] = 0.f; }
      }
      const float b = seg_scan_sum(lf, tid, s_tmp);
      const float uu = li - b;
      const float pm = seg_scan_max(tid < 256 ? uu : -INFINITY, tid, s_tmp);
      if (tid < 256) {
        const int seq = d * 4 + h, j = d == 0 ? c + 2 : 65 - c;
        const float mst = ment[seq * 66 + j];
        const float a = b + mst;
        const float mt = fmaxf(a, b + pm);
        s_b[ix] = b; s_u[ix] = uu; s_mt[ix] = mt; s_in[ix] = expf(a - mt);
      }
    }
    {
      const int row = tid >> 2, part = tid & 3;
      const uint4* q4 = (const uint4*)(qp + (size_t)row * 1024 + part * 64);
      const float4* nf4 = (const float4*)(nent + (size_t)((0 + h) * 66 + (c + 2)) * 256 + part * 64);
      const float4* nb4 = (const float4*)(nent + (size_t)((4 + h) * 66 + (65 - c)) * 256 + part * 64);
      uint4 qv[8];
#pragma unroll
      for (int i = 0; i < 8; ++i) qv[i] = q4[i];
      float af = 0, ab = 0;
#pragma unroll
      for (int i = 0; i < 8; ++i) {
        const float4 f0 = nf4[2 * i], f1 = nf4[2 * i + 1], b0 = nb4[2 * i], b1 = nb4[2 * i + 1];
        const float q0 = bf2f((bfraw)(qv[i].x & 0xffff)), q1 = bf2f((bfraw)(qv[i].x >> 16)), q2 = bf2f((bfraw)(qv[i].y & 0xffff)), q3 = bf2f((bfraw)(qv[i].y >> 16));
        const float q4_ = bf2f((bfraw)(qv[i].z & 0xffff)), q5 = bf2f((bfraw)(qv[i].z >> 16)), q6 = bf2f((bfraw)(qv[i].w & 0xffff)), q7 = bf2f((bfraw)(qv[i].w >> 16));
        af += q0 * f0.x + q1 * f0.y + q2 * f0.z + q3 * f0.w + q4_ * f1.x + q5 * f1.y + q6 * f1.z + q7 * f1.w;
        ab += q0 * b0.x + q1 * b0.y + q2 * b0.z + q3 * b0.w + q4_ * b1.x + q5 * b1.y + q6 * b1.z + q7 * b1.w;
      }
      af += __shfl_xor(af, 1, 64); af += __shfl_xor(af, 2, 64);
      ab += __shfl_xor(ab, 1, 64); ab += __shfl_xor(ab, 2, 64);
      if (part == 0) { s_dq[row] = af; s_dq[128 + row] = ab; }
    }
    __syncthreads();
    {
      f32x4 S[4][2]; ZERO_ACC(S, 4, 2);
      gemm_tile<128, 128, false, false, false>(qp, 1024, kp, 1024, 256, nullptr, S, st, nullptr, 0);
#pragma unroll 1
      for (int d = 0; d < 2; ++d)
#pragma unroll
        for (int i = 0; i < 4; ++i)
#pragma unroll
          for (int r = 0; r < 4; ++r) {
            const int row = wm * 64 + i * 16 + fq * 4 + r;
            const float bt = s_b[d * 128 + row] - s_mt[d * 128 + row];
            float rs = 0;
#pragma unroll
            for (int j = 0; j < 2; ++j) {
              const int col = wn * 32 + j * 16 + fr;
              const bool valid = d == 0 ? (col <= row) : (col >= row);
              const float val = valid ? S[i][j][r] * fexp(bt + s_u[d * 128 + col]) : 0.f;
              rs += val;
              sS[(d * 128 + row) * 136 + col] = f2bf(val);
            }
            rs = red16(rs);
            if (fr == 0) atomicAdd(&s_den[d * 128 + row], rs);
          }
    }
    __syncthreads();
    f32x4 hs[4][4];
    bfraw* hpark = (bfraw*)(wsb + O_HPARK) + (size_t)R0 * 1024 + h * 256;
#pragma unroll 1
    for (int d = 0; d < 2; ++d) {
      f32x4 (&acc)[4][4] = hs; ZERO_ACC(acc, 4, 4);
      const int seq = d * 4 + h, j2 = d == 0 ? c + 2 : 65 - c;
      gemm_tile<128, 256, false, false, false>(qp, 1024, states + (size_t)(seq * 66 + j2) * 65536, 256, 256, nullptr, acc, st, nullptr, 0);
      EPIR_BEGIN(128, 256)
        const float sin_ = s_in[d * 128 + row];
        EPIR_COLS(256) acc[i][j][r] *= sin_; (void)col;
      EPIR_END
      gemm_tile<128, 256, false, true, true>(nullptr, 0, vv + (size_t)R0 * 1024 + h * 256, 1024, 128, nullptr, acc, st, sS + d * 128 * 136, 136);
      EPIR_BEGIN(128, 256)
        const float den = s_den[d * 128 + row] + s_in[d * 128 + row] * s_dq[d * 128 + row];
        const float inv = 1.f / fmaxf(fabsf(den), expf(-s_mt[d * 128 + row]));
        EPIR_COLS(256)
          const float hv = acc[i][j][r] * inv;
          if (d == 0) hpark[(size_t)row * 1024 + col] = f2bf(hv);
          else hs[i][j][r] = hv + bf2f(hpark[(size_t)row * 1024 + col]);
      EPIR_END
    }
#pragma unroll
    for (int i = 0; i < 4; ++i)
#pragma unroll
      for (int r = 0; r < 4; ++r) {
        float ps = hs[i][0][r] + hs[i][1][r] + hs[i][2][r] + hs[i][3][r];
        ps = red16(ps);
        if (fr == 0) atomicAdd(&s_sum[wm * 64 + i * 16 + fq * 4 + r], ps);
      }
    __syncthreads();
#pragma unroll
    for (int i = 0; i < 4; ++i)
#pragma unroll
      for (int r = 0; r < 4; ++r) {
        const float mu = s_sum[wm * 64 + i * 16 + fq * 4 + r] * (1.f / 256.f);
        float ps = 0;
#pragma unroll
        for (int j = 0; j < 4; ++j) { float dlt = hs[i][j][r] - mu; ps += dlt * dlt; }
        ps = red16(ps);
        if (fr == 0) atomicAdd(&s_sq[wm * 64 + i * 16 + fq * 4 + r], ps);
      }
    __syncthreads();
    const float* gh = p.in[I_GHEAD] + h * 256;
    EPIR_BEGIN(128, 256)
      const float mu = s_sum[row] * (1.f / 256.f);
      const float rstd = rsqrtf(s_sq[row] * (1.f / 256.f) + EPS);
      EPIR_COLS(256)
        vv[(size_t)(R0 + row) * 1024 + h * 256 + col] = f2bf((hs[i][j][r] - mu) * rstd * gh[col]);
    EPIR_END
  }
}

constexpr int NPH = 28;
#define PHASE_PROGRAM \
  PHASE(0, phase_p0(p, lds)) \
  PHASE(1, phase_p0b(p)) \
  PHASE(2, phase_rows<1>(p, lds)) \
  PHASE(3, phase_ffn_in(p, lds, O_W1IN, 16896)) \
  PHASE(4, phase_ffn_out(p, lds, O_W1OUT, 2, true)) \
  PHASE(5, phase_r2_g2c(p, lds)) \
  PHASE(6, phase_rows<2>(p, lds, 16384, 16896)) \
  PHASE(7, phase_g3c(p, lds)) \
  PHASE(8, phase_g3a(p, lds, 0)) \
  PHASE(9, phase_cv(p, 0)) \
  PHASE(10, phase_ma(p, lds, 0)) \
  PHASE(11, phase_mb(p, lds)) \
  PHASE(12, phase_mc(p, lds, 0)) \
  PHASE(13, phase_g3b(p, lds, 0)) \
  PHASE(14, phase_g4(p, lds)) \
  PHASE(15, phase_addmix(p, 0); __syncthreads(); phase_g3a(p, lds, 1)) \
  PHASE(16, phase_cv(p, 1)) \
  PHASE(17, phase_ma(p, lds, 1)) \
  PHASE(18, phase_mb(p, lds)) \
  PHASE(19, phase_mc(p, lds, 1)) \
  PHASE(20, phase_g3b(p, lds, 1)) \
  PHASE(21, phase_g4(p, lds)) \
  PHASE(22, phase_addmix(p, 1)) \
  PHASE(23, phase_g5(p, lds)) \
  PHASE(24, phase_rows<3>(p, lds)) \
  PHASE(25, phase_ffn_in(p, lds, O_W2IN, 16384)) \
  PHASE(26, phase_ffn_out(p, lds, O_W2OUT, 8, false)) \
  PHASE(27, phase_rows<4>(p, lds))

#if !MULTI_LAUNCH
#ifndef USE_CG
#define USE_CG 0
#endif
#if USE_CG
#define PHASE(n, call) if (lo <= (n) && (n) < hi) { if ((n) > lo) { if ((n) == 1) grid.sync(); else xcd_barrier(xbar); } call; }
#else
#define PHASE(n, call) if (lo <= (n) && (n) < hi) { if ((n) > lo) xcd_barrier(xbar); call; }
#endif
__global__ void __launch_bounds__(512) mk(P p, int lo, int hi) {
  extern __shared__ __attribute__((aligned(16))) unsigned char lds[];
#if USE_CG
  cg::grid_group grid = cg::this_grid();
#endif
  volatile LAS unsigned* stw = (volatile LAS unsigned*)(lds + LDS_BYTES - 16);
  if (threadIdx.x == 0) { stw[0] = 0u; stw[1] = 0u; stw[2] = 0u; stw[3] = 0u; }
  __syncthreads();
  XcdBarrier xbar = xcd_barrier_post((unsigned*)(p.ws + O_BAR), stw);
  PHASE_PROGRAM
}
#undef PHASE
#else
#define PHASE(n, call) if constexpr (PH == (n)) { call; }
template <int PH>
__global__ void __launch_bounds__(512) mkp(P p) {
  extern __shared__ __attribute__((aligned(16))) unsigned char lds[];
  PHASE_PROGRAM
}
#undef PHASE
template <int PH> static void launch_all(const P& p, int grid, hipStream_t stream) {
  if constexpr (PH < NPH) {
    (void)hipFuncSetAttribute((const void*)mkp<PH>, hipFuncAttributeMaxDynamicSharedMemorySize, LDS_BYTES);
    hipLaunchKernelGGL(mkp<PH>, dim3(grid), dim3(NTHR), LDS_BYTES, stream, p);
    launch_all<PH + 1>(p, grid, stream);
  }
}
#endif

extern "C" void kernel_launch(void* const* d_in, const int* in_sizes, int n_in, void* d_out, int out_size, void* d_ws, size_t ws_size, hipStream_t stream) {
  static int grid_blocks = 0;
  if (!grid_blocks) {
    if (n_in != 25 || ws_size < O_END || ws_size < O_ACT + 16896ull * 2816 * 2) { fprintf(stderr, "kernel_launch: unexpected n_in %d / ws %zu\n", n_in, ws_size); grid_blocks = -1; return; }
    int dev = 0, cus = 0, per_cu = 0;
    (void)hipGetDevice(&dev);
    (void)hipDeviceGetAttribute(&cus, hipDeviceAttributeMultiprocessorCount, dev);
#if !MULTI_LAUNCH
    if (hipFuncSetAttribute((const void*)mk, hipFuncAttributeMaxDynamicSharedMemorySize, LDS_BYTES) != hipSuccess) { fprintf(stderr, "hipFuncSetAttribute failed\n"); grid_blocks = -1; return; }
    if (hipOccupancyMaxActiveBlocksPerMultiprocessor(&per_cu, (const void*)mk, NTHR, LDS_BYTES) != hipSuccess || per_cu < 1) { fprintf(stderr, "occupancy query failed (%d)\n", per_cu); grid_blocks = -1; return; }
#endif
    grid_blocks = cus * 1;
    fprintf(stderr, "kernel_launch: cus %d per_cu %d grid %d\n", cus, per_cu, grid_blocks);
  }
  if (grid_blocks < 0) return;
  P p{};
  for (int i = 0; i < 25; ++i) p.in[i] = (const float*)d_in[i];
  p.out = (float*)d_out; p.ws = (unsigned char*)d_ws;
#if MULTI_LAUNCH
  launch_all<0>(p, grid_blocks, stream);
#else
  int lo = 0, hi = NPH;
  if (hipMemsetAsync((unsigned char*)d_ws + O_BAR, 0, 16384, stream) != hipSuccess) { fprintf(stderr, "memset of barrier words failed\n"); return; }
  void* args[] = {&p, &lo, &hi};
#ifdef PROBE_K
  {
    hipLaunchKernelGGL(mk, dim3(grid_blocks), dim3(NTHR), LDS_BYTES, stream, p, 0, PROBE_K + 1);
    (void)hipMemsetAsync((unsigned char*)d_ws + O_BAR, 0, 16384, stream);
  }
#endif
#if USE_CG
  hipError_t e = hipLaunchCooperativeKernel((const void*)mk, dim3(grid_blocks), dim3(NTHR), args, LDS_BYTES, stream);
#else
  (void)args;
  hipLaunchKernelGGL(mk, dim3(grid_blocks), dim3(NTHR), LDS_BYTES, stream, p, lo, hi);
  hipError_t e = hipPeekAtLastError();
#endif
  if (e != hipSuccess) fprintf(stderr, "cooperative launch failed: %s (grid %d)\n", hipGetErrorString(e), grid_blocks);
#endif
}
```

```cpp
#include <hip/hip_runtime.h>
#include <hip/hip_cooperative_groups.h>
#include <cstdio>
#include <cstdint>
namespace cg = cooperative_groups;

#ifndef MULTI_LAUNCH
#define MULTI_LAUNCH 0
#endif

typedef unsigned short bfraw;
typedef __attribute__((ext_vector_type(8))) short bf16x8;
typedef __attribute__((ext_vector_type(4))) float f32x4;
#define DEVI __device__ __forceinline__

constexpr int NTHR = 512;
constexpr int GBM = 128;
constexpr int LROW = 40;
constexpr int LDS_BYTES = 143360;
constexpr float EPS = 1e-6f;

enum { I_X, I_C, I_CTX, I_CCTX, I_WADA, I_BADA, I_GFFN1, I_W1IN, I_W1OUT, I_GMIX, I_WIN, I_BGATES, I_CONVW, I_CONVB,
       I_GHEAD, I_GSGU, I_WS, I_BS, I_WA, I_WB, I_WO, I_GFFN2, I_W2IN, I_W2OUT, I_GFINAL };

struct P { const float* in[25]; float* out; unsigned char* ws; };

constexpr size_t O_W1IN  = 0;
constexpr size_t O_W1OUT = O_W1IN  + 5632ull * 1024 * 2;
constexpr size_t O_WTA   = O_W1OUT + 1024ull * 2816 * 2;
constexpr size_t O_WTB   = O_WTA   + 4096ull * 1024 * 2;
constexpr size_t O_WA    = O_WTB   + 4096ull * 1024 * 2;
constexpr size_t O_WB    = O_WA    + 1024ull * 1024 * 2;
constexpr size_t O_WO    = O_WB    + 1024ull * 1024 * 2;
constexpr size_t O_W2IN  = O_WO    + 1024ull * 1024 * 2;
constexpr size_t O_W2OUT = O_W2IN  + 5632ull * 1024 * 2;
constexpr size_t O_WSB   = O_W2OUT + 1024ull * 2816 * 2;
constexpr size_t O_MODSP = O_WSB   + 4ull * 128 * 128 * 2;
constexpr size_t O_MODS  = O_MODSP + 16ull * 3 * 9216 * 4;
constexpr size_t O_HCTX  = O_MODS  + 3ull * 9216 * 4;
constexpr size_t O_HN    = O_HCTX  + 512ull * 1024 * 4;
constexpr size_t O_GATES = O_HN    + 16896ull * 1024 * 2;
constexpr size_t O_CTXRAW= O_GATES + 16896ull * 16 * 4;
constexpr size_t O_BIG   = O_CTXRAW+ 2ull * 256 * 3072 * 2;
constexpr size_t O_ACT   = O_BIG;
constexpr size_t O_ST    = O_BIG;
constexpr size_t O_QRAW  = O_BIG;
constexpr size_t O_KRAW  = O_QRAW  + 8448ull * 1024 * 2;
constexpr size_t O_V     = O_ST    + 8ull * 66 * 131072;
constexpr size_t O_GVS   = O_V     + 8448ull * 1024 * 2;
constexpr size_t O_QC    = O_GVS   + 8192ull * 1024 * 2;
constexpr size_t O_KC    = O_QC    + 8448ull * 1024 * 2;
constexpr size_t O_NLOC  = O_KC    + 8448ull * 1024 * 2;
constexpr size_t O_NENT  = O_NLOC  + 8ull * 66 * 256 * 4;
constexpr size_t O_MG    = O_NENT  + 8ull * 66 * 256 * 4;
constexpr size_t O_RS    = O_MG    + 8192;
constexpr size_t O_HPARK = O_RS    + 8192ull * 4;
constexpr size_t O_BAR   = O_HPARK + 8192ull * 1024 * 2;
constexpr size_t O_END   = O_BAR + 16384;
static_assert(O_ACT + 16896ull * 2816 * 2 <= 268435456ull, "ws");
static_assert(O_END <= 268435456ull, "ws");
static_assert(O_KRAW + 8448ull * 1024 * 2 <= O_V, "overlay");

DEVI int ltid() { int t = __builtin_amdgcn_workitem_id_x(); asm volatile("" : "+v"(t)); return t; }
DEVI unsigned char* lws(unsigned char* w) { asm volatile("" : "+s"(w)); return w; }
DEVI bfraw f2bf(float f) { unsigned u = __float_as_uint(f); u += 0x7fffu + ((u >> 16) & 1u); return (bfraw)(u >> 16); }
DEVI float bf2f(bfraw h) { return __uint_as_float(((unsigned)h) << 16); }
DEVI float fexp(float x) { return __builtin_amdgcn_exp2f(x * 1.4426950408889634f); }
DEVI float sigmoidf_(float x) { return __builtin_amdgcn_rcpf(1.f + fexp(-x)); }
DEVI float siluf_(float x) { return x * sigmoidf_(x); }
DEVI float geluf_(float x) { return x * sigmoidf_(1.5957691216057308f * (x + 0.044715f * x * x * x)); }
DEVI float logsigf_(float x) { return fminf(x, 0.f) - log1pf(expf(-fabsf(x))); }
DEVI float wave_sum(float v) {
#pragma unroll
  for (int o = 32; o > 0; o >>= 1) v += __shfl_xor(v, o, 64);
  return v;
}
DEVI float red16(float v) {
  v += __shfl_xor(v, 1, 64); v += __shfl_xor(v, 2, 64); v += __shfl_xor(v, 4, 64); v += __shfl_xor(v, 8, 64);
  return v;
}
DEVI float redsin(float a, bool cosine) {
  float k = rintf(a * 0.15915494309189535f);
  float r = fmaf(-k, 6.2831854820251465f, a);
  r = fmaf(-k, -1.7484555e-7f, r);
  return cosine ? __cosf(r) : __sinf(r);
}


DEVI float seg_scan_sum(float v, int tid, float* s_x) {
  const int lane = tid & 63;
#pragma unroll
  for (int o = 1; o < 64; o <<= 1) { float t = __shfl_up(v, o, 64); if (lane >= o) v += t; }
  if (lane == 63 && tid < 256) s_x[tid >> 6] = v;
  __syncthreads();
  if (tid < 256 && ((tid >> 6) & 1)) v += s_x[(tid >> 6) - 1];
  __syncthreads();
  return v;
}
DEVI float seg_scan_max(float v, int tid, float* s_x) {
  const int lane = tid & 63;
#pragma unroll
  for (int o = 1; o < 64; o <<= 1) { float t = __shfl_up(v, o, 64); if (lane >= o) v = fmaxf(v, t); }
  if (lane == 63 && tid < 256) s_x[tid >> 6] = v;
  __syncthreads();
  if (tid < 256 && ((tid >> 6) & 1)) v = fmaxf(v, s_x[(tid >> 6) - 1]);
  __syncthreads();
  return v;
}

#define XB_TMO      128
#define XB_XCNT(j)  (256  + 64 * (j))
#define XB_XSUB(j)  (1280 + 64 * (j))
#define XB_XGEN(j)  (2304 + 64 * (j))
#define XB_TOP      3328
#define XB_TOPGEN   3392
#define XCD_BAR_WORDS 3456
#define XB_SPIN_CAP (1u << 18)
#define LAS __attribute__((address_space(3)))

__device__ __forceinline__ unsigned xb_ld(unsigned* p)              { return __hip_atomic_load(p, __ATOMIC_RELAXED, __HIP_MEMORY_SCOPE_AGENT); }
__device__ __forceinline__ unsigned xb_add(unsigned* p, unsigned v) { return __hip_atomic_fetch_add(p, v, __ATOMIC_RELAXED, __HIP_MEMORY_SCOPE_AGENT); }
__device__ __forceinline__ unsigned xb_xcc_id() { return (unsigned)__builtin_amdgcn_s_getreg((3 << 11) | 20) & 0xFu; }
#define XB_SPIN(cond, bar) do { unsigned _sp = 0; while (cond) { __builtin_amdgcn_s_sleep(1); \
    if ((++_sp & 255u) == 0u) { if (xb_ld(&(bar)[XB_TMO])) break; if (_sp > XB_SPIN_CAP) { atomicAdd(&(bar)[XB_TMO], 1u); break; } } } } while (0)

struct XcdBarrier {
    unsigned* bar; unsigned x;
    volatile LAS unsigned* st;
};

__device__ __forceinline__ XcdBarrier xcd_barrier_post(unsigned* bar, volatile LAS unsigned* st) {
    XcdBarrier b; b.bar = bar; b.x = xb_xcc_id(); b.st = st;
    if (threadIdx.x == 0) (void)xb_add(&bar[XB_XCNT(b.x)], 1u);
    return b;
}
__device__ __forceinline__ void xcd_barrier_complete(unsigned* bar, unsigned x, unsigned& nloc, unsigned& nx) {
    const unsigned G = gridDim.x * gridDim.y * gridDim.z;
    unsigned sum, cnt, mine, sp = 0u;
    for (;;) {
        sum = 0u; cnt = 0u; mine = 0u;
#pragma unroll
        for (unsigned j = 0; j < 16; ++j) { const unsigned c = xb_ld(&bar[XB_XCNT(j)]); sum += c; cnt += (c > 0u) ? 1u : 0u; mine = (j == x) ? c : mine; }
        if (sum == G) break;
        __builtin_amdgcn_s_sleep(1);
        if ((++sp & 255u) == 0u) { if (xb_ld(&bar[XB_TMO])) break; if (sp > XB_SPIN_CAP) { atomicAdd(&bar[XB_TMO], 1u); break; } }
    }
    nloc = mine > 0u ? mine : 1u; nx = cnt > 0u ? cnt : 1u;
}

__device__ __forceinline__ void xcd_barrier(const XcdBarrier& b) {
    asm volatile("s_waitcnt vmcnt(0)" ::: "memory");
    __syncthreads();
    if (threadIdx.x == 0) {
        unsigned* bar = b.bar;
        __builtin_amdgcn_s_waitcnt(0);
        unsigned nloc = b.st[0], nx = b.st[1];
        if (nloc == 0u) { xcd_barrier_complete(bar, b.x, nloc, nx); b.st[0] = nloc; b.st[1] = nx; }
        const unsigned old = xb_add(&bar[XB_XSUB(b.x)], 1u);
        const unsigned gen = old / nloc;
        if (old + 1u == (gen + 1u) * nloc) {
            __builtin_amdgcn_fence(__ATOMIC_RELEASE, "agent");
            asm volatile("s_waitcnt vmcnt(0)" ::: "memory");
            const unsigned og = xb_add(&bar[XB_TOP], 1u);
            const unsigned tg = og / nx;
            if (og + 1u == (tg + 1u) * nx) xb_add(&bar[XB_TOPGEN], 1u);
            else XB_SPIN(xb_ld(&bar[XB_TOPGEN]) == tg, bar);
            __builtin_amdgcn_fence(__ATOMIC_ACQUIRE, "agent");
            xb_add(&bar[XB_XGEN(b.x)], 1u);
            asm volatile("s_waitcnt vmcnt(0)" ::: "memory");
        } else {
            XB_SPIN(xb_ld(&bar[XB_XGEN(b.x)]) == gen, bar);
            __builtin_amdgcn_fence(__ATOMIC_ACQUIRE, "agent");
            asm volatile("s_waitcnt vmcnt(0)" ::: "memory");
        }
    }
    __syncthreads();
}

template <int BM, int BN, bool ATR, bool BTR, bool ALDS>
DEVI void gemm_tile(const bfraw* __restrict__ A, int lda, const bfraw* __restrict__ B, int ldb, int K,
                    const float* kscale, f32x4 (&acc)[BM / 32][BN / 64], bfraw* st, const bfraw* sAres, int ldres) {
  constexpr int MI = BM / 32, NJ = BN / 64, CA = BM / 128, CB = BN / 128, WM = BM / 2, WN = BN / 4;
  constexpr int STAGE = (ALDS ? BN : (BM + BN)) * LROW;
  int tid_ = ltid();
  const int tid = tid_, lane = tid & 63, wid = tid >> 6, wm = wid >> 2, wn = wid & 3;
  const int fr = lane & 15, fq = lane >> 4;
  uint4 ra0 = {0, 0, 0, 0}, ra1 = {0, 0, 0, 0}, rb0 = {0, 0, 0, 0}, rb1 = {0, 0, 0, 0};
  const int nk = K >> 5;

  auto gla = [&](int c, int k0) -> uint4 {
    if (!ATR) { int row = c >> 2, kc = (c & 3) * 8; return *(const uint4*)(A + (size_t)row * lda + k0 + kc); }
    else { int krow = c / (BM / 8), m0 = (c % (BM / 8)) * 8; return *(const uint4*)(A + (size_t)(k0 + krow) * lda + m0); }
  };
  auto glb = [&](int c, int k0) -> uint4 {
    if (!BTR) { int row = c >> 2, kc = (c & 3) * 8; return *(const uint4*)(B + (size_t)row * ldb + k0 + kc); }
    else { int krow = c / (BN / 8), n0 = (c % (BN / 8)) * 8; return *(const uint4*)(B + (size_t)(k0 + krow) * ldb + n0); }
  };
  auto gload = [&](int kt) {
    const int k0 = kt << 5;
    if (!ALDS) { ra0 = gla(tid, k0); if (CA > 1) ra1 = gla(tid + NTHR, k0); }
    rb0 = glb(tid, k0); if (CB > 1) rb1 = glb(tid + NTHR, k0);
  };
  constexpr int TSA = BM + 8, TSB = BN + 8;
  auto scale8 = [&](uint4 r, float sc) -> uint4 {
    unsigned w[4] = {r.x, r.y, r.z, r.w};
#pragma unroll
    for (int e = 0; e < 4; ++e) w[e] = (unsigned)f2bf(bf2f((bfraw)(w[e] & 0xffff)) * sc) | ((unsigned)f2bf(bf2f((bfraw)(w[e] >> 16)) * sc) << 16);
    return uint4{w[0], w[1], w[2], w[3]};
  };
  auto lstore = [&](int buf, int kt) {
    bfraw* sA = st + buf * STAGE;
    bfraw* sB = sA + (ALDS ? 0 : BM * LROW);
    auto sta = [&](int c, uint4 v) {
      if (!ATR) { int row = c >> 2, kc = (c & 3) * 8; *(uint4*)(sA + row * LROW + kc) = v; }
      else { int krow = c / (BM / 8), m0 = (c % (BM / 8)) * 8; *(uint4*)(sA + krow * TSA + m0) = v; }
    };
    auto stb = [&](int c, uint4 v) {
      if (!BTR) { int row = c >> 2, kc = (c & 3) * 8; *(uint4*)(sB + row * LROW + kc) = v; }
      else {
        int krow = c / (BN / 8), n0 = (c % (BN / 8)) * 8;
        if (kscale) v = scale8(v, kscale[(kt << 5) + krow]);
        *(uint4*)(sB + krow * TSB + n0) = v;
      }
    };
    if (!ALDS) { sta(tid, ra0); if (CA > 1) sta(tid + NTHR, ra1); }
    stb(tid, rb0); if (CB > 1) stb(tid + NTHR, rb1);
  };
  typedef short s16x4 __attribute__((ext_vector_type(4)));
  auto trfrag = [&](const bfraw* sT, int TS, int mt) -> bf16x8 {
    const bfraw* a1 = sT + (8 * fq + (fr >> 2)) * TS + mt + (fr & 3) * 4;
    s16x4 r1 = __builtin_amdgcn_ds_read_tr16_b64_v4i16((__attribute__((address_space(3))) s16x4*)a1);
    s16x4 r2 = __builtin_amdgcn_ds_read_tr16_b64_v4i16((__attribute__((address_space(3))) s16x4*)(a1 + 4 * TS));
    return bf16x8{r1[0], r1[1], r1[2], r1[3], r2[0], r2[1], r2[2], r2[3]};
  };
  auto compute = [&](int buf, int kt) {
    const bfraw* sA = st + buf * STAGE;
    const bfraw* sB = sA + (ALDS ? 0 : BM * LROW);
    bf16x8 af[MI], bfr[NJ];
#pragma unroll
    for (int i = 0; i < MI; ++i) {
      if (ALDS) af[i] = *(const bf16x8*)(sAres + (wm * WM + i * 16 + fr) * ldres + (kt << 5) + fq * 8);
      else if (ATR) af[i] = trfrag(sA, TSA, wm * WM + i * 16);
      else af[i] = *(const bf16x8*)(sA + (wm * WM + i * 16 + fr) * LROW + fq * 8);
    }
#pragma unroll
    for (int j = 0; j < NJ; ++j) {
      if (BTR) bfr[j] = trfrag(sB, TSB, wn * WN + j * 16);
      else bfr[j] = *(const bf16x8*)(sB + (wn * WN + j * 16 + fr) * LROW + fq * 8);
    }
#pragma unroll
    for (int i = 0; i < MI; ++i)
#pragma unroll
      for (int j = 0; j < NJ; ++j) acc[i][j] = __builtin_amdgcn_mfma_f32_16x16x32_bf16(af[i], bfr[j], acc[i][j], 0, 0, 0);
  };

  uint4 xa0 = {0, 0, 0, 0}, xa1 = {0, 0, 0, 0}, xb0 = {0, 0, 0, 0}, xb1 = {0, 0, 0, 0};
  auto swapsets = [&]() { uint4 t; t = ra0; ra0 = xa0; xa0 = t; t = ra1; ra1 = xa1; xa1 = t; t = rb0; rb0 = xb0; xb0 = t; t = rb1; rb1 = xb1; xb1 = t; };
  __syncthreads();
  gload(0); lstore(0, 0);
  if (nk > 1) gload(1);
  if (nk > 2) { swapsets(); gload(2); swapsets(); }
  __syncthreads();
  for (int kt = 0; kt < nk; kt += 2) {
    compute(0, kt);
    if (kt + 1 < nk) lstore(1, kt + 1);
    if (kt + 3 < nk) gload(kt + 3);
    __syncthreads();
    if (kt + 1 >= nk) break;
    compute(1, kt + 1);
    swapsets();
    if (kt + 2 < nk) lstore(0, kt + 2);
    if (kt + 4 < nk) gload(kt + 4);
    swapsets();
    __syncthreads();
  }
}

#define ZERO_ACC(acc, MI, NJ) _Pragma("unroll") for (int _i = 0; _i < (MI); ++_i) _Pragma("unroll") for (int _j = 0; _j < (NJ); ++_j) acc[_i][_j] = f32x4{0.f, 0.f, 0.f, 0.f};
#define EPI_BEGIN(BM, BN) { int _t = ltid(); const int _l = _t & 63, _w = _t >> 6; \
    const int _rb = (_w >> 2) * ((BM) / 2) + (_l >> 4) * 4, _cb = (_w & 3) * ((BN) / 4) + (_l & 15); \
    _Pragma("unroll") for (int i = 0; i < (BM) / 32; ++i) _Pragma("unroll") for (int j = 0; j < (BN) / 64; ++j) _Pragma("unroll") for (int r = 0; r < 4; ++r) { \
      const int row = _rb + i * 16 + r, col = _cb + j * 16;
#define EPI_END }}
#define EPIR_BEGIN(BM, BN) { int _t = ltid(); const int _l = _t & 63, _w = _t >> 6; \
    const int _rb = (_w >> 2) * ((BM) / 2) + (_l >> 4) * 4, _cb = (_w & 3) * ((BN) / 4) + (_l & 15); \
    _Pragma("unroll") for (int i = 0; i < (BM) / 32; ++i) _Pragma("unroll") for (int r = 0; r < 4; ++r) { \
      const int row = _rb + i * 16 + r;
#define EPIR_COLS(BN) _Pragma("unroll") for (int j = 0; j < (BN) / 64; ++j) { const int col = _cb + j * 16;
#define EPIR_END }}}


namespace pg8 {
#define PG8_LAS __attribute__((address_space(3)))
typedef unsigned short bf16_t;
typedef short bf16x8 __attribute__((ext_vector_type(8)));
typedef float f32x4 __attribute__((ext_vector_type(4)));
typedef unsigned u32x4 __attribute__((ext_vector_type(4)));
constexpr int BM = 256, BK = 64, HALF = 128, HTB = HALF * BK * 2  , STAGE_BYTES = 8 * HTB, NXCD = 8, WGM = 8;

__host__ __device__ __forceinline__ int lds_byte(int r, int c) { const int st = (r >> 4) * 2 + (c >> 5), rr = r & 15, cc = c & 31, ob = rr * 64 + cc * 2; return st * 1024 + (ob ^ (((ob >> 9) & 1) << 5)); }
__host__ __device__ __forceinline__ void stage_rc(int b, int& R, int& C) { const int st = b / 1024, sb = b % 1024, swz = sb ^ (((sb >> 9) & 1) << 5); R = (st >> 1) * 16 + swz / 64; C = (st & 1) * 32 + (swz % 64) / 2; }
__host__ __device__ __forceinline__ int perm32(int rho) { const int n = rho >> 4, i = rho & 15; return 8 * (i >> 2) + 4 * n + (i & 3); }

struct Unit { int pm, pn; };
struct Gemm { const bf16_t* A; const bf16_t* Bt; int M, N, K, ld; };
struct StaticOrder {
    int nM, nN, nwg, G, c;
    __host__ __device__ void init(int M, int N, int G_, int c_) { nM = M / BM; nN = N / BM; nwg = nM * nN; G = G_; c = c_; }
    __host__ __device__ bool next(int i, Unit& u) const {
        const long L = (long)i * G + c; if (L >= nwg) return false;
        int wgid = (int)L; { const int q = nwg / NXCD, r = nwg % NXCD, xcd = wgid % NXCD, off = wgid / NXCD; wgid = (xcd < r ? xcd * (q + 1) : r * (q + 1) + (xcd - r) * q) + off; }
        const int nig = WGM * nN, gid = wgid / nig, fm = gid * WGM, gsz = (nM - fm) < WGM ? (nM - fm) : WGM;
        u.pm = fm + ((wgid % nig) % gsz); u.pn = (wgid % nig) / gsz; return true;
    }
    __device__ __forceinline__ void a_ready(const Unit&) const {}
    __device__ __forceinline__ void done(const Unit&) const {}
};
__device__ __forceinline__ unsigned cvt_pk_bf16(float lo, float hi) { unsigned r; asm volatile("v_cvt_pk_bf16_f32 %0, %1, %2" : "=v"(r) : "v"(lo), "v"(hi)); return r; }
template <class Epi, class Sched, bool STAMP = false>
__device__ __forceinline__ void gemm_phase(PG8_LAS unsigned char* lds, const Gemm g, const Sched& S, const Epi& E, unsigned long long* stamps) {
    const int tid = threadIdx.x, wid = __builtin_amdgcn_readfirstlane(tid >> 6), lane = tid & 63, wr = wid >> 2, wc = wid & 3, fr = lane & 15, fq = lane >> 4;
    const int K = g.K, nt = K / BK;
    int ts_lo = 0, ts_hi = 0, nts = 0; const unsigned long long rt_entry = STAMP ? (unsigned long long)wall_clock64() : 0ull;
#define PG8_STAMP() do { if (STAMP && wid == 0 && nts < 64) { const unsigned long long _c = (unsigned long long)clock64(); \
        ts_lo = (lane == nts) ? (int)(unsigned)_c : ts_lo; ts_hi = (lane == nts) ? (int)(unsigned)(_c >> 32) : ts_hi; ++nts; } } while (0)
    PG8_STAMP();
    unsigned voffA[2], voffB[2];
#pragma unroll
    for (int i = 0; i < 2; ++i) { int R, C; stage_rc(tid * 16 + i * 8192, R, C); const int Rb = Epi::PERM ? ((R & ~31) + perm32(R & 31)) : R;
        voffA[i] = (unsigned)(R * g.ld + C) * 2u; voffB[i] = (unsigned)(Rb * g.ld + C) * 2u; }
    const size_t kstep = (size_t)(BK * 2);
    const size_t hstep = (size_t)HALF * g.ld * 2;
    const size_t tstep = 2 * hstep;
    const unsigned ldsw = (unsigned)wid * 1024u;
    const int aoff = lds_byte(wr * 64 + fr, fq * 8), boff = lds_byte(wc * 32 + fr, fq * 8);
#define PG8_SA(b, h) (((b) * 2 + (h)) * HTB)
#define PG8_SB(b, h) ((4 + (b) * 2 + (h)) * HTB)
#define PG8_STAGE(bufoff, gbase, voff) do { _Pragma("unroll") for (int _i = 0; _i < 2; ++_i) \
        __builtin_amdgcn_global_load_lds((const unsigned*)((const char*)(gbase) + (voff)[_i]), (PG8_LAS unsigned*)(lds + (bufoff) + ldsw + _i * 8192), 16, 0, 0); } while (0)
#define PG8_LDA(dst, b, h) do { _Pragma("unroll") for (int m = 0; m < 4; ++m) _Pragma("unroll") for (int k = 0; k < 2; ++k) dst[m][k] = *(const PG8_LAS bf16x8*)(lds + PG8_SA(b, h) + aoff + m * 2048 + k * 1024); } while (0)
#define PG8_LDB(dst, b, h) do { _Pragma("unroll") for (int n = 0; n < 2; ++n) _Pragma("unroll") for (int k = 0; k < 2; ++k) dst[n][k] = *(const PG8_LAS bf16x8*)(lds + PG8_SB(b, h) + boff + n * 2048 + k * 1024); } while (0)
#define PG8_MMA(ai, bj, At, Bt) do { __builtin_amdgcn_s_setprio(1); _Pragma("unroll") for (int m = 0; m < 4; ++m) _Pragma("unroll") for (int n = 0; n < 2; ++n) _Pragma("unroll") for (int k = 0; k < 2; ++k) \
        acc[ai][bj][m][n] = __builtin_amdgcn_mfma_f32_16x16x32_bf16(Bt[n][k], At[m][k], acc[ai][bj][m][n], 0, 0, 0); __builtin_amdgcn_s_setprio(0); } while (0)
#define PG8_WAIT_V(n) asm volatile("s_waitcnt vmcnt(" #n ")" ::: "memory")
#define PG8_WAIT_L(n) asm volatile("s_waitcnt lgkmcnt(" #n ")" ::: "memory")
#define PG8_BAR __builtin_amdgcn_s_barrier()
#define PG8_SCHED __builtin_amdgcn_sched_barrier(0)
    Unit cur, nxt; int ui = 0;
    if (!S.next(0, cur)) return;
    f32x4 acc[2][2][4][2];
#pragma unroll
    for (int a = 0; a < 2; ++a)
#pragma unroll
        for (int b = 0; b < 2; ++b)
#pragma unroll
            for (int m = 0; m < 4; ++m)
#pragma unroll
                for (int n = 0; n < 2; ++n) acc[a][b][m][n] = (f32x4){0.f, 0.f, 0.f, 0.f};
    bf16x8 At[4][2], B0[2][2], B1[2][2];
    const char* cA = (const char*)g.A + (size_t)cur.pm * tstep; const char* cB = (const char*)g.Bt + (size_t)cur.pn * tstep;
    S.a_ready(cur);
    PG8_STAGE(PG8_SB(0, 0), cB, voffB); PG8_STAGE(PG8_SA(0, 0), cA, voffA); PG8_STAGE(PG8_SB(0, 1), cB + hstep, voffB); PG8_STAGE(PG8_SA(0, 1), cA + hstep, voffA);
    if (wr == 1) PG8_BAR;
    PG8_WAIT_V(4); PG8_BAR;
    PG8_STAGE(PG8_SB(1, 0), cB + kstep, voffB); PG8_STAGE(PG8_SA(1, 0), cA + kstep, voffA); PG8_STAGE(PG8_SB(1, 1), cB + hstep + kstep, voffB);
    PG8_WAIT_V(6); PG8_BAR;
    PG8_STAMP();
    for (;;) {
        const bool has_next = S.next(ui + 1, nxt);
        const char* nA = has_next ? (const char*)g.A + (size_t)nxt.pm * tstep : cA; const char* nB = has_next ? (const char*)g.Bt + (size_t)nxt.pn * tstep : cB;
        for (int t = 0; t < nt; t += 2) {
            const bool last = (t == nt - 2);
            const char* a1 = cA + (size_t)(t + 1) * kstep;
            const char* a2 = last ? nA : cA + (size_t)(t + 2) * kstep; const char* b2 = last ? nB : cB + (size_t)(t + 2) * kstep;
            const char* a3 = a2 + kstep; const char* b3 = b2 + kstep;
            if (last && has_next) S.a_ready(nxt);
            PG8_LDB(B0, 0, 0); PG8_SCHED; PG8_LDA(At, 0, 0); PG8_STAGE(PG8_SA(1, 1), a1 + hstep, voffA);
            PG8_WAIT_L(8); PG8_BAR; PG8_WAIT_L(0); PG8_MMA(0, 0, At, B0); PG8_BAR; PG8_SCHED;
            PG8_LDB(B1, 0, 1); PG8_STAGE(PG8_SB(0, 0), b2, voffB);
            PG8_BAR; PG8_WAIT_L(0); PG8_MMA(0, 1, At, B1); PG8_BAR;
            PG8_LDA(At, 0, 1); PG8_STAGE(PG8_SA(0, 0), a2, voffA);
            PG8_BAR; PG8_WAIT_L(0); PG8_MMA(1, 0, At, B0); PG8_BAR; PG8_SCHED;
            PG8_STAGE(PG8_SB(0, 1), b2 + hstep, voffB);
            PG8_WAIT_V(6); PG8_BAR; PG8_MMA(1, 1, At, B1); PG8_BAR;
            PG8_LDB(B0, 1, 0); PG8_SCHED; PG8_LDA(At, 1, 0); PG8_STAGE(PG8_SA(0, 1), a2 + hstep, voffA);
            PG8_WAIT_L(8); PG8_BAR; PG8_WAIT_L(0); PG8_MMA(0, 0, At, B0); PG8_BAR; PG8_SCHED;
            PG8_LDB(B1, 1, 1); PG8_STAGE(PG8_SB(1, 0), b3, voffB);
            PG8_BAR; PG8_WAIT_L(0); PG8_MMA(0, 1, At, B1); PG8_BAR;
            PG8_LDA(At, 1, 1); PG8_STAGE(PG8_SA(1, 0), a3, voffA);
            PG8_BAR; PG8_WAIT_L(0); PG8_MMA(1, 0, At, B0); PG8_BAR; PG8_SCHED;
            PG8_STAGE(PG8_SB(1, 1), b3 + hstep, voffB);
            PG8_WAIT_V(6); PG8_BAR; PG8_MMA(1, 1, At, B1); PG8_BAR;
        }
        PG8_STAMP();
        if constexpr (!Epi::AFTER_DRAIN) { E(acc, cur, wr, wc, fr, fq); S.done(cur); }
        PG8_STAMP();
        if (!has_next) break;
#pragma unroll
        for (int a = 0; a < 2; ++a)
#pragma unroll
            for (int b = 0; b < 2; ++b)
#pragma unroll
                for (int m = 0; m < 4; ++m)
#pragma unroll
                    for (int n = 0; n < 2; ++n) acc[a][b][m][n] = (f32x4){0.f, 0.f, 0.f, 0.f};
        cur = nxt; cA = nA; cB = nB; ++ui;
    }
    PG8_WAIT_V(0);
    if (wr == 0) PG8_BAR;
    PG8_BAR;
    if constexpr (Epi::AFTER_DRAIN) { E.fused(acc, cur, wr, wc, fr, fq, lds, wid, lane); S.done(cur); }
    PG8_STAMP();
    if (STAMP && wid == 0) { stamps[lane] = lane < nts ? (((unsigned long long)(unsigned)ts_hi << 32) | (unsigned)ts_lo) : 0ull;
        if (lane == 62) stamps[62] = rt_entry; if (lane == 63) stamps[63] = (unsigned long long)wall_clock64(); }
#undef PG8_STAMP
#undef PG8_SA
#undef PG8_SB
#undef PG8_STAGE
#undef PG8_LDA
#undef PG8_LDB
#undef PG8_MMA
#undef PG8_WAIT_V
#undef PG8_WAIT_L
#undef PG8_BAR
#undef PG8_SCHED
}
}

typedef pg8::f32x4 pf4;
DEVI float4 ld4(const float* p) { return *(const float4*)p; }
struct EpiFfnIn {
  static constexpr bool PERM = false, AFTER_DRAIN = false;
  bfraw* act;
  DEVI void operator()(const pf4 (&acc)[2][2][4][2], const pg8::Unit& u, int wr, int wc, int fr, int fq) const {
    const int row0 = u.pm * 256 + wr * 64 + fr, f0 = (u.pn * 256 + wc * 32) / 2 + 4 * fq;
#pragma unroll
    for (int ai = 0; ai < 2; ++ai)
#pragma unroll
      for (int m = 0; m < 4; ++m) {
        bfraw* rowp = act + (size_t)(row0 + ai * 128 + m * 16) * 2816 + f0;
#pragma unroll
        for (int bj = 0; bj < 2; ++bj) {
          const pf4 a = acc[ai][bj][m][0], b = acc[ai][bj][m][1];
          uint2 w; w.x = pg8::cvt_pk_bf16(siluf_(a[0]) * b[0], siluf_(a[1]) * b[1]); w.y = pg8::cvt_pk_bf16(siluf_(a[2]) * b[2], siluf_(a[3]) * b[3]);
          *(uint2*)(rowp + bj * 64) = w;
        }
      }
  }
};
struct EpiResid {
  static constexpr bool PERM = false, AFTER_DRAIN = false;
  float* h; const float* mods; int rowoff, gidx; float scale; int mrow;
  DEVI void operator()(const pf4 (&acc)[2][2][4][2], const pg8::Unit& u, int wr, int wc, int fr, int fq) const {
    const int row0 = rowoff + u.pm * 256 + wr * 64 + fr, col0 = u.pn * 256 + wc * 32 + 4 * fq;
#pragma unroll
    for (int ai = 0; ai < 2; ++ai)
#pragma unroll
      for (int m = 0; m < 4; ++m) {
        const int r = row0 + ai * 128 + m * 16;
        float* rowp = h + (size_t)r * 1024 + col0;
        const float* gp = mods + (mrow >= 0 ? mrow : (r >> 13)) * 9216 + gidx * 1024 + col0;
#pragma unroll
        for (int bj = 0; bj < 2; ++bj)
#pragma unroll
          for (int n = 0; n < 2; ++n) {
            float4 hv = ld4(rowp + bj * 128 + n * 16); const float4 g = ld4(gp + bj * 128 + n * 16); const pf4 a = acc[ai][bj][m][n];
            hv.x += scale * g.x * a[0]; hv.y += scale * g.y * a[1]; hv.z += scale * g.z * a[2]; hv.w += scale * g.w * a[3];
            *(float4*)(rowp + bj * 128 + n * 16) = hv;
          }
      }
  }
};
struct EpiResidAtomic {
  static constexpr bool PERM = false, AFTER_DRAIN = false;
  float* h; const float* mods; int rowoff, gidx; float scale; int mrow;
  DEVI void operator()(const pf4 (&acc)[2][2][4][2], const pg8::Unit& u, int wr, int wc, int fr, int fq) const {
    const int row0 = rowoff + u.pm * 256 + wr * 64 + fr, col0 = u.pn * 256 + wc * 32 + 4 * fq;
#pragma unroll
    for (int ai = 0; ai < 2; ++ai)
#pragma unroll
      for (int m = 0; m < 4; ++m) {
        const int r = row0 + ai * 128 + m * 16;
        float* rowp = h + (size_t)r * 1024 + col0;
        const float* gp = mods + (mrow >= 0 ? mrow : (r >> 13)) * 9216 + gidx * 1024 + col0;
#pragma unroll
        for (int bj = 0; bj < 2; ++bj)
#pragma unroll
          for (int n = 0; n < 2; ++n) {
            const float4 g = ld4(gp + bj * 128 + n * 16); const pf4 a = acc[ai][bj][m][n];
            float* q = rowp + bj * 128 + n * 16;
            atomicAdd(q, scale * g.x * a[0]); atomicAdd(q + 1, scale * g.y * a[1]); atomicAdd(q + 2, scale * g.z * a[2]); atomicAdd(q + 3, scale * g.w * a[3]);
          }
      }
  }
};
template <int MODE> struct EpiMix {
  static constexpr bool PERM = true, AFTER_DRAIN = false;
  bfraw* d0; bfraw* d1; bfraw* d2; bfraw* d3;
  DEVI void operator()(const pf4 (&acc)[2][2][4][2], const pg8::Unit& u, int wr, int wc, int fr, int fq) const {
    const int row0 = u.pm * 256 + wr * 64 + fr;
    const int pc = u.pn >> 2;
    bfraw* dst = MODE == 0 ? d0 : (MODE == 1 || MODE == 2) ? (pc == 0 ? d0 : pc == 1 ? d1 : pc == 2 ? d2 : d3) : (MODE == 3 ? d0 : d1);
    const int ld = MODE == 0 ? 3072 : 1024;
    const int col0 = (MODE == 1 || MODE == 2 ? (u.pn & 3) : u.pn) * 256 + wc * 32 + 8 * fq;
#pragma unroll
    for (int ai = 0; ai < 2; ++ai)
#pragma unroll
      for (int m = 0; m < 4; ++m) {
        const size_t ro = (size_t)(row0 + ai * 128 + m * 16) * ld + col0;
#pragma unroll
        for (int bj = 0; bj < 2; ++bj) {
          float v[8];
#pragma unroll
          for (int e = 0; e < 4; ++e) { v[e] = acc[ai][bj][m][0][e]; v[4 + e] = acc[ai][bj][m][1][e]; }
          bfraw* dp = dst + ro + bj * 128;
          if (MODE == 1) { if (pc == 3) {
#pragma unroll
            for (int e = 0; e < 8; ++e) v[e] = geluf_(v[e]); } }
          if (MODE == 2 && pc >= 2) {
#pragma unroll
            for (int e = 0; e < 8; ++e) v[e] = sigmoidf_(v[e]);
          } else if (MODE == 2 || MODE == 3 || MODE == 4) {
            const uint4 o = *(const uint4*)dp; const unsigned ow[4] = {o.x, o.y, o.z, o.w};
            float p[8];
#pragma unroll
            for (int e = 0; e < 4; ++e) { p[2 * e] = bf2f((bfraw)(ow[e] & 0xffff)); p[2 * e + 1] = bf2f((bfraw)(ow[e] >> 16)); }
            if (MODE == 2) {
#pragma unroll
              for (int e = 0; e < 8; ++e) v[e] = (pc == 0 ? sigmoidf_(v[e]) : geluf_(v[e])) * p[e];
            } else if (MODE == 3) {
#pragma unroll
              for (int e = 0; e < 8; ++e) v[e] *= p[e];
            } else {
              const uint4 t = *(const uint4*)(d0 + ro + bj * 128); const unsigned tw[4] = {t.x, t.y, t.z, t.w};
#pragma unroll
              for (int e = 0; e < 4; ++e) { v[2 * e] = bf2f((bfraw)(tw[e] & 0xffff)) + p[2 * e] * v[2 * e]; v[2 * e + 1] = bf2f((bfraw)(tw[e] >> 16)) + p[2 * e + 1] * v[2 * e + 1]; }
            }
          }
          uint4 w; w.x = pg8::cvt_pk_bf16(v[0], v[1]); w.y = pg8::cvt_pk_bf16(v[2], v[3]); w.z = pg8::cvt_pk_bf16(v[4], v[5]); w.w = pg8::cvt_pk_bf16(v[6], v[7]);
          *(uint4*)dp = w;
        }
      }
  }
};
template <class Epi>
DEVI void run8(unsigned char* lds, const bfraw* A, const bfraw* Bt, int M, int N, int K, const Epi& E, int G = -1, int c = -1, int ld = -1) {
  pg8::Gemm g{A, Bt, M, N, K, ld < 0 ? K : ld};
  pg8::StaticOrder S; S.init(M, N, G < 0 ? (int)gridDim.x : G, c < 0 ? (int)blockIdx.x : c);
  pg8::gemm_phase<Epi, pg8::StaticOrder, false>((PG8_LAS unsigned char*)lds, g, S, E, nullptr);
}

struct TrJob { const float* src; bfraw* dst; int ldw, K, kt, nt, drow0, mode; };
DEVI TrJob tr_decode(const P& p, int t) {
  TrJob j; int u = t;
  if (u < 1408) { j = TrJob{p.in[I_W1IN], (bfraw*)(p.ws + O_W1IN), 5632, 1024, u / 88, u % 88, 0, 1}; return j; }
  u -= 1408;
  if (u < 704) { j = TrJob{p.in[I_W1OUT], (bfraw*)(p.ws + O_W1OUT), 1024, 2816, u / 16, u % 16, 0, 0}; return j; }
  u -= 704;
  if (u < 2048) {
    const int pc = u >> 8; u &= 255;
    const int col0 = pc == 0 ? 0 : pc == 1 ? 1024 : pc == 2 ? 2048 : pc == 3 ? 5136 : pc == 4 ? 3088 : pc == 5 ? 4112 : pc == 6 ? 6160 : 7184;
    j = TrJob{p.in[I_WIN] + col0, (bfraw*)(p.ws + (pc < 4 ? O_WTA : O_WTB)), 8208, 1024, u >> 4, u & 15, (pc & 3) * 1024, 0}; return j;
  }
  u -= 2048;
  if (u < 768) { const int m = u >> 8; u &= 255; j = TrJob{p.in[m == 0 ? I_WA : m == 1 ? I_WB : I_WO], (bfraw*)(p.ws + (m == 0 ? O_WA : m == 1 ? O_WB : O_WO)), 1024, 1024, u >> 4, u & 15, 0, 0}; return j; }
  u -= 768;
  if (u < 1408) { j = TrJob{p.in[I_W2IN], (bfraw*)(p.ws + O_W2IN), 5632, 1024, u / 88, u % 88, 0, 1}; return j; }
  u -= 1408;
  j = TrJob{p.in[I_W2OUT], (bfraw*)(p.ws + O_W2OUT), 1024, 2816, u / 16, u % 16, 0, 0}; return j;
}

DEVI void phase_p0(const P& p, unsigned char* lds) {
  float* sf = (float*)lds;
  const int tid = ltid();
  for (int i = tid; i < 3072; i += NTHR) { float v = i < 2048 ? p.in[I_C][i] : p.in[I_CCTX][i - 2048]; sf[i] = v / (1.f + expf(-v)); }
  __syncthreads();
  {
    const float* w = p.in[I_WADA];
    float* mp = (float*)(p.ws + O_MODSP);
    for (int id = blockIdx.x * NTHR + tid; id < 16 * 9216; id += gridDim.x * NTHR) {
      int s = id / 9216, j = id - s * 9216;
      float a0 = 0, a1 = 0, a2 = 0;
#pragma unroll 16
      for (int k = s * 64; k < s * 64 + 64; ++k) { float wv = w[(size_t)k * 9216 + j]; a0 += sf[k] * wv; a1 += sf[1024 + k] * wv; a2 += sf[2048 + k] * wv; }
      mp[(s * 3 + 0) * 9216 + j] = a0; mp[(s * 3 + 1) * 9216 + j] = a1; mp[(s * 3 + 2) * 9216 + j] = a2;
    }
  }
  __syncthreads();
  {
    float rg[8];
    int t = blockIdx.x;
    TrJob jb = tr_decode(p, t < 7040 ? t : 0);
    if (t < 7040) {
#pragma unroll
      for (int i = 0; i < 8; ++i) { int e = tid + i * NTHR; int kk = e >> 6, nn = e & 63; rg[i] = jb.src[(size_t)(jb.kt * 64 + kk) * jb.ldw + jb.nt * 64 + nn]; }
    }
    for (; t < 7040; t += gridDim.x) {
#pragma unroll
      for (int i = 0; i < 8; ++i) { int e = tid + i * NTHR; int kk = e >> 6, nn = e & 63; sf[kk * 65 + nn] = rg[i]; }
      __syncthreads();
      const TrJob cj = jb;
      const int tn = t + gridDim.x;
      if (tn < 7040) {
        jb = tr_decode(p, tn);
#pragma unroll
        for (int i = 0; i < 8; ++i) { int e = tid + i * NTHR; int kk = e >> 6, nn = e & 63; rg[i] = jb.src[(size_t)(jb.kt * 64 + kk) * jb.ldw + jb.nt * 64 + nn]; }
      }
#pragma unroll
      for (int i = 0; i < 8; ++i) {
        int e = tid + i * NTHR; int nn = e >> 6, kk = e & 63;
        int n = cj.nt * 64 + nn, dr;
        if (cj.mode == 1) { int isb = n >= 2816; int f = n - isb * 2816; dr = (f >> 4) * 32 + isb * 16 + (f & 15); } else dr = cj.drow0 + n;
        cj.dst[(size_t)dr * cj.K + cj.kt * 64 + kk] = f2bf(sf[kk * 65 + nn]);
      }
      __syncthreads();
    }
  }
  { bfraw* d = (bfraw*)(p.ws + O_WSB); for (int id = blockIdx.x * NTHR + tid; id < 65536; id += gridDim.x * NTHR) d[id] = f2bf(p.in[I_WS][id]); }
}

DEVI void phase_p0b(const P& p) {
  const float* mp = (const float*)(p.ws + O_MODSP);
  float* m = (float*)(p.ws + O_MODS);
  for (int id = blockIdx.x * NTHR + ltid(); id < 3 * 9216; id += gridDim.x * NTHR) {
    int j = id % 9216;
    float a = p.in[I_BADA][j];
    for (int s = 0; s < 16; ++s) a += mp[s * 3 * 9216 + id];
    m[id] = a;
  }
}

template <int MODE>
DEVI void phase_rows(const P& p, unsigned char* lds, int row_lo = 0, int row_hi = -1, int vb = -1, int nvb = -1) {
  const int tid = ltid(), lane = tid & 63, wid = tid >> 6;
  const float* mods = (const float*)(p.ws + O_MODS);
  float* hctx = (float*)(p.ws + O_HCTX);
  bfraw* hn = (bfraw*)(p.ws + O_HN);
  float* wg = (float*)lds;
  if (MODE == 2) {
    __syncthreads();
    for (int i = tid; i < 16384; i += NTHR) { int k = i >> 4, g = i & 15; wg[g * 1024 + k] = p.in[I_WIN][(size_t)k * 8208 + 3072 + g]; }
    __syncthreads();
  }
  const int nrows = row_hi >= 0 ? row_hi : ((MODE == 1 || MODE == 2) ? 16896 : 16384);
  if (vb < 0) { vb = (int)blockIdx.x; nvb = (int)gridDim.x; }
  const float* gvec = p.in[MODE == 1 ? I_GFFN1 : MODE == 2 ? I_GMIX : MODE == 3 ? I_GFFN2 : I_GFINAL];
  const int msh = MODE == 1 ? 0 : MODE == 2 ? 3 : 6;
  for (int row = row_lo + vb * 8 + wid; row < nrows; row += nvb * 8) {
    const bool lat = row < 16384;
    const int mrow = lat ? (row >> 13) : 2;
    float4 v[4];
    if (MODE == 1) {
      const float* src = lat ? p.in[I_X] + (size_t)row * 1024 : p.in[I_CTX] + (size_t)(row - 16384) * 1024;
#pragma unroll
      for (int i = 0; i < 4; ++i) v[i] = *(const float4*)(src + i * 256 + lane * 4);
      if (lat) {
        int ts = row & 8191; float rr = (float)(ts >> 6), cc = (float)(ts & 63);
        float fqv[4];
#pragma unroll
        for (int e = 0; e < 4; ++e) fqv[e] = expf((-9.210340371976184f * (float)(lane * 4 + e)) / 256.f);
        v[0].x += redsin(rr * fqv[0], false); v[0].y += redsin(rr * fqv[1], false); v[0].z += redsin(rr * fqv[2], false); v[0].w += redsin(rr * fqv[3], false);
        v[1].x += redsin(rr * fqv[0], true);  v[1].y += redsin(rr * fqv[1], true);  v[1].z += redsin(rr * fqv[2], true);  v[1].w += redsin(rr * fqv[3], true);
        v[2].x += redsin(cc * fqv[0], false); v[2].y += redsin(cc * fqv[1], false); v[2].z += redsin(cc * fqv[2], false); v[2].w += redsin(cc * fqv[3], false);
        v[3].x += redsin(cc * fqv[0], true);  v[3].y += redsin(cc * fqv[1], true);  v[3].z += redsin(cc * fqv[2], true);  v[3].w += redsin(cc * fqv[3], true);
      }
      float* dsth = lat ? p.out + (size_t)row * 1024 : hctx + (size_t)(row - 16384) * 1024;
#pragma unroll
      for (int i = 0; i < 4; ++i) *(float4*)(dsth + i * 256 + lane * 4) = v[i];
    } else {
      const float* src = lat ? p.out + (size_t)row * 1024 : hctx + (size_t)(row - 16384) * 1024;
#pragma unroll
      for (int i = 0; i < 4; ++i) v[i] = *(const float4*)(src + i * 256 + lane * 4);
    }
    float ss = 0;
#pragma unroll
    for (int i = 0; i < 4; ++i) ss += v[i].x * v[i].x + v[i].y * v[i].y + v[i].z * v[i].z + v[i].w * v[i].w;
    ss = wave_sum(ss);
    const float rs = rsqrtf(ss * (1.f / 1024.f) + EPS);
    if (MODE == 4) {
#pragma unroll
      for (int i = 0; i < 4; ++i) {
        float4 g = *(const float4*)(gvec + i * 256 + lane * 4);
        float4 o = {v[i].x * rs * g.x, v[i].y * rs * g.y, v[i].z * rs * g.z, v[i].w * rs * g.w};
        *(float4*)(p.out + (size_t)row * 1024 + i * 256 + lane * 4) = o;
      }
    } else {
      const float* sh = mods + (size_t)(mrow * 9216 + msh * 1024);
      const float* scp = sh + 1024;
      float y[16];
#pragma unroll
      for (int i = 0; i < 4; ++i) {
        const int c = i * 256 + lane * 4;
        float4 g = *(const float4*)(gvec + c), s4 = *(const float4*)(sh + c), c4 = *(const float4*)(scp + c);
        y[i * 4 + 0] = v[i].x * rs * g.x * (1.f + c4.x) + s4.x; y[i * 4 + 1] = v[i].y * rs * g.y * (1.f + c4.y) + s4.y;
        y[i * 4 + 2] = v[i].z * rs * g.z * (1.f + c4.z) + s4.z; y[i * 4 + 3] = v[i].w * rs * g.w * (1.f + c4.w) + s4.w;
        uint2 pk; pk.x = (unsigned)f2bf(y[i * 4]) | ((unsigned)f2bf(y[i * 4 + 1]) << 16); pk.y = (unsigned)f2bf(y[i * 4 + 2]) | ((unsigned)f2bf(y[i * 4 + 3]) << 16);
        *(uint2*)(hn + (size_t)row * 1024 + c) = pk;
      }
      if (MODE == 2) {
        float ga[16];
#pragma unroll
        for (int g2 = 0; g2 < 16; ++g2) {
          float a = 0.f;
#pragma unroll
          for (int i = 0; i < 4; ++i) { float4 w4 = *(const float4*)(wg + g2 * 1024 + i * 256 + lane * 4); a += y[i * 4] * w4.x + y[i * 4 + 1] * w4.y + y[i * 4 + 2] * w4.z + y[i * 4 + 3] * w4.w; }
          ga[g2] = a;
          if ((g2 & 3) == 3) asm volatile("" ::: "memory");
        }
        const bool b5 = lane & 32, b4 = lane & 16, b3 = lane & 8, b2 = lane & 4;
        float r8[8], r4[4], r2[2];
#pragma unroll
        for (int g = 0; g < 8; ++g) { const float snd = b5 ? ga[g] : ga[g + 8], kp = b5 ? ga[g + 8] : ga[g]; r8[g] = kp + __shfl_xor(snd, 32, 64); }
#pragma unroll
        for (int g = 0; g < 4; ++g) { const float snd = b4 ? r8[g] : r8[g + 4], kp = b4 ? r8[g + 4] : r8[g]; r4[g] = kp + __shfl_xor(snd, 16, 64); }
#pragma unroll
        for (int g = 0; g < 2; ++g) { const float snd = b3 ? r4[g] : r4[g + 2], kp = b3 ? r4[g + 2] : r4[g]; r2[g] = kp + __shfl_xor(snd, 8, 64); }
        float r1 = (b2 ? r2[1] : r2[0]) + __shfl_xor(b2 ? r2[0] : r2[1], 4, 64);
        r1 += __shfl_xor(r1, 2, 64); r1 += __shfl_xor(r1, 1, 64);
        const int gi = (b5 ? 8 : 0) + (b4 ? 4 : 0) + (b3 ? 2 : 0) + (b2 ? 1 : 0);
        if ((lane & 3) == 0) ((float*)(p.ws + O_GATES))[(size_t)row * 16 + gi] = r1;
      }
    }
  }
}

DEVI void phase_ffn_in(const P& p, unsigned char* lds, size_t o_w, int nrows) {
  EpiFfnIn E{(bfraw*)(p.ws + O_ACT)};
  run8(lds, (const bfraw*)(p.ws + O_HN), (const bfraw*)(p.ws + o_w), nrows, 5632, 1024, E);
}

DEVI void phase_ffn_out(const P& p, unsigned char* lds, size_t o_w, int gidx, bool with_ctx) {
  EpiResid E{p.out, (const float*)(p.ws + O_MODS), 0, gidx, 0.5f, -1};
  run8(lds, (const bfraw*)(p.ws + O_ACT), (const bfraw*)(p.ws + o_w), 16384, 1024, 2816, E);
  (void)with_ctx;
}

DEVI void phase_r2_g2c(const P& p, unsigned char* lds) {
  const int G = (int)gridDim.x, nc = G >= 48 ? 24 : 0;
  if (nc == 0) {
    EpiResid E{(float*)(p.ws + O_HCTX), (const float*)(p.ws + O_MODS), 0, 2, 0.5f, 2};
    run8(lds, (const bfraw*)(p.ws + O_ACT) + (size_t)16384 * 2816, (const bfraw*)(p.ws + O_W1OUT), 512, 1024, 2816, E);
    __syncthreads();
  } else if ((int)blockIdx.x < nc) {
    const int sl = (int)blockIdx.x >> 3, k0 = sl * 1024, kl = sl == 2 ? 768 : 1024;
    EpiResidAtomic E{(float*)(p.ws + O_HCTX), (const float*)(p.ws + O_MODS), 0, 2, 0.5f, 2};
    run8(lds, (const bfraw*)(p.ws + O_ACT) + (size_t)16384 * 2816 + k0, (const bfraw*)(p.ws + O_W1OUT) + k0, 512, 1024, kl, E, 8, (int)blockIdx.x & 7, 2816);
    return;
  }
  phase_rows<2>(p, lds, 0, 16384, (int)blockIdx.x - nc, G - nc);
}

DEVI void phase_g3c(const P& p, unsigned char* lds) {
  EpiMix<0> E{(bfraw*)(p.ws + O_CTXRAW), nullptr, nullptr, nullptr};
  run8(lds, (const bfraw*)(p.ws + O_HN) + (size_t)16384 * 1024, (const bfraw*)(p.ws + O_WTA), 512, 3072, 1024, E);
}

DEVI void phase_g3a(const P& p, unsigned char* lds, int hb) {
  EpiMix<1> E{(bfraw*)(p.ws + O_QRAW), (bfraw*)(p.ws + O_KRAW), (bfraw*)(p.ws + O_V), (bfraw*)(p.ws + O_GVS)};
  run8(lds, (const bfraw*)(p.ws + O_HN) + (size_t)hb * 8192 * 1024, (const bfraw*)(p.ws + O_WTA), 8192, 4096, 1024, E);
}

DEVI void phase_g3b(const P& p, unsigned char* lds, int hb) {
  EpiMix<2> E{(bfraw*)(p.ws + O_V), (bfraw*)(p.ws + O_GVS), (bfraw*)(p.ws + O_QC), (bfraw*)(p.ws + O_KC)};
  run8(lds, (const bfraw*)(p.ws + O_HN) + (size_t)hb * 8192 * 1024, (const bfraw*)(p.ws + O_WTB), 8192, 4096, 1024, E);
}

DEVI void phase_g4(const P& p, unsigned char* lds) {
  const int Gh = (int)gridDim.x >> 1, grp = (int)blockIdx.x / Gh, c = (int)blockIdx.x % Gh;
  if (grp == 0) { EpiMix<3> E{(bfraw*)(p.ws + O_QC), nullptr, nullptr, nullptr}; run8(lds, (const bfraw*)(p.ws + O_V), (const bfraw*)(p.ws + O_WA), 8192, 1024, 1024, E, Gh, c); }
  else if (grp == 1) { EpiMix<3> E{(bfraw*)(p.ws + O_KC), nullptr, nullptr, nullptr}; run8(lds, (const bfraw*)(p.ws + O_GVS), (const bfraw*)(p.ws + O_WB), 8192, 1024, 1024, E, Gh, c); }
}

DEVI void phase_addmix(const P& p, int hb) {
  const uint4* t1 = (const uint4*)(p.ws + O_QC);
  const uint4* t2 = (const uint4*)(p.ws + O_KC);
  uint4* dst = (uint4*)(p.ws + (hb == 0 ? O_W1IN : O_QC));
  const int tid = ltid();
  for (int i = blockIdx.x * NTHR + tid; i < 8192 * 128; i += gridDim.x * NTHR) {
    const uint4 a = t1[i], b = t2[i];
    const unsigned aw[4] = {a.x, a.y, a.z, a.w}, bw[4] = {b.x, b.y, b.z, b.w}; unsigned o[4];
#pragma unroll
    for (int e = 0; e < 4; ++e) o[e] = (unsigned)f2bf(bf2f((bfraw)(aw[e] & 0xffff)) + bf2f((bfraw)(bw[e] & 0xffff))) | ((unsigned)f2bf(bf2f((bfraw)(aw[e] >> 16)) + bf2f((bfraw)(bw[e] >> 16))) << 16);
    dst[i] = uint4{o[0], o[1], o[2], o[3]};
  }
}

DEVI void phase_g5(const P& p, unsigned char* lds) {
  const int Gh = (int)gridDim.x >> 1, grp = (int)blockIdx.x / Gh, c = (int)blockIdx.x % Gh;
  EpiResid E{p.out, (const float*)(p.ws + O_MODS), grp * 8192, 5, 1.f, -1};
  if (grp < 2) run8(lds, (const bfraw*)(p.ws + (grp == 0 ? O_W1IN : O_QC)), (const bfraw*)(p.ws + O_WO), 8192, 1024, 1024, E, Gh, c);
}

DEVI void phase_cv(const P& p, int hb) {
  const int tid = ltid(), lane = tid & 63, wid = tid >> 6;
  const bfraw* qraw = (const bfraw*)(p.ws + O_QRAW);
  const bfraw* kraw = (const bfraw*)(p.ws + O_KRAW);
  const bfraw* craw = (const bfraw*)(p.ws + O_CTXRAW) + (size_t)hb * 256 * 3072;
  bfraw* qc = (bfraw*)(p.ws + O_QC);
  bfraw* kc = (bfraw*)(p.ws + O_KC);
  bfraw* vv = (bfraw*)(p.ws + O_V);
  const bfraw* gvs = (const bfraw*)(p.ws + O_GVS);
  float* rsb = (float*)(p.ws + O_RS);
  const float* cw = p.in[I_CONVW];
  const float* cb = p.in[I_CONVB];
  for (int task = blockIdx.x * 8 + wid; task < 1056 * 4; task += gridDim.x * 8) {
    const int sidx = task >> 2, part = task & 3, isk = part >> 1;
    const bool lat = sidx < 1024;
    const int lr0 = (lat ? sidx : sidx - 1024) * 8, len = lat ? 8192 : 256, orow0 = sidx * 8;
    const bfraw* src = lat ? (isk ? kraw : qraw) : (craw + isk * 1024);
    const size_t ld = lat ? 1024 : 3072;
    const int ch = (part & 1) * 512 + lane * 8, wch = isk * 1024 + ch;
    float w0[8], w1[8], w2[8], bb[8];
#pragma unroll
    for (int e = 0; e < 8; e += 4) {
      float4 a = ld4(cw + wch + e), b = ld4(cw + 2048 + wch + e), c4 = ld4(cw + 4096 + wch + e), d = ld4(cb + wch + e);
      w0[e] = a.x; w0[e + 1] = a.y; w0[e + 2] = a.z; w0[e + 3] = a.w; w1[e] = b.x; w1[e + 1] = b.y; w1[e + 2] = b.z; w1[e + 3] = b.w;
      w2[e] = c4.x; w2[e + 1] = c4.y; w2[e + 2] = c4.z; w2[e + 3] = c4.w; bb[e] = d.x; bb[e + 1] = d.y; bb[e + 2] = d.z; bb[e + 3] = d.w;
    }
    uint4 rw[10];
#pragma unroll
    for (int i = 0; i < 10; ++i) { const int lr = lr0 - 1 + i; uint4 t = {0u, 0u, 0u, 0u}; if (lr >= 0 && lr < len) t = *(const uint4*)(src + (size_t)lr * ld + ch); rw[i] = t; }
    const float osc = isk ? 1.f : 0.0625f;
    bfraw* dst = (isk ? kc : qc) + (size_t)orow0 * 1024 + ch;
#pragma unroll
    for (int i = 0; i < 8; ++i) {
      const unsigned av[4] = {rw[i].x, rw[i].y, rw[i].z, rw[i].w}, bv[4] = {rw[i + 1].x, rw[i + 1].y, rw[i + 1].z, rw[i + 1].w}, cv[4] = {rw[i + 2].x, rw[i + 2].y, rw[i + 2].z, rw[i + 2].w};
      unsigned ov[4];
#pragma unroll
      for (int e = 0; e < 4; ++e) {
        const float y0 = bf2f((bfraw)(av[e] & 0xffff)) * w0[2 * e] + bf2f((bfraw)(bv[e] & 0xffff)) * w1[2 * e] + bf2f((bfraw)(cv[e] & 0xffff)) * w2[2 * e] + bb[2 * e];
        const float y1 = bf2f((bfraw)(av[e] >> 16)) * w0[2 * e + 1] + bf2f((bfraw)(bv[e] >> 16)) * w1[2 * e + 1] + bf2f((bfraw)(cv[e] >> 16)) * w2[2 * e + 1] + bb[2 * e + 1];
        ov[e] = (unsigned)f2bf(siluf_(y0) * osc) | ((unsigned)f2bf(siluf_(y1) * osc) << 16);
      }
      *(uint4*)(dst + (size_t)i * 1024) = uint4{ov[0], ov[1], ov[2], ov[3]};
    }
  }
  for (int row = blockIdx.x * 8 + wid; row < 8448; row += gridDim.x * 8) {
    if (row < 8192) {
      float ss = 0;
#pragma unroll
      for (int hlf = 0; hlf < 2; ++hlf) {
        uint4 g = *(const uint4*)(gvs + (size_t)row * 1024 + hlf * 512 + lane * 8);
        unsigned gv[4] = {g.x, g.y, g.z, g.w};
#pragma unroll
        for (int e = 0; e < 4; ++e) { float a = bf2f((bfraw)(gv[e] & 0xffff)), b = bf2f((bfraw)(gv[e] >> 16)); ss += a * a + b * b; }
      }
      ss = wave_sum(ss);
      if (lane == 0) rsb[row] = rsqrtf(ss * (1.f / 1024.f) + EPS);
    } else {
#pragma unroll
      for (int hlf = 0; hlf < 2; ++hlf)
        *(uint4*)(vv + (size_t)row * 1024 + hlf * 512 + lane * 8) = *(const uint4*)(craw + 2048 + (size_t)(row - 8192) * 3072 + hlf * 512 + lane * 8);
    }
  }
}

DEVI void phase_ma(const P& p, unsigned char* lds, int hb) {
  const int tid = ltid();
  bfraw* st = (bfraw*)lds;
  float* sc = (float*)(lds + 131072);
  float* s_w = sc + 128, *s_ws = sc + 256, *s_red = sc + 384, *s_part = sc + 512;
  const float* bg = p.in[I_BGATES];
  for (int item = blockIdx.x; item < 528 + 256; item += gridDim.x) {
    unsigned char* wsb = lws(p.ws);
    const float* gates = (const float*)(wsb + O_GATES);
    const bfraw* kc = (const bfraw*)(wsb + O_KC);
    const bfraw* vv = (const bfraw*)(wsb + O_V);
    bfraw* states = (bfraw*)(wsb + O_ST);
    float* nloc = (float*)(wsb + O_NLOC);
    float* mg = (float*)(wsb + O_MG);
    if (item < 528) {
      const int seq = item / 66, j = item % 66, d = seq >> 2, h = seq & 3;
      int rbase, grow;
      if (j < 2) { int cc = d == 0 ? j : 1 - j; rbase = 8192 + cc * 128; grow = 16384 + hb * 256 + cc * 128; }
      else { int c = d == 0 ? j - 2 : 65 - j; rbase = c * 128; grow = hb * 8192 + c * 128; }
      __syncthreads();
      const int el = d == 0 ? (tid & 127) : 127 - (tid & 127);
      float li = 0.f, lf = 0.f;
      if (tid < 128) {
        li = gates[(size_t)(grow + el) * 16 + d * 8 + h] + bg[d * 8 + h];
        lf = logsigf_(gates[(size_t)(grow + el) * 16 + d * 8 + 4 + h] + bg[d * 8 + 4 + h]);
      }
      const float bcum = seg_scan_sum(lf, tid, s_red + 4);
      if (tid == 127) s_red[1] = bcum;
      __syncthreads();
      const float gtot = s_red[1];
      const float wv = gtot - bcum + li;
      if (tid < 128) s_w[el] = wv;
      __syncthreads();
      if (tid < 64) {
        float m = fmaxf(s_w[tid], s_w[tid + 64]);
#pragma unroll
        for (int o = 32; o > 0; o >>= 1) m = fmaxf(m, __shfl_xor(m, o, 64));
        if (tid == 0) s_red[0] = m;
      }
      __syncthreads();
      const float mloc = s_red[0];
      if (tid < 128) s_ws[el] = expf(wv - mloc);
      if (tid == 0) { mg[seq * 66 + j] = mloc; mg[528 + seq * 66 + j] = gtot; }
      __syncthreads();
      {
        const int k = tid & 255, part = tid >> 8;
        const bfraw* kp0 = kc + (size_t)(rbase + part * 64) * 1024 + h * 256 + k;
        float n = 0;
#pragma unroll 16
        for (int t = 0; t < 64; ++t) n += s_ws[part * 64 + t] * bf2f(kp0[(size_t)t * 1024]);
        s_part[tid] = n;
      }
      bfraw* dst = states + (size_t)(seq * 66 + j) * 65536;
      {
        f32x4 acc[8][4]; ZERO_ACC(acc, 8, 4);
        gemm_tile<256, 256, true, true, false>(vv + (size_t)rbase * 1024 + h * 256, 1024, kc + (size_t)rbase * 1024 + h * 256, 1024, 128, s_ws, acc, st, nullptr, 0);
        EPI_BEGIN(256, 256)
          dst[row * 256 + col] = f2bf(acc[i][j][r]);
        EPI_END
      }
      if (tid < 256) nloc[(size_t)(seq * 66 + j) * 256 + tid] = s_part[tid] + s_part[tid + 256];
    } else {
      const int it = item - 528, c = it >> 2, g = it & 3;
      bfraw* gvs = (bfraw*)(wsb + O_GVS);
      const float* rsb = (const float*)(wsb + O_RS);
      f32x4 acc[4][4]; ZERO_ACC(acc, 4, 4);
      gemm_tile<128, 256, false, true, false>((const bfraw*)(wsb + O_WSB) + g * 16384, 128, gvs + (size_t)c * 128 * 1024 + g * 256, 1024, 128, rsb + c * 128, acc, st, nullptr, 0);
      const float* gs = p.in[I_GSGU] + g * 256;
      const float* bs = p.in[I_BS] + g * 128;
      EPI_BEGIN(128, 256)
        gvs[(size_t)(c * 128 + row) * 1024 + g * 256 + col] = f2bf(gs[col] * acc[i][j][r] + bs[row]);
      EPI_END
    }
  }
}

DEVI void phase_mb(const P& p, unsigned char* lds) {
  bfraw* states = (bfraw*)(p.ws + O_ST);
  const float* mg = (const float*)(p.ws + O_MG);
  float* ment = (float*)(p.ws + O_MG) + 1056;
  const float* nloc = (const float*)(p.ws + O_NLOC);
  float* nent = (float*)(p.ws + O_NENT);
  const int gid = blockIdx.x * NTHR + ltid(), gsz = gridDim.x * NTHR;
  float* s_dec = (float*)lds, *s_scl = s_dec + 528;
  __syncthreads();
  if (ltid() < 8) {
    const int seq = ltid(); float m = 0;
    for (int j = 0; j < 66; ++j) {
      const float mloc = mg[seq * 66 + j], g = mg[528 + seq * 66 + j];
      const float mnew = fmaxf(g + m, mloc);
      s_dec[seq * 66 + j] = expf(g + m - mnew); s_scl[seq * 66 + j] = expf(mloc - mnew);
      if (blockIdx.x == 0) ment[seq * 66 + j] = m;
      m = mnew;
    }
  }
  __syncthreads();
  for (int id = gid; id < 8 * 16384; id += gsz) {
    const int seq = id >> 14, e = (id & 16383) * 4;
    float s0 = 0, s1 = 0, s2 = 0, s3 = 0;
    bfraw* base = states + (size_t)seq * 66 * 65536 + e;
#pragma unroll 1
    for (int cb = 0; cb < 66; cb += 22) {
      uint2 buf[22];
#pragma unroll
      for (int i = 0; i < 22; ++i) buf[i] = *(const uint2*)(base + (size_t)(cb + i) * 65536);
#pragma unroll
      for (int i = 0; i < 22; ++i) {
        const int j = cb + i; const uint2 cur = buf[i];
        const float dec = s_dec[seq * 66 + j], scl = s_scl[seq * 66 + j];
        if (j >= 2) { uint2 o; o.x = (unsigned)f2bf(s0) | ((unsigned)f2bf(s1) << 16); o.y = (unsigned)f2bf(s2) | ((unsigned)f2bf(s3) << 16);
          *(uint2*)(base + (size_t)j * 65536) = o; }
        s0 = dec * s0 + scl * bf2f((bfraw)(cur.x & 0xffff)); s1 = dec * s1 + scl * bf2f((bfraw)(cur.x >> 16));
        s2 = dec * s2 + scl * bf2f((bfraw)(cur.y & 0xffff)); s3 = dec * s3 + scl * bf2f((bfraw)(cur.y >> 16));
      }
    }
  }
  for (int id = gid; id < 8 * 256; id += gsz) {
    const int seq = id >> 8, k = id & 255;
    float n = 0;
    for (int j = 0; j < 66; ++j) {
      nent[(size_t)(seq * 66 + j) * 256 + k] = n;
      n = s_dec[seq * 66 + j] * n + s_scl[seq * 66 + j] * nloc[(size_t)(seq * 66 + j) * 256 + k];
    }
  }
}

DEVI void phase_mc(const P& p, unsigned char* lds, int hb) {
  const int tid = ltid(), lane = tid & 63, wid = tid >> 6, wm = wid >> 2, wn = wid & 3, fr = lane & 15, fq = lane >> 4;
  bfraw* st = (bfraw*)lds;
  bfraw* sS = (bfraw*)(lds + 61440);
  float* sc = (float*)(lds + 131072);
  float* s_b = sc, *s_u = sc + 256, *s_mt = sc + 512, *s_in = sc + 768, *s_den = sc + 1024, *s_dq = sc + 1280, *s_tmp = sc + 1536;
  float* s_sum = sc + 1792, *s_sq = sc + 1920;
  const float* bg = p.in[I_BGATES];
  for (int item = blockIdx.x; item < 256; item += gridDim.x) {
    unsigned char* wsb = lws(p.ws);
    const float* gates = (const float*)(wsb + O_GATES);
    const bfraw* qc = (const bfraw*)(wsb + O_QC);
    const bfraw* kc = (const bfraw*)(wsb + O_KC);
    bfraw* vv = (bfraw*)(wsb + O_V);
    const bfraw* states = (const bfraw*)(wsb + O_ST);
    const float* ment = (const float*)(wsb + O_MG) + 1056;
    const float* nent = (const float*)(wsb + O_NENT);
    const int c = item >> 2, h = item & 3, R0 = c * 128;
    const bfraw* qp = qc + (size_t)R0 * 1024 + h * 256;
    const bfraw* kp = kc + (size_t)R0 * 1024 + h * 256;
    __syncthreads();
    {
      const int d = (tid >> 7) & 1, t = tid & 127, el = d == 0 ? t : 127 - t, ix = d * 128 + el;
      float li = 0.f, lf = 0.f;
      if (tid < 256) {
        const size_t grow = (size_t)hb * 8192 + R0 + el;
        li = gates[grow * 16 + d * 8 + h] + bg[d * 8 + h];
        lf = logsigf_(gates[grow * 16 + d * 8 + 4 + h] + bg[d * 8 + 4 + h]);
        s_den[tid] = 0.f;
        if (tid < 128) { s_sum[tid] = 0.f; s_sq[tid] = 0.f; }
      }
      const float b = seg_scan_sum(lf, tid, s_tmp);
      const float uu = li - b;
      const float pm = seg_scan_max(tid < 256 ? uu : -INFINITY, tid, s_tmp);
      if (tid < 256) {
        const int seq = d * 4 + h, j = d == 0 ? c + 2 : 65 - c;
        const float mst = ment[seq * 66 + j];
        const float a = b + mst;
        const float mt = fmaxf(a, b + pm);
        s_b[ix] = b; s_u[ix] = uu; s_mt[ix] = mt; s_in[ix] = expf(a - mt);
      }
    }
    {
      const int row = tid >> 2, part = tid & 3;
      const uint4* q4 = (const uint4*)(qp + (size_t)row * 1024 + part * 64);
      const float4* nf4 = (const float4*)(nent + (size_t)((0 + h) * 66 + (c + 2)) * 256 + part * 64);
      const float4* nb4 = (const float4*)(nent + (size_t)((4 + h) * 66 + (65 - c)) * 256 + part * 64);
      uint4 qv[8];
#pragma unroll
      for (int i = 0; i < 8; ++i) qv[i] = q4[i];
      float af = 0, ab = 0;
#pragma unroll
      for (int i = 0; i < 8; ++i) {
        const float4 f0 = nf4[2 * i], f1 = nf4[2 * i + 1], b0 = nb4[2 * i], b1 = nb4[2 * i + 1];
        const float q0 = bf2f((bfraw)(qv[i].x & 0xffff)), q1 = bf2f((bfraw)(qv[i].x >> 16)), q2 = bf2f((bfraw)(qv[i].y & 0xffff)), q3 = bf2f((bfraw)(qv[i].y >> 16));
        const float q4_ = bf2f((bfraw)(qv[i].z & 0xffff)), q5 = bf2f((bfraw)(qv[i].z >> 16)), q6 = bf2f((bfraw)(qv[i].w & 0xffff)), q7 = bf2f((bfraw)(qv[i].w >> 16));
        af += q0 * f0.x + q1 * f0.y + q2 * f0.z + q3 * f0.w + q4_ * f1.x + q5 * f1.y + q6 * f1.z + q7 * f1.w;
        ab += q0 * b0.x + q1 * b0.y + q2 * b0.z + q3 * b0.w + q4_ * b1.x + q5 * b1.y + q6 * b1.z + q7 * b1.w;
      }
      af += __shfl_xor(af, 1, 64); af += __shfl_xor(af, 2, 64);
      ab += __shfl_xor(ab, 1, 64); ab += __shfl_xor(ab, 2, 64);
      if (part == 0) { s_dq[row] = af; s_dq[128 + row] = ab; }
    }
    __syncthreads();
    {
      f32x4 S[4][2]; ZERO_ACC(S, 4, 2);
      gemm_tile<128, 128, false, false, false>(qp, 1024, kp, 1024, 256, nullptr, S, st, nullptr, 0);
#pragma unroll 1
      for (int d = 0; d < 2; ++d)
#pragma unroll
        for (int i = 0; i < 4; ++i)
#pragma unroll
          for (int r = 0; r < 4; ++r) {
            const int row = wm * 64 + i * 16 + fq * 4 + r;
            const float bt = s_b[d * 128 + row] - s_mt[d * 128 + row];
            float rs = 0;
#pragma unroll
            for (int j = 0; j < 2; ++j) {
              const int col = wn * 32 + j * 16 + fr;
              const bool valid = d == 0 ? (col <= row) : (col >= row);
              const float val = valid ? S[i][j][r] * fexp(bt + s_u[d * 128 + col]) : 0.f;
              rs += val;
              sS[(d * 128 + row) * 136 + col] = f2bf(val);
            }
            rs = red16(rs);
            if (fr == 0) atomicAdd(&s_den[d * 128 + row], rs);
          }
    }
    __syncthreads();
    f32x4 hs[4][4];
    bfraw* hpark = (bfraw*)(wsb + O_HPARK) + (size_t)R0 * 1024 + h * 256;
#pragma unroll 1
    for (int d = 0; d < 2; ++d) {
      f32x4 (&acc)[4][4] = hs; ZERO_ACC(acc, 4, 4);
      const int seq = d * 4 + h, j2 = d == 0 ? c + 2 : 65 - c;
      gemm_tile<128, 256, false, false, false>(qp, 1024, states + (size_t)(seq * 66 + j2) * 65536, 256, 256, nullptr, acc, st, nullptr, 0);
      EPIR_BEGIN(128, 256)
        const float sin_ = s_in[d * 128 + row];
        EPIR_COLS(256) acc[i][j][r] *= sin_; (void)col;
      EPIR_END
      gemm_tile<128, 256, false, true, true>(nullptr, 0, vv + (size_t)R0 * 1024 + h * 256, 1024, 128, nullptr, acc, st, sS + d * 128 * 136, 136);
      EPIR_BEGIN(128, 256)
        const float den = s_den[d * 128 + row] + s_in[d * 128 + row] * s_dq[d * 128 + row];
        const float inv = 1.f / fmaxf(fabsf(den), expf(-s_mt[d * 128 + row]));
        EPIR_COLS(256)
          const float hv = acc[i][j][r] * inv;
          if (d == 0) hpark[(size_t)row * 1024 + col] = f2bf(hv);
          else hs[i][j][r] = hv + bf2f(hpark[(size_t)row * 1024 + col]);
      EPIR_END
    }
#pragma unroll
    for (int i = 0; i < 4; ++i)
#pragma unroll
      for (int r = 0; r < 4; ++r) {
        float ps = hs[i][0][r] + hs[i][1][r] + hs[i][2][r] + hs[i][3][r];
        ps = red16(ps);
        if (fr == 0) atomicAdd(&s_sum[wm * 64 + i * 16 + fq * 4 + r], ps);
      }
    __syncthreads();
#pragma unroll
    for (int i = 0; i < 4; ++i)
#pragma unroll
      for (int r = 0; r < 4; ++r) {
        const float mu = s_sum[wm * 64 + i * 16 + fq * 4 + r] * (1.f / 256.f);
        float ps = 0;
#pragma unroll
        for (int j = 0; j < 4; ++j) { float dlt = hs[i][j][r] - mu; ps += dlt * dlt; }
        ps = red16(ps);
        if (fr == 0) atomicAdd(&s_sq[wm * 64 + i * 16 + fq * 4 + r], ps);
      }
    __syncthreads();
    const float* gh = p.in[I_GHEAD] + h * 256;
    EPIR_BEGIN(128, 256)
      const float mu = s_sum[row] * (1.f / 256.f);
      const float rstd = rsqrtf(s_sq[row] * (1.f / 256.f) + EPS);
      EPIR_COLS(256)
        vv[(size_t)(R0 + row) * 1024 + h * 256 + col] = f2bf((hs[i][j][r] - mu) * rstd * gh[col]);
    EPIR_END
  }
}

constexpr int NPH = 28;
#define PHASE_PROGRAM \
  PHASE(0, phase_p0(p, lds)) \
  PHASE(1, phase_p0b(p)) \
  PHASE(2, phase_rows<1>(p, lds)) \
  PHASE(3, phase_ffn_in(p, lds, O_W1IN, 16896)) \
  PHASE(4, phase_ffn_out(p, lds, O_W1OUT, 2, true)) \
  PHASE(5, phase_r2_g2c(p, lds)) \
  PHASE(6, phase_rows<2>(p, lds, 16384, 16896)) \
  PHASE(7, phase_g3c(p, lds)) \
  PHASE(8, phase_g3a(p, lds, 0)) \
  PHASE(9, phase_cv(p, 0)) \
  PHASE(10, phase_ma(p, lds, 0)) \
  PHASE(11, phase_mb(p, lds)) \
  PHASE(12, phase_mc(p, lds, 0)) \
  PHASE(13, phase_g3b(p, lds, 0)) \
  PHASE(14, phase_g4(p, lds)) \
  PHASE(15, phase_addmix(p, 0); __syncthreads(); phase_g3a(p, lds, 1)) \
  PHASE(16, phase_cv(p, 1)) \
  PHASE(17, phase_ma(p, lds, 1)) \
  PHASE(18, phase_mb(p, lds)) \
  PHASE(19, phase_mc(p, lds, 1)) \
  PHASE(20, phase_g3b(p, lds, 1)) \
  PHASE(21, phase_g4(p, lds)) \
  PHASE(22, phase_addmix(p, 1)) \
  PHASE(23, phase_g5(p, lds)) \
  PHASE(24, phase_rows<3>(p, lds)) \
  PHASE(25, phase_ffn_in(p, lds, O_W2IN, 16384)) \
  PHASE(26, phase_ffn_out(p, lds, O_W2OUT, 8, false)) \
  PHASE(27, phase_rows<4>(p, lds))

#if !MULTI_LAUNCH
#ifndef USE_CG
#define USE_CG 0
#endif
#if USE_CG
#define PHASE(n, call) if (lo <= (n) && (n) < hi) { if ((n) > lo) { if ((n) == 1) grid.sync(); else xcd_barrier(xbar); } call; }
#else
#define PHASE(n, call) if (lo <= (n) && (n) < hi) { if ((n) > lo) xcd_barrier(xbar); call; }
#endif
__global__ void __launch_bounds__(512) mk(P p, int lo, int hi) {
  extern __shared__ __attribute__((aligned(16))) unsigned char lds[];
#if USE_CG
  cg::grid_group grid = cg::this_grid();
#endif
  volatile LAS unsigned* stw = (volatile LAS unsigned*)(lds + LDS_BYTES - 16);
  if (threadIdx.x == 0) { stw[0] = 0u; stw[1] = 0u; stw[2] = 0u; stw[3] = 0u; }
  __syncthreads();
  XcdBarrier xbar = xcd_barrier_post((unsigned*)(p.ws + O_BAR), stw);
  PHASE_PROGRAM
}
#undef PHASE
#else
#define PHASE(n, call) if constexpr (PH == (n)) { call; }
template <int PH>
__global__ void __launch_bounds__(512) mkp(P p) {
  extern __shared__ __attribute__((aligned(16))) unsigned char lds[];
  PHASE_PROGRAM
}
#undef PHASE
template <int PH> static void launch_all(const P& p, int grid, hipStream_t stream) {
  if constexpr (PH < NPH) {
    (void)hipFuncSetAttribute((const void*)mkp<PH>, hipFuncAttributeMaxDynamicSharedMemorySize, LDS_BYTES);
    hipLaunchKernelGGL(mkp<PH>, dim3(grid), dim3(NTHR), LDS_BYTES, stream, p);
    launch_all<PH + 1>(p, grid, stream);
  }
}
#endif

extern "C" void kernel_launch(void* const* d_in, const int* in_sizes, int n_in, void* d_out, int out_size, void* d_ws, size_t ws_size, hipStream_t stream) {
  static int grid_blocks = 0;
  if (!grid_blocks) {
    if (n_in != 25 || ws_size < O_END || ws_size < O_ACT + 16896ull * 2816 * 2) { fprintf(stderr, "kernel_launch: unexpected n_in %d / ws %zu\n", n_in, ws_size); grid_blocks = -1; return; }
    int dev = 0, cus = 0, per_cu = 0;
    (void)hipGetDevice(&dev);
    (void)hipDeviceGetAttribute(&cus, hipDeviceAttributeMultiprocessorCount, dev);
#if !MULTI_LAUNCH
    if (hipFuncSetAttribute((const void*)mk, hipFuncAttributeMaxDynamicSharedMemorySize, LDS_BYTES) != hipSuccess) { fprintf(stderr, "hipFuncSetAttribute failed\n"); grid_blocks = -1; return; }
    if (hipOccupancyMaxActiveBlocksPerMultiprocessor(&per_cu, (const void*)mk, NTHR, LDS_BYTES) != hipSuccess || per_cu < 1) { fprintf(stderr, "occupancy query failed (%d)\n", per_cu); grid_blocks = -1; return; }
#endif
    grid_blocks = cus * 1;
    fprintf(stderr, "kernel_launch: cus %d per_cu %d grid %d\n", cus, per_cu, grid_blocks);
  }
  if (grid_blocks < 0) return;
  P p{};
  for (int i = 0; i < 25; ++i) p.in[i] = (const float*)d_in[i];
  p.out = (float*)d_out; p.ws = (unsigned char*)d_ws;
#if MULTI_LAUNCH
  launch_all<0>(p, grid_blocks, stream);
#else
  int lo = 0, hi = NPH;
  if (hipMemsetAsync((unsigned char*)d_ws + O_BAR, 0, 16384, stream) != hipSuccess) { fprintf(stderr, "memset of barrier words failed\n"); return; }
  void* args[] = {&p, &lo, &hi};
#ifdef PROBE_K
  {
    hipLaunchKernelGGL(mk, dim3(grid_blocks), dim3(NTHR), LDS_BYTES, stream, p, 0, PROBE_K + 1);
    (void)hipMemsetAsync((unsigned char*)d_ws + O_BAR, 0, 16384, stream);
  }
#endif
#if USE_CG
  hipError_t e = hipLaunchCooperativeKernel((const void*)mk, dim3(grid_blocks), dim3(NTHR), args, LDS_BYTES, stream);
#else
  (void)args;
  hipLaunchKernelGGL(mk, dim3(grid_blocks), dim3(NTHR), LDS_BYTES, stream, p, lo, hi);
  hipError_t e = hipPeekAtLastError();
#endif
  if (e != hipSuccess) fprintf(stderr, "cooperative launch failed: %s (grid %d)\n", hipGetErrorString(e), grid_blocks);
#endif
}
```

```cpp
#include <hip/hip_runtime.h>
#include <hip/hip_cooperative_groups.h>
#include <cstdio>
#include <cstdint>
namespace cg = cooperative_groups;

#ifndef MULTI_LAUNCH
#define MULTI_LAUNCH 0
#endif

typedef unsigned short bfraw;
typedef __attribute__((ext_vector_type(8))) short bf16x8;
typedef __attribute__((ext_vector_type(4))) float f32x4;
#define DEVI __device__ __forceinline__

constexpr int NTHR = 512;
constexpr int GBM = 128;
constexpr int LROW = 40;
constexpr int LDS_BYTES = 143360;
constexpr float EPS = 1e-6f;

enum { I_X, I_C, I_CTX, I_CCTX, I_WADA, I_BADA, I_GFFN1, I_W1IN, I_W1OUT, I_GMIX, I_WIN, I_BGATES, I_CONVW, I_CONVB,
       I_GHEAD, I_GSGU, I_WS, I_BS, I_WA, I_WB, I_WO, I_GFFN2, I_W2IN, I_W2OUT, I_GFINAL };

struct P { const float* in[25]; float* out; unsigned char* ws; };

constexpr size_t O_W1IN  = 0;
constexpr size_t O_W1OUT = O_W1IN  + 5632ull * 1024 * 2;
constexpr size_t O_WTA   = O_W1OUT + 1024ull * 2816 * 2;
constexpr size_t O_WTB   = O_WTA   + 4096ull * 1024 * 2;
constexpr size_t O_WA    = O_WTB   + 4096ull * 1024 * 2;
constexpr size_t O_WB    = O_WA    + 1024ull * 1024 * 2;
constexpr size_t O_WO    = O_WB    + 1024ull * 1024 * 2;
constexpr size_t O_W2IN  = O_WO    + 1024ull * 1024 * 2;
constexpr size_t O_W2OUT = O_W2IN  + 5632ull * 1024 * 2;
constexpr size_t O_WSB   = O_W2OUT + 1024ull * 2816 * 2;
constexpr size_t O_MODSP = O_WSB   + 4ull * 128 * 128 * 2;
constexpr size_t O_MODS  = O_MODSP + 16ull * 3 * 9216 * 4;
constexpr size_t O_HCTX  = O_MODS  + 3ull * 9216 * 4;
constexpr size_t O_HN    = O_HCTX  + 512ull * 1024 * 4;
constexpr size_t O_GATES = O_HN    + 16896ull * 1024 * 2;
constexpr size_t O_CTXRAW= O_GATES + 16896ull * 16 * 4;
constexpr size_t O_BIG   = O_CTXRAW+ 2ull * 256 * 3072 * 2;
constexpr size_t O_ACT   = O_BIG;
constexpr size_t O_ST    = O_BIG;
constexpr size_t O_QRAW  = O_BIG;
constexpr size_t O_KRAW  = O_QRAW  + 8448ull * 1024 * 2;
constexpr size_t O_V     = O_ST    + 8ull * 66 * 131072;
constexpr size_t O_GVS   = O_V     + 8448ull * 1024 * 2;
constexpr size_t O_QC    = O_GVS   + 8192ull * 1024 * 2;
constexpr size_t O_KC    = O_QC    + 8448ull * 1024 * 2;
constexpr size_t O_NLOC  = O_KC    + 8448ull * 1024 * 2;
constexpr size_t O_NENT  = O_NLOC  + 8ull * 66 * 256 * 4;
constexpr size_t O_MG    = O_NENT  + 8ull * 66 * 256 * 4;
constexpr size_t O_RS    = O_MG    + 8192;
constexpr size_t O_HPARK = O_RS    + 8192ull * 4;
constexpr size_t O_BAR   = O_HPARK + 8192ull * 1024 * 2;
constexpr size_t O_END   = O_BAR + 16384;
static_assert(O_ACT + 16896ull * 2816 * 2 <= 268435456ull, "ws");
static_assert(O_END <= 268435456ull, "ws");
static_assert(O_KRAW + 8448ull * 1024 * 2 <= O_V, "overlay");

DEVI int ltid() { int t = __builtin_amdgcn_workitem_id_x(); asm volatile("" : "+v"(t)); return t; }
DEVI unsigned char* lws(unsigned char* w) { asm volatile("" : "+s"(w)); return w; }
DEVI bfraw f2bf(float f) { unsigned u = __float_as_uint(f); u += 0x7fffu + ((u >> 16) & 1u); return (bfraw)(u >> 16); }
DEVI float bf2f(bfraw h) { return __uint_as_float(((unsigned)h) << 16); }
DEVI float fexp(float x) { return __builtin_amdgcn_exp2f(x * 1.4426950408889634f); }
DEVI float sigmoidf_(float x) { return __builtin_amdgcn_rcpf(1.f + fexp(-x)); }
DEVI float siluf_(float x) { return x * sigmoidf_(x); }
DEVI float geluf_(float x) { return x * sigmoidf_(1.5957691216057308f * (x + 0.044715f * x * x * x)); }
DEVI float logsigf_(float x) { return fminf(x, 0.f) - log1pf(expf(-fabsf(x))); }
DEVI float wave_sum(float v) {
#pragma unroll
  for (int o = 32; o > 0; o >>= 1) v += __shfl_xor(v, o, 64);
  return v;
}
DEVI float red16(float v) {
  v += __shfl_xor(v, 1, 64); v += __shfl_xor(v, 2, 64); v += __shfl_xor(v, 4, 64); v += __shfl_xor(v, 8, 64);
  return v;
}
DEVI float redsin(float a, bool cosine) {
  float k = rintf(a * 0.15915494309189535f);
  float r = fmaf(-k, 6.2831854820251465f, a);
  r = fmaf(-k, -1.7484555e-7f, r);
  return cosine ? __cosf(r) : __sinf(r);
}


DEVI float seg_scan_sum(float v, int tid, float* s_x) {
  const int lane = tid & 63;
#pragma unroll
  for (int o = 1; o < 64; o <<= 1) { float t = __shfl_up(v, o, 64); if (lane >= o) v += t; }
  if (lane == 63 && tid < 256) s_x[tid >> 6] = v;
  __syncthreads();
  if (tid < 256 && ((tid >> 6) & 1)) v += s_x[(tid >> 6) - 1];
  __syncthreads();
  return v;
}
DEVI float seg_scan_max(float v, int tid, float* s_x) {
  const int lane = tid & 63;
#pragma unroll
  for (int o = 1; o < 64; o <<= 1) { float t = __shfl_up(v, o, 64); if (lane >= o) v = fmaxf(v, t); }
  if (lane == 63 && tid < 256) s_x[tid >> 6] = v;
  __syncthreads();
  if (tid < 256 && ((tid >> 6) & 1)) v = fmaxf(v, s_x[(tid >> 6) - 1]);
  __syncthreads();
  return v;
}

#define XB_TMO      128
#define XB_XCNT(j)  (256  + 64 * (j))
#define XB_XSUB(j)  (1280 + 64 * (j))
#define XB_XGEN(j)  (2304 + 64 * (j))
#define XB_TOP      3328
#define XB_TOPGEN   3392
#define XCD_BAR_WORDS 3456
#define XB_SPIN_CAP (1u << 18)
#define LAS __attribute__((address_space(3)))

__device__ __forceinline__ unsigned xb_ld(unsigned* p)              { return __hip_atomic_load(p, __ATOMIC_RELAXED, __HIP_MEMORY_SCOPE_AGENT); }
__device__ __forceinline__ unsigned xb_add(unsigned* p, unsigned v) { return __hip_atomic_fetch_add(p, v, __ATOMIC_RELAXED, __HIP_MEMORY_SCOPE_AGENT); }
__device__ __forceinline__ unsigned xb_xcc_id() { return (unsigned)__builtin_amdgcn_s_getreg((3 << 11) | 20) & 0xFu; }
#define XB_SPIN(cond, bar) do { unsigned _sp = 0; while (cond) { __builtin_amdgcn_s_sleep(1); \
    if ((++_sp & 255u) == 0u) { if (xb_ld(&(bar)[XB_TMO])) break; if (_sp > XB_SPIN_CAP) { atomicAdd(&(bar)[XB_TMO], 1u); break; } } } } while (0)

struct XcdBarrier {
    unsigned* bar; unsigned x;
    volatile LAS unsigned* st;
};

__device__ __forceinline__ XcdBarrier xcd_barrier_post(unsigned* bar, volatile LAS unsigned* st) {
    XcdBarrier b; b.bar = bar; b.x = xb_xcc_id(); b.st = st;
    if (threadIdx.x == 0) (void)xb_add(&bar[XB_XCNT(b.x)], 1u);
    return b;
}
__device__ __forceinline__ void xcd_barrier_complete(unsigned* bar, unsigned x, unsigned& nloc, unsigned& nx) {
    const unsigned G = gridDim.x * gridDim.y * gridDim.z;
    unsigned sum, cnt, mine, sp = 0u;
    for (;;) {
        sum = 0u; cnt = 0u; mine = 0u;
#pragma unroll
        for (unsigned j = 0; j < 16; ++j) { const unsigned c = xb_ld(&bar[XB_XCNT(j)]); sum += c; cnt += (c > 0u) ? 1u : 0u; mine = (j == x) ? c : mine; }
        if (sum == G) break;
        __builtin_amdgcn_s_sleep(1);
        if ((++sp & 255u) == 0u) { if (xb_ld(&bar[XB_TMO])) break; if (sp > XB_SPIN_CAP) { atomicAdd(&bar[XB_TMO], 1u); break; } }
    }
    nloc = mine > 0u ? mine : 1u; nx = cnt > 0u ? cnt : 1u;
}

__device__ __forceinline__ void xcd_barrier(const XcdBarrier& b) {
    asm volatile("s_waitcnt vmcnt(0)" ::: "memory");
    __syncthreads();
    if (threadIdx.x == 0) {
        unsigned* bar = b.bar;
        __builtin_amdgcn_s_waitcnt(0);
        unsigned nloc = b.st[0], nx = b.st[1];
        if (nloc == 0u) { xcd_barrier_complete(bar, b.x, nloc, nx); b.st[0] = nloc; b.st[1] = nx; }
        const unsigned old = xb_add(&bar[XB_XSUB(b.x)], 1u);
        const unsigned gen = old / nloc;
        if (old + 1u == (gen + 1u) * nloc) {
            __builtin_amdgcn_fence(__ATOMIC_RELEASE, "agent");
            asm volatile("s_waitcnt vmcnt(0)" ::: "memory");
            const unsigned og = xb_add(&bar[XB_TOP], 1u);
            const unsigned tg = og / nx;
            if (og + 1u == (tg + 1u) * nx) xb_add(&bar[XB_TOPGEN], 1u);
            else XB_SPIN(xb_ld(&bar[XB_TOPGEN]) == tg, bar);
            __builtin_amdgcn_fence(__ATOMIC_ACQUIRE, "agent");
            xb_add(&bar[XB_XGEN(b.x)], 1u);
            asm volatile("s_waitcnt vmcnt(0)" ::: "memory");
        } else {
            XB_SPIN(xb_ld(&bar[XB_XGEN(b.x)]) == gen, bar);
            __builtin_amdgcn_fence(__ATOMIC_ACQUIRE, "agent");
            asm volatile("s_waitcnt vmcnt(0)" ::: "memory");
        }
    }
    __syncthreads();
}

template <int BM, int BN, bool ATR, bool BTR, bool ALDS>
DEVI void gemm_tile(const bfraw* __restrict__ A, int lda, const bfraw* __restrict__ B, int ldb, int K,
                    const float* kscale, f32x4 (&acc)[BM / 32][BN / 64], bfraw* st, const bfraw* sAres, int ldres) {
  constexpr int MI = BM / 32, NJ = BN / 64, CA = BM / 128, CB = BN / 128, WM = BM / 2, WN = BN / 4;
  constexpr int STAGE = (ALDS ? BN : (BM + BN)) * LROW;
  int tid_ = ltid();
  const int tid = tid_, lane = tid & 63, wid = tid >> 6, wm = wid >> 2, wn = wid & 3;
  const int fr = lane & 15, fq = lane >> 4;
  uint4 ra0 = {0, 0, 0, 0}, ra1 = {0, 0, 0, 0}, rb0 = {0, 0, 0, 0}, rb1 = {0, 0, 0, 0};
  const int nk = K >> 5;

  auto gla = [&](int c, int k0) -> uint4 {
    if (!ATR) { int row = c >> 2, kc = (c & 3) * 8; return *(const uint4*)(A + (size_t)row * lda + k0 + kc); }
    else { int krow = c / (BM / 8), m0 = (c % (BM / 8)) * 8; return *(const uint4*)(A + (size_t)(k0 + krow) * lda + m0); }
  };
  auto glb = [&](int c, int k0) -> uint4 {
    if (!BTR) { int row = c >> 2, kc = (c & 3) * 8; return *(const uint4*)(B + (size_t)row * ldb + k0 + kc); }
    else { int krow = c / (BN / 8), n0 = (c % (BN / 8)) * 8; return *(const uint4*)(B + (size_t)(k0 + krow) * ldb + n0); }
  };
  auto gload = [&](int kt) {
    const int k0 = kt << 5;
    if (!ALDS) { ra0 = gla(tid, k0); if (CA > 1) ra1 = gla(tid + NTHR, k0); }
    rb0 = glb(tid, k0); if (CB > 1) rb1 = glb(tid + NTHR, k0);
  };
  constexpr int TSA = BM + 8, TSB = BN + 8;
  auto scale8 = [&](uint4 r, float sc) -> uint4 {
    unsigned w[4] = {r.x, r.y, r.z, r.w};
#pragma unroll
    for (int e = 0; e < 4; ++e) w[e] = (unsigned)f2bf(bf2f((bfraw)(w[e] & 0xffff)) * sc) | ((unsigned)f2bf(bf2f((bfraw)(w[e] >> 16)) * sc) << 16);
    return uint4{w[0], w[1], w[2], w[3]};
  };
  auto lstore = [&](int buf, int kt) {
    bfraw* sA = st + buf * STAGE;
    bfraw* sB = sA + (ALDS ? 0 : BM * LROW);
    auto sta = [&](int c, uint4 v) {
      if (!ATR) { int row = c >> 2, kc = (c & 3) * 8; *(uint4*)(sA + row * LROW + kc) = v; }
      else { int krow = c / (BM / 8), m0 = (c % (BM / 8)) * 8; *(uint4*)(sA + krow * TSA + m0) = v; }
    };
    auto stb = [&](int c, uint4 v) {
      if (!BTR) { int row = c >> 2, kc = (c & 3) * 8; *(uint4*)(sB + row * LROW + kc) = v; }
      else {
        int krow = c / (BN / 8), n0 = (c % (BN / 8)) * 8;
        if (kscale) v = scale8(v, kscale[(kt << 5) + krow]);
        *(uint4*)(sB + krow * TSB + n0) = v;
      }
    };
    if (!ALDS) { sta(tid, ra0); if (CA > 1) sta(tid + NTHR, ra1); }
    stb(tid, rb0); if (CB > 1) stb(tid + NTHR, rb1);
  };
  typedef short s16x4 __attribute__((ext_vector_type(4)));
  auto trfrag = [&](const bfraw* sT, int TS, int mt) -> bf16x8 {
    const bfraw* a1 = sT + (8 * fq + (fr >> 2)) * TS + mt + (fr & 3) * 4;
    s16x4 r1 = __builtin_amdgcn_ds_read_tr16_b64_v4i16((__attribute__((address_space(3))) s16x4*)a1);
    s16x4 r2 = __builtin_amdgcn_ds_read_tr16_b64_v4i16((__attribute__((address_space(3))) s16x4*)(a1 + 4 * TS));
    return bf16x8{r1[0], r1[1], r1[2], r1[3], r2[0], r2[1], r2[2], r2[3]};
  };
  auto compute = [&](int buf, int kt) {
    const bfraw* sA = st + buf * STAGE;
    const bfraw* sB = sA + (ALDS ? 0 : BM * LROW);
    bf16x8 af[MI], bfr[NJ];
#pragma unroll
    for (int i = 0; i < MI; ++i) {
      if (ALDS) af[i] = *(const bf16x8*)(sAres + (wm * WM + i * 16 + fr) * ldres + (kt << 5) + fq * 8);
      else if (ATR) af[i] = trfrag(sA, TSA, wm * WM + i * 16);
      else af[i] = *(const bf16x8*)(sA + (wm * WM + i * 16 + fr) * LROW + fq * 8);
    }
#pragma unroll
    for (int j = 0; j < NJ; ++j) {
      if (BTR) bfr[j] = trfrag(sB, TSB, wn * WN + j * 16);
      else bfr[j] = *(const bf16x8*)(sB + (wn * WN + j * 16 + fr) * LROW + fq * 8);
    }
#pragma unroll
    for (int i = 0; i < MI; ++i)
#pragma unroll
      for (int j = 0; j < NJ; ++j) acc[i][j] = __builtin_amdgcn_mfma_f32_16x16x32_bf16(af[i], bfr[j], acc[i][j], 0, 0, 0);
  };

  uint4 xa0 = {0, 0, 0, 0}, xa1 = {0, 0, 0, 0}, xb0 = {0, 0, 0, 0}, xb1 = {0, 0, 0, 0};
  auto swapsets = [&]() { uint4 t; t = ra0; ra0 = xa0; xa0 = t; t = ra1; ra1 = xa1; xa1 = t; t = rb0; rb0 = xb0; xb0 = t; t = rb1; rb1 = xb1; xb1 = t; };
  __syncthreads();
  gload(0); lstore(0, 0);
  if (nk > 1) gload(1);
  if (nk > 2) { swapsets(); gload(2); swapsets(); }
  __syncthreads();
  for (int kt = 0; kt < nk; kt += 2) {
    compute(0, kt);
    if (kt + 1 < nk) lstore(1, kt + 1);
    if (kt + 3 < nk) gload(kt + 3);
    __syncthreads();
    if (kt + 1 >= nk) break;
    compute(1, kt + 1);
    swapsets();
    if (kt + 2 < nk) lstore(0, kt + 2);
    if (kt + 4 < nk) gload(kt + 4);
    swapsets();
    __syncthreads();
  }
}

#define ZERO_ACC(acc, MI, NJ) _Pragma("unroll") for (int _i = 0; _i < (MI); ++_i) _Pragma("unroll") for (int _j = 0; _j < (NJ); ++_j) acc[_i][_j] = f32x4{0.f, 0.f, 0.f, 0.f};
#define EPI_BEGIN(BM, BN) { int _t = ltid(); const int _l = _t & 63, _w = _t >> 6; \
    const int _rb = (_w >> 2) * ((BM) / 2) + (_l >> 4) * 4, _cb = (_w & 3) * ((BN) / 4) + (_l & 15); \
    _Pragma("unroll") for (int i = 0; i < (BM) / 32; ++i) _Pragma("unroll") for (int j = 0; j < (BN) / 64; ++j) _Pragma("unroll") for (int r = 0; r < 4; ++r) { \
      const int row = _rb + i * 16 + r, col = _cb + j * 16;
#define EPI_END }}
#define EPIR_BEGIN(BM, BN) { int _t = ltid(); const int _l = _t & 63, _w = _t >> 6; \
    const int _rb = (_w >> 2) * ((BM) / 2) + (_l >> 4) * 4, _cb = (_w & 3) * ((BN) / 4) + (_l & 15); \
    _Pragma("unroll") for (int i = 0; i < (BM) / 32; ++i) _Pragma("unroll") for (int r = 0; r < 4; ++r) { \
      const int row = _rb + i * 16 + r;
#define EPIR_COLS(BN) _Pragma("unroll") for (int j = 0; j < (BN) / 64; ++j) { const int col = _cb + j * 16;
#define EPIR_END }}}


namespace pg8 {
#define PG8_LAS __attribute__((address_space(3)))
typedef unsigned short bf16_t;
typedef short bf16x8 __attribute__((ext_vector_type(8)));
typedef float f32x4 __attribute__((ext_vector_type(4)));
typedef unsigned u32x4 __attribute__((ext_vector_type(4)));
constexpr int BM = 256, BK = 64, HALF = 128, HTB = HALF * BK * 2  , STAGE_BYTES = 8 * HTB, NXCD = 8, WGM = 8;

__host__ __device__ __forceinline__ int lds_byte(int r, int c) { const int st = (r >> 4) * 2 + (c >> 5), rr = r & 15, cc = c & 31, ob = rr * 64 + cc * 2; return st * 1024 + (ob ^ (((ob >> 9) & 1) << 5)); }
__host__ __device__ __forceinline__ void stage_rc(int b, int& R, int& C) { const int st = b / 1024, sb = b % 1024, swz = sb ^ (((sb >> 9) & 1) << 5); R = (st >> 1) * 16 + swz / 64; C = (st & 1) * 32 + (swz % 64) / 2; }
__host__ __device__ __forceinline__ int perm32(int rho) { const int n = rho >> 4, i = rho & 15; return 8 * (i >> 2) + 4 * n + (i & 3); }

struct Unit { int pm, pn; };
struct Gemm { const bf16_t* A; const bf16_t* Bt; int M, N, K, ld; };
struct StaticOrder {
    int nM, nN, nwg, G, c;
    __host__ __device__ void init(int M, int N, int G_, int c_) { nM = M / BM; nN = N / BM; nwg = nM * nN; G = G_; c = c_; }
    __host__ __device__ bool next(int i, Unit& u) const {
        const long L = (long)i * G + c; if (L >= nwg) return false;
        int wgid = (int)L; { const int q = nwg / NXCD, r = nwg % NXCD, xcd = wgid % NXCD, off = wgid / NXCD; wgid = (xcd < r ? xcd * (q + 1) : r * (q + 1) + (xcd - r) * q) + off; }
        const int nig = WGM * nN, gid = wgid / nig, fm = gid * WGM, gsz = (nM - fm) < WGM ? (nM - fm) : WGM;
        u.pm = fm + ((wgid % nig) % gsz); u.pn = (wgid % nig) / gsz; return true;
    }
    __device__ __forceinline__ void a_ready(const Unit&) const {}
    __device__ __forceinline__ void done(const Unit&) const {}
};
__device__ __forceinline__ unsigned cvt_pk_bf16(float lo, float hi) { unsigned r; asm volatile("v_cvt_pk_bf16_f32 %0, %1, %2" : "=v"(r) : "v"(lo), "v"(hi)); return r; }
template <class Epi, class Sched, bool STAMP = false>
__device__ __forceinline__ void gemm_phase(PG8_LAS unsigned char* lds, const Gemm g, const Sched& S, const Epi& E, unsigned long long* stamps) {
    const int tid = threadIdx.x, wid = __builtin_amdgcn_readfirstlane(tid >> 6), lane = tid & 63, wr = wid >> 2, wc = wid & 3, fr = lane & 15, fq = lane >> 4;
    const int K = g.K, nt = K / BK;
    int ts_lo = 0, ts_hi = 0, nts = 0; const unsigned long long rt_entry = STAMP ? (unsigned long long)wall_clock64() : 0ull;
#define PG8_STAMP() do { if (STAMP && wid == 0 && nts < 64) { const unsigned long long _c = (unsigned long long)clock64(); \
        ts_lo = (lane == nts) ? (int)(unsigned)_c : ts_lo; ts_hi = (lane == nts) ? (int)(unsigned)(_c >> 32) : ts_hi; ++nts; } } while (0)
    PG8_STAMP();
    unsigned voffA[2], voffB[2];
#pragma unroll
    for (int i = 0; i < 2; ++i) { int R, C; stage_rc(tid * 16 + i * 8192, R, C); const int Rb = Epi::PERM ? ((R & ~31) + perm32(R & 31)) : R;
        voffA[i] = (unsigned)(R * g.ld + C) * 2u; voffB[i] = (unsigned)(Rb * g.ld + C) * 2u; }
    const size_t kstep = (size_t)(BK * 2);
    const size_t hstep = (size_t)HALF * g.ld * 2;
    const size_t tstep = 2 * hstep;
    const unsigned ldsw = (unsigned)wid * 1024u;
    const int aoff = lds_byte(wr * 64 + fr, fq * 8), boff = lds_byte(wc * 32 + fr, fq * 8);
#define PG8_SA(b, h) (((b) * 2 + (h)) * HTB)
#define PG8_SB(b, h) ((4 + (b) * 2 + (h)) * HTB)
#define PG8_STAGE(bufoff, gbase, voff) do { _Pragma("unroll") for (int _i = 0; _i < 2; ++_i) \
        __builtin_amdgcn_global_load_lds((const unsigned*)((const char*)(gbase) + (voff)[_i]), (PG8_LAS unsigned*)(lds + (bufoff) + ldsw + _i * 8192), 16, 0, 0); } while (0)
#define PG8_LDA(dst, b, h) do { _Pragma("unroll") for (int m = 0; m < 4; ++m) _Pragma("unroll") for (int k = 0; k < 2; ++k) dst[m][k] = *(const PG8_LAS bf16x8*)(lds + PG8_SA(b, h) + aoff + m * 2048 + k * 1024); } while (0)
#define PG8_LDB(dst, b, h) do { _Pragma("unroll") for (int n = 0; n < 2; ++n) _Pragma("unroll") for (int k = 0; k < 2; ++k) dst[n][k] = *(const PG8_LAS bf16x8*)(lds + PG8_SB(b, h) + boff + n * 2048 + k * 1024); } while (0)
#define PG8_MMA(ai, bj, At, Bt) do { __builtin_amdgcn_s_setprio(1); _Pragma("unroll") for (int m = 0; m < 4; ++m) _Pragma("unroll") for (int n = 0; n < 2; ++n) _Pragma("unroll") for (int k = 0; k < 2; ++k) \
        acc[ai][bj][m][n] = __builtin_amdgcn_mfma_f32_16x16x32_bf16(Bt[n][k], At[m][k], acc[ai][bj][m][n], 0, 0, 0); __builtin_amdgcn_s_setprio(0); } while (0)
#define PG8_WAIT_V(n) asm volatile("s_waitcnt vmcnt(" #n ")" ::: "memory")
#define PG8_WAIT_L(n) asm volatile("s_waitcnt lgkmcnt(" #n ")" ::: "memory")
#define PG8_BAR __builtin_amdgcn_s_barrier()
#define PG8_SCHED __builtin_amdgcn_sched_barrier(0)
    Unit cur, nxt; int ui = 0;
    if (!S.next(0, cur)) return;
    f32x4 acc[2][2][4][2];
#pragma unroll
    for (int a = 0; a < 2; ++a)
#pragma unroll
        for (int b = 0; b < 2; ++b)
#pragma unroll
            for (int m = 0; m < 4; ++m)
#pragma unroll
                for (int n = 0; n < 2; ++n) acc[a][b][m][n] = (f32x4){0.f, 0.f, 0.f, 0.f};
    bf16x8 At[4][2], B0[2][2], B1[2][2];
    const char* cA = (const char*)g.A + (size_t)cur.pm * tstep; const char* cB = (const char*)g.Bt + (size_t)cur.pn * tstep;
    S.a_ready(cur);
    PG8_STAGE(PG8_SB(0, 0), cB, voffB); PG8_STAGE(PG8_SA(0, 0), cA, voffA); PG8_STAGE(PG8_SB(0, 1), cB + hstep, voffB); PG8_STAGE(PG8_SA(0, 1), cA + hstep, voffA);
    if (wr == 1) PG8_BAR;
    PG8_WAIT_V(4); PG8_BAR;
    PG8_STAGE(PG8_SB(1, 0), cB + kstep, voffB); PG8_STAGE(PG8_SA(1, 0), cA + kstep, voffA); PG8_STAGE(PG8_SB(1, 1), cB + hstep + kstep, voffB);
    PG8_WAIT_V(6); PG8_BAR;
    PG8_STAMP();
    for (;;) {
        const bool has_next = S.next(ui + 1, nxt);
        const char* nA = has_next ? (const char*)g.A + (size_t)nxt.pm * tstep : cA; const char* nB = has_next ? (const char*)g.Bt + (size_t)nxt.pn * tstep : cB;
        for (int t = 0; t < nt; t += 2) {
            const bool last = (t == nt - 2);
            const char* a1 = cA + (size_t)(t + 1) * kstep;
            const char* a2 = last ? nA : cA + (size_t)(t + 2) * kstep; const char* b2 = last ? nB : cB + (size_t)(t + 2) * kstep;
            const char* a3 = a2 + kstep; const char* b3 = b2 + kstep;
            if (last && has_next) S.a_ready(nxt);
            PG8_LDB(B0, 0, 0); PG8_SCHED; PG8_LDA(At, 0, 0); PG8_STAGE(PG8_SA(1, 1), a1 + hstep, voffA);
            PG8_WAIT_L(8); PG8_BAR; PG8_WAIT_L(0); PG8_MMA(0, 0, At, B0); PG8_BAR; PG8_SCHED;
            PG8_LDB(B1, 0, 1); PG8_STAGE(PG8_SB(0, 0), b2, voffB);
            PG8_BAR; PG8_WAIT_L(0); PG8_MMA(0, 1, At, B1); PG8_BAR;
            PG8_LDA(At, 0, 1); PG8_STAGE(PG8_SA(0, 0), a2, voffA);
            PG8_BAR; PG8_WAIT_L(0); PG8_MMA(1, 0, At, B0); PG8_BAR; PG8_SCHED;
            PG8_STAGE(PG8_SB(0, 1), b2 + hstep, voffB);
            PG8_WAIT_V(6); PG8_BAR; PG8_MMA(1, 1, At, B1); PG8_BAR;
            PG8_LDB(B0, 1, 0); PG8_SCHED; PG8_LDA(At, 1, 0); PG8_STAGE(PG8_SA(0, 1), a2 + hstep, voffA);
            PG8_WAIT_L(8); PG8_BAR; PG8_WAIT_L(0); PG8_MMA(0, 0, At, B0); PG8_BAR; PG8_SCHED;
            PG8_LDB(B1, 1, 1); PG8_STAGE(PG8_SB(1, 0), b3, voffB);
            PG8_BAR; PG8_WAIT_L(0); PG8_MMA(0, 1, At, B1); PG8_BAR;
            PG8_LDA(At, 1, 1); PG8_STAGE(PG8_SA(1, 0), a3, voffA);
            PG8_BAR; PG8_WAIT_L(0); PG8_MMA(1, 0, At, B0); PG8_BAR; PG8_SCHED;
            PG8_STAGE(PG8_SB(1, 1), b3 + hstep, voffB);
            PG8_WAIT_V(6); PG8_BAR; PG8_MMA(1, 1, At, B1); PG8_BAR;
        }
        PG8_STAMP();
        if constexpr (!Epi::AFTER_DRAIN) { E(acc, cur, wr, wc, fr, fq); S.done(cur); }
        PG8_STAMP();
        if (!has_next) break;
#pragma unroll
        for (int a = 0; a < 2; ++a)
#pragma unroll
            for (int b = 0; b < 2; ++b)
#pragma unroll
                for (int m = 0; m < 4; ++m)
#pragma unroll
                    for (int n = 0; n < 2; ++n) acc[a][b][m][n] = (f32x4){0.f, 0.f, 0.f, 0.f};
        cur = nxt; cA = nA; cB = nB; ++ui;
    }
    PG8_WAIT_V(0);
    if (wr == 0) PG8_BAR;
    PG8_BAR;
    if constexpr (Epi::AFTER_DRAIN) { E.fused(acc, cur, wr, wc, fr, fq, lds, wid, lane); S.done(cur); }
    PG8_STAMP();
    if (STAMP && wid == 0) { stamps[lane] = lane < nts ? (((unsigned long long)(unsigned)ts_hi << 32) | (unsigned)ts_lo) : 0ull;
        if (lane == 62) stamps[62] = rt_entry; if (lane == 63) stamps[63] = (unsigned long long)wall_clock64(); }
#undef PG8_STAMP
#undef PG8_SA
#undef PG8_SB
#undef PG8_STAGE
#undef PG8_LDA
#undef PG8_LDB
#undef PG8_MMA
#undef PG8_WAIT_V
#undef PG8_WAIT_L
#undef PG8_BAR
#undef PG8_SCHED
}
}

typedef pg8::f32x4 pf4;
DEVI float4 ld4(const float* p) { return *(const float4*)p; }
struct EpiFfnIn {
  static constexpr bool PERM = false, AFTER_DRAIN = false;
  bfraw* act;
  DEVI void operator()(const pf4 (&acc)[2][2][4][2], const pg8::Unit& u, int wr, int wc, int fr, int fq) const {
    const int row0 = u.pm * 256 + wr * 64 + fr, f0 = (u.pn * 256 + wc * 32) / 2 + 4 * fq;
#pragma unroll
    for (int ai = 0; ai < 2; ++ai)
#pragma unroll
      for (int m = 0; m < 4; ++m) {
        bfraw* rowp = act + (size_t)(row0 + ai * 128 + m * 16) * 2816 + f0;
#pragma unroll
        for (int bj = 0; bj < 2; ++bj) {
          const pf4 a = acc[ai][bj][m][0], b = acc[ai][bj][m][1];
          uint2 w; w.x = pg8::cvt_pk_bf16(siluf_(a[0]) * b[0], siluf_(a[1]) * b[1]); w.y = pg8::cvt_pk_bf16(siluf_(a[2]) * b[2], siluf_(a[3]) * b[3]);
          *(uint2*)(rowp + bj * 64) = w;
        }
      }
  }
};
struct EpiResid {
  static constexpr bool PERM = false, AFTER_DRAIN = false;
  float* h; const float* mods; int rowoff, gidx; float scale; int mrow;
  DEVI void operator()(const pf4 (&acc)[2][2][4][2], const pg8::Unit& u, int wr, int wc, int fr, int fq) const {
    const int row0 = rowoff + u.pm * 256 + wr * 64 + fr, col0 = u.pn * 256 + wc * 32 + 4 * fq;
#pragma unroll
    for (int ai = 0; ai < 2; ++ai)
#pragma unroll
      for (int m = 0; m < 4; ++m) {
        const int r = row0 + ai * 128 + m * 16;
        float* rowp = h + (size_t)r * 1024 + col0;
        const float* gp = mods + (mrow >= 0 ? mrow : (r >> 13)) * 9216 + gidx * 1024 + col0;
#pragma unroll
        for (int bj = 0; bj < 2; ++bj)
#pragma unroll
          for (int n = 0; n < 2; ++n) {
            float4 hv = ld4(rowp + bj * 128 + n * 16); const float4 g = ld4(gp + bj * 128 + n * 16); const pf4 a = acc[ai][bj][m][n];
            hv.x += scale * g.x * a[0]; hv.y += scale * g.y * a[1]; hv.z += scale * g.z * a[2]; hv.w += scale * g.w * a[3];
            *(float4*)(rowp + bj * 128 + n * 16) = hv;
          }
      }
  }
};
struct EpiResidAtomic {
  static constexpr bool PERM = false, AFTER_DRAIN = false;
  float* h; const float* mods; int rowoff, gidx; float scale; int mrow;
  DEVI void operator()(const pf4 (&acc)[2][2][4][2], const pg8::Unit& u, int wr, int wc, int fr, int fq) const {
    const int row0 = rowoff + u.pm * 256 + wr * 64 + fr, col0 = u.pn * 256 + wc * 32 + 4 * fq;
#pragma unroll
    for (int ai = 0; ai < 2; ++ai)
#pragma unroll
      for (int m = 0; m < 4; ++m) {
        const int r = row0 + ai * 128 + m * 16;
        float* rowp = h + (size_t)r * 1024 + col0;
        const float* gp = mods + (mrow >= 0 ? mrow : (r >> 13)) * 9216 + gidx * 1024 + col0;
#pragma unroll
        for (int bj = 0; bj < 2; ++bj)
#pragma unroll
          for (int n = 0; n < 2; ++n) {
            const float4 g = ld4(gp + bj * 128 + n * 16); const pf4 a = acc[ai][bj][m][n];
            float* q = rowp + bj * 128 + n * 16;
            atomicAdd(q, scale * g.x * a[0]); atomicAdd(q + 1, scale * g.y * a[1]); atomicAdd(q + 2, scale * g.z * a[2]); atomicAdd(q + 3, scale * g.w * a[3]);
          }
      }
  }
};
template <int MODE> struct EpiMix {
  static constexpr bool PERM = true, AFTER_DRAIN = false;
  bfraw* d0; bfraw* d1; bfraw* d2; bfraw* d3;
  DEVI void operator()(const pf4 (&acc)[2][2][4][2], const pg8::Unit& u, int wr, int wc, int fr, int fq) const {
    const int row0 = u.pm * 256 + wr * 64 + fr;
    const int pc = u.pn >> 2;
    bfraw* dst = MODE == 0 ? d0 : (MODE == 1 || MODE == 2) ? (pc == 0 ? d0 : pc == 1 ? d1 : pc == 2 ? d2 : d3) : (MODE == 3 ? d0 : d1);
    const int ld = MODE == 0 ? 3072 : 1024;
    const int col0 = (MODE == 1 || MODE == 2 ? (u.pn & 3) : u.pn) * 256 + wc * 32 + 8 * fq;
#pragma unroll
    for (int ai = 0; ai < 2; ++ai)
#pragma unroll
      for (int m = 0; m < 4; ++m) {
        const size_t ro = (size_t)(row0 + ai * 128 + m * 16) * ld + col0;
#pragma unroll
        for (int bj = 0; bj < 2; ++bj) {
          float v[8];
#pragma unroll
          for (int e = 0; e < 4; ++e) { v[e] = acc[ai][bj][m][0][e]; v[4 + e] = acc[ai][bj][m][1][e]; }
          bfraw* dp = dst + ro + bj * 128;
          if (MODE == 1) { if (pc == 3) {
#pragma unroll
            for (int e = 0; e < 8; ++e) v[e] = geluf_(v[e]); } }
          if (MODE == 2 && pc >= 2) {
#pragma unroll
            for (int e = 0; e < 8; ++e) v[e] = sigmoidf_(v[e]);
          } else if (MODE == 2 || MODE == 3 || MODE == 4) {
            const uint4 o = *(const uint4*)dp; const unsigned ow[4] = {o.x, o.y, o.z, o.w};
            float p[8];
#pragma unroll
            for (int e = 0; e < 4; ++e) { p[2 * e] = bf2f((bfraw)(ow[e] & 0xffff)); p[2 * e + 1] = bf2f((bfraw)(ow[e] >> 16)); }
            if (MODE == 2) {
#pragma unroll
              for (int e = 0; e < 8; ++e) v[e] = (pc == 0 ? sigmoidf_(v[e]) : geluf_(v[e])) * p[e];
            } else if (MODE == 3) {
#pragma unroll
              for (int e = 0; e < 8; ++e) v[e] *= p[e];
            } else {
              const uint4 t = *(const uint4*)(d0 + ro + bj * 128); const unsigned tw[4] = {t.x, t.y, t.z, t.w};
#pragma unroll
              for (int e = 0; e < 4; ++e) { v[2 * e] = bf2f((bfraw)(tw[e] & 0xffff)) + p[2 * e] * v[2 * e]; v[2 * e + 1] = bf2f((bfraw)(tw[e] >> 16)) + p[2 * e + 1] * v[2 * e + 1]; }
            }
          }
          uint4 w; w.x = pg8::cvt_pk_bf16(v[0], v[1]); w.y = pg8::cvt_pk_bf16(v[2], v[3]); w.z = pg8::cvt_pk_bf16(v[4], v[5]); w.w = pg8::cvt_pk_bf16(v[6], v[7]);
          *(uint4*)dp = w;
        }
      }
  }
};
template <class Epi>
DEVI void run8(unsigned char* lds, const bfraw* A, const bfraw* Bt, int M, int N, int K, const Epi& E, int G = -1, int c = -1, int ld = -1) {
  pg8::Gemm g{A, Bt, M, N, K, ld < 0 ? K : ld};
  pg8::StaticOrder S; S.init(M, N, G < 0 ? (int)gridDim.x : G, c < 0 ? (int)blockIdx.x : c);
  pg8::gemm_phase<Epi, pg8::StaticOrder, false>((PG8_LAS unsigned char*)lds, g, S, E, nullptr);
}

struct TrJob { const float* src; bfraw* dst; int ldw, K, kt, nt, drow0, mode; };
DEVI TrJob tr_decode(const P& p, int t) {
  TrJob j; int u = t;
  if (u < 1408) { j = TrJob{p.in[I_W1IN], (bfraw*)(p.ws + O_W1IN), 5632, 1024, u / 88, u % 88, 0, 1}; return j; }
  u -= 1408;
  if (u < 704) { j = TrJob{p.in[I_W1OUT], (bfraw*)(p.ws + O_W1OUT), 1024, 2816, u / 16, u % 16, 0, 0}; return j; }
  u -= 704;
  if (u < 2048) {
    const int pc = u >> 8; u &= 255;
    const int col0 = pc == 0 ? 0 : pc == 1 ? 1024 : pc == 2 ? 2048 : pc == 3 ? 5136 : pc == 4 ? 3088 : pc == 5 ? 4112 : pc == 6 ? 6160 : 7184;
    j = TrJob{p.in[I_WIN] + col0, (bfraw*)(p.ws + (pc < 4 ? O_WTA : O_WTB)), 8208, 1024, u >> 4, u & 15, (pc & 3) * 1024, 0}; return j;
  }
  u -= 2048;
  if (u < 768) { const int m = u >> 8; u &= 255; j = TrJob{p.in[m == 0 ? I_WA : m == 1 ? I_WB : I_WO], (bfraw*)(p.ws + (m == 0 ? O_WA : m == 1 ? O_WB : O_WO)), 1024, 1024, u >> 4, u & 15, 0, 0}; return j; }
  u -= 768;
  if (u < 1408) { j = TrJob{p.in[I_W2IN], (bfraw*)(p.ws + O_W2IN), 5632, 1024, u / 88, u % 88, 0, 1}; return j; }
  u -= 1408;
  j = TrJob{p.in[I_W2OUT], (bfraw*)(p.ws + O_W2OUT), 1024, 2816, u / 16, u % 16, 0, 0}; return j;
}

DEVI void phase_p0(const P& p, unsigned char* lds) {
  float* sf = (float*)lds;
  const int tid = ltid();
  for (int i = tid; i < 3072; i += NTHR) { float v = i < 2048 ? p.in[I_C][i] : p.in[I_CCTX][i - 2048]; sf[i] = v / (1.f + expf(-v)); }
  __syncthreads();
  {
    const float* w = p.in[I_WADA];
    float* mp = (float*)(p.ws + O_MODSP);
    for (int id = blockIdx.x * NTHR + tid; id < 16 * 9216; id += gridDim.x * NTHR) {
      int s = id / 9216, j = id - s * 9216;
      float a0 = 0, a1 = 0, a2 = 0;
#pragma unroll 16
      for (int k = s * 64; k < s * 64 + 64; ++k) { float wv = w[(size_t)k * 9216 + j]; a0 += sf[k] * wv; a1 += sf[1024 + k] * wv; a2 += sf[2048 + k] * wv; }
      mp[(s * 3 + 0) * 9216 + j] = a0; mp[(s * 3 + 1) * 9216 + j] = a1; mp[(s * 3 + 2) * 9216 + j] = a2;
    }
  }
  __syncthreads();
  {
    float rg[8];
    int t = blockIdx.x;
    TrJob jb = tr_decode(p, t < 7040 ? t : 0);
    if (t < 7040) {
#pragma unroll
      for (int i = 0; i < 8; ++i) { int e = tid + i * NTHR; int kk = e >> 6, nn = e & 63; rg[i] = jb.src[(size_t)(jb.kt * 64 + kk) * jb.ldw + jb.nt * 64 + nn]; }
    }
    for (; t < 7040; t += gridDim.x) {
#pragma unroll
      for (int i = 0; i < 8; ++i) { int e = tid + i * NTHR; int kk = e >> 6, nn = e & 63; sf[kk * 65 + nn] = rg[i]; }
      __syncthreads();
      const TrJob cj = jb;
      const int tn = t + gridDim.x;
      if (tn < 7040) {
        jb = tr_decode(p, tn);
#pragma unroll
        for (int i = 0; i < 8; ++i) { int e = tid + i * NTHR; int kk = e >> 6, nn = e & 63; rg[i] = jb.src[(size_t)(jb.kt * 64 + kk) * jb.ldw + jb.nt * 64 + nn]; }
      }
#pragma unroll
      for (int i = 0; i < 8; ++i) {
        int e = tid + i * NTHR; int nn = e >> 6, kk = e & 63;
        int n = cj.nt * 64 + nn, dr;
        if (cj.mode == 1) { int isb = n >= 2816; int f = n - isb * 2816; dr = (f >> 4) * 32 + isb * 16 + (f & 15); } else dr = cj.drow0 + n;
        cj.dst[(size_t)dr * cj.K + cj.kt * 64 + kk] = f2bf(sf[kk * 65 + nn]);
      }
      __syncthreads();
    }
  }
  { bfraw* d = (bfraw*)(p.ws + O_WSB); for (int id = blockIdx.x * NTHR + tid; id < 65536; id += gridDim.x * NTHR) d[id] = f2bf(p.in[I_WS][id]); }
}

DEVI void phase_p0b(const P& p) {
  const float* mp = (const float*)(p.ws + O_MODSP);
  float* m = (float*)(p.ws + O_MODS);
  for (int id = blockIdx.x * NTHR + ltid(); id < 3 * 9216; id += gridDim.x * NTHR) {
    int j = id % 9216;
    float a = p.in[I_BADA][j];
    for (int s = 0; s < 16; ++s) a += mp[s * 3 * 9216 + id];
    m[id] = a;
  }
}

template <int MODE>
DEVI void phase_rows(const P& p, unsigned char* lds, int row_lo = 0, int row_hi = -1, int vb = -1, int nvb = -1) {
  const int tid = ltid(), lane = tid & 63, wid = tid >> 6;
  const float* mods = (const float*)(p.ws + O_MODS);
  float* hctx = (float*)(p.ws + O_HCTX);
  bfraw* hn = (bfraw*)(p.ws + O_HN);
  float* wg = (float*)lds;
  if (MODE == 2) {
    __syncthreads();
    for (int i = tid; i < 16384; i += NTHR) { int k = i >> 4, g = i & 15; wg[g * 1024 + k] = p.in[I_WIN][(size_t)k * 8208 + 3072 + g]; }
    __syncthreads();
  }
  const int nrows = row_hi >= 0 ? row_hi : ((MODE == 1 || MODE == 2) ? 16896 : 16384);
  if (vb < 0) { vb = (int)blockIdx.x; nvb = (int)gridDim.x; }
  const float* gvec = p.in[MODE == 1 ? I_GFFN1 : MODE == 2 ? I_GMIX : MODE == 3 ? I_GFFN2 : I_GFINAL];
  const int msh = MODE == 1 ? 0 : MODE == 2 ? 3 : 6;
  for (int row = row_lo + vb * 8 + wid; row < nrows; row += nvb * 8) {
    const bool lat = row < 16384;
    const int mrow = lat ? (row >> 13) : 2;
    float4 v[4];
    if (MODE == 1) {
      const float* src = lat ? p.in[I_X] + (size_t)row * 1024 : p.in[I_CTX] + (size_t)(row - 16384) * 1024;
#pragma unroll
      for (int i = 0; i < 4; ++i) v[i] = *(const float4*)(src + i * 256 + lane * 4);
      if (lat) {
        int ts = row & 8191; float rr = (float)(ts >> 6), cc = (float)(ts & 63);
        float fqv[4];
#pragma unroll
        for (int e = 0; e < 4; ++e) fqv[e] = expf((-9.210340371976184f * (float)(lane * 4 + e)) / 256.f);
        v[0].x += redsin(rr * fqv[0], false); v[0].y += redsin(rr * fqv[1], false); v[0].z += redsin(rr * fqv[2], false); v[0].w += redsin(rr * fqv[3], false);
        v[1].x += redsin(rr * fqv[0], true);  v[1].y += redsin(rr * fqv[1], true);  v[1].z += redsin(rr * fqv[2], true);  v[1].w += redsin(rr * fqv[3], true);
        v[2].x += redsin(cc * fqv[0], false); v[2].y += redsin(cc * fqv[1], false); v[2].z += redsin(cc * fqv[2], false); v[2].w += redsin(cc * fqv[3], false);
        v[3].x += redsin(cc * fqv[0], true);  v[3].y += redsin(cc * fqv[1], true);  v[3].z += redsin(cc * fqv[2], true);  v[3].w += redsin(cc * fqv[3], true);
      }
      float* dsth = lat ? p.out + (size_t)row * 1024 : hctx + (size_t)(row - 16384) * 1024;
#pragma unroll
      for (int i = 0; i < 4; ++i) *(float4*)(dsth + i * 256 + lane * 4) = v[i];
    } else {
      const float* src = lat ? p.out + (size_t)row * 1024 : hctx + (size_t)(row - 16384) * 1024;
#pragma unroll
      for (int i = 0; i < 4; ++i) v[i] = *(const float4*)(src + i * 256 + lane * 4);
    }
    float ss = 0;
#pragma unroll
    for (int i = 0; i < 4; ++i) ss += v[i].x * v[i].x + v[i].y * v[i].y + v[i].z * v[i].z + v[i].w * v[i].w;
    ss = wave_sum(ss);
    const float rs = rsqrtf(ss * (1.f / 1024.f) + EPS);
    if (MODE == 4) {
#pragma unroll
      for (int i = 0; i < 4; ++i) {
        float4 g = *(const float4*)(gvec + i * 256 + lane * 4);
        float4 o = {v[i].x * rs * g.x, v[i].y * rs * g.y, v[i].z * rs * g.z, v[i].w * rs * g.w};
        *(float4*)(p.out + (size_t)row * 1024 + i * 256 + lane * 4) = o;
      }
    } else {
      const float* sh = mods + (size_t)(mrow * 9216 + msh * 1024);
      const float* scp = sh + 1024;
      float y[16];
#pragma unroll
      for (int i = 0; i < 4; ++i) {
        const int c = i * 256 + lane * 4;
        float4 g = *(const float4*)(gvec + c), s4 = *(const float4*)(sh + c), c4 = *(const float4*)(scp + c);
        y[i * 4 + 0] = v[i].x * rs * g.x * (1.f + c4.x) + s4.x; y[i * 4 + 1] = v[i].y * rs * g.y * (1.f + c4.y) + s4.y;
        y[i * 4 + 2] = v[i].z * rs * g.z * (1.f + c4.z) + s4.z; y[i * 4 + 3] = v[i].w * rs * g.w * (1.f + c4.w) + s4.w;
        uint2 pk; pk.x = (unsigned)f2bf(y[i * 4]) | ((unsigned)f2bf(y[i * 4 + 1]) << 16); pk.y = (unsigned)f2bf(y[i * 4 + 2]) | ((unsigned)f2bf(y[i * 4 + 3]) << 16);
        *(uint2*)(hn + (size_t)row * 1024 + c) = pk;
      }
      if (MODE == 2) {
        float ga[16];
#pragma unroll
        for (int g2 = 0; g2 < 16; ++g2) {
          float a = 0.f;
#pragma unroll
          for (int i = 0; i < 4; ++i) { float4 w4 = *(const float4*)(wg + g2 * 1024 + i * 256 + lane * 4); a += y[i * 4] * w4.x + y[i * 4 + 1] * w4.y + y[i * 4 + 2] * w4.z + y[i * 4 + 3] * w4.w; }
          ga[g2] = a;
          if ((g2 & 3) == 3) asm volatile("" ::: "memory");
        }
        const bool b5 = lane & 32, b4 = lane & 16, b3 = lane & 8, b2 = lane & 4;
        float r8[8], r4[4], r2[2];
#pragma unroll
        for (int g = 0; g < 8; ++g) { const float snd = b5 ? ga[g] : ga[g + 8], kp = b5 ? ga[g + 8] : ga[g]; r8[g] = kp + __shfl_xor(snd, 32, 64); }
#pragma unroll
        for (int g = 0; g < 4; ++g) { const float snd = b4 ? r8[g] : r8[g + 4], kp = b4 ? r8[g + 4] : r8[g]; r4[g] = kp + __shfl_xor(snd, 16, 64); }
#pragma unroll
        for (int g = 0; g < 2; ++g) { const float snd = b3 ? r4[g] : r4[g + 2], kp = b3 ? r4[g + 2] : r4[g]; r2[g] = kp + __shfl_xor(snd, 8, 64); }
        float r1 = (b2 ? r2[1] : r2[0]) + __shfl_xor(b2 ? r2[0] : r2[1], 4, 64);
        r1 += __shfl_xor(r1, 2, 64); r1 += __shfl_xor(r1, 1, 64);
        const int gi = (b5 ? 8 : 0) + (b4 ? 4 : 0) + (b3 ? 2 : 0) + (b2 ? 1 : 0);
        if ((lane & 3) == 0) ((float*)(p.ws + O_GATES))[(size_t)row * 16 + gi] = r1;
      }
    }
  }
}

DEVI void phase_ffn_in(const P& p, unsigned char* lds, size_t o_w, int nrows) {
  EpiFfnIn E{(bfraw*)(p.ws + O_ACT)};
  run8(lds, (const bfraw*)(p.ws + O_HN), (const bfraw*)(p.ws + o_w), nrows, 5632, 1024, E);
}

DEVI void phase_ffn_out(const P& p, unsigned char* lds, size_t o_w, int gidx, bool with_ctx) {
  EpiResid E{p.out, (const float*)(p.ws + O_MODS), 0, gidx, 0.5f, -1};
  run8(lds, (const bfraw*)(p.ws + O_ACT), (const bfraw*)(p.ws + o_w), 16384, 1024, 2816, E);
  (void)with_ctx;
}

DEVI void phase_r2_g2c(const P& p, unsigned char* lds) {
  const int G = (int)gridDim.x, nc = G >= 48 ? 24 : 0;
  if (nc == 0) {
    EpiResid E{(float*)(p.ws + O_HCTX), (const float*)(p.ws + O_MODS), 0, 2, 0.5f, 2};
    run8(lds, (const bfraw*)(p.ws + O_ACT) + (size_t)16384 * 2816, (const bfraw*)(p.ws + O_W1OUT), 512, 1024, 2816, E);
    __syncthreads();
  } else if ((int)blockIdx.x < nc) {
    const int sl = (int)blockIdx.x >> 3, k0 = sl * 1024, kl = sl == 2 ? 768 : 1024;
    EpiResidAtomic E{(float*)(p.ws + O_HCTX), (const float*)(p.ws + O_MODS), 0, 2, 0.5f, 2};
    run8(lds, (const bfraw*)(p.ws + O_ACT) + (size_t)16384 * 2816 + k0, (const bfraw*)(p.ws + O_W1OUT) + k0, 512, 1024, kl, E, 8, (int)blockIdx.x & 7, 2816);
    return;
  }
  phase_rows<2>(p, lds, 0, 16384, (int)blockIdx.x - nc, G - nc);
}

DEVI void phase_g3c(const P& p, unsigned char* lds) {
  EpiMix<0> E{(bfraw*)(p.ws + O_CTXRAW), nullptr, nullptr, nullptr};
  run8(lds, (const bfraw*)(p.ws + O_HN) + (size_t)16384 * 1024, (const bfraw*)(p.ws + O_WTA), 512, 3072, 1024, E);
}

DEVI void phase_g3a(const P& p, unsigned char* lds, int hb) {
  EpiMix<1> E{(bfraw*)(p.ws + O_QRAW), (bfraw*)(p.ws + O_KRAW), (bfraw*)(p.ws + O_V), (bfraw*)(p.ws + O_GVS)};
  run8(lds, (const bfraw*)(p.ws + O_HN) + (size_t)hb * 8192 * 1024, (const bfraw*)(p.ws + O_WTA), 8192, 4096, 1024, E);
}

DEVI void phase_g3b(const P& p, unsigned char* lds, int hb) {
  EpiMix<2> E{(bfraw*)(p.ws + O_V), (bfraw*)(p.ws + O_GVS), (bfraw*)(p.ws + O_QC), (bfraw*)(p.ws + O_KC)};
  run8(lds, (const bfraw*)(p.ws + O_HN) + (size_t)hb * 8192 * 1024, (const bfraw*)(p.ws + O_WTB), 8192, 4096, 1024, E);
}

DEVI void phase_g4(const P& p, unsigned char* lds) {
  const int Gh = (int)gridDim.x >> 1, grp = (int)blockIdx.x / Gh, c = (int)blockIdx.x % Gh;
  if (grp == 0) { EpiMix<3> E{(bfraw*)(p.ws + O_QC), nullptr, nullptr, nullptr}; run8(lds, (const bfraw*)(p.ws + O_V), (const bfraw*)(p.ws + O_WA), 8192, 1024, 1024, E, Gh, c); }
  else if (grp == 1) { EpiMix<3> E{(bfraw*)(p.ws + O_KC), nullptr, nullptr, nullptr}; run8(lds, (const bfraw*)(p.ws + O_GVS), (const bfraw*)(p.ws + O_WB), 8192, 1024, 1024, E, Gh, c); }
}

DEVI void phase_addmix(const P& p, int hb) {
  const uint4* t1 = (const uint4*)(p.ws + O_QC);
  const uint4* t2 = (const uint4*)(p.ws + O_KC);
  uint4* dst = (uint4*)(p.ws + (hb == 0 ? O_W1IN : O_QC));
  const int tid = ltid();
  for (int i = blockIdx.x * NTHR + tid; i < 8192 * 128; i += gridDim.x * NTHR) {
    const uint4 a = t1[i], b = t2[i];
    const unsigned aw[4] = {a.x, a.y, a.z, a.w}, bw[4] = {b.x, b.y, b.z, b.w}; unsigned o[4];
#pragma unroll
    for (int e = 0; e < 4; ++e) o[e] = (unsigned)f2bf(bf2f((bfraw)(aw[e] & 0xffff)) + bf2f((bfraw)(bw[e] & 0xffff))) | ((unsigned)f2bf(bf2f((bfraw)(aw[e] >> 16)) + bf2f((bfraw)(bw[e] >> 16))) << 16);
    dst[i] = uint4{o[0], o[1], o[2], o[3]};
  }
}

DEVI void phase_g5(const P& p, unsigned char* lds) {
  const int Gh = (int)gridDim.x >> 1, grp = (int)blockIdx.x / Gh, c = (int)blockIdx.x % Gh;
  EpiResid E{p.out, (const float*)(p.ws + O_MODS), grp * 8192, 5, 1.f, -1};
  if (grp < 2) run8(lds, (const bfraw*)(p.ws + (grp == 0 ? O_W1IN : O_QC)), (const bfraw*)(p.ws + O_WO), 8192, 1024, 1024, E, Gh, c);
}

DEVI void phase_cv(const P& p, int hb) {
  const int tid = ltid(), lane = tid & 63, wid = tid >> 6;
  const bfraw* qraw = (const bfraw*)(p.ws + O_QRAW);
  const bfraw* kraw = (const bfraw*)(p.ws + O_KRAW);
  const bfraw* craw = (const bfraw*)(p.ws + O_CTXRAW) + (size_t)hb * 256 * 3072;
  bfraw* qc = (bfraw*)(p.ws + O_QC);
  bfraw* kc = (bfraw*)(p.ws + O_KC);
  bfraw* vv = (bfraw*)(p.ws + O_V);
  const bfraw* gvs = (const bfraw*)(p.ws + O_GVS);
  float* rsb = (float*)(p.ws + O_RS);
  const float* cw = p.in[I_CONVW];
  const float* cb = p.in[I_CONVB];
  for (int task = blockIdx.x * 8 + wid; task < 1056 * 4; task += gridDim.x * 8) {
    const int sidx = task >> 2, part = task & 3, isk = part >> 1;
    const bool lat = sidx < 1024;
    const int lr0 = (lat ? sidx : sidx - 1024) * 8, len = lat ? 8192 : 256, orow0 = sidx * 8;
    const bfraw* src = lat ? (isk ? kraw : qraw) : (craw + isk * 1024);
    const size_t ld = lat ? 1024 : 3072;
    const int ch = (part & 1) * 512 + lane * 8, wch = isk * 1024 + ch;
    float w0[8], w1[8], w2[8], bb[8];
#pragma unroll
    for (int e = 0; e < 8; e += 4) {
      float4 a = ld4(cw + wch + e), b = ld4(cw + 2048 + wch + e), c4 = ld4(cw + 4096 + wch + e), d = ld4(cb + wch + e);
      w0[e] = a.x; w0[e + 1] = a.y; w0[e + 2] = a.z; w0[e + 3] = a.w; w1[e] = b.x; w1[e + 1] = b.y; w1[e + 2] = b.z; w1[e + 3] = b.w;
      w2[e] = c4.x; w2[e + 1] = c4.y; w2[e + 2] = c4.z; w2[e + 3] = c4.w; bb[e] = d.x; bb[e + 1] = d.y; bb[e + 2] = d.z; bb[e + 3] = d.w;
    }
    uint4 rw[10];
#pragma unroll
    for (int i = 0; i < 10; ++i) { const int lr = lr0 - 1 + i; uint4 t = {0u, 0u, 0u, 0u}; if (lr >= 0 && lr < len) t = *(const uint4*)(src + (size_t)lr * ld + ch); rw[i] = t; }
    const float osc = isk ? 1.f : 0.0625f;
    bfraw* dst = (isk ? kc : qc) + (size_t)orow0 * 1024 + ch;
#pragma unroll
    for (int i = 0; i < 8; ++i) {
      const unsigned av[4] = {rw[i].x, rw[i].y, rw[i].z, rw[i].w}, bv[4] = {rw[i + 1].x, rw[i + 1].y, rw[i + 1].z, rw[i + 1].w}, cv[4] = {rw[i + 2].x, rw[i + 2].y, rw[i + 2].z, rw[i + 2].w};
      unsigned ov[4];
#pragma unroll
      for (int e = 0; e < 4; ++e) {
        const float y0 = bf2f((bfraw)(av[e] & 0xffff)) * w0[2 * e] + bf2f((bfraw)(bv[e] & 0xffff)) * w1[2 * e] + bf2f((bfraw)(cv[e] & 0xffff)) * w2[2 * e] + bb[2 * e];
        const float y1 = bf2f((bfraw)(av[e] >> 16)) * w0[2 * e + 1] + bf2f((bfraw)(bv[e] >> 16)) * w1[2 * e + 1] + bf2f((bfraw)(cv[e] >> 16)) * w2[2 * e + 1] + bb[2 * e + 1];
        ov[e] = (unsigned)f2bf(siluf_(y0) * osc) | ((unsigned)f2bf(siluf_(y1) * osc) << 16);
      }
      *(uint4*)(dst + (size_t)i * 1024) = uint4{ov[0], ov[1], ov[2], ov[3]};
    }
  }
  for (int row = blockIdx.x * 8 + wid; row < 8448; row += gridDim.x * 8) {
    if (row < 8192) {
      float ss = 0;
#pragma unroll
      for (int hlf = 0; hlf < 2; ++hlf) {
        uint4 g = *(const uint4*)(gvs + (size_t)row * 1024 + hlf * 512 + lane * 8);
        unsigned gv[4] = {g.x, g.y, g.z, g.w};
#pragma unroll
        for (int e = 0; e < 4; ++e) { float a = bf2f((bfraw)(gv[e] & 0xffff)), b = bf2f((bfraw)(gv[e] >> 16)); ss += a * a + b * b; }
      }
      ss = wave_sum(ss);
      if (lane == 0) rsb[row] = rsqrtf(ss * (1.f / 1024.f) + EPS);
    } else {
#pragma unroll
      for (int hlf = 0; hlf < 2; ++hlf)
        *(uint4*)(vv + (size_t)row * 1024 + hlf * 512 + lane * 8) = *(const uint4*)(craw + 2048 + (size_t)(row - 8192) * 3072 + hlf * 512 + lane * 8);
    }
  }
}

DEVI void phase_ma(const P& p, unsigned char* lds, int hb) {
  const int tid = ltid();
  bfraw* st = (bfraw*)lds;
  float* sc = (float*)(lds + 131072);
  float* s_w = sc + 128, *s_ws = sc + 256, *s_red = sc + 384, *s_part = sc + 512;
  const float* bg = p.in[I_BGATES];
  for (int item = blockIdx.x; item < 528 + 256; item += gridDim.x) {
    unsigned char* wsb = lws(p.ws);
    const float* gates = (const float*)(wsb + O_GATES);
    const bfraw* kc = (const bfraw*)(wsb + O_KC);
    const bfraw* vv = (const bfraw*)(wsb + O_V);
    bfraw* states = (bfraw*)(wsb + O_ST);
    float* nloc = (float*)(wsb + O_NLOC);
    float* mg = (float*)(wsb + O_MG);
    if (item < 528) {
      const int seq = item / 66, j = item % 66, d = seq >> 2, h = seq & 3;
      int rbase, grow;
      if (j < 2) { int cc = d == 0 ? j : 1 - j; rbase = 8192 + cc * 128; grow = 16384 + hb * 256 + cc * 128; }
      else { int c = d == 0 ? j - 2 : 65 - j; rbase = c * 128; grow = hb * 8192 + c * 128; }
      __syncthreads();
      const int el = d == 0 ? (tid & 127) : 127 - (tid & 127);
      float li = 0.f, lf = 0.f;
      if (tid < 128) {
        li = gates[(size_t)(grow + el) * 16 + d * 8 + h] + bg[d * 8 + h];
        lf = logsigf_(gates[(size_t)(grow + el) * 16 + d * 8 + 4 + h] + bg[d * 8 + 4 + h]);
      }
      const float bcum = seg_scan_sum(lf, tid, s_red + 4);
      if (tid == 127) s_red[1] = bcum;
      __syncthreads();
      const float gtot = s_red[1];
      const float wv = gtot - bcum + li;
      if (tid < 128) s_w[el] = wv;
      __syncthreads();
      if (tid < 64) {
        float m = fmaxf(s_w[tid], s_w[tid + 64]);
#pragma unroll
        for (int o = 32; o > 0; o >>= 1) m = fmaxf(m, __shfl_xor(m, o, 64));
        if (tid == 0) s_red[0] = m;
      }
      __syncthreads();
      const float mloc = s_red[0];
      if (tid < 128) s_ws[el] = expf(wv - mloc);
      if (tid == 0) { mg[seq * 66 + j] = mloc; mg[528 + seq * 66 + j] = gtot; }
      __syncthreads();
      {
        const int k = tid & 255, part = tid >> 8;
        const bfraw* kp0 = kc + (size_t)(rbase + part * 64) * 1024 + h * 256 + k;
        float n = 0;
#pragma unroll 16
        for (int t = 0; t < 64; ++t) n += s_ws[part * 64 + t] * bf2f(kp0[(size_t)t * 1024]);
        s_part[tid] = n;
      }
      bfraw* dst = states + (size_t)(seq * 66 + j) * 65536;
      {
        f32x4 acc[8][4]; ZERO_ACC(acc, 8, 4);
        gemm_tile<256, 256, true, true, false>(vv + (size_t)rbase * 1024 + h * 256, 1024, kc + (size_t)rbase * 1024 + h * 256, 1024, 128, s_ws, acc, st, nullptr, 0);
        EPI_BEGIN(256, 256)
          dst[row * 256 + col] = f2bf(acc[i][j][r]);
        EPI_END
      }
      if (tid < 256) nloc[(size_t)(seq * 66 + j) * 256 + tid] = s_part[tid] + s_part[tid + 256];
    } else {
      const int it = item - 528, c = it >> 2, g = it & 3;
      bfraw* gvs = (bfraw*)(wsb + O_GVS);
      const float* rsb = (const float*)(wsb + O_RS);
      f32x4 acc[4][4]; ZERO_ACC(acc, 4, 4);
      gemm_tile<128, 256, false, true, false>((const bfraw*)(wsb + O_WSB) + g * 16384, 128, gvs + (size_t)c * 128 * 1024 + g * 256, 1024, 128, rsb + c * 128, acc, st, nullptr, 0);
      const float* gs = p.in[I_GSGU] + g * 256;
      const float* bs = p.in[I_BS] + g * 128;
      EPI_BEGIN(128, 256)
        gvs[(size_t)(c * 128 + row) * 1024 + g * 256 + col] = f2bf(gs[col] * acc[i][j][r] + bs[row]);
      EPI_END
    }
  }
}

DEVI void phase_mb(const P& p, unsigned char* lds) {
  bfraw* states = (bfraw*)(p.ws + O_ST);
  const float* mg = (const float*)(p.ws + O_MG);
  float* ment = (float*)(p.ws + O_MG) + 1056;
  const float* nloc = (const float*)(p.ws + O_NLOC);
  float* nent = (float*)(p.ws + O_NENT);
  const int gid = blockIdx.x * NTHR + ltid(), gsz = gridDim.x * NTHR;
  float* s_dec = (float*)lds, *s_scl = s_dec + 528;
  __syncthreads();
  if (ltid() < 8) {
    const int seq = ltid(); float m = 0;
    for (int j = 0; j < 66; ++j) {
      const float mloc = mg[seq * 66 + j], g = mg[528 + seq * 66 + j];
      const float mnew = fmaxf(g + m, mloc);
      s_dec[seq * 66 + j] = expf(g + m - mnew); s_scl[seq * 66 + j] = expf(mloc - mnew);
      if (blockIdx.x == 0) ment[seq * 66 + j] = m;
      m = mnew;
    }
  }
  __syncthreads();
  for (int id = gid; id < 8 * 16384; id += gsz) {
    const int seq = id >> 14, e = (id & 16383) * 4;
    float s0 = 0, s1 = 0, s2 = 0, s3 = 0;
    bfraw* base = states + (size_t)seq * 66 * 65536 + e;
#pragma unroll 1
    for (int cb = 0; cb < 66; cb += 22) {
      uint2 buf[22];
#pragma unroll
      for (int i = 0; i < 22; ++i) buf[i] = *(const uint2*)(base + (size_t)(cb + i) * 65536);
#pragma unroll
      for (int i = 0; i < 22; ++i) {
        const int j = cb + i; const uint2 cur = buf[i];
        const float dec = s_dec[seq * 66 + j], scl = s_scl[seq * 66 + j];
        if (j >= 2) { uint2 o; o.x = (unsigned)f2bf(s0) | ((unsigned)f2bf(s1) << 16); o.y = (unsigned)f2bf(s2) | ((unsigned)f2bf(s3) << 16);
          *(uint2*)(base + (size_t)j * 65536) = o; }
        s0 = dec * s0 + scl * bf2f((bfraw)(cur.x & 0xffff)); s1 = dec * s1 + scl * bf2f((bfraw)(cur.x >> 16));
        s2 = dec * s2 + scl * bf2f((bfraw)(cur.y & 0xffff)); s3 = dec * s3 + scl * bf2f((bfraw)(cur.y >> 16));
      }
    }
  }
  for (int id = gid; id < 8 * 256; id += gsz) {
    const int seq = id >> 8, k = id & 255;
    float n = 0;
    for (int j = 0; j < 66; ++j) {
      nent[(size_t)(seq * 66 + j) * 256 + k] = n;
      n = s_dec[seq * 66 + j] * n + s_scl[seq * 66 + j] * nloc[(size_t)(seq * 66 + j) * 256 + k];
    }
  }
}

DEVI void phase_mc(const P& p, unsigned char* lds, int hb) {
  const int tid = ltid(), lane = tid & 63, wid = tid >> 6, wm = wid >> 2, wn = wid & 3, fr = lane & 15, fq = lane >> 4;
  bfraw* st = (bfraw*)lds;
  bfraw* sS = (bfraw*)(lds + 61440);
  float* sc = (float*)(lds + 131072);
  float* s_b = sc, *s_u = sc + 256, *s_mt = sc + 512, *s_in = sc + 768, *s_den = sc + 1024, *s_dq = sc + 1280, *s_tmp = sc + 1536;
  float* s_sum = sc + 1792, *s_sq = sc + 1920;
  const float* bg = p.in[I_BGATES];
  for (int item = blockIdx.x; item < 256; item += gridDim.x) {
    unsigned char* wsb = lws(p.ws);
    const float* gates = (const float*)(wsb + O_GATES);
    const bfraw* qc = (const bfraw*)(wsb + O_QC);
    const bfraw* kc = (const bfraw*)(wsb + O_KC);
    bfraw* vv = (bfraw*)(wsb + O_V);
    const bfraw* states = (const bfraw*)(wsb + O_ST);
    const float* ment = (const float*)(wsb + O_MG) + 1056;
    const float* nent = (const float*)(wsb + O_NENT);
    const int c = item >> 2, h = item & 3, R0 = c * 128;
    const bfraw* qp = qc + (size_t)R0 * 1024 + h * 256;
    const bfraw* kp = kc + (size_t)R0 * 1024 + h * 256;
    __syncthreads();
    {
      const int d = (tid >> 7) & 1, t = tid & 127, el = d == 0 ? t : 127 - t, ix = d * 128 + el;
      float li = 0.f, lf = 0.f;
      if (tid < 256) {
        const size_t grow = (size_t)hb * 8192 + R0 + el;
        li = gates[grow * 16 + d * 8 + h] + bg[d * 8 + h];
        lf = logsigf_(gates[grow * 16 + d * 8 + 4 + h] + bg[d * 8 + 4 + h]);
        s_den[tid] = 0.f;
        if (tid < 128) { s_sum[tid] = 0.f; s_sq[tid] = 0.f; }
      }
      const float b = seg_scan_sum(lf, tid, s_tmp);
      const float uu = li - b;
      const float pm = seg_scan_max(tid < 256 ? uu : -INFINITY, tid, s_tmp);
      if (tid < 256) {
        const int seq = d * 4 + h, j = d == 0 ? c + 2 : 65 - c;
        const float mst = ment[seq * 66 + j];
        const float a = b + mst;
        const float mt = fmaxf(a, b + pm);
        s_b[ix] = b; s_u[ix] = uu; s_mt[ix] = mt; s_in[ix] = expf(a - mt);
      }
    }
    {
      const int row = tid >> 2, part = tid & 3;
      const uint4* q4 = (const uint4*)(qp + (size_t)row * 1024 + part * 64);
      const float4* nf4 = (const float4*)(nent + (size_t)((0 + h) * 66 + (c + 2)) * 256 + part * 64);
      const float4* nb4 = (const float4*)(nent + (size_t)((4 + h) * 66 + (65 - c)) * 256 + part * 64);
      uint4 qv[8];
#pragma unroll
      for (int i = 0; i < 8; ++i) qv[i] = q4[i];
      float af = 0, ab = 0;
#pragma unroll
      for (int i = 0; i < 8; ++i) {
        const float4 f0 = nf4[2 * i], f1 = nf4[2 * i + 1], b0 = nb4[2 * i], b1 = nb4[2 * i + 1];
        const float q0 = bf2f((bfraw)(qv[i].x & 0xffff)), q1 = bf2f((bfraw)(qv[i].x >> 16)), q2 = bf2f((bfraw)(qv[i].y & 0xffff)), q3 = bf2f((bfraw)(qv[i].y >> 16));
        const float q4_ = bf2f((bfraw)(qv[i].z & 0xffff)), q5 = bf2f((bfraw)(qv[i].z >> 16)), q6 = bf2f((bfraw)(qv[i].w & 0xffff)), q7 = bf2f((bfraw)(qv[i].w >> 16));
        af += q0 * f0.x + q1 * f0.y + q2 * f0.z + q3 * f0.w + q4_ * f1.x + q5 * f1.y + q6 * f1.z + q7 * f1.w;
        ab += q0 * b0.x + q1 * b0.y + q2 * b0.z + q3 * b0.w + q4_ * b1.x + q5 * b1.y + q6 * b1.z + q7 * b1.w;
      }
      af += __shfl_xor(af, 1, 64); af += __shfl_xor(af, 2, 64);
      ab += __shfl_xor(ab, 1, 64); ab += __shfl_xor(ab, 2, 64);
      if (part == 0) { s_dq[row] = af; s_dq[128 + row] = ab; }
    }
    __syncthreads();
    {
      f32x4 S[4][2]; ZERO_ACC(S, 4, 2);
      gemm_tile<128, 128, false, false, false>(qp, 1024, kp, 1024, 256, nullptr, S, st, nullptr, 0);
#pragma unroll 1
      for (int d = 0; d < 2; ++d)
#pragma unroll
        for (int i = 0; i < 4; ++i)
#pragma unroll
          for (int r = 0; r < 4; ++r) {
            const int row = wm * 64 + i * 16 + fq * 4 + r;
            const float bt = s_b[d * 128 + row] - s_mt[d * 128 + row];
            float rs = 0;
#pragma unroll
            for (int j = 0; j < 2; ++j) {
              const int col = wn * 32 + j * 16 + fr;
              const bool valid = d == 0 ? (col <= row) : (col >= row);
              const float val = valid ? S[i][j][r] * fexp(bt + s_u[d * 128 + col]) : 0.f;
              rs += val;
              sS[(d * 128 + row) * 136 + col] = f2bf(val);
            }
            rs = red16(rs);
            if (fr == 0) atomicAdd(&s_den[d * 128 + row], rs);
          }
    }
    __syncthreads();
    f32x4 hs[4][4];
    uint4* hpark = (uint4*)(wsb + O_HPARK) + ((size_t)item * NTHR + tid) * 8;
#pragma unroll 1
    for (int d = 0; d < 2; ++d) {
      f32x4 (&acc)[4][4] = hs; ZERO_ACC(acc, 4, 4);
      const int seq = d * 4 + h, j2 = d == 0 ? c + 2 : 65 - c;
      gemm_tile<128, 256, false, false, false>(qp, 1024, states + (size_t)(seq * 66 + j2) * 65536, 256, 256, nullptr, acc, st, nullptr, 0);
      EPIR_BEGIN(128, 256)
        const float sin_ = s_in[d * 128 + row];
        EPIR_COLS(256) acc[i][j][r] *= sin_; (void)col;
      EPIR_END
      gemm_tile<128, 256, false, true, true>(nullptr, 0, vv + (size_t)R0 * 1024 + h * 256, 1024, 128, nullptr, acc, st, sS + d * 128 * 136, 136);
      EPIR_BEGIN(128, 256)
        const float den = s_den[d * 128 + row] + s_in[d * 128 + row] * s_dq[d * 128 + row];
        const float inv = 1.f / fmaxf(fabsf(den), expf(-s_mt[d * 128 + row]));
        EPIR_COLS(256) acc[i][j][r] *= inv; (void)col;
      EPIR_END
      if (d == 0) {
#pragma unroll
        for (int i = 0; i < 4; ++i) {
          uint4 w0, w1;
          w0.x = (unsigned)f2bf(acc[i][0][0]) | ((unsigned)f2bf(acc[i][0][1]) << 16); w0.y = (unsigned)f2bf(acc[i][0][2]) | ((unsigned)f2bf(acc[i][0][3]) << 16);
          w0.z = (unsigned)f2bf(acc[i][1][0]) | ((unsigned)f2bf(acc[i][1][1]) << 16); w0.w = (unsigned)f2bf(acc[i][1][2]) | ((unsigned)f2bf(acc[i][1][3]) << 16);
          w1.x = (unsigned)f2bf(acc[i][2][0]) | ((unsigned)f2bf(acc[i][2][1]) << 16); w1.y = (unsigned)f2bf(acc[i][2][2]) | ((unsigned)f2bf(acc[i][2][3]) << 16);
          w1.z = (unsigned)f2bf(acc[i][3][0]) | ((unsigned)f2bf(acc[i][3][1]) << 16); w1.w = (unsigned)f2bf(acc[i][3][2]) | ((unsigned)f2bf(acc[i][3][3]) << 16);
          hpark[2 * i] = w0; hpark[2 * i + 1] = w1;
        }
      } else {
#pragma unroll
        for (int i = 0; i < 4; ++i) {
          const uint4 w0 = hpark[2 * i], w1 = hpark[2 * i + 1];
          const unsigned ww[8] = {w0.x, w0.y, w0.z, w0.w, w1.x, w1.y, w1.z, w1.w};
#pragma unroll
          for (int j = 0; j < 4; ++j) {
            hs[i][j][0] += bf2f((bfraw)(ww[2 * j] & 0xffff)); hs[i][j][1] += bf2f((bfraw)(ww[2 * j] >> 16));
            hs[i][j][2] += bf2f((bfraw)(ww[2 * j + 1] & 0xffff)); hs[i][j][3] += bf2f((bfraw)(ww[2 * j + 1] >> 16));
          }
        }
      }
    }
#pragma unroll
    for (int i = 0; i < 4; ++i)
#pragma unroll
      for (int r = 0; r < 4; ++r) {
        float ps = hs[i][0][r] + hs[i][1][r] + hs[i][2][r] + hs[i][3][r];
        ps = red16(ps);
        if (fr == 0) atomicAdd(&s_sum[wm * 64 + i * 16 + fq * 4 + r], ps);
      }
    __syncthreads();
#pragma unroll
    for (int i = 0; i < 4; ++i)
#pragma unroll
      for (int r = 0; r < 4; ++r) {
        const float mu = s_sum[wm * 64 + i * 16 + fq * 4 + r] * (1.f / 256.f);
        float ps = 0;
#pragma unroll
        for (int j = 0; j < 4; ++j) { float dlt = hs[i][j][r] - mu; ps += dlt * dlt; }
        ps = red16(ps);
        if (fr == 0) atomicAdd(&s_sq[wm * 64 + i * 16 + fq * 4 + r], ps);
      }
    __syncthreads();
    const float* gh = p.in[I_GHEAD] + h * 256;
    EPIR_BEGIN(128, 256)
      const float mu = s_sum[row] * (1.f / 256.f);
      const float rstd = rsqrtf(s_sq[row] * (1.f / 256.f) + EPS);
      EPIR_COLS(256)
        vv[(size_t)(R0 + row) * 1024 + h * 256 + col] = f2bf((hs[i][j][r] - mu) * rstd * gh[col]);
    EPIR_END
  }
}

constexpr int NPH = 28;
#define PHASE_PROGRAM \
  PHASE(0, phase_p0(p, lds)) \
  PHASE(1, phase_p0b(p)) \
  PHASE(2, phase_rows<1>(p, lds)) \
  PHASE(3, phase_ffn_in(p, lds, O_W1IN, 16896)) \
  PHASE(4, phase_ffn_out(p, lds, O_W1OUT, 2, true)) \
  PHASE(5, phase_r2_g2c(p, lds)) \
  PHASE(6, phase_rows<2>(p, lds, 16384, 16896)) \
  PHASE(7, phase_g3c(p, lds)) \
  PHASE(8, phase_g3a(p, lds, 0)) \
  PHASE(9, phase_cv(p, 0)) \
  PHASE(10, phase_ma(p, lds, 0)) \
  PHASE(11, phase_mb(p, lds)) \
  PHASE(12, phase_mc(p, lds, 0)) \
  PHASE(13, phase_g3b(p, lds, 0)) \
  PHASE(14, phase_g4(p, lds)) \
  PHASE(15, phase_addmix(p, 0); __syncthreads(); phase_g3a(p, lds, 1)) \
  PHASE(16, phase_cv(p, 1)) \
  PHASE(17, phase_ma(p, lds, 1)) \
  PHASE(18, phase_mb(p, lds)) \
  PHASE(19, phase_mc(p, lds, 1)) \
  PHASE(20, phase_g3b(p, lds, 1)) \
  PHASE(21, phase_g4(p, lds)) \
  PHASE(22, phase_addmix(p, 1)) \
  PHASE(23, phase_g5(p, lds)) \
  PHASE(24, phase_rows<3>(p, lds)) \
  PHASE(25, phase_ffn_in(p, lds, O_W2IN, 16384)) \
  PHASE(26, phase_ffn_out(p, lds, O_W2OUT, 8, false)) \
  PHASE(27, phase_rows<4>(p, lds))

#if !MULTI_LAUNCH
#ifndef USE_CG
#define USE_CG 0
#endif
#if USE_CG
#define PHASE(n, call) if (lo <= (n) && (n) < hi) { if ((n) > lo) { if ((n) == 1) grid.sync(); else xcd_barrier(xbar); } call; }
#else
#define PHASE(n, call) if (lo <= (n) && (n) < hi) { if ((n) > lo) xcd_barrier(xbar); call; }
#endif
__global__ void __launch_bounds__(512) mk(P p, int lo, int hi) {
  extern __shared__ __attribute__((aligned(16))) unsigned char lds[];
#if USE_CG
  cg::grid_group grid = cg::this_grid();
#endif
  volatile LAS unsigned* stw = (volatile LAS unsigned*)(lds + LDS_BYTES - 16);
  if (threadIdx.x == 0) { stw[0] = 0u; stw[1] = 0u; stw[2] = 0u; stw[3] = 0u; }
  __syncthreads();
  XcdBarrier xbar = xcd_barrier_post((unsigned*)(p.ws + O_BAR), stw);
  PHASE_PROGRAM
}
#undef PHASE
#else
#define PHASE(n, call) if constexpr (PH == (n)) { call; }
template <int PH>
__global__ void __launch_bounds__(512) mkp(P p) {
  extern __shared__ __attribute__((aligned(16))) unsigned char lds[];
  PHASE_PROGRAM
}
#undef PHASE
template <int PH> static void launch_all(const P& p, int grid, hipStream_t stream) {
  if constexpr (PH < NPH) {
    (void)hipFuncSetAttribute((const void*)mkp<PH>, hipFuncAttributeMaxDynamicSharedMemorySize, LDS_BYTES);
    hipLaunchKernelGGL(mkp<PH>, dim3(grid), dim3(NTHR), LDS_BYTES, stream, p);
    launch_all<PH + 1>(p, grid, stream);
  }
}
#endif

extern "C" void kernel_launch(void* const* d_in, const int* in_sizes, int n_in, void* d_out, int out_size, void* d_ws, size_t ws_size, hipStream_t stream) {
  static int grid_blocks = 0;
  if (!grid_blocks) {
    if (n_in != 25 || ws_size < O_END || ws_size < O_ACT + 16896ull * 2816 * 2) { fprintf(stderr, "kernel_launch: unexpected n_in %d / ws %zu\n", n_in, ws_size); grid_blocks = -1; return; }
    int dev = 0, cus = 0, per_cu = 0;
    (void)hipGetDevice(&dev);
    (void)hipDeviceGetAttribute(&cus, hipDeviceAttributeMultiprocessorCount, dev);
#if !MULTI_LAUNCH
    if (hipFuncSetAttribute((const void*)mk, hipFuncAttributeMaxDynamicSharedMemorySize, LDS_BYTES) != hipSuccess) { fprintf(stderr, "hipFuncSetAttribute failed\n"); grid_blocks = -1; return; }
    if (hipOccupancyMaxActiveBlocksPerMultiprocessor(&per_cu, (const void*)mk, NTHR, LDS_BYTES) != hipSuccess || per_cu < 1) { fprintf(stderr, "occupancy query failed (%d)\n", per_cu); grid_blocks = -1; return; }
#endif
    grid_blocks = cus * 1;
    fprintf(stderr, "kernel_launch: cus %d per_cu %d grid %d\n", cus, per_cu, grid_blocks);
  }
  if (grid_blocks < 0) return;
  P p{};
  for (int i = 0; i < 25; ++i) p.in[i] = (const float*)d_in[i];
  p.out = (float*)d_out; p.ws = (unsigned char*)d_ws;
#if MULTI_LAUNCH
  launch_all<0>(p, grid_blocks, stream);
#else
  int lo = 0, hi = NPH;
  if (hipMemsetAsync((unsigned char*)d_ws + O_BAR, 0, 16384, stream) != hipSuccess) { fprintf(stderr, "memset of barrier words failed\n"); return; }
  void* args[] = {&p, &lo, &hi};
#ifdef PROBE_K
  {
    hipLaunchKernelGGL(mk, dim3(grid_blocks), dim3(NTHR), LDS_BYTES, stream, p, 0, PROBE_K + 1);
    (void)hipMemsetAsync((unsigned char*)d_ws + O_BAR, 0, 16384, stream);
  }
#endif
#if USE_CG
  hipError_t e = hipLaunchCooperativeKernel((const void*)mk, dim3(grid_blocks), dim3(NTHR), args, LDS_BYTES, stream);
#else
  (void)args;
  hipLaunchKernelGGL(mk, dim3(grid_blocks), dim3(NTHR), LDS_BYTES, stream, p, lo, hi);
  hipError_t e = hipPeekAtLastError();
#endif
  if (e != hipSuccess) fprintf(stderr, "cooperative launch failed: %s (grid %d)\n", hipGetErrorString(e), grid_blocks);
#endif
}
```

```cpp
#include <hip/hip_runtime.h>
#include <hip/hip_cooperative_groups.h>
#include <cstdio>
#include <cstdint>
namespace cg = cooperative_groups;

#ifndef MULTI_LAUNCH
#define MULTI_LAUNCH 0
#endif

typedef unsigned short bfraw;
typedef __attribute__((ext_vector_type(8))) short bf16x8;
typedef __attribute__((ext_vector_type(4))) float f32x4;
#define DEVI __device__ __forceinline__

constexpr int NTHR = 512;
constexpr int GBM = 128;
constexpr int LROW = 40;
constexpr int LDS_BYTES = 143360;
constexpr float EPS = 1e-6f;

enum { I_X, I_C, I_CTX, I_CCTX, I_WADA, I_BADA, I_GFFN1, I_W1IN, I_W1OUT, I_GMIX, I_WIN, I_BGATES, I_CONVW, I_CONVB,
       I_GHEAD, I_GSGU, I_WS, I_BS, I_WA, I_WB, I_WO, I_GFFN2, I_W2IN, I_W2OUT, I_GFINAL };

struct P { const float* in[25]; float* out; unsigned char* ws; };

constexpr size_t O_W1IN  = 0;
constexpr size_t O_W1OUT = O_W1IN  + 5632ull * 1024 * 2;
constexpr size_t O_WTA   = O_W1OUT + 1024ull * 2816 * 2;
constexpr size_t O_WTB   = O_WTA   + 4096ull * 1024 * 2;
constexpr size_t O_WA    = O_WTB   + 4096ull * 1024 * 2;
constexpr size_t O_WB    = O_WA    + 1024ull * 1024 * 2;
constexpr size_t O_WO    = O_WB    + 1024ull * 1024 * 2;
constexpr size_t O_W2IN  = O_WO    + 1024ull * 1024 * 2;
constexpr size_t O_W2OUT = O_W2IN  + 5632ull * 1024 * 2;
constexpr size_t O_WSB   = O_W2OUT + 1024ull * 2816 * 2;
constexpr size_t O_MODSP = O_WSB   + 4ull * 128 * 128 * 2;
constexpr size_t O_MODS  = O_MODSP + 16ull * 3 * 9216 * 4;
constexpr size_t O_HCTX  = O_MODS  + 3ull * 9216 * 4;
constexpr size_t O_HN    = O_HCTX  + 512ull * 1024 * 4;
constexpr size_t O_GATES = O_HN    + 16896ull * 1024 * 2;
constexpr size_t O_CTXRAW= O_GATES + 16896ull * 16 * 4;
constexpr size_t O_BIG   = O_CTXRAW+ 2ull * 256 * 3072 * 2;
constexpr size_t O_ACT   = O_BIG;
constexpr size_t O_ST    = O_BIG;
constexpr size_t O_QRAW  = O_BIG;
constexpr size_t O_KRAW  = O_QRAW  + 8448ull * 1024 * 2;
constexpr size_t O_V     = O_ST    + 8ull * 66 * 131072;
constexpr size_t O_GVS   = O_V     + 8448ull * 1024 * 2;
constexpr size_t O_QC    = O_GVS   + 8192ull * 1024 * 2;
constexpr size_t O_KC    = O_QC    + 8448ull * 1024 * 2;
constexpr size_t O_NLOC  = O_KC    + 8448ull * 1024 * 2;
constexpr size_t O_NENT  = O_NLOC  + 8ull * 66 * 256 * 4;
constexpr size_t O_MG    = O_NENT  + 8ull * 66 * 256 * 4;
constexpr size_t O_RS    = O_MG    + 8192;
constexpr size_t O_HPARK = O_RS    + 8192ull * 4;
constexpr size_t O_BAR   = O_HPARK + 8192ull * 1024 * 2;
constexpr size_t O_END   = O_BAR + 16384;
static_assert(O_ACT + 16896ull * 2816 * 2 <= 268435456ull, "ws");
static_assert(O_END <= 268435456ull, "ws");
static_assert(O_KRAW + 8448ull * 1024 * 2 <= O_V, "overlay");

DEVI int ltid() { int t = __builtin_amdgcn_workitem_id_x(); asm volatile("" : "+v"(t)); return t; }
DEVI unsigned char* lws(unsigned char* w) { asm volatile("" : "+s"(w)); return w; }
DEVI float4 ld4(const float* p);
DEVI bfraw f2bf(float f) { unsigned u = __float_as_uint(f); u += 0x7fffu + ((u >> 16) & 1u); return (bfraw)(u >> 16); }
DEVI float bf2f(bfraw h) { return __uint_as_float(((unsigned)h) << 16); }
DEVI float fexp(float x) { return __builtin_amdgcn_exp2f(x * 1.4426950408889634f); }
DEVI float sigmoidf_(float x) { return __builtin_amdgcn_rcpf(1.f + fexp(-x)); }
DEVI float siluf_(float x) { return x * sigmoidf_(x); }
DEVI float geluf_(float x) { return x * sigmoidf_(1.5957691216057308f * (x + 0.044715f * x * x * x)); }
DEVI float logsigf_(float x) { return fminf(x, 0.f) - log1pf(expf(-fabsf(x))); }
DEVI float wave_sum(float v) {
#pragma unroll
  for (int o = 32; o > 0; o >>= 1) v += __shfl_xor(v, o, 64);
  return v;
}
DEVI float red16(float v) {
  v += __shfl_xor(v, 1, 64); v += __shfl_xor(v, 2, 64); v += __shfl_xor(v, 4, 64); v += __shfl_xor(v, 8, 64);
  return v;
}
DEVI float redsin(float a, bool cosine) {
  float k = rintf(a * 0.15915494309189535f);
  float r = fmaf(-k, 6.2831854820251465f, a);
  r = fmaf(-k, -1.7484555e-7f, r);
  return cosine ? __cosf(r) : __sinf(r);
}


DEVI float seg_scan_sum(float v, int tid, float* s_x) {
  const int lane = tid & 63;
#pragma unroll
  for (int o = 1; o < 64; o <<= 1) { float t = __shfl_up(v, o, 64); if (lane >= o) v += t; }
  if (lane == 63 && tid < 256) s_x[tid >> 6] = v;
  __syncthreads();
  if (tid < 256 && ((tid >> 6) & 1)) v += s_x[(tid >> 6) - 1];
  __syncthreads();
  return v;
}
DEVI float seg_scan_max(float v, int tid, float* s_x) {
  const int lane = tid & 63;
#pragma unroll
  for (int o = 1; o < 64; o <<= 1) { float t = __shfl_up(v, o, 64); if (lane >= o) v = fmaxf(v, t); }
  if (lane == 63 && tid < 256) s_x[tid >> 6] = v;
  __syncthreads();
  if (tid < 256 && ((tid >> 6) & 1)) v = fmaxf(v, s_x[(tid >> 6) - 1]);
  __syncthreads();
  return v;
}

#define XB_TMO      128
#define XB_XCNT(j)  (256  + 64 * (j))
#define XB_XSUB(j)  (1280 + 64 * (j))
#define XB_XGEN(j)  (2304 + 64 * (j))
#define XB_TOP      3328
#define XB_TOPGEN   3392
#define XCD_BAR_WORDS 3456
#define XB_SPIN_CAP (1u << 18)
#define LAS __attribute__((address_space(3)))

__device__ __forceinline__ unsigned xb_ld(unsigned* p)              { return __hip_atomic_load(p, __ATOMIC_RELAXED, __HIP_MEMORY_SCOPE_AGENT); }
__device__ __forceinline__ unsigned xb_add(unsigned* p, unsigned v) { return __hip_atomic_fetch_add(p, v, __ATOMIC_RELAXED, __HIP_MEMORY_SCOPE_AGENT); }
__device__ __forceinline__ unsigned xb_xcc_id() { return (unsigned)__builtin_amdgcn_s_getreg((3 << 11) | 20) & 0xFu; }
#define XB_SPIN(cond, bar) do { unsigned _sp = 0; while (cond) { __builtin_amdgcn_s_sleep(1); \
    if ((++_sp & 255u) == 0u) { if (xb_ld(&(bar)[XB_TMO])) break; if (_sp > XB_SPIN_CAP) { atomicAdd(&(bar)[XB_TMO], 1u); break; } } } } while (0)

struct XcdBarrier {
    unsigned* bar; unsigned x;
    volatile LAS unsigned* st;
};

__device__ __forceinline__ XcdBarrier xcd_barrier_post(unsigned* bar, volatile LAS unsigned* st) {
    XcdBarrier b; b.bar = bar; b.x = xb_xcc_id(); b.st = st;
    if (threadIdx.x == 0) (void)xb_add(&bar[XB_XCNT(b.x)], 1u);
    return b;
}
__device__ __forceinline__ void xcd_barrier_complete(unsigned* bar, unsigned x, unsigned& nloc, unsigned& nx) {
    const unsigned G = gridDim.x * gridDim.y * gridDim.z;
    unsigned sum, cnt, mine, sp = 0u;
    for (;;) {
        sum = 0u; cnt = 0u; mine = 0u;
#pragma unroll
        for (unsigned j = 0; j < 16; ++j) { const unsigned c = xb_ld(&bar[XB_XCNT(j)]); sum += c; cnt += (c > 0u) ? 1u : 0u; mine = (j == x) ? c : mine; }
        if (sum == G) break;
        __builtin_amdgcn_s_sleep(1);
        if ((++sp & 255u) == 0u) { if (xb_ld(&bar[XB_TMO])) break; if (sp > XB_SPIN_CAP) { atomicAdd(&bar[XB_TMO], 1u); break; } }
    }
    nloc = mine > 0u ? mine : 1u; nx = cnt > 0u ? cnt : 1u;
}

__device__ __forceinline__ void xcd_barrier(const XcdBarrier& b) {
    asm volatile("s_waitcnt vmcnt(0)" ::: "memory");
    __syncthreads();
    if (threadIdx.x == 0) {
        unsigned* bar = b.bar;
        __builtin_amdgcn_s_waitcnt(0);
        unsigned nloc = b.st[0], nx = b.st[1];
        if (nloc == 0u) { xcd_barrier_complete(bar, b.x, nloc, nx); b.st[0] = nloc; b.st[1] = nx; }
        const unsigned old = xb_add(&bar[XB_XSUB(b.x)], 1u);
        const unsigned gen = old / nloc;
        if (old + 1u == (gen + 1u) * nloc) {
            __builtin_amdgcn_fence(__ATOMIC_RELEASE, "agent");
            asm volatile("s_waitcnt vmcnt(0)" ::: "memory");
            const unsigned og = xb_add(&bar[XB_TOP], 1u);
            const unsigned tg = og / nx;
            if (og + 1u == (tg + 1u) * nx) xb_add(&bar[XB_TOPGEN], 1u);
            else XB_SPIN(xb_ld(&bar[XB_TOPGEN]) == tg, bar);
            __builtin_amdgcn_fence(__ATOMIC_ACQUIRE, "agent");
            xb_add(&bar[XB_XGEN(b.x)], 1u);
            asm volatile("s_waitcnt vmcnt(0)" ::: "memory");
        } else {
            XB_SPIN(xb_ld(&bar[XB_XGEN(b.x)]) == gen, bar);
            __builtin_amdgcn_fence(__ATOMIC_ACQUIRE, "agent");
            asm volatile("s_waitcnt vmcnt(0)" ::: "memory");
        }
    }
    __syncthreads();
}

template <int BM, int BN, bool ATR, bool BTR, bool ALDS>
DEVI void gemm_tile(const bfraw* __restrict__ A, int lda, const bfraw* __restrict__ B, int ldb, int K,
                    const float* kscale, f32x4 (&acc)[BM / 32][BN / 64], bfraw* st, const bfraw* sAres, int ldres) {
  constexpr int MI = BM / 32, NJ = BN / 64, CA = BM / 128, CB = BN / 128, WM = BM / 2, WN = BN / 4;
  constexpr int STAGE = (ALDS ? BN : (BM + BN)) * LROW;
  int tid_ = ltid();
  const int tid = tid_, lane = tid & 63, wid = tid >> 6, wm = wid >> 2, wn = wid & 3;
  const int fr = lane & 15, fq = lane >> 4;
  uint4 ra0 = {0, 0, 0, 0}, ra1 = {0, 0, 0, 0}, rb0 = {0, 0, 0, 0}, rb1 = {0, 0, 0, 0};
  const int nk = K >> 5;

  auto gla = [&](int c, int k0) -> uint4 {
    if (!ATR) { int row = c >> 2, kc = (c & 3) * 8; return *(const uint4*)(A + (size_t)row * lda + k0 + kc); }
    else { int krow = c / (BM / 8), m0 = (c % (BM / 8)) * 8; return *(const uint4*)(A + (size_t)(k0 + krow) * lda + m0); }
  };
  auto glb = [&](int c, int k0) -> uint4 {
    if (!BTR) { int row = c >> 2, kc = (c & 3) * 8; return *(const uint4*)(B + (size_t)row * ldb + k0 + kc); }
    else { int krow = c / (BN / 8), n0 = (c % (BN / 8)) * 8; return *(const uint4*)(B + (size_t)(k0 + krow) * ldb + n0); }
  };
  auto gload = [&](int kt) {
    const int k0 = kt << 5;
    if (!ALDS) { ra0 = gla(tid, k0); if (CA > 1) ra1 = gla(tid + NTHR, k0); }
    rb0 = glb(tid, k0); if (CB > 1) rb1 = glb(tid + NTHR, k0);
  };
  constexpr int TSA = BM + 8, TSB = BN + 8;
  auto scale8 = [&](uint4 r, float sc) -> uint4 {
    unsigned w[4] = {r.x, r.y, r.z, r.w};
#pragma unroll
    for (int e = 0; e < 4; ++e) w[e] = (unsigned)f2bf(bf2f((bfraw)(w[e] & 0xffff)) * sc) | ((unsigned)f2bf(bf2f((bfraw)(w[e] >> 16)) * sc) << 16);
    return uint4{w[0], w[1], w[2], w[3]};
  };
  auto lstore = [&](int buf, int kt) {
    bfraw* sA = st + buf * STAGE;
    bfraw* sB = sA + (ALDS ? 0 : BM * LROW);
    auto sta = [&](int c, uint4 v) {
      if (!ATR) { int row = c >> 2, kc = (c & 3) * 8; *(uint4*)(sA + row * LROW + kc) = v; }
      else { int krow = c / (BM / 8), m0 = (c % (BM / 8)) * 8; *(uint4*)(sA + krow * TSA + m0) = v; }
    };
    auto stb = [&](int c, uint4 v) {
      if (!BTR) { int row = c >> 2, kc = (c & 3) * 8; *(uint4*)(sB + row * LROW + kc) = v; }
      else {
        int krow = c / (BN / 8), n0 = (c % (BN / 8)) * 8;
        if (kscale) v = scale8(v, kscale[(kt << 5) + krow]);
        *(uint4*)(sB + krow * TSB + n0) = v;
      }
    };
    if (!ALDS) { sta(tid, ra0); if (CA > 1) sta(tid + NTHR, ra1); }
    stb(tid, rb0); if (CB > 1) stb(tid + NTHR, rb1);
  };
  typedef short s16x4 __attribute__((ext_vector_type(4)));
  auto trfrag = [&](const bfraw* sT, int TS, int mt) -> bf16x8 {
    const bfraw* a1 = sT + (8 * fq + (fr >> 2)) * TS + mt + (fr & 3) * 4;
    s16x4 r1 = __builtin_amdgcn_ds_read_tr16_b64_v4i16((__attribute__((address_space(3))) s16x4*)a1);
    s16x4 r2 = __builtin_amdgcn_ds_read_tr16_b64_v4i16((__attribute__((address_space(3))) s16x4*)(a1 + 4 * TS));
    return bf16x8{r1[0], r1[1], r1[2], r1[3], r2[0], r2[1], r2[2], r2[3]};
  };
  auto compute = [&](int buf, int kt) {
    const bfraw* sA = st + buf * STAGE;
    const bfraw* sB = sA + (ALDS ? 0 : BM * LROW);
    bf16x8 af[MI], bfr[NJ];
#pragma unroll
    for (int i = 0; i < MI; ++i) {
      if (ALDS) af[i] = *(const bf16x8*)(sAres + (wm * WM + i * 16 + fr) * ldres + (kt << 5) + fq * 8);
      else if (ATR) af[i] = trfrag(sA, TSA, wm * WM + i * 16);
      else af[i] = *(const bf16x8*)(sA + (wm * WM + i * 16 + fr) * LROW + fq * 8);
    }
#pragma unroll
    for (int j = 0; j < NJ; ++j) {
      if (BTR) bfr[j] = trfrag(sB, TSB, wn * WN + j * 16);
      else bfr[j] = *(const bf16x8*)(sB + (wn * WN + j * 16 + fr) * LROW + fq * 8);
    }
#pragma unroll
    for (int i = 0; i < MI; ++i)
#pragma unroll
      for (int j = 0; j < NJ; ++j) acc[i][j] = __builtin_amdgcn_mfma_f32_16x16x32_bf16(af[i], bfr[j], acc[i][j], 0, 0, 0);
  };

  uint4 xa0 = {0, 0, 0, 0}, xa1 = {0, 0, 0, 0}, xb0 = {0, 0, 0, 0}, xb1 = {0, 0, 0, 0};
  auto swapsets = [&]() { uint4 t; t = ra0; ra0 = xa0; xa0 = t; t = ra1; ra1 = xa1; xa1 = t; t = rb0; rb0 = xb0; xb0 = t; t = rb1; rb1 = xb1; xb1 = t; };
  __syncthreads();
  gload(0); lstore(0, 0);
  if (nk > 1) gload(1);
  if (nk > 2) { swapsets(); gload(2); swapsets(); }
  __syncthreads();
  for (int kt = 0; kt < nk; kt += 2) {
    compute(0, kt);
    if (kt + 1 < nk) lstore(1, kt + 1);
    if (kt + 3 < nk) gload(kt + 3);
    __syncthreads();
    if (kt + 1 >= nk) break;
    compute(1, kt + 1);
    swapsets();
    if (kt + 2 < nk) lstore(0, kt + 2);
    if (kt + 4 < nk) gload(kt + 4);
    swapsets();
    __syncthreads();
  }
}

#define ZERO_ACC(acc, MI, NJ) _Pragma("unroll") for (int _i = 0; _i < (MI); ++_i) _Pragma("unroll") for (int _j = 0; _j < (NJ); ++_j) acc[_i][_j] = f32x4{0.f, 0.f, 0.f, 0.f};
#define EPI_BEGIN(BM, BN) { int _t = ltid(); const int _l = _t & 63, _w = _t >> 6; \
    const int _rb = (_w >> 2) * ((BM) / 2) + (_l >> 4) * 4, _cb = (_w & 3) * ((BN) / 4) + (_l & 15); \
    _Pragma("unroll") for (int i = 0; i < (BM) / 32; ++i) _Pragma("unroll") for (int j = 0; j < (BN) / 64; ++j) _Pragma("unroll") for (int r = 0; r < 4; ++r) { \
      const int row = _rb + i * 16 + r, col = _cb + j * 16;
#define EPI_END }}
#define EPIR_BEGIN(BM, BN) { int _t = ltid(); const int _l = _t & 63, _w = _t >> 6; \
    const int _rb = (_w >> 2) * ((BM) / 2) + (_l >> 4) * 4, _cb = (_w & 3) * ((BN) / 4) + (_l & 15); \
    _Pragma("unroll") for (int i = 0; i < (BM) / 32; ++i) _Pragma("unroll") for (int r = 0; r < 4; ++r) { \
      const int row = _rb + i * 16 + r;
#define EPIR_COLS(BN) _Pragma("unroll") for (int j = 0; j < (BN) / 64; ++j) { const int col = _cb + j * 16;
#define EPIR_END }}}


namespace pg8 {
#define PG8_LAS __attribute__((address_space(3)))
typedef unsigned short bf16_t;
typedef short bf16x8 __attribute__((ext_vector_type(8)));
typedef float f32x4 __attribute__((ext_vector_type(4)));
typedef unsigned u32x4 __attribute__((ext_vector_type(4)));
constexpr int BM = 256, BK = 64, HALF = 128, HTB = HALF * BK * 2  , STAGE_BYTES = 8 * HTB, NXCD = 8, WGM = 8;

__host__ __device__ __forceinline__ int lds_byte(int r, int c) { const int st = (r >> 4) * 2 + (c >> 5), rr = r & 15, cc = c & 31, ob = rr * 64 + cc * 2; return st * 1024 + (ob ^ (((ob >> 9) & 1) << 5)); }
__host__ __device__ __forceinline__ void stage_rc(int b, int& R, int& C) { const int st = b / 1024, sb = b % 1024, swz = sb ^ (((sb >> 9) & 1) << 5); R = (st >> 1) * 16 + swz / 64; C = (st & 1) * 32 + (swz % 64) / 2; }
__host__ __device__ __forceinline__ int perm32(int rho) { const int n = rho >> 4, i = rho & 15; return 8 * (i >> 2) + 4 * n + (i & 3); }

struct Unit { int pm, pn; };
struct Gemm { const bf16_t* A; const bf16_t* Bt; int M, N, K, ld; };
struct StaticOrder {
    int nM, nN, nwg, G, c;
    __host__ __device__ void init(int M, int N, int G_, int c_) { nM = M / BM; nN = N / BM; nwg = nM * nN; G = G_; c = c_; }
    __host__ __device__ bool next(int i, Unit& u) const {
        const long L = (long)i * G + c; if (L >= nwg) return false;
        int wgid = (int)L; { const int q = nwg / NXCD, r = nwg % NXCD, xcd = wgid % NXCD, off = wgid / NXCD; wgid = (xcd < r ? xcd * (q + 1) : r * (q + 1) + (xcd - r) * q) + off; }
        const int nig = WGM * nN, gid = wgid / nig, fm = gid * WGM, gsz = (nM - fm) < WGM ? (nM - fm) : WGM;
        u.pm = fm + ((wgid % nig) % gsz); u.pn = (wgid % nig) / gsz; return true;
    }
    __device__ __forceinline__ void a_ready(const Unit&) const {}
    __device__ __forceinline__ void done(const Unit&) const {}
};
__device__ __forceinline__ unsigned cvt_pk_bf16(float lo, float hi) { unsigned r; asm volatile("v_cvt_pk_bf16_f32 %0, %1, %2" : "=v"(r) : "v"(lo), "v"(hi)); return r; }
template <class Epi, class Sched, bool STAMP = false>
__device__ __forceinline__ void gemm_phase(PG8_LAS unsigned char* lds, const Gemm g, const Sched& S, const Epi& E, unsigned long long* stamps) {
    const int tid = threadIdx.x, wid = __builtin_amdgcn_readfirstlane(tid >> 6), lane = tid & 63, wr = wid >> 2, wc = wid & 3, fr = lane & 15, fq = lane >> 4;
    const int K = g.K, nt = K / BK;
    int ts_lo = 0, ts_hi = 0, nts = 0; const unsigned long long rt_entry = STAMP ? (unsigned long long)wall_clock64() : 0ull;
#define PG8_STAMP() do { if (STAMP && wid == 0 && nts < 64) { const unsigned long long _c = (unsigned long long)clock64(); \
        ts_lo = (lane == nts) ? (int)(unsigned)_c : ts_lo; ts_hi = (lane == nts) ? (int)(unsigned)(_c >> 32) : ts_hi; ++nts; } } while (0)
    PG8_STAMP();
    unsigned voffA[2], voffB[2];
#pragma unroll
    for (int i = 0; i < 2; ++i) { int R, C; stage_rc(tid * 16 + i * 8192, R, C); const int Rb = Epi::PERM ? ((R & ~31) + perm32(R & 31)) : R;
        voffA[i] = (unsigned)(R * g.ld + C) * 2u; voffB[i] = (unsigned)(Rb * g.ld + C) * 2u; }
    const size_t kstep = (size_t)(BK * 2);
    const size_t hstep = (size_t)HALF * g.ld * 2;
    const size_t tstep = 2 * hstep;
    const unsigned ldsw = (unsigned)wid * 1024u;
    const int aoff = lds_byte(wr * 64 + fr, fq * 8), boff = lds_byte(wc * 32 + fr, fq * 8);
#define PG8_SA(b, h) (((b) * 2 + (h)) * HTB)
#define PG8_SB(b, h) ((4 + (b) * 2 + (h)) * HTB)
#define PG8_STAGE(bufoff, gbase, voff) do { _Pragma("unroll") for (int _i = 0; _i < 2; ++_i) \
        __builtin_amdgcn_global_load_lds((const unsigned*)((const char*)(gbase) + (voff)[_i]), (PG8_LAS unsigned*)(lds + (bufoff) + ldsw + _i * 8192), 16, 0, 0); } while (0)
#define PG8_LDA(dst, b, h) do { _Pragma("unroll") for (int m = 0; m < 4; ++m) _Pragma("unroll") for (int k = 0; k < 2; ++k) dst[m][k] = *(const PG8_LAS bf16x8*)(lds + PG8_SA(b, h) + aoff + m * 2048 + k * 1024); } while (0)
#define PG8_LDB(dst, b, h) do { _Pragma("unroll") for (int n = 0; n < 2; ++n) _Pragma("unroll") for (int k = 0; k < 2; ++k) dst[n][k] = *(const PG8_LAS bf16x8*)(lds + PG8_SB(b, h) + boff + n * 2048 + k * 1024); } while (0)
#define PG8_MMA(ai, bj, At, Bt) do { __builtin_amdgcn_s_setprio(1); _Pragma("unroll") for (int m = 0; m < 4; ++m) _Pragma("unroll") for (int n = 0; n < 2; ++n) _Pragma("unroll") for (int k = 0; k < 2; ++k) \
        acc[ai][bj][m][n] = __builtin_amdgcn_mfma_f32_16x16x32_bf16(Bt[n][k], At[m][k], acc[ai][bj][m][n], 0, 0, 0); __builtin_amdgcn_s_setprio(0); } while (0)
#define PG8_WAIT_V(n) asm volatile("s_waitcnt vmcnt(" #n ")" ::: "memory")
#define PG8_WAIT_L(n) asm volatile("s_waitcnt lgkmcnt(" #n ")" ::: "memory")
#define PG8_BAR __builtin_amdgcn_s_barrier()
#define PG8_SCHED __builtin_amdgcn_sched_barrier(0)
    Unit cur, nxt; int ui = 0;
    if (!S.next(0, cur)) return;
    f32x4 acc[2][2][4][2];
#pragma unroll
    for (int a = 0; a < 2; ++a)
#pragma unroll
        for (int b = 0; b < 2; ++b)
#pragma unroll
            for (int m = 0; m < 4; ++m)
#pragma unroll
                for (int n = 0; n < 2; ++n) acc[a][b][m][n] = (f32x4){0.f, 0.f, 0.f, 0.f};
    bf16x8 At[4][2], B0[2][2], B1[2][2];
    const char* cA = (const char*)g.A + (size_t)cur.pm * tstep; const char* cB = (const char*)g.Bt + (size_t)cur.pn * tstep;
    S.a_ready(cur);
    PG8_STAGE(PG8_SB(0, 0), cB, voffB); PG8_STAGE(PG8_SA(0, 0), cA, voffA); PG8_STAGE(PG8_SB(0, 1), cB + hstep, voffB); PG8_STAGE(PG8_SA(0, 1), cA + hstep, voffA);
    if (wr == 1) PG8_BAR;
    PG8_WAIT_V(4); PG8_BAR;
    PG8_STAGE(PG8_SB(1, 0), cB + kstep, voffB); PG8_STAGE(PG8_SA(1, 0), cA + kstep, voffA); PG8_STAGE(PG8_SB(1, 1), cB + hstep + kstep, voffB);
    PG8_WAIT_V(6); PG8_BAR;
    PG8_STAMP();
    for (;;) {
        const bool has_next = S.next(ui + 1, nxt);
        const char* nA = has_next ? (const char*)g.A + (size_t)nxt.pm * tstep : cA; const char* nB = has_next ? (const char*)g.Bt + (size_t)nxt.pn * tstep : cB;
        for (int t = 0; t < nt; t += 2) {
            const bool last = (t == nt - 2);
            const char* a1 = cA + (size_t)(t + 1) * kstep;
            const char* a2 = last ? nA : cA + (size_t)(t + 2) * kstep; const char* b2 = last ? nB : cB + (size_t)(t + 2) * kstep;
            const char* a3 = a2 + kstep; const char* b3 = b2 + kstep;
            if (last && has_next) S.a_ready(nxt);
            PG8_LDB(B0, 0, 0); PG8_SCHED; PG8_LDA(At, 0, 0); PG8_STAGE(PG8_SA(1, 1), a1 + hstep, voffA);
            PG8_WAIT_L(8); PG8_BAR; PG8_WAIT_L(0); PG8_MMA(0, 0, At, B0); PG8_BAR; PG8_SCHED;
            PG8_LDB(B1, 0, 1); PG8_STAGE(PG8_SB(0, 0), b2, voffB);
            PG8_BAR; PG8_WAIT_L(0); PG8_MMA(0, 1, At, B1); PG8_BAR;
            PG8_LDA(At, 0, 1); PG8_STAGE(PG8_SA(0, 0), a2, voffA);
            PG8_BAR; PG8_WAIT_L(0); PG8_MMA(1, 0, At, B0); PG8_BAR; PG8_SCHED;
            PG8_STAGE(PG8_SB(0, 1), b2 + hstep, voffB);
            PG8_WAIT_V(6); PG8_BAR; PG8_MMA(1, 1, At, B1); PG8_BAR;
            PG8_LDB(B0, 1, 0); PG8_SCHED; PG8_LDA(At, 1, 0); PG8_STAGE(PG8_SA(0, 1), a2 + hstep, voffA);
            PG8_WAIT_L(8); PG8_BAR; PG8_WAIT_L(0); PG8_MMA(0, 0, At, B0); PG8_BAR; PG8_SCHED;
            PG8_LDB(B1, 1, 1); PG8_STAGE(PG8_SB(1, 0), b3, voffB);
            PG8_BAR; PG8_WAIT_L(0); PG8_MMA(0, 1, At, B1); PG8_BAR;
            PG8_LDA(At, 1, 1); PG8_STAGE(PG8_SA(1, 0), a3, voffA);
            PG8_BAR; PG8_WAIT_L(0); PG8_MMA(1, 0, At, B0); PG8_BAR; PG8_SCHED;
            PG8_STAGE(PG8_SB(1, 1), b3 + hstep, voffB);
            PG8_WAIT_V(6); PG8_BAR; PG8_MMA(1, 1, At, B1); PG8_BAR;
        }
        PG8_STAMP();
        if constexpr (!Epi::AFTER_DRAIN) { E(acc, cur, wr, wc, fr, fq); S.done(cur); }
        PG8_STAMP();
        if (!has_next) break;
#pragma unroll
        for (int a = 0; a < 2; ++a)
#pragma unroll
            for (int b = 0; b < 2; ++b)
#pragma unroll
                for (int m = 0; m < 4; ++m)
#pragma unroll
                    for (int n = 0; n < 2; ++n) acc[a][b][m][n] = (f32x4){0.f, 0.f, 0.f, 0.f};
        cur = nxt; cA = nA; cB = nB; ++ui;
    }
    PG8_WAIT_V(0);
    if (wr == 0) PG8_BAR;
    PG8_BAR;
    if constexpr (Epi::AFTER_DRAIN) { E.fused(acc, cur, wr, wc, fr, fq, lds, wid, lane); S.done(cur); }
    PG8_STAMP();
    if (STAMP && wid == 0) { stamps[lane] = lane < nts ? (((unsigned long long)(unsigned)ts_hi << 32) | (unsigned)ts_lo) : 0ull;
        if (lane == 62) stamps[62] = rt_entry; if (lane == 63) stamps[63] = (unsigned long long)wall_clock64(); }
#undef PG8_STAMP
#undef PG8_SA
#undef PG8_SB
#undef PG8_STAGE
#undef PG8_LDA
#undef PG8_LDB
#undef PG8_MMA
#undef PG8_WAIT_V
#undef PG8_WAIT_L
#undef PG8_BAR
#undef PG8_SCHED
}
}

typedef pg8::f32x4 pf4;
DEVI float4 ld4(const float* p) { return *(const float4*)p; }
struct EpiFfnIn {
  static constexpr bool PERM = false, AFTER_DRAIN = false;
  bfraw* act;
  DEVI void operator()(const pf4 (&acc)[2][2][4][2], const pg8::Unit& u, int wr, int wc, int fr, int fq) const {
    const int row0 = u.pm * 256 + wr * 64 + fr, f0 = (u.pn * 256 + wc * 32) / 2 + 4 * fq;
#pragma unroll
    for (int ai = 0; ai < 2; ++ai)
#pragma unroll
      for (int m = 0; m < 4; ++m) {
        bfraw* rowp = act + (size_t)(row0 + ai * 128 + m * 16) * 2816 + f0;
#pragma unroll
        for (int bj = 0; bj < 2; ++bj) {
          const pf4 a = acc[ai][bj][m][0], b = acc[ai][bj][m][1];
          uint2 w; w.x = pg8::cvt_pk_bf16(siluf_(a[0]) * b[0], siluf_(a[1]) * b[1]); w.y = pg8::cvt_pk_bf16(siluf_(a[2]) * b[2], siluf_(a[3]) * b[3]);
          *(uint2*)(rowp + bj * 64) = w;
        }
      }
  }
};
struct EpiResid {
  static constexpr bool PERM = false, AFTER_DRAIN = false;
  float* h; const float* mods; int rowoff, gidx; float scale; int mrow;
  DEVI void operator()(const pf4 (&acc)[2][2][4][2], const pg8::Unit& u, int wr, int wc, int fr, int fq) const {
    const int row0 = rowoff + u.pm * 256 + wr * 64 + fr, col0 = u.pn * 256 + wc * 32 + 4 * fq;
#pragma unroll
    for (int ai = 0; ai < 2; ++ai)
#pragma unroll
      for (int m = 0; m < 4; ++m) {
        const int r = row0 + ai * 128 + m * 16;
        float* rowp = h + (size_t)r * 1024 + col0;
        const float* gp = mods + (mrow >= 0 ? mrow : (r >> 13)) * 9216 + gidx * 1024 + col0;
#pragma unroll
        for (int bj = 0; bj < 2; ++bj)
#pragma unroll
          for (int n = 0; n < 2; ++n) {
            float4 hv = ld4(rowp + bj * 128 + n * 16); const float4 g = ld4(gp + bj * 128 + n * 16); const pf4 a = acc[ai][bj][m][n];
            hv.x += scale * g.x * a[0]; hv.y += scale * g.y * a[1]; hv.z += scale * g.z * a[2]; hv.w += scale * g.w * a[3];
            *(float4*)(rowp + bj * 128 + n * 16) = hv;
          }
      }
  }
};
struct EpiResidAtomic {
  static constexpr bool PERM = false, AFTER_DRAIN = false;
  float* h; const float* mods; int rowoff, gidx; float scale; int mrow;
  DEVI void operator()(const pf4 (&acc)[2][2][4][2], const pg8::Unit& u, int wr, int wc, int fr, int fq) const {
    const int row0 = rowoff + u.pm * 256 + wr * 64 + fr, col0 = u.pn * 256 + wc * 32 + 4 * fq;
#pragma unroll
    for (int ai = 0; ai < 2; ++ai)
#pragma unroll
      for (int m = 0; m < 4; ++m) {
        const int r = row0 + ai * 128 + m * 16;
        float* rowp = h + (size_t)r * 1024 + col0;
        const float* gp = mods + (mrow >= 0 ? mrow : (r >> 13)) * 9216 + gidx * 1024 + col0;
#pragma unroll
        for (int bj = 0; bj < 2; ++bj)
#pragma unroll
          for (int n = 0; n < 2; ++n) {
            const float4 g = ld4(gp + bj * 128 + n * 16); const pf4 a = acc[ai][bj][m][n];
            float* q = rowp + bj * 128 + n * 16;
            atomicAdd(q, scale * g.x * a[0]); atomicAdd(q + 1, scale * g.y * a[1]); atomicAdd(q + 2, scale * g.z * a[2]); atomicAdd(q + 3, scale * g.w * a[3]);
          }
      }
  }
};
template <int MODE> struct EpiMix {
  static constexpr bool PERM = true, AFTER_DRAIN = false;
  bfraw* d0; bfraw* d1; bfraw* d2; bfraw* d3;
  DEVI void operator()(const pf4 (&acc)[2][2][4][2], const pg8::Unit& u, int wr, int wc, int fr, int fq) const {
    const int row0 = u.pm * 256 + wr * 64 + fr;
    const int pc = u.pn >> 2;
    bfraw* dst = MODE == 0 ? d0 : (MODE == 1 || MODE == 2) ? (pc == 0 ? d0 : pc == 1 ? d1 : pc == 2 ? d2 : d3) : (MODE == 3 ? d0 : d1);
    const int ld = MODE == 0 ? 3072 : 1024;
    const int col0 = (MODE == 1 || MODE == 2 ? (u.pn & 3) : u.pn) * 256 + wc * 32 + 8 * fq;
#pragma unroll
    for (int ai = 0; ai < 2; ++ai)
#pragma unroll
      for (int m = 0; m < 4; ++m) {
        const size_t ro = (size_t)(row0 + ai * 128 + m * 16) * ld + col0;
#pragma unroll
        for (int bj = 0; bj < 2; ++bj) {
          float v[8];
#pragma unroll
          for (int e = 0; e < 4; ++e) { v[e] = acc[ai][bj][m][0][e]; v[4 + e] = acc[ai][bj][m][1][e]; }
          bfraw* dp = dst + ro + bj * 128;
          if (MODE == 1) { if (pc == 3) {
#pragma unroll
            for (int e = 0; e < 8; ++e) v[e] = geluf_(v[e]); } }
          if (MODE == 2 && pc >= 2) {
#pragma unroll
            for (int e = 0; e < 8; ++e) v[e] = sigmoidf_(v[e]);
          } else if (MODE == 2 || MODE == 3 || MODE == 4) {
            const uint4 o = *(const uint4*)dp; const unsigned ow[4] = {o.x, o.y, o.z, o.w};
            float p[8];
#pragma unroll
            for (int e = 0; e < 4; ++e) { p[2 * e] = bf2f((bfraw)(ow[e] & 0xffff)); p[2 * e + 1] = bf2f((bfraw)(ow[e] >> 16)); }
            if (MODE == 2) {
#pragma unroll
              for (int e = 0; e < 8; ++e) v[e] = (pc == 0 ? sigmoidf_(v[e]) : geluf_(v[e])) * p[e];
            } else if (MODE == 3) {
#pragma unroll
              for (int e = 0; e < 8; ++e) v[e] *= p[e];
            } else {
              const uint4 t = *(const uint4*)(d0 + ro + bj * 128); const unsigned tw[4] = {t.x, t.y, t.z, t.w};
#pragma unroll
              for (int e = 0; e < 4; ++e) { v[2 * e] = bf2f((bfraw)(tw[e] & 0xffff)) + p[2 * e] * v[2 * e]; v[2 * e + 1] = bf2f((bfraw)(tw[e] >> 16)) + p[2 * e + 1] * v[2 * e + 1]; }
            }
          }
          uint4 w; w.x = pg8::cvt_pk_bf16(v[0], v[1]); w.y = pg8::cvt_pk_bf16(v[2], v[3]); w.z = pg8::cvt_pk_bf16(v[4], v[5]); w.w = pg8::cvt_pk_bf16(v[6], v[7]);
          *(uint4*)dp = w;
        }
      }
  }
};
template <class Epi>
DEVI void run8(unsigned char* lds, const bfraw* A, const bfraw* Bt, int M, int N, int K, const Epi& E, int G = -1, int c = -1, int ld = -1) {
  pg8::Gemm g{A, Bt, M, N, K, ld < 0 ? K : ld};
  pg8::StaticOrder S; S.init(M, N, G < 0 ? (int)gridDim.x : G, c < 0 ? (int)blockIdx.x : c);
  pg8::gemm_phase<Epi, pg8::StaticOrder, false>((PG8_LAS unsigned char*)lds, g, S, E, nullptr);
}

struct TrJob { const float* src; bfraw* dst; int ldw, K, kt, nt, drow0, mode; };
DEVI TrJob tr_decode(const P& p, int t) {
  TrJob j; int u = t;
  if (u < 1408) { j = TrJob{p.in[I_W1IN], (bfraw*)(p.ws + O_W1IN), 5632, 1024, u / 88, u % 88, 0, 1}; return j; }
  u -= 1408;
  if (u < 704) { j = TrJob{p.in[I_W1OUT], (bfraw*)(p.ws + O_W1OUT), 1024, 2816, u / 16, u % 16, 0, 0}; return j; }
  u -= 704;
  if (u < 2048) {
    const int pc = u >> 8; u &= 255;
    const int col0 = pc == 0 ? 0 : pc == 1 ? 1024 : pc == 2 ? 2048 : pc == 3 ? 5136 : pc == 4 ? 3088 : pc == 5 ? 4112 : pc == 6 ? 6160 : 7184;
    j = TrJob{p.in[I_WIN] + col0, (bfraw*)(p.ws + (pc < 4 ? O_WTA : O_WTB)), 8208, 1024, u >> 4, u & 15, (pc & 3) * 1024, 0}; return j;
  }
  u -= 2048;
  if (u < 768) { const int m = u >> 8; u &= 255; j = TrJob{p.in[m == 0 ? I_WA : m == 1 ? I_WB : I_WO], (bfraw*)(p.ws + (m == 0 ? O_WA : m == 1 ? O_WB : O_WO)), 1024, 1024, u >> 4, u & 15, 0, 0}; return j; }
  u -= 768;
  if (u < 1408) { j = TrJob{p.in[I_W2IN], (bfraw*)(p.ws + O_W2IN), 5632, 1024, u / 88, u % 88, 0, 1}; return j; }
  u -= 1408;
  j = TrJob{p.in[I_W2OUT], (bfraw*)(p.ws + O_W2OUT), 1024, 2816, u / 16, u % 16, 0, 0}; return j;
}

DEVI void phase_p0(const P& p, unsigned char* lds) {
  float* sf = (float*)lds;
  const int tid = ltid();
  for (int i = tid; i < 3072; i += NTHR) { float v = i < 2048 ? p.in[I_C][i] : p.in[I_CCTX][i - 2048]; sf[i] = v / (1.f + expf(-v)); }
  __syncthreads();
  {
    const float* w = p.in[I_WADA];
    float* mp = (float*)(p.ws + O_MODSP);
    for (int id = blockIdx.x * NTHR + tid; id < 16 * 9216; id += gridDim.x * NTHR) {
      int s = id / 9216, j = id - s * 9216;
      float a0 = 0, a1 = 0, a2 = 0;
#pragma unroll 16
      for (int k = s * 64; k < s * 64 + 64; ++k) { float wv = w[(size_t)k * 9216 + j]; a0 += sf[k] * wv; a1 += sf[1024 + k] * wv; a2 += sf[2048 + k] * wv; }
      mp[(s * 3 + 0) * 9216 + j] = a0; mp[(s * 3 + 1) * 9216 + j] = a1; mp[(s * 3 + 2) * 9216 + j] = a2;
    }
  }
  __syncthreads();
  {
    float4 rg0 = {0.f, 0.f, 0.f, 0.f}, rg1 = {0.f, 0.f, 0.f, 0.f};
    const int lk = tid >> 4, ln = (tid & 15) * 4;
    const int sn = tid >> 3, sk = (tid & 7) * 8;
    int t = blockIdx.x;
    TrJob jb = tr_decode(p, t < 7040 ? t : 0);
    if (t < 7040) {
      rg0 = ld4(jb.src + (size_t)(jb.kt * 64 + lk) * jb.ldw + jb.nt * 64 + ln);
      rg1 = ld4(jb.src + (size_t)(jb.kt * 64 + lk + 32) * jb.ldw + jb.nt * 64 + ln);
    }
    for (; t < 7040; t += gridDim.x) {
      sf[lk * 65 + ln] = rg0.x; sf[lk * 65 + ln + 1] = rg0.y; sf[lk * 65 + ln + 2] = rg0.z; sf[lk * 65 + ln + 3] = rg0.w;
      sf[(lk + 32) * 65 + ln] = rg1.x; sf[(lk + 32) * 65 + ln + 1] = rg1.y; sf[(lk + 32) * 65 + ln + 2] = rg1.z; sf[(lk + 32) * 65 + ln + 3] = rg1.w;
      __syncthreads();
      const TrJob cj = jb;
      const int tn = t + gridDim.x;
      if (tn < 7040) {
        jb = tr_decode(p, tn);
        rg0 = ld4(jb.src + (size_t)(jb.kt * 64 + lk) * jb.ldw + jb.nt * 64 + ln);
        rg1 = ld4(jb.src + (size_t)(jb.kt * 64 + lk + 32) * jb.ldw + jb.nt * 64 + ln);
      }
      {
        const int n = cj.nt * 64 + sn; int dr;
        if (cj.mode == 1) { int isb = n >= 2816; int f = n - isb * 2816; dr = (f >> 4) * 32 + isb * 16 + (f & 15); } else dr = cj.drow0 + n;
        unsigned w[4];
#pragma unroll
        for (int e = 0; e < 4; ++e) w[e] = (unsigned)f2bf(sf[(sk + 2 * e) * 65 + sn]) | ((unsigned)f2bf(sf[(sk + 2 * e + 1) * 65 + sn]) << 16);
        *(uint4*)(cj.dst + (size_t)dr * cj.K + cj.kt * 64 + sk) = uint4{w[0], w[1], w[2], w[3]};
      }
      __syncthreads();
    }
  }
  { bfraw* d = (bfraw*)(p.ws + O_WSB); for (int id = blockIdx.x * NTHR + tid; id < 65536; id += gridDim.x * NTHR) d[id] = f2bf(p.in[I_WS][id]); }
}

DEVI void phase_p0b(const P& p) {
  const float* mp = (const float*)(p.ws + O_MODSP);
  float* m = (float*)(p.ws + O_MODS);
  for (int id = blockIdx.x * NTHR + ltid(); id < 3 * 9216; id += gridDim.x * NTHR) {
    int j = id % 9216;
    float a = p.in[I_BADA][j];
    for (int s = 0; s < 16; ++s) a += mp[s * 3 * 9216 + id];
    m[id] = a;
  }
}

template <int MODE>
DEVI void phase_rows(const P& p, unsigned char* lds, int row_lo = 0, int row_hi = -1, int vb = -1, int nvb = -1) {
  const int tid = ltid(), lane = tid & 63, wid = tid >> 6;
  const float* mods = (const float*)(p.ws + O_MODS);
  float* hctx = (float*)(p.ws + O_HCTX);
  bfraw* hn = (bfraw*)(p.ws + O_HN);
  float* wg = (float*)lds;
  if (MODE == 2) {
    __syncthreads();
    for (int i = tid; i < 16384; i += NTHR) { int k = i >> 4, g = i & 15; wg[g * 1024 + k] = p.in[I_WIN][(size_t)k * 8208 + 3072 + g]; }
    __syncthreads();
  }
  const int nrows = row_hi >= 0 ? row_hi : ((MODE == 1 || MODE == 2) ? 16896 : 16384);
  if (vb < 0) { vb = (int)blockIdx.x; nvb = (int)gridDim.x; }
  const float* gvec = p.in[MODE == 1 ? I_GFFN1 : MODE == 2 ? I_GMIX : MODE == 3 ? I_GFFN2 : I_GFINAL];
  const int msh = MODE == 1 ? 0 : MODE == 2 ? 3 : 6;
  for (int row = row_lo + vb * 8 + wid; row < nrows; row += nvb * 8) {
    const bool lat = row < 16384;
    const int mrow = lat ? (row >> 13) : 2;
    float4 v[4];
    if (MODE == 1) {
      const float* src = lat ? p.in[I_X] + (size_t)row * 1024 : p.in[I_CTX] + (size_t)(row - 16384) * 1024;
#pragma unroll
      for (int i = 0; i < 4; ++i) v[i] = *(const float4*)(src + i * 256 + lane * 4);
      if (lat) {
        int ts = row & 8191; float rr = (float)(ts >> 6), cc = (float)(ts & 63);
        float fqv[4];
#pragma unroll
        for (int e = 0; e < 4; ++e) fqv[e] = expf((-9.210340371976184f * (float)(lane * 4 + e)) / 256.f);
        v[0].x += redsin(rr * fqv[0], false); v[0].y += redsin(rr * fqv[1], false); v[0].z += redsin(rr * fqv[2], false); v[0].w += redsin(rr * fqv[3], false);
        v[1].x += redsin(rr * fqv[0], true);  v[1].y += redsin(rr * fqv[1], true);  v[1].z += redsin(rr * fqv[2], true);  v[1].w += redsin(rr * fqv[3], true);
        v[2].x += redsin(cc * fqv[0], false); v[2].y += redsin(cc * fqv[1], false); v[2].z += redsin(cc * fqv[2], false); v[2].w += redsin(cc * fqv[3], false);
        v[3].x += redsin(cc * fqv[0], true);  v[3].y += redsin(cc * fqv[1], true);  v[3].z += redsin(cc * fqv[2], true);  v[3].w += redsin(cc * fqv[3], true);
      }
      float* dsth = lat ? p.out + (size_t)row * 1024 : hctx + (size_t)(row - 16384) * 1024;
#pragma unroll
      for (int i = 0; i < 4; ++i) *(float4*)(dsth + i * 256 + lane * 4) = v[i];
    } else {
      const float* src = lat ? p.out + (size_t)row * 1024 : hctx + (size_t)(row - 16384) * 1024;
#pragma unroll
      for (int i = 0; i < 4; ++i) v[i] = *(const float4*)(src + i * 256 + lane * 4);
    }
    float ss = 0;
#pragma unroll
    for (int i = 0; i < 4; ++i) ss += v[i].x * v[i].x + v[i].y * v[i].y + v[i].z * v[i].z + v[i].w * v[i].w;
    ss = wave_sum(ss);
    const float rs = rsqrtf(ss * (1.f / 1024.f) + EPS);
    if (MODE == 4) {
#pragma unroll
      for (int i = 0; i < 4; ++i) {
        float4 g = *(const float4*)(gvec + i * 256 + lane * 4);
        float4 o = {v[i].x * rs * g.x, v[i].y * rs * g.y, v[i].z * rs * g.z, v[i].w * rs * g.w};
        *(float4*)(p.out + (size_t)row * 1024 + i * 256 + lane * 4) = o;
      }
    } else {
      const float* sh = mods + (size_t)(mrow * 9216 + msh * 1024);
      const float* scp = sh + 1024;
      float y[16];
#pragma unroll
      for (int i = 0; i < 4; ++i) {
        const int c = i * 256 + lane * 4;
        float4 g = *(const float4*)(gvec + c), s4 = *(const float4*)(sh + c), c4 = *(const float4*)(scp + c);
        y[i * 4 + 0] = v[i].x * rs * g.x * (1.f + c4.x) + s4.x; y[i * 4 + 1] = v[i].y * rs * g.y * (1.f + c4.y) + s4.y;
        y[i * 4 + 2] = v[i].z * rs * g.z * (1.f + c4.z) + s4.z; y[i * 4 + 3] = v[i].w * rs * g.w * (1.f + c4.w) + s4.w;
        uint2 pk; pk.x = (unsigned)f2bf(y[i * 4]) | ((unsigned)f2bf(y[i * 4 + 1]) << 16); pk.y = (unsigned)f2bf(y[i * 4 + 2]) | ((unsigned)f2bf(y[i * 4 + 3]) << 16);
        *(uint2*)(hn + (size_t)row * 1024 + c) = pk;
      }
      if (MODE == 2) {
        float ga[16];
#pragma unroll
        for (int g2 = 0; g2 < 16; ++g2) {
          float a = 0.f;
#pragma unroll
          for (int i = 0; i < 4; ++i) { float4 w4 = *(const float4*)(wg + g2 * 1024 + i * 256 + lane * 4); a += y[i * 4] * w4.x + y[i * 4 + 1] * w4.y + y[i * 4 + 2] * w4.z + y[i * 4 + 3] * w4.w; }
          ga[g2] = a;
          if ((g2 & 3) == 3) asm volatile("" ::: "memory");
        }
        const bool b5 = lane & 32, b4 = lane & 16, b3 = lane & 8, b2 = lane & 4;
        float r8[8], r4[4], r2[2];
#pragma unroll
        for (int g = 0; g < 8; ++g) { const float snd = b5 ? ga[g] : ga[g + 8], kp = b5 ? ga[g + 8] : ga[g]; r8[g] = kp + __shfl_xor(snd, 32, 64); }
#pragma unroll
        for (int g = 0; g < 4; ++g) { const float snd = b4 ? r8[g] : r8[g + 4], kp = b4 ? r8[g + 4] : r8[g]; r4[g] = kp + __shfl_xor(snd, 16, 64); }
#pragma unroll
        for (int g = 0; g < 2; ++g) { const float snd = b3 ? r4[g] : r4[g + 2], kp = b3 ? r4[g + 2] : r4[g]; r2[g] = kp + __shfl_xor(snd, 8, 64); }
        float r1 = (b2 ? r2[1] : r2[0]) + __shfl_xor(b2 ? r2[0] : r2[1], 4, 64);
        r1 += __shfl_xor(r1, 2, 64); r1 += __shfl_xor(r1, 1, 64);
        const int gi = (b5 ? 8 : 0) + (b4 ? 4 : 0) + (b3 ? 2 : 0) + (b2 ? 1 : 0);
        if ((lane & 3) == 0) ((float*)(p.ws + O_GATES))[(size_t)row * 16 + gi] = r1;
      }
    }
  }
}

DEVI void phase_ffn_in(const P& p, unsigned char* lds, size_t o_w, int nrows) {
  EpiFfnIn E{(bfraw*)(p.ws + O_ACT)};
  run8(lds, (const bfraw*)(p.ws + O_HN), (const bfraw*)(p.ws + o_w), nrows, 5632, 1024, E);
}

DEVI void phase_ffn_out(const P& p, unsigned char* lds, size_t o_w, int gidx, bool with_ctx) {
  EpiResid E{p.out, (const float*)(p.ws + O_MODS), 0, gidx, 0.5f, -1};
  run8(lds, (const bfraw*)(p.ws + O_ACT), (const bfraw*)(p.ws + o_w), 16384, 1024, 2816, E);
  (void)with_ctx;
}

DEVI void phase_r2_g2c(const P& p, unsigned char* lds) {
  const int G = (int)gridDim.x, nc = G >= 48 ? 24 : 0;
  if (nc == 0) {
    EpiResid E{(float*)(p.ws + O_HCTX), (const float*)(p.ws + O_MODS), 0, 2, 0.5f, 2};
    run8(lds, (const bfraw*)(p.ws + O_ACT) + (size_t)16384 * 2816, (const bfraw*)(p.ws + O_W1OUT), 512, 1024, 2816, E);
    __syncthreads();
  } else if ((int)blockIdx.x < nc) {
    const int sl = (int)blockIdx.x >> 3, k0 = sl * 1024, kl = sl == 2 ? 768 : 1024;
    EpiResidAtomic E{(float*)(p.ws + O_HCTX), (const float*)(p.ws + O_MODS), 0, 2, 0.5f, 2};
    run8(lds, (const bfraw*)(p.ws + O_ACT) + (size_t)16384 * 2816 + k0, (const bfraw*)(p.ws + O_W1OUT) + k0, 512, 1024, kl, E, 8, (int)blockIdx.x & 7, 2816);
    return;
  }
  phase_rows<2>(p, lds, 0, 16384, (int)blockIdx.x - nc, G - nc);
}

DEVI void phase_g3c(const P& p, unsigned char* lds) {
  EpiMix<0> E{(bfraw*)(p.ws + O_CTXRAW), nullptr, nullptr, nullptr};
  run8(lds, (const bfraw*)(p.ws + O_HN) + (size_t)16384 * 1024, (const bfraw*)(p.ws + O_WTA), 512, 3072, 1024, E);
}

DEVI void phase_g3a(const P& p, unsigned char* lds, int hb) {
  EpiMix<1> E{(bfraw*)(p.ws + O_QRAW), (bfraw*)(p.ws + O_KRAW), (bfraw*)(p.ws + O_V), (bfraw*)(p.ws + O_GVS)};
  run8(lds, (const bfraw*)(p.ws + O_HN) + (size_t)hb * 8192 * 1024, (const bfraw*)(p.ws + O_WTA), 8192, 4096, 1024, E);
}

DEVI void phase_g3b(const P& p, unsigned char* lds, int hb) {
  EpiMix<2> E{(bfraw*)(p.ws + O_V), (bfraw*)(p.ws + O_GVS), (bfraw*)(p.ws + O_QC), (bfraw*)(p.ws + O_KC)};
  run8(lds, (const bfraw*)(p.ws + O_HN) + (size_t)hb * 8192 * 1024, (const bfraw*)(p.ws + O_WTB), 8192, 4096, 1024, E);
}

DEVI void phase_g4(const P& p, unsigned char* lds) {
  const int Gh = (int)gridDim.x >> 1, grp = (int)blockIdx.x / Gh, c = (int)blockIdx.x % Gh;
  if (grp == 0) { EpiMix<3> E{(bfraw*)(p.ws + O_QC), nullptr, nullptr, nullptr}; run8(lds, (const bfraw*)(p.ws + O_V), (const bfraw*)(p.ws + O_WA), 8192, 1024, 1024, E, Gh, c); }
  else if (grp == 1) { EpiMix<3> E{(bfraw*)(p.ws + O_KC), nullptr, nullptr, nullptr}; run8(lds, (const bfraw*)(p.ws + O_GVS), (const bfraw*)(p.ws + O_WB), 8192, 1024, 1024, E, Gh, c); }
}

DEVI void phase_addmix(const P& p, int hb) {
  const uint4* t1 = (const uint4*)(p.ws + O_QC);
  const uint4* t2 = (const uint4*)(p.ws + O_KC);
  uint4* dst = (uint4*)(p.ws + (hb == 0 ? O_W1IN : O_QC));
  const int tid = ltid();
  for (int i = blockIdx.x * NTHR + tid; i < 8192 * 128; i += gridDim.x * NTHR) {
    const uint4 a = t1[i], b = t2[i];
    const unsigned aw[4] = {a.x, a.y, a.z, a.w}, bw[4] = {b.x, b.y, b.z, b.w}; unsigned o[4];
#pragma unroll
    for (int e = 0; e < 4; ++e) o[e] = (unsigned)f2bf(bf2f((bfraw)(aw[e] & 0xffff)) + bf2f((bfraw)(bw[e] & 0xffff))) | ((unsigned)f2bf(bf2f((bfraw)(aw[e] >> 16)) + bf2f((bfraw)(bw[e] >> 16))) << 16);
    dst[i] = uint4{o[0], o[1], o[2], o[3]};
  }
}

DEVI void phase_g5(const P& p, unsigned char* lds) {
  const int Gh = (int)gridDim.x >> 1, grp = (int)blockIdx.x / Gh, c = (int)blockIdx.x % Gh;
  EpiResid E{p.out, (const float*)(p.ws + O_MODS), grp * 8192, 5, 1.f, -1};
  if (grp < 2) run8(lds, (const bfraw*)(p.ws + (grp == 0 ? O_W1IN : O_QC)), (const bfraw*)(p.ws + O_WO), 8192, 1024, 1024, E, Gh, c);
}

DEVI void phase_cv(const P& p, int hb) {
  const int tid = ltid(), lane = tid & 63, wid = tid >> 6;
  const bfraw* qraw = (const bfraw*)(p.ws + O_QRAW);
  const bfraw* kraw = (const bfraw*)(p.ws + O_KRAW);
  const bfraw* craw = (const bfraw*)(p.ws + O_CTXRAW) + (size_t)hb * 256 * 3072;
  bfraw* qc = (bfraw*)(p.ws + O_QC);
  bfraw* kc = (bfraw*)(p.ws + O_KC);
  bfraw* vv = (bfraw*)(p.ws + O_V);
  const bfraw* gvs = (const bfraw*)(p.ws + O_GVS);
  float* rsb = (float*)(p.ws + O_RS);
  const float* cw = p.in[I_CONVW];
  const float* cb = p.in[I_CONVB];
  for (int task = blockIdx.x * 8 + wid; task < 1056 * 4; task += gridDim.x * 8) {
    const int sidx = task >> 2, part = task & 3, isk = part >> 1;
    const bool lat = sidx < 1024;
    const int lr0 = (lat ? sidx : sidx - 1024) * 8, len = lat ? 8192 : 256, orow0 = sidx * 8;
    const bfraw* src = lat ? (isk ? kraw : qraw) : (craw + isk * 1024);
    const size_t ld = lat ? 1024 : 3072;
    const int ch = (part & 1) * 512 + lane * 8, wch = isk * 1024 + ch;
    float w0[8], w1[8], w2[8], bb[8];
#pragma unroll
    for (int e = 0; e < 8; e += 4) {
      float4 a = ld4(cw + wch + e), b = ld4(cw + 2048 + wch + e), c4 = ld4(cw + 4096 + wch + e), d = ld4(cb + wch + e);
      w0[e] = a.x; w0[e + 1] = a.y; w0[e + 2] = a.z; w0[e + 3] = a.w; w1[e] = b.x; w1[e + 1] = b.y; w1[e + 2] = b.z; w1[e + 3] = b.w;
      w2[e] = c4.x; w2[e + 1] = c4.y; w2[e + 2] = c4.z; w2[e + 3] = c4.w; bb[e] = d.x; bb[e + 1] = d.y; bb[e + 2] = d.z; bb[e + 3] = d.w;
    }
    uint4 rw[10];
#pragma unroll
    for (int i = 0; i < 10; ++i) { const int lr = lr0 - 1 + i; uint4 t = {0u, 0u, 0u, 0u}; if (lr >= 0 && lr < len) t = *(const uint4*)(src + (size_t)lr * ld + ch); rw[i] = t; }
    const float osc = isk ? 1.f : 0.0625f;
    bfraw* dst = (isk ? kc : qc) + (size_t)orow0 * 1024 + ch;
#pragma unroll
    for (int i = 0; i < 8; ++i) {
      const unsigned av[4] = {rw[i].x, rw[i].y, rw[i].z, rw[i].w}, bv[4] = {rw[i + 1].x, rw[i + 1].y, rw[i + 1].z, rw[i + 1].w}, cv[4] = {rw[i + 2].x, rw[i + 2].y, rw[i + 2].z, rw[i + 2].w};
      unsigned ov[4];
#pragma unroll
      for (int e = 0; e < 4; ++e) {
        const float y0 = bf2f((bfraw)(av[e] & 0xffff)) * w0[2 * e] + bf2f((bfraw)(bv[e] & 0xffff)) * w1[2 * e] + bf2f((bfraw)(cv[e] & 0xffff)) * w2[2 * e] + bb[2 * e];
        const float y1 = bf2f((bfraw)(av[e] >> 16)) * w0[2 * e + 1] + bf2f((bfraw)(bv[e] >> 16)) * w1[2 * e + 1] + bf2f((bfraw)(cv[e] >> 16)) * w2[2 * e + 1] + bb[2 * e + 1];
        ov[e] = (unsigned)f2bf(siluf_(y0) * osc) | ((unsigned)f2bf(siluf_(y1) * osc) << 16);
      }
      *(uint4*)(dst + (size_t)i * 1024) = uint4{ov[0], ov[1], ov[2], ov[3]};
    }
  }
  for (int row = blockIdx.x * 8 + wid; row < 8448; row += gridDim.x * 8) {
    if (row < 8192) {
      float ss = 0;
#pragma unroll
      for (int hlf = 0; hlf < 2; ++hlf) {
        uint4 g = *(const uint4*)(gvs + (size_t)row * 1024 + hlf * 512 + lane * 8);
        unsigned gv[4] = {g.x, g.y, g.z, g.w};
#pragma unroll
        for (int e = 0; e < 4; ++e) { float a = bf2f((bfraw)(gv[e] & 0xffff)), b = bf2f((bfraw)(gv[e] >> 16)); ss += a * a + b * b; }
      }
      ss = wave_sum(ss);
      if (lane == 0) rsb[row] = rsqrtf(ss * (1.f / 1024.f) + EPS);
    } else {
#pragma unroll
      for (int hlf = 0; hlf < 2; ++hlf)
        *(uint4*)(vv + (size_t)row * 1024 + hlf * 512 + lane * 8) = *(const uint4*)(craw + 2048 + (size_t)(row - 8192) * 3072 + hlf * 512 + lane * 8);
    }
  }
}

DEVI void phase_ma(const P& p, unsigned char* lds, int hb) {
  const int tid = ltid();
  bfraw* st = (bfraw*)lds;
  float* sc = (float*)(lds + 131072);
  float* s_w = sc + 128, *s_ws = sc + 256, *s_red = sc + 384, *s_part = sc + 512;
  const float* bg = p.in[I_BGATES];
  for (int item = blockIdx.x; item < 528 + 256; item += gridDim.x) {
    unsigned char* wsb = lws(p.ws);
    const float* gates = (const float*)(wsb + O_GATES);
    const bfraw* kc = (const bfraw*)(wsb + O_KC);
    const bfraw* vv = (const bfraw*)(wsb + O_V);
    bfraw* states = (bfraw*)(wsb + O_ST);
    float* nloc = (float*)(wsb + O_NLOC);
    float* mg = (float*)(wsb + O_MG);
    if (item < 528) {
      const int seq = item / 66, j = item % 66, d = seq >> 2, h = seq & 3;
      int rbase, grow;
      if (j < 2) { int cc = d == 0 ? j : 1 - j; rbase = 8192 + cc * 128; grow = 16384 + hb * 256 + cc * 128; }
      else { int c = d == 0 ? j - 2 : 65 - j; rbase = c * 128; grow = hb * 8192 + c * 128; }
      __syncthreads();
      const int el = d == 0 ? (tid & 127) : 127 - (tid & 127);
      float li = 0.f, lf = 0.f;
      if (tid < 128) {
        li = gates[(size_t)(grow + el) * 16 + d * 8 + h] + bg[d * 8 + h];
        lf = logsigf_(gates[(size_t)(grow + el) * 16 + d * 8 + 4 + h] + bg[d * 8 + 4 + h]);
      }
      const float bcum = seg_scan_sum(lf, tid, s_red + 4);
      if (tid == 127) s_red[1] = bcum;
      __syncthreads();
      const float gtot = s_red[1];
      const float wv = gtot - bcum + li;
      if (tid < 128) s_w[el] = wv;
      __syncthreads();
      if (tid < 64) {
        float m = fmaxf(s_w[tid], s_w[tid + 64]);
#pragma unroll
        for (int o = 32; o > 0; o >>= 1) m = fmaxf(m, __shfl_xor(m, o, 64));
        if (tid == 0) s_red[0] = m;
      }
      __syncthreads();
      const float mloc = s_red[0];
      if (tid < 128) s_ws[el] = expf(wv - mloc);
      if (tid == 0) { mg[seq * 66 + j] = mloc; mg[528 + seq * 66 + j] = gtot; }
      __syncthreads();
      {
        const int k = tid & 255, part = tid >> 8;
        const bfraw* kp0 = kc + (size_t)(rbase + part * 64) * 1024 + h * 256 + k;
        float n = 0;
#pragma unroll 16
        for (int t = 0; t < 64; ++t) n += s_ws[part * 64 + t] * bf2f(kp0[(size_t)t * 1024]);
        s_part[tid] = n;
      }
      bfraw* dst = states + (size_t)(seq * 66 + j) * 65536;
      {
        f32x4 acc[8][4]; ZERO_ACC(acc, 8, 4);
        gemm_tile<256, 256, true, true, false>(vv + (size_t)rbase * 1024 + h * 256, 1024, kc + (size_t)rbase * 1024 + h * 256, 1024, 128, s_ws, acc, st, nullptr, 0);
        EPI_BEGIN(256, 256)
          dst[row * 256 + col] = f2bf(acc[i][j][r]);
        EPI_END
      }
      if (tid < 256) nloc[(size_t)(seq * 66 + j) * 256 + tid] = s_part[tid] + s_part[tid + 256];
    } else {
      const int it = item - 528, c = it >> 2, g = it & 3;
      bfraw* gvs = (bfraw*)(wsb + O_GVS);
      const float* rsb = (const float*)(wsb + O_RS);
      f32x4 acc[4][4]; ZERO_ACC(acc, 4, 4);
      gemm_tile<128, 256, false, true, false>((const bfraw*)(wsb + O_WSB) + g * 16384, 128, gvs + (size_t)c * 128 * 1024 + g * 256, 1024, 128, rsb + c * 128, acc, st, nullptr, 0);
      const float* gs = p.in[I_GSGU] + g * 256;
      const float* bs = p.in[I_BS] + g * 128;
      EPI_BEGIN(128, 256)
        gvs[(size_t)(c * 128 + row) * 1024 + g * 256 + col] = f2bf(gs[col] * acc[i][j][r] + bs[row]);
      EPI_END
    }
  }
}

DEVI void phase_mb(const P& p, unsigned char* lds) {
  bfraw* states = (bfraw*)(p.ws + O_ST);
  const float* mg = (const float*)(p.ws + O_MG);
  float* ment = (float*)(p.ws + O_MG) + 1056;
  const float* nloc = (const float*)(p.ws + O_NLOC);
  float* nent = (float*)(p.ws + O_NENT);
  const int gid = blockIdx.x * NTHR + ltid(), gsz = gridDim.x * NTHR;
  float* s_dec = (float*)lds, *s_scl = s_dec + 528;
  __syncthreads();
  if (ltid() < 8) {
    const int seq = ltid(); float m = 0;
    for (int j = 0; j < 66; ++j) {
      const float mloc = mg[seq * 66 + j], g = mg[528 + seq * 66 + j];
      const float mnew = fmaxf(g + m, mloc);
      s_dec[seq * 66 + j] = expf(g + m - mnew); s_scl[seq * 66 + j] = expf(mloc - mnew);
      if (blockIdx.x == 0) ment[seq * 66 + j] = m;
      m = mnew;
    }
  }
  __syncthreads();
  for (int id = gid; id < 8 * 16384; id += gsz) {
    const int seq = id >> 14, e = (id & 16383) * 4;
    float s0 = 0, s1 = 0, s2 = 0, s3 = 0;
    bfraw* base = states + (size_t)seq * 66 * 65536 + e;
#pragma unroll 1
    for (int cb = 0; cb < 66; cb += 22) {
      uint2 buf[22];
#pragma unroll
      for (int i = 0; i < 22; ++i) buf[i] = *(const uint2*)(base + (size_t)(cb + i) * 65536);
#pragma unroll
      for (int i = 0; i < 22; ++i) {
        const int j = cb + i; const uint2 cur = buf[i];
        const float dec = s_dec[seq * 66 + j], scl = s_scl[seq * 66 + j];
        if (j >= 2) { uint2 o; o.x = (unsigned)f2bf(s0) | ((unsigned)f2bf(s1) << 16); o.y = (unsigned)f2bf(s2) | ((unsigned)f2bf(s3) << 16);
          *(uint2*)(base + (size_t)j * 65536) = o; }
        s0 = dec * s0 + scl * bf2f((bfraw)(cur.x & 0xffff)); s1 = dec * s1 + scl * bf2f((bfraw)(cur.x >> 16));
        s2 = dec * s2 + scl * bf2f((bfraw)(cur.y & 0xffff)); s3 = dec * s3 + scl * bf2f((bfraw)(cur.y >> 16));
      }
    }
  }
  for (int id = gid; id < 8 * 256; id += gsz) {
    const int seq = id >> 8, k = id & 255;
    float n = 0;
    for (int j = 0; j < 66; ++j) {
      nent[(size_t)(seq * 66 + j) * 256 + k] = n;
      n = s_dec[seq * 66 + j] * n + s_scl[seq * 66 + j] * nloc[(size_t)(seq * 66 + j) * 256 + k];
    }
  }
}

DEVI void phase_mc(const P& p, unsigned char* lds, int hb) {
  const int tid = ltid(), lane = tid & 63, wid = tid >> 6, wm = wid >> 2, wn = wid & 3, fr = lane & 15, fq = lane >> 4;
  bfraw* st = (bfraw*)lds;
  bfraw* sS = (bfraw*)(lds + 61440);
  float* sc = (float*)(lds + 131072);
  float* s_b = sc, *s_u = sc + 256, *s_mt = sc + 512, *s_in = sc + 768, *s_den = sc + 1024, *s_dq = sc + 1280, *s_tmp = sc + 1536;
  float* s_sum = sc + 1792, *s_sq = sc + 1920;
  const float* bg = p.in[I_BGATES];
  for (int item = blockIdx.x; item < 256; item += gridDim.x) {
    unsigned char* wsb = lws(p.ws);
    const float* gates = (const float*)(wsb + O_GATES);
    const bfraw* qc = (const bfraw*)(wsb + O_QC);
    const bfraw* kc = (const bfraw*)(wsb + O_KC);
    bfraw* vv = (bfraw*)(wsb + O_V);
    const bfraw* states = (const bfraw*)(wsb + O_ST);
    const float* ment = (const float*)(wsb + O_MG) + 1056;
    const float* nent = (const float*)(wsb + O_NENT);
    const int c = item >> 2, h = item & 3, R0 = c * 128;
    const bfraw* qp = qc + (size_t)R0 * 1024 + h * 256;
    const bfraw* kp = kc + (size_t)R0 * 1024 + h * 256;
    __syncthreads();
    {
      const int d = (tid >> 7) & 1, t = tid & 127, el = d == 0 ? t : 127 - t, ix = d * 128 + el;
      float li = 0.f, lf = 0.f;
      if (tid < 256) {
        const size_t grow = (size_t)hb * 8192 + R0 + el;
        li = gates[grow * 16 + d * 8 + h] + bg[d * 8 + h];
        lf = logsigf_(gates[grow * 16 + d * 8 + 4 + h] + bg[d * 8 + 4 + h]);
        s_den[tid] = 0.f;
        if (tid < 128) { s_sum[tid] = 0.f; s_sq[tid] = 0.f; }
      }
      const float b = seg_scan_sum(lf, tid, s_tmp);
      const float uu = li - b;
      const float pm = seg_scan_max(tid < 256 ? uu : -INFINITY, tid, s_tmp);
      if (tid < 256) {
        const int seq = d * 4 + h, j = d == 0 ? c + 2 : 65 - c;
        const float mst = ment[seq * 66 + j];
        const float a = b + mst;
        const float mt = fmaxf(a, b + pm);
        s_b[ix] = b; s_u[ix] = uu; s_mt[ix] = mt; s_in[ix] = expf(a - mt);
      }
    }
    {
      const int row = tid >> 2, part = tid & 3;
      const uint4* q4 = (const uint4*)(qp + (size_t)row * 1024 + part * 64);
      const float4* nf4 = (const float4*)(nent + (size_t)((0 + h) * 66 + (c + 2)) * 256 + part * 64);
      const float4* nb4 = (const float4*)(nent + (size_t)((4 + h) * 66 + (65 - c)) * 256 + part * 64);
      uint4 qv[8];
#pragma unroll
      for (int i = 0; i < 8; ++i) qv[i] = q4[i];
      float af = 0, ab = 0;
#pragma unroll
      for (int i = 0; i < 8; ++i) {
        const float4 f0 = nf4[2 * i], f1 = nf4[2 * i + 1], b0 = nb4[2 * i], b1 = nb4[2 * i + 1];
        const float q0 = bf2f((bfraw)(qv[i].x & 0xffff)), q1 = bf2f((bfraw)(qv[i].x >> 16)), q2 = bf2f((bfraw)(qv[i].y & 0xffff)), q3 = bf2f((bfraw)(qv[i].y >> 16));
        const float q4_ = bf2f((bfraw)(qv[i].z & 0xffff)), q5 = bf2f((bfraw)(qv[i].z >> 16)), q6 = bf2f((bfraw)(qv[i].w & 0xffff)), q7 = bf2f((bfraw)(qv[i].w >> 16));
        af += q0 * f0.x + q1 * f0.y + q2 * f0.z + q3 * f0.w + q4_ * f1.x + q5 * f1.y + q6 * f1.z + q7 * f1.w;
        ab += q0 * b0.x + q1 * b0.y + q2 * b0.z + q3 * b0.w + q4_ * b1.x + q5 * b1.y + q6 * b1.z + q7 * b1.w;
      }
      af += __shfl_xor(af, 1, 64); af += __shfl_xor(af, 2, 64);
      ab += __shfl_xor(ab, 1, 64); ab += __shfl_xor(ab, 2, 64);
      if (part == 0) { s_dq[row] = af; s_dq[128 + row] = ab; }
    }
    __syncthreads();
    {
      f32x4 S[4][2]; ZERO_ACC(S, 4, 2);
      gemm_tile<128, 128, false, false, false>(qp, 1024, kp, 1024, 256, nullptr, S, st, nullptr, 0);
#pragma unroll 1
      for (int d = 0; d < 2; ++d)
#pragma unroll
        for (int i = 0; i < 4; ++i)
#pragma unroll
          for (int r = 0; r < 4; ++r) {
            const int row = wm * 64 + i * 16 + fq * 4 + r;
            const float bt = s_b[d * 128 + row] - s_mt[d * 128 + row];
            float rs = 0;
#pragma unroll
            for (int j = 0; j < 2; ++j) {
              const int col = wn * 32 + j * 16 + fr;
              const bool valid = d == 0 ? (col <= row) : (col >= row);
              const float val = valid ? S[i][j][r] * fexp(bt + s_u[d * 128 + col]) : 0.f;
              rs += val;
              sS[(d * 128 + row) * 136 + col] = f2bf(val);
            }
            rs = red16(rs);
            if (fr == 0) atomicAdd(&s_den[d * 128 + row], rs);
          }
    }
    __syncthreads();
    f32x4 hs[4][4];
    uint4* hpark = (uint4*)(wsb + O_HPARK) + ((size_t)item * NTHR + tid) * 8;
#pragma unroll 1
    for (int d = 0; d < 2; ++d) {
      f32x4 (&acc)[4][4] = hs; ZERO_ACC(acc, 4, 4);
      const int seq = d * 4 + h, j2 = d == 0 ? c + 2 : 65 - c;
      gemm_tile<128, 256, false, false, false>(qp, 1024, states + (size_t)(seq * 66 + j2) * 65536, 256, 256, nullptr, acc, st, nullptr, 0);
      EPIR_BEGIN(128, 256)
        const float sin_ = s_in[d * 128 + row];
        EPIR_COLS(256) acc[i][j][r] *= sin_; (void)col;
      EPIR_END
      gemm_tile<128, 256, false, true, true>(nullptr, 0, vv + (size_t)R0 * 1024 + h * 256, 1024, 128, nullptr, acc, st, sS + d * 128 * 136, 136);
      EPIR_BEGIN(128, 256)
        const float den = s_den[d * 128 + row] + s_in[d * 128 + row] * s_dq[d * 128 + row];
        const float inv = 1.f / fmaxf(fabsf(den), expf(-s_mt[d * 128 + row]));
        EPIR_COLS(256) acc[i][j][r] *= inv; (void)col;
      EPIR_END
      if (d == 0) {
#pragma unroll
        for (int i = 0; i < 4; ++i) {
          uint4 w0, w1;
          w0.x = (unsigned)f2bf(acc[i][0][0]) | ((unsigned)f2bf(acc[i][0][1]) << 16); w0.y = (unsigned)f2bf(acc[i][0][2]) | ((unsigned)f2bf(acc[i][0][3]) << 16);
          w0.z = (unsigned)f2bf(acc[i][1][0]) | ((unsigned)f2bf(acc[i][1][1]) << 16); w0.w = (unsigned)f2bf(acc[i][1][2]) | ((unsigned)f2bf(acc[i][1][3]) << 16);
          w1.x = (unsigned)f2bf(acc[i][2][0]) | ((unsigned)f2bf(acc[i][2][1]) << 16); w1.y = (unsigned)f2bf(acc[i][2][2]) | ((unsigned)f2bf(acc[i][2][3]) << 16);
          w1.z = (unsigned)f2bf(acc[i][3][0]) | ((unsigned)f2bf(acc[i][3][1]) << 16); w1.w = (unsigned)f2bf(acc[i][3][2]) | ((unsigned)f2bf(acc[i][3][3]) << 16);
          hpark[2 * i] = w0; hpark[2 * i + 1] = w1;
        }
      } else {
#pragma unroll
        for (int i = 0; i < 4; ++i) {
          const uint4 w0 = hpark[2 * i], w1 = hpark[2 * i + 1];
          const unsigned ww[8] = {w0.x, w0.y, w0.z, w0.w, w1.x, w1.y, w1.z, w1.w};
#pragma unroll
          for (int j = 0; j < 4; ++j) {
            hs[i][j][0] += bf2f((bfraw)(ww[2 * j] & 0xffff)); hs[i][j][1] += bf2f((bfraw)(ww[2 * j] >> 16));
            hs[i][j][2] += bf2f((bfraw)(ww[2 * j + 1] & 0xffff)); hs[i][j][3] += bf2f((bfraw)(ww[2 * j + 1] >> 16));
          }
        }
      }
    }
#pragma unroll
    for (int i = 0; i < 4; ++i)
#pragma unroll
      for (int r = 0; r < 4; ++r) {
        float ps = hs[i][0][r] + hs[i][1][r] + hs[i][2][r] + hs[i][3][r];
        ps = red16(ps);
        if (fr == 0) atomicAdd(&s_sum[wm * 64 + i * 16 + fq * 4 + r], ps);
      }
    __syncthreads();
#pragma unroll
    for (int i = 0; i < 4; ++i)
#pragma unroll
      for (int r = 0; r < 4; ++r) {
        const float mu = s_sum[wm * 64 + i * 16 + fq * 4 + r] * (1.f / 256.f);
        float ps = 0;
#pragma unroll
        for (int j = 0; j < 4; ++j) { float dlt = hs[i][j][r] - mu; ps += dlt * dlt; }
        ps = red16(ps);
        if (fr == 0) atomicAdd(&s_sq[wm * 64 + i * 16 + fq * 4 + r], ps);
      }
    __syncthreads();
    const float* gh = p.in[I_GHEAD] + h * 256;
    EPIR_BEGIN(128, 256)
      const float mu = s_sum[row] * (1.f / 256.f);
      const float rstd = rsqrtf(s_sq[row] * (1.f / 256.f) + EPS);
      EPIR_COLS(256)
        vv[(size_t)(R0 + row) * 1024 + h * 256 + col] = f2bf((hs[i][j][r] - mu) * rstd * gh[col]);
    EPIR_END
  }
}

constexpr int NPH = 28;
#define PHASE_PROGRAM \
  PHASE(0, phase_p0(p, lds)) \
  PHASE(1, phase_p0b(p)) \
  PHASE(2, phase_rows<1>(p, lds)) \
  PHASE(3, phase_ffn_in(p, lds, O_W1IN, 16896)) \
  PHASE(4, phase_ffn_out(p, lds, O_W1OUT, 2, true)) \
  PHASE(5, phase_r2_g2c(p, lds)) \
  PHASE(6, phase_rows<2>(p, lds, 16384, 16896)) \
  PHASE(7, phase_g3c(p, lds)) \
  PHASE(8, phase_g3a(p, lds, 0)) \
  PHASE(9, phase_cv(p, 0)) \
  PHASE(10, phase_ma(p, lds, 0)) \
  PHASE(11, phase_mb(p, lds)) \
  PHASE(12, phase_mc(p, lds, 0)) \
  PHASE(13, phase_g3b(p, lds, 0)) \
  PHASE(14, phase_g4(p, lds)) \
  PHASE(15, phase_addmix(p, 0); __syncthreads(); phase_g3a(p, lds, 1)) \
  PHASE(16, phase_cv(p, 1)) \
  PHASE(17, phase_ma(p, lds, 1)) \
  PHASE(18, phase_mb(p, lds)) \
  PHASE(19, phase_mc(p, lds, 1)) \
  PHASE(20, phase_g3b(p, lds, 1)) \
  PHASE(21, phase_g4(p, lds)) \
  PHASE(22, phase_addmix(p, 1)) \
  PHASE(23, phase_g5(p, lds)) \
  PHASE(24, phase_rows<3>(p, lds)) \
  PHASE(25, phase_ffn_in(p, lds, O_W2IN, 16384)) \
  PHASE(26, phase_ffn_out(p, lds, O_W2OUT, 8, false)) \
  PHASE(27, phase_rows<4>(p, lds))

#if !MULTI_LAUNCH
#ifndef USE_CG
#define USE_CG 0
#endif
#if USE_CG
#define PHASE(n, call) if (lo <= (n) && (n) < hi) { if ((n) > lo) { if ((n) == 1) grid.sync(); else xcd_barrier(xbar); } call; }
#else
#define PHASE(n, call) if (lo <= (n) && (n) < hi) { if ((n) > lo) xcd_barrier(xbar); call; }
#endif
__global__ void __launch_bounds__(512) mk(P p, int lo, int hi) {
  extern __shared__ __attribute__((aligned(16))) unsigned char lds[];
#if USE_CG
  cg::grid_group grid = cg::this_grid();
#endif
  volatile LAS unsigned* stw = (volatile LAS unsigned*)(lds + LDS_BYTES - 16);
  if (threadIdx.x == 0) { stw[0] = 0u; stw[1] = 0u; stw[2] = 0u; stw[3] = 0u; }
  __syncthreads();
  XcdBarrier xbar = xcd_barrier_post((unsigned*)(p.ws + O_BAR), stw);
  PHASE_PROGRAM
}
#undef PHASE
#else
#define PHASE(n, call) if constexpr (PH == (n)) { call; }
template <int PH>
__global__ void __launch_bounds__(512) mkp(P p) {
  extern __shared__ __attribute__((aligned(16))) unsigned char lds[];
  PHASE_PROGRAM
}
#undef PHASE
template <int PH> static void launch_all(const P& p, int grid, hipStream_t stream) {
  if constexpr (PH < NPH) {
    (void)hipFuncSetAttribute((const void*)mkp<PH>, hipFuncAttributeMaxDynamicSharedMemorySize, LDS_BYTES);
    hipLaunchKernelGGL(mkp<PH>, dim3(grid), dim3(NTHR), LDS_BYTES, stream, p);
    launch_all<PH + 1>(p, grid, stream);
  }
}
#endif

extern "C" void kernel_launch(void* const* d_in, const int* in_sizes, int n_in, void* d_out, int out_size, void* d_ws, size_t ws_size, hipStream_t stream) {
  static int grid_blocks = 0;
  if (!grid_blocks) {
    if (n_in != 25 || ws_size < O_END || ws_size < O_ACT + 16896ull * 2816 * 2) { fprintf(stderr, "kernel_launch: unexpected n_in %d / ws %zu\n", n_in, ws_size); grid_blocks = -1; return; }
    int dev = 0, cus = 0, per_cu = 0;
    (void)hipGetDevice(&dev);
    (void)hipDeviceGetAttribute(&cus, hipDeviceAttributeMultiprocessorCount, dev);
#if !MULTI_LAUNCH
    if (hipFuncSetAttribute((const void*)mk, hipFuncAttributeMaxDynamicSharedMemorySize, LDS_BYTES) != hipSuccess) { fprintf(stderr, "hipFuncSetAttribute failed\n"); grid_blocks = -1; return; }
    if (hipOccupancyMaxActiveBlocksPerMultiprocessor(&per_cu, (const void*)mk, NTHR, LDS_BYTES) != hipSuccess || per_cu < 1) { fprintf(stderr, "occupancy query failed (%d)\n", per_cu); grid_blocks = -1; return; }
#endif
    grid_blocks = cus * 1;
    fprintf(stderr, "kernel_launch: cus %d per_cu %d grid %d\n", cus, per_cu, grid_blocks);
  }
  if (grid_blocks < 0) return;
  P p{};
  for (int i = 0; i < 25; ++i) p.in[i] = (const float*)d_in[i];
  p.out = (float*)d_out; p.ws = (unsigned char*)d_ws;
#if MULTI_LAUNCH
  launch_all<0>(p, grid_blocks, stream);
#else
  int lo = 0, hi = NPH;
  if (hipMemsetAsync((unsigned char*)d_ws + O_BAR, 0, 16384, stream) != hipSuccess) { fprintf(stderr, "memset of barrier words failed\n"); return; }
  void* args[] = {&p, &lo, &hi};
#ifdef PROBE_K
  {
    hipLaunchKernelGGL(mk, dim3(grid_blocks), dim3(NTHR), LDS_BYTES, stream, p, 0, PROBE_K + 1);
    (void)hipMemsetAsync((unsigned char*)d_ws + O_BAR, 0, 16384, stream);
  }
#endif
#if USE_CG
  hipError_t e = hipLaunchCooperativeKernel((const void*)mk, dim3(grid_blocks), dim3(NTHR), args, LDS_BYTES, stream);
#else
  (void)args;
  hipLaunchKernelGGL(mk, dim3(grid_blocks), dim3(NTHR), LDS_BYTES, stream, p, lo, hi);
  hipError_t e = hipPeekAtLastError();
#endif
  if (e != hipSuccess) fprintf(stderr, "cooperative launch failed: %s (grid %d)\n", hipGetErrorString(e), grid_blocks);
#endif
}
```

```cpp
#include <hip/hip_runtime.h>
#include <hip/hip_cooperative_groups.h>
#include <cstdio>
#include <cstdint>
namespace cg = cooperative_groups;

#ifndef MULTI_LAUNCH
#define MULTI_LAUNCH 0
#endif

typedef unsigned short bfraw;
typedef __attribute__((ext_vector_type(8))) short bf16x8;
typedef __attribute__((ext_vector_type(4))) float f32x4;
#define DEVI __device__ __forceinline__

constexpr int NTHR = 512;
constexpr int GBM = 128;
constexpr int LROW = 40;
constexpr int LDS_BYTES = 143360;
constexpr float EPS = 1e-6f;

enum { I_X, I_C, I_CTX, I_CCTX, I_WADA, I_BADA, I_GFFN1, I_W1IN, I_W1OUT, I_GMIX, I_WIN, I_BGATES, I_CONVW, I_CONVB,
       I_GHEAD, I_GSGU, I_WS, I_BS, I_WA, I_WB, I_WO, I_GFFN2, I_W2IN, I_W2OUT, I_GFINAL };

struct P { const float* in[25]; float* out; unsigned char* ws; };

constexpr size_t O_W1IN  = 0;
constexpr size_t O_W1OUT = O_W1IN  + 5632ull * 1024 * 2;
constexpr size_t O_WTA   = O_W1OUT + 1024ull * 2816 * 2;
constexpr size_t O_WTB   = O_WTA   + 4096ull * 1024 * 2;
constexpr size_t O_WA    = O_WTB   + 4096ull * 1024 * 2;
constexpr size_t O_WB    = O_WA    + 1024ull * 1024 * 2;
constexpr size_t O_WO    = O_WB    + 1024ull * 1024 * 2;
constexpr size_t O_W2IN  = O_WO    + 1024ull * 1024 * 2;
constexpr size_t O_W2OUT = O_W2IN  + 5632ull * 1024 * 2;
constexpr size_t O_WSB   = O_W2OUT + 1024ull * 2816 * 2;
constexpr size_t O_MODSP = O_WSB   + 4ull * 128 * 128 * 2;
constexpr size_t O_MODS  = O_MODSP + 16ull * 3 * 9216 * 4;
constexpr size_t O_HCTX  = O_MODS  + 3ull * 9216 * 4;
constexpr size_t O_HN    = O_HCTX  + 512ull * 1024 * 4;
constexpr size_t O_GATES = O_HN    + 16896ull * 1024 * 2;
constexpr size_t O_CTXRAW= O_GATES + 16896ull * 16 * 4;
constexpr size_t O_BIG   = O_CTXRAW+ 2ull * 256 * 3072 * 2;
constexpr size_t O_ACT   = O_BIG;
constexpr size_t O_ST    = O_BIG;
constexpr size_t O_QRAW  = O_BIG;
constexpr size_t O_KRAW  = O_QRAW  + 8448ull * 1024 * 2;
constexpr size_t O_V     = O_ST    + 8ull * 66 * 131072;
constexpr size_t O_GVS   = O_V     + 8448ull * 1024 * 2;
constexpr size_t O_QC    = O_GVS   + 8192ull * 1024 * 2;
constexpr size_t O_KC    = O_QC    + 8448ull * 1024 * 2;
constexpr size_t O_NLOC  = O_KC    + 8448ull * 1024 * 2;
constexpr size_t O_NENT  = O_NLOC  + 8ull * 66 * 256 * 4;
constexpr size_t O_MG    = O_NENT  + 8ull * 66 * 256 * 4;
constexpr size_t O_RS    = O_MG    + 8192;
constexpr size_t O_HPARK = O_RS    + 8192ull * 4;
constexpr size_t O_BAR   = O_HPARK + 8192ull * 1024 * 2;
constexpr size_t O_END   = O_BAR + 16384;
static_assert(O_ACT + 16896ull * 2816 * 2 <= 268435456ull, "ws");
static_assert(O_END <= 268435456ull, "ws");
static_assert(O_KRAW + 8448ull * 1024 * 2 <= O_V, "overlay");

DEVI int ltid() { int t = __builtin_amdgcn_workitem_id_x(); asm volatile("" : "+v"(t)); return t; }
DEVI unsigned char* lws(unsigned char* w) { asm volatile("" : "+s"(w)); return w; }
DEVI float4 ld4(const float* p);
typedef float nt_f4 __attribute__((ext_vector_type(4)));
typedef unsigned nt_u2 __attribute__((ext_vector_type(2)));
DEVI bfraw f2bf(float f) { unsigned u = __float_as_uint(f); u += 0x7fffu + ((u >> 16) & 1u); return (bfraw)(u >> 16); }
DEVI float bf2f(bfraw h) { return __uint_as_float(((unsigned)h) << 16); }
DEVI float fexp(float x) { return __builtin_amdgcn_exp2f(x * 1.4426950408889634f); }
DEVI float sigmoidf_(float x) { return __builtin_amdgcn_rcpf(1.f + fexp(-x)); }
DEVI float siluf_(float x) { return x * sigmoidf_(x); }
DEVI float geluf_(float x) { return x * sigmoidf_(1.5957691216057308f * (x + 0.044715f * x * x * x)); }
DEVI float logsigf_(float x) { return fminf(x, 0.f) - log1pf(expf(-fabsf(x))); }
DEVI float wave_sum(float v) {
#pragma unroll
  for (int o = 32; o > 0; o >>= 1) v += __shfl_xor(v, o, 64);
  return v;
}
DEVI float red16(float v) {
  v += __shfl_xor(v, 1, 64); v += __shfl_xor(v, 2, 64); v += __shfl_xor(v, 4, 64); v += __shfl_xor(v, 8, 64);
  return v;
}
DEVI float redsin(float a, bool cosine) {
  float k = rintf(a * 0.15915494309189535f);
  float r = fmaf(-k, 6.2831854820251465f, a);
  r = fmaf(-k, -1.7484555e-7f, r);
  return cosine ? __cosf(r) : __sinf(r);
}


DEVI float seg_scan_sum(float v, int tid, float* s_x) {
  const int lane = tid & 63;
#pragma unroll
  for (int o = 1; o < 64; o <<= 1) { float t = __shfl_up(v, o, 64); if (lane >= o) v += t; }
  if (lane == 63 && tid < 256) s_x[tid >> 6] = v;
  __syncthreads();
  if (tid < 256 && ((tid >> 6) & 1)) v += s_x[(tid >> 6) - 1];
  __syncthreads();
  return v;
}
DEVI float seg_scan_max(float v, int tid, float* s_x) {
  const int lane = tid & 63;
#pragma unroll
  for (int o = 1; o < 64; o <<= 1) { float t = __shfl_up(v, o, 64); if (lane >= o) v = fmaxf(v, t); }
  if (lane == 63 && tid < 256) s_x[tid >> 6] = v;
  __syncthreads();
  if (tid < 256 && ((tid >> 6) & 1)) v = fmaxf(v, s_x[(tid >> 6) - 1]);
  __syncthreads();
  return v;
}

#define XB_TMO      128
#define XB_XCNT(j)  (256  + 64 * (j))
#define XB_XSUB(j)  (1280 + 64 * (j))
#define XB_XGEN(j)  (2304 + 64 * (j))
#define XB_TOP      3328
#define XB_TOPGEN   3392
#define XCD_BAR_WORDS 3456
#define XB_SPIN_CAP (1u << 18)
#define LAS __attribute__((address_space(3)))

__device__ __forceinline__ unsigned xb_ld(unsigned* p)              { return __hip_atomic_load(p, __ATOMIC_RELAXED, __HIP_MEMORY_SCOPE_AGENT); }
__device__ __forceinline__ unsigned xb_add(unsigned* p, unsigned v) { return __hip_atomic_fetch_add(p, v, __ATOMIC_RELAXED, __HIP_MEMORY_SCOPE_AGENT); }
__device__ __forceinline__ unsigned xb_xcc_id() { return (unsigned)__builtin_amdgcn_s_getreg((3 << 11) | 20) & 0xFu; }
#define XB_SPIN(cond, bar) do { unsigned _sp = 0; while (cond) { __builtin_amdgcn_s_sleep(1); \
    if ((++_sp & 255u) == 0u) { if (xb_ld(&(bar)[XB_TMO])) break; if (_sp > XB_SPIN_CAP) { atomicAdd(&(bar)[XB_TMO], 1u); break; } } } } while (0)

struct XcdBarrier {
    unsigned* bar; unsigned x;
    volatile LAS unsigned* st;
};

__device__ __forceinline__ XcdBarrier xcd_barrier_post(unsigned* bar, volatile LAS unsigned* st) {
    XcdBarrier b; b.bar = bar; b.x = xb_xcc_id(); b.st = st;
    if (threadIdx.x == 0) (void)xb_add(&bar[XB_XCNT(b.x)], 1u);
    return b;
}
__device__ __forceinline__ void xcd_barrier_complete(unsigned* bar, unsigned x, unsigned& nloc, unsigned& nx) {
    const unsigned G = gridDim.x * gridDim.y * gridDim.z;
    unsigned sum, cnt, mine, sp = 0u;
    for (;;) {
        sum = 0u; cnt = 0u; mine = 0u;
#pragma unroll
        for (unsigned j = 0; j < 16; ++j) { const unsigned c = xb_ld(&bar[XB_XCNT(j)]); sum += c; cnt += (c > 0u) ? 1u : 0u; mine = (j == x) ? c : mine; }
        if (sum == G) break;
        __builtin_amdgcn_s_sleep(1);
        if ((++sp & 255u) == 0u) { if (xb_ld(&bar[XB_TMO])) break; if (sp > XB_SPIN_CAP) { atomicAdd(&bar[XB_TMO], 1u); break; } }
    }
    nloc = mine > 0u ? mine : 1u; nx = cnt > 0u ? cnt : 1u;
}

__device__ __forceinline__ void xcd_barrier(const XcdBarrier& b) {
    asm volatile("s_waitcnt vmcnt(0)" ::: "memory");
    __syncthreads();
    if (threadIdx.x == 0) {
        unsigned* bar = b.bar;
        __builtin_amdgcn_s_waitcnt(0);
        unsigned nloc = b.st[0], nx = b.st[1];
        if (nloc == 0u) { xcd_barrier_complete(bar, b.x, nloc, nx); b.st[0] = nloc; b.st[1] = nx; }
        const unsigned old = xb_add(&bar[XB_XSUB(b.x)], 1u);
        const unsigned gen = old / nloc;
        if (old + 1u == (gen + 1u) * nloc) {
            __builtin_amdgcn_fence(__ATOMIC_RELEASE, "agent");
            asm volatile("s_waitcnt vmcnt(0)" ::: "memory");
            const unsigned og = xb_add(&bar[XB_TOP], 1u);
            const unsigned tg = og / nx;
            if (og + 1u == (tg + 1u) * nx) xb_add(&bar[XB_TOPGEN], 1u);
            else XB_SPIN(xb_ld(&bar[XB_TOPGEN]) == tg, bar);
            __builtin_amdgcn_fence(__ATOMIC_ACQUIRE, "agent");
            xb_add(&bar[XB_XGEN(b.x)], 1u);
            asm volatile("s_waitcnt vmcnt(0)" ::: "memory");
        } else {
            XB_SPIN(xb_ld(&bar[XB_XGEN(b.x)]) == gen, bar);
            __builtin_amdgcn_fence(__ATOMIC_ACQUIRE, "agent");
            asm volatile("s_waitcnt vmcnt(0)" ::: "memory");
        }
    }
    __syncthreads();
}

template <int BM, int BN, bool ATR, bool BTR, bool ALDS>
DEVI void gemm_tile(const bfraw* __restrict__ A, int lda, const bfraw* __restrict__ B, int ldb, int K,
                    const float* kscale, f32x4 (&acc)[BM / 32][BN / 64], bfraw* st, const bfraw* sAres, int ldres) {
  constexpr int MI = BM / 32, NJ = BN / 64, CA = BM / 128, CB = BN / 128, WM = BM / 2, WN = BN / 4;
  constexpr int STAGE = (ALDS ? BN : (BM + BN)) * LROW;
  int tid_ = ltid();
  const int tid = tid_, lane = tid & 63, wid = tid >> 6, wm = wid >> 2, wn = wid & 3;
  const int fr = lane & 15, fq = lane >> 4;
  uint4 ra0 = {0, 0, 0, 0}, ra1 = {0, 0, 0, 0}, rb0 = {0, 0, 0, 0}, rb1 = {0, 0, 0, 0};
  const int nk = K >> 5;

  auto gla = [&](int c, int k0) -> uint4 {
    if (!ATR) { int row = c >> 2, kc = (c & 3) * 8; return *(const uint4*)(A + (size_t)row * lda + k0 + kc); }
    else { int krow = c / (BM / 8), m0 = (c % (BM / 8)) * 8; return *(const uint4*)(A + (size_t)(k0 + krow) * lda + m0); }
  };
  auto glb = [&](int c, int k0) -> uint4 {
    if (!BTR) { int row = c >> 2, kc = (c & 3) * 8; return *(const uint4*)(B + (size_t)row * ldb + k0 + kc); }
    else { int krow = c / (BN / 8), n0 = (c % (BN / 8)) * 8; return *(const uint4*)(B + (size_t)(k0 + krow) * ldb + n0); }
  };
  auto gload = [&](int kt) {
    const int k0 = kt << 5;
    if (!ALDS) { ra0 = gla(tid, k0); if (CA > 1) ra1 = gla(tid + NTHR, k0); }
    rb0 = glb(tid, k0); if (CB > 1) rb1 = glb(tid + NTHR, k0);
  };
  constexpr int TSA = BM + 8, TSB = BN + 8;
  auto scale8 = [&](uint4 r, float sc) -> uint4 {
    unsigned w[4] = {r.x, r.y, r.z, r.w};
#pragma unroll
    for (int e = 0; e < 4; ++e) w[e] = (unsigned)f2bf(bf2f((bfraw)(w[e] & 0xffff)) * sc) | ((unsigned)f2bf(bf2f((bfraw)(w[e] >> 16)) * sc) << 16);
    return uint4{w[0], w[1], w[2], w[3]};
  };
  auto lstore = [&](int buf, int kt) {
    bfraw* sA = st + buf * STAGE;
    bfraw* sB = sA + (ALDS ? 0 : BM * LROW);
    auto sta = [&](int c, uint4 v) {
      if (!ATR) { int row = c >> 2, kc = (c & 3) * 8; *(uint4*)(sA + row * LROW + kc) = v; }
      else { int krow = c / (BM / 8), m0 = (c % (BM / 8)) * 8; *(uint4*)(sA + krow * TSA + m0) = v; }
    };
    auto stb = [&](int c, uint4 v) {
      if (!BTR) { int row = c >> 2, kc = (c & 3) * 8; *(uint4*)(sB + row * LROW + kc) = v; }
      else {
        int krow = c / (BN / 8), n0 = (c % (BN / 8)) * 8;
        if (kscale) v = scale8(v, kscale[(kt << 5) + krow]);
        *(uint4*)(sB + krow * TSB + n0) = v;
      }
    };
    if (!ALDS) { sta(tid, ra0); if (CA > 1) sta(tid + NTHR, ra1); }
    stb(tid, rb0); if (CB > 1) stb(tid + NTHR, rb1);
  };
  typedef short s16x4 __attribute__((ext_vector_type(4)));
  auto trfrag = [&](const bfraw* sT, int TS, int mt) -> bf16x8 {
    const bfraw* a1 = sT + (8 * fq + (fr >> 2)) * TS + mt + (fr & 3) * 4;
    s16x4 r1 = __builtin_amdgcn_ds_read_tr16_b64_v4i16((__attribute__((address_space(3))) s16x4*)a1);
    s16x4 r2 = __builtin_amdgcn_ds_read_tr16_b64_v4i16((__attribute__((address_space(3))) s16x4*)(a1 + 4 * TS));
    return bf16x8{r1[0], r1[1], r1[2], r1[3], r2[0], r2[1], r2[2], r2[3]};
  };
  auto compute = [&](int buf, int kt) {
    const bfraw* sA = st + buf * STAGE;
    const bfraw* sB = sA + (ALDS ? 0 : BM * LROW);
    bf16x8 af[MI], bfr[NJ];
#pragma unroll
    for (int i = 0; i < MI; ++i) {
      if (ALDS) af[i] = *(const bf16x8*)(sAres + (wm * WM + i * 16 + fr) * ldres + (kt << 5) + fq * 8);
      else if (ATR) af[i] = trfrag(sA, TSA, wm * WM + i * 16);
      else af[i] = *(const bf16x8*)(sA + (wm * WM + i * 16 + fr) * LROW + fq * 8);
    }
#pragma unroll
    for (int j = 0; j < NJ; ++j) {
      if (BTR) bfr[j] = trfrag(sB, TSB, wn * WN + j * 16);
      else bfr[j] = *(const bf16x8*)(sB + (wn * WN + j * 16 + fr) * LROW + fq * 8);
    }
#pragma unroll
    for (int i = 0; i < MI; ++i)
#pragma unroll
      for (int j = 0; j < NJ; ++j) acc[i][j] = __builtin_amdgcn_mfma_f32_16x16x32_bf16(af[i], bfr[j], acc[i][j], 0, 0, 0);
  };

  uint4 xa0 = {0, 0, 0, 0}, xa1 = {0, 0, 0, 0}, xb0 = {0, 0, 0, 0}, xb1 = {0, 0, 0, 0};
  auto swapsets = [&]() { uint4 t; t = ra0; ra0 = xa0; xa0 = t; t = ra1; ra1 = xa1; xa1 = t; t = rb0; rb0 = xb0; xb0 = t; t = rb1; rb1 = xb1; xb1 = t; };
  __syncthreads();
  gload(0); lstore(0, 0);
  if (nk > 1) gload(1);
  if (nk > 2) { swapsets(); gload(2); swapsets(); }
  __syncthreads();
  for (int kt = 0; kt < nk; kt += 2) {
    compute(0, kt);
    if (kt + 1 < nk) lstore(1, kt + 1);
    if (kt + 3 < nk) gload(kt + 3);
    __syncthreads();
    if (kt + 1 >= nk) break;
    compute(1, kt + 1);
    swapsets();
    if (kt + 2 < nk) lstore(0, kt + 2);
    if (kt + 4 < nk) gload(kt + 4);
    swapsets();
    __syncthreads();
  }
}

#define ZERO_ACC(acc, MI, NJ) _Pragma("unroll") for (int _i = 0; _i < (MI); ++_i) _Pragma("unroll") for (int _j = 0; _j < (NJ); ++_j) acc[_i][_j] = f32x4{0.f, 0.f, 0.f, 0.f};
#define EPI_BEGIN(BM, BN) { int _t = ltid(); const int _l = _t & 63, _w = _t >> 6; \
    const int _rb = (_w >> 2) * ((BM) / 2) + (_l >> 4) * 4, _cb = (_w & 3) * ((BN) / 4) + (_l & 15); \
    _Pragma("unroll") for (int i = 0; i < (BM) / 32; ++i) _Pragma("unroll") for (int j = 0; j < (BN) / 64; ++j) _Pragma("unroll") for (int r = 0; r < 4; ++r) { \
      const int row = _rb + i * 16 + r, col = _cb + j * 16;
#define EPI_END }}
#define EPIR_BEGIN(BM, BN) { int _t = ltid(); const int _l = _t & 63, _w = _t >> 6; \
    const int _rb = (_w >> 2) * ((BM) / 2) + (_l >> 4) * 4, _cb = (_w & 3) * ((BN) / 4) + (_l & 15); \
    _Pragma("unroll") for (int i = 0; i < (BM) / 32; ++i) _Pragma("unroll") for (int r = 0; r < 4; ++r) { \
      const int row = _rb + i * 16 + r;
#define EPIR_COLS(BN) _Pragma("unroll") for (int j = 0; j < (BN) / 64; ++j) { const int col = _cb + j * 16;
#define EPIR_END }}}


namespace pg8 {
#define PG8_LAS __attribute__((address_space(3)))
typedef unsigned short bf16_t;
typedef short bf16x8 __attribute__((ext_vector_type(8)));
typedef float f32x4 __attribute__((ext_vector_type(4)));
typedef unsigned u32x4 __attribute__((ext_vector_type(4)));
constexpr int BM = 256, BK = 64, HALF = 128, HTB = HALF * BK * 2  , STAGE_BYTES = 8 * HTB, NXCD = 8, WGM = 8;

__host__ __device__ __forceinline__ int lds_byte(int r, int c) { const int st = (r >> 4) * 2 + (c >> 5), rr = r & 15, cc = c & 31, ob = rr * 64 + cc * 2; return st * 1024 + (ob ^ (((ob >> 9) & 1) << 5)); }
__host__ __device__ __forceinline__ void stage_rc(int b, int& R, int& C) { const int st = b / 1024, sb = b % 1024, swz = sb ^ (((sb >> 9) & 1) << 5); R = (st >> 1) * 16 + swz / 64; C = (st & 1) * 32 + (swz % 64) / 2; }
__host__ __device__ __forceinline__ int perm32(int rho) { const int n = rho >> 4, i = rho & 15; return 8 * (i >> 2) + 4 * n + (i & 3); }

struct Unit { int pm, pn; };
struct Gemm { const bf16_t* A; const bf16_t* Bt; int M, N, K, ld; };
struct StaticOrder {
    int nM, nN, nwg, G, c;
    __host__ __device__ void init(int M, int N, int G_, int c_) { nM = M / BM; nN = N / BM; nwg = nM * nN; G = G_; c = c_; }
    __host__ __device__ bool next(int i, Unit& u) const {
        const long L = (long)i * G + c; if (L >= nwg) return false;
        int wgid = (int)L; { const int q = nwg / NXCD, r = nwg % NXCD, xcd = wgid % NXCD, off = wgid / NXCD; wgid = (xcd < r ? xcd * (q + 1) : r * (q + 1) + (xcd - r) * q) + off; }
        const int nig = WGM * nN, gid = wgid / nig, fm = gid * WGM, gsz = (nM - fm) < WGM ? (nM - fm) : WGM;
        u.pm = fm + ((wgid % nig) % gsz); u.pn = (wgid % nig) / gsz; return true;
    }
    __device__ __forceinline__ void a_ready(const Unit&) const {}
    __device__ __forceinline__ void done(const Unit&) const {}
};
__device__ __forceinline__ unsigned cvt_pk_bf16(float lo, float hi) { unsigned r; asm volatile("v_cvt_pk_bf16_f32 %0, %1, %2" : "=v"(r) : "v"(lo), "v"(hi)); return r; }
template <class Epi, class Sched, bool STAMP = false>
__device__ __forceinline__ void gemm_phase(PG8_LAS unsigned char* lds, const Gemm g, const Sched& S, const Epi& E, unsigned long long* stamps) {
    const int tid = threadIdx.x, wid = __builtin_amdgcn_readfirstlane(tid >> 6), lane = tid & 63, wr = wid >> 2, wc = wid & 3, fr = lane & 15, fq = lane >> 4;
    const int K = g.K, nt = K / BK;
    int ts_lo = 0, ts_hi = 0, nts = 0; const unsigned long long rt_entry = STAMP ? (unsigned long long)wall_clock64() : 0ull;
#define PG8_STAMP() do { if (STAMP && wid == 0 && nts < 64) { const unsigned long long _c = (unsigned long long)clock64(); \
        ts_lo = (lane == nts) ? (int)(unsigned)_c : ts_lo; ts_hi = (lane == nts) ? (int)(unsigned)(_c >> 32) : ts_hi; ++nts; } } while (0)
    PG8_STAMP();
    unsigned voffA[2], voffB[2];
#pragma unroll
    for (int i = 0; i < 2; ++i) { int R, C; stage_rc(tid * 16 + i * 8192, R, C); const int Rb = Epi::PERM ? ((R & ~31) + perm32(R & 31)) : R;
        voffA[i] = (unsigned)(R * g.ld + C) * 2u; voffB[i] = (unsigned)(Rb * g.ld + C) * 2u; }
    const size_t kstep = (size_t)(BK * 2);
    const size_t hstep = (size_t)HALF * g.ld * 2;
    const size_t tstep = 2 * hstep;
    const unsigned ldsw = (unsigned)wid * 1024u;
    const int aoff = lds_byte(wr * 64 + fr, fq * 8), boff = lds_byte(wc * 32 + fr, fq * 8);
#define PG8_SA(b, h) (((b) * 2 + (h)) * HTB)
#define PG8_SB(b, h) ((4 + (b) * 2 + (h)) * HTB)
#define PG8_STAGE(bufoff, gbase, voff) do { _Pragma("unroll") for (int _i = 0; _i < 2; ++_i) \
        __builtin_amdgcn_global_load_lds((const unsigned*)((const char*)(gbase) + (voff)[_i]), (PG8_LAS unsigned*)(lds + (bufoff) + ldsw + _i * 8192), 16, 0, 0); } while (0)
#define PG8_LDA(dst, b, h) do { _Pragma("unroll") for (int m = 0; m < 4; ++m) _Pragma("unroll") for (int k = 0; k < 2; ++k) dst[m][k] = *(const PG8_LAS bf16x8*)(lds + PG8_SA(b, h) + aoff + m * 2048 + k * 1024); } while (0)
#define PG8_LDB(dst, b, h) do { _Pragma("unroll") for (int n = 0; n < 2; ++n) _Pragma("unroll") for (int k = 0; k < 2; ++k) dst[n][k] = *(const PG8_LAS bf16x8*)(lds + PG8_SB(b, h) + boff + n * 2048 + k * 1024); } while (0)
#define PG8_MMA(ai, bj, At, Bt) do { __builtin_amdgcn_s_setprio(1); _Pragma("unroll") for (int m = 0; m < 4; ++m) _Pragma("unroll") for (int n = 0; n < 2; ++n) _Pragma("unroll") for (int k = 0; k < 2; ++k) \
        acc[ai][bj][m][n] = __builtin_amdgcn_mfma_f32_16x16x32_bf16(Bt[n][k], At[m][k], acc[ai][bj][m][n], 0, 0, 0); __builtin_amdgcn_s_setprio(0); } while (0)
#define PG8_WAIT_V(n) asm volatile("s_waitcnt vmcnt(" #n ")" ::: "memory")
#define PG8_WAIT_L(n) asm volatile("s_waitcnt lgkmcnt(" #n ")" ::: "memory")
#define PG8_BAR __builtin_amdgcn_s_barrier()
#define PG8_SCHED __builtin_amdgcn_sched_barrier(0)
    Unit cur, nxt; int ui = 0;
    if (!S.next(0, cur)) return;
    f32x4 acc[2][2][4][2];
#pragma unroll
    for (int a = 0; a < 2; ++a)
#pragma unroll
        for (int b = 0; b < 2; ++b)
#pragma unroll
            for (int m = 0; m < 4; ++m)
#pragma unroll
                for (int n = 0; n < 2; ++n) acc[a][b][m][n] = (f32x4){0.f, 0.f, 0.f, 0.f};
    bf16x8 At[4][2], B0[2][2], B1[2][2];
    const char* cA = (const char*)g.A + (size_t)cur.pm * tstep; const char* cB = (const char*)g.Bt + (size_t)cur.pn * tstep;
    S.a_ready(cur);
    PG8_STAGE(PG8_SB(0, 0), cB, voffB); PG8_STAGE(PG8_SA(0, 0), cA, voffA); PG8_STAGE(PG8_SB(0, 1), cB + hstep, voffB); PG8_STAGE(PG8_SA(0, 1), cA + hstep, voffA);
    if (wr == 1) PG8_BAR;
    PG8_WAIT_V(4); PG8_BAR;
    PG8_STAGE(PG8_SB(1, 0), cB + kstep, voffB); PG8_STAGE(PG8_SA(1, 0), cA + kstep, voffA); PG8_STAGE(PG8_SB(1, 1), cB + hstep + kstep, voffB);
    PG8_WAIT_V(6); PG8_BAR;
    PG8_STAMP();
    for (;;) {
        const bool has_next = S.next(ui + 1, nxt);
        const char* nA = has_next ? (const char*)g.A + (size_t)nxt.pm * tstep : cA; const char* nB = has_next ? (const char*)g.Bt + (size_t)nxt.pn * tstep : cB;
        for (int t = 0; t < nt; t += 2) {
            const bool last = (t == nt - 2);
            const char* a1 = cA + (size_t)(t + 1) * kstep;
            const char* a2 = last ? nA : cA + (size_t)(t + 2) * kstep; const char* b2 = last ? nB : cB + (size_t)(t + 2) * kstep;
            const char* a3 = a2 + kstep; const char* b3 = b2 + kstep;
            if (last && has_next) S.a_ready(nxt);
            PG8_LDB(B0, 0, 0); PG8_SCHED; PG8_LDA(At, 0, 0); PG8_STAGE(PG8_SA(1, 1), a1 + hstep, voffA);
            PG8_WAIT_L(8); PG8_BAR; PG8_WAIT_L(0); PG8_MMA(0, 0, At, B0); PG8_BAR; PG8_SCHED;
            PG8_LDB(B1, 0, 1); PG8_STAGE(PG8_SB(0, 0), b2, voffB);
            PG8_BAR; PG8_WAIT_L(0); PG8_MMA(0, 1, At, B1); PG8_BAR;
            PG8_LDA(At, 0, 1); PG8_STAGE(PG8_SA(0, 0), a2, voffA);
            PG8_BAR; PG8_WAIT_L(0); PG8_MMA(1, 0, At, B0); PG8_BAR; PG8_SCHED;
            PG8_STAGE(PG8_SB(0, 1), b2 + hstep, voffB);
            PG8_WAIT_V(6); PG8_BAR; PG8_MMA(1, 1, At, B1); PG8_BAR;
            PG8_LDB(B0, 1, 0); PG8_SCHED; PG8_LDA(At, 1, 0); PG8_STAGE(PG8_SA(0, 1), a2 + hstep, voffA);
            PG8_WAIT_L(8); PG8_BAR; PG8_WAIT_L(0); PG8_MMA(0, 0, At, B0); PG8_BAR; PG8_SCHED;
            PG8_LDB(B1, 1, 1); PG8_STAGE(PG8_SB(1, 0), b3, voffB);
            PG8_BAR; PG8_WAIT_L(0); PG8_MMA(0, 1, At, B1); PG8_BAR;
            PG8_LDA(At, 1, 1); PG8_STAGE(PG8_SA(1, 0), a3, voffA);
            PG8_BAR; PG8_WAIT_L(0); PG8_MMA(1, 0, At, B0); PG8_BAR; PG8_SCHED;
            PG8_STAGE(PG8_SB(1, 1), b3 + hstep, voffB);
            PG8_WAIT_V(6); PG8_BAR; PG8_MMA(1, 1, At, B1); PG8_BAR;
        }
        PG8_STAMP();
        if constexpr (!Epi::AFTER_DRAIN) { E(acc, cur, wr, wc, fr, fq); S.done(cur); }
        PG8_STAMP();
        if (!has_next) break;
#pragma unroll
        for (int a = 0; a < 2; ++a)
#pragma unroll
            for (int b = 0; b < 2; ++b)
#pragma unroll
                for (int m = 0; m < 4; ++m)
#pragma unroll
                    for (int n = 0; n < 2; ++n) acc[a][b][m][n] = (f32x4){0.f, 0.f, 0.f, 0.f};
        cur = nxt; cA = nA; cB = nB; ++ui;
    }
    PG8_WAIT_V(0);
    if (wr == 0) PG8_BAR;
    PG8_BAR;
    if constexpr (Epi::AFTER_DRAIN) { E.fused(acc, cur, wr, wc, fr, fq, lds, wid, lane); S.done(cur); }
    PG8_STAMP();
    if (STAMP && wid == 0) { stamps[lane] = lane < nts ? (((unsigned long long)(unsigned)ts_hi << 32) | (unsigned)ts_lo) : 0ull;
        if (lane == 62) stamps[62] = rt_entry; if (lane == 63) stamps[63] = (unsigned long long)wall_clock64(); }
#undef PG8_STAMP
#undef PG8_SA
#undef PG8_SB
#undef PG8_STAGE
#undef PG8_LDA
#undef PG8_LDB
#undef PG8_MMA
#undef PG8_WAIT_V
#undef PG8_WAIT_L
#undef PG8_BAR
#undef PG8_SCHED
}
}

typedef pg8::f32x4 pf4;
DEVI float4 ld4(const float* p) { return *(const float4*)p; }
struct EpiFfnIn {
  static constexpr bool PERM = false, AFTER_DRAIN = false;
  bfraw* act;
  DEVI void operator()(const pf4 (&acc)[2][2][4][2], const pg8::Unit& u, int wr, int wc, int fr, int fq) const {
    const int row0 = u.pm * 256 + wr * 64 + fr, f0 = (u.pn * 256 + wc * 32) / 2 + 4 * fq;
#pragma unroll
    for (int ai = 0; ai < 2; ++ai)
#pragma unroll
      for (int m = 0; m < 4; ++m) {
        bfraw* rowp = act + (size_t)(row0 + ai * 128 + m * 16) * 2816 + f0;
#pragma unroll
        for (int bj = 0; bj < 2; ++bj) {
          const pf4 a = acc[ai][bj][m][0], b = acc[ai][bj][m][1];
          uint2 w; w.x = pg8::cvt_pk_bf16(siluf_(a[0]) * b[0], siluf_(a[1]) * b[1]); w.y = pg8::cvt_pk_bf16(siluf_(a[2]) * b[2], siluf_(a[3]) * b[3]);
          *(uint2*)(rowp + bj * 64) = w;
        }
      }
  }
};
struct EpiResid {
  static constexpr bool PERM = false, AFTER_DRAIN = false;
  float* h; const float* mods; int rowoff, gidx; float scale; int mrow;
  DEVI void operator()(const pf4 (&acc)[2][2][4][2], const pg8::Unit& u, int wr, int wc, int fr, int fq) const {
    const int row0 = rowoff + u.pm * 256 + wr * 64 + fr, col0 = u.pn * 256 + wc * 32 + 4 * fq;
#pragma unroll
    for (int ai = 0; ai < 2; ++ai)
#pragma unroll
      for (int m = 0; m < 4; ++m) {
        const int r = row0 + ai * 128 + m * 16;
        float* rowp = h + (size_t)r * 1024 + col0;
        const float* gp = mods + (mrow >= 0 ? mrow : (r >> 13)) * 9216 + gidx * 1024 + col0;
#pragma unroll
        for (int bj = 0; bj < 2; ++bj)
#pragma unroll
          for (int n = 0; n < 2; ++n) {
            float4 hv = ld4(rowp + bj * 128 + n * 16); const float4 g = ld4(gp + bj * 128 + n * 16); const pf4 a = acc[ai][bj][m][n];
            hv.x += scale * g.x * a[0]; hv.y += scale * g.y * a[1]; hv.z += scale * g.z * a[2]; hv.w += scale * g.w * a[3];
            *(float4*)(rowp + bj * 128 + n * 16) = hv;
          }
      }
  }
};
struct EpiResidAtomic {
  static constexpr bool PERM = false, AFTER_DRAIN = false;
  float* h; const float* mods; int rowoff, gidx; float scale; int mrow;
  DEVI void operator()(const pf4 (&acc)[2][2][4][2], const pg8::Unit& u, int wr, int wc, int fr, int fq) const {
    const int row0 = rowoff + u.pm * 256 + wr * 64 + fr, col0 = u.pn * 256 + wc * 32 + 4 * fq;
#pragma unroll
    for (int ai = 0; ai < 2; ++ai)
#pragma unroll
      for (int m = 0; m < 4; ++m) {
        const int r = row0 + ai * 128 + m * 16;
        float* rowp = h + (size_t)r * 1024 + col0;
        const float* gp = mods + (mrow >= 0 ? mrow : (r >> 13)) * 9216 + gidx * 1024 + col0;
#pragma unroll
        for (int bj = 0; bj < 2; ++bj)
#pragma unroll
          for (int n = 0; n < 2; ++n) {
            const float4 g = ld4(gp + bj * 128 + n * 16); const pf4 a = acc[ai][bj][m][n];
            float* q = rowp + bj * 128 + n * 16;
            atomicAdd(q, scale * g.x * a[0]); atomicAdd(q + 1, scale * g.y * a[1]); atomicAdd(q + 2, scale * g.z * a[2]); atomicAdd(q + 3, scale * g.w * a[3]);
          }
      }
  }
};
template <int MODE> struct EpiMix {
  static constexpr bool PERM = true, AFTER_DRAIN = false;
  bfraw* d0; bfraw* d1; bfraw* d2; bfraw* d3;
  DEVI void operator()(const pf4 (&acc)[2][2][4][2], const pg8::Unit& u, int wr, int wc, int fr, int fq) const {
    const int row0 = u.pm * 256 + wr * 64 + fr;
    const int pc = u.pn >> 2;
    bfraw* dst = MODE == 0 ? d0 : (MODE == 1 || MODE == 2) ? (pc == 0 ? d0 : pc == 1 ? d1 : pc == 2 ? d2 : d3) : (MODE == 3 ? d0 : d1);
    const int ld = MODE == 0 ? 3072 : 1024;
    const int col0 = (MODE == 1 || MODE == 2 ? (u.pn & 3) : u.pn) * 256 + wc * 32 + 8 * fq;
#pragma unroll
    for (int ai = 0; ai < 2; ++ai)
#pragma unroll
      for (int m = 0; m < 4; ++m) {
        const size_t ro = (size_t)(row0 + ai * 128 + m * 16) * ld + col0;
#pragma unroll
        for (int bj = 0; bj < 2; ++bj) {
          float v[8];
#pragma unroll
          for (int e = 0; e < 4; ++e) { v[e] = acc[ai][bj][m][0][e]; v[4 + e] = acc[ai][bj][m][1][e]; }
          bfraw* dp = dst + ro + bj * 128;
          if (MODE == 1) { if (pc == 3) {
#pragma unroll
            for (int e = 0; e < 8; ++e) v[e] = geluf_(v[e]); } }
          if (MODE == 2 && pc >= 2) {
#pragma unroll
            for (int e = 0; e < 8; ++e) v[e] = sigmoidf_(v[e]);
          } else if (MODE == 2 || MODE == 3 || MODE == 4) {
            const uint4 o = *(const uint4*)dp; const unsigned ow[4] = {o.x, o.y, o.z, o.w};
            float p[8];
#pragma unroll
            for (int e = 0; e < 4; ++e) { p[2 * e] = bf2f((bfraw)(ow[e] & 0xffff)); p[2 * e + 1] = bf2f((bfraw)(ow[e] >> 16)); }
            if (MODE == 2) {
#pragma unroll
              for (int e = 0; e < 8; ++e) v[e] = (pc == 0 ? sigmoidf_(v[e]) : geluf_(v[e])) * p[e];
            } else if (MODE == 3) {
#pragma unroll
              for (int e = 0; e < 8; ++e) v[e] *= p[e];
            } else {
              const uint4 t = *(const uint4*)(d0 + ro + bj * 128); const unsigned tw[4] = {t.x, t.y, t.z, t.w};
#pragma unroll
              for (int e = 0; e < 4; ++e) { v[2 * e] = bf2f((bfraw)(tw[e] & 0xffff)) + p[2 * e] * v[2 * e]; v[2 * e + 1] = bf2f((bfraw)(tw[e] >> 16)) + p[2 * e + 1] * v[2 * e + 1]; }
            }
          }
          uint4 w; w.x = pg8::cvt_pk_bf16(v[0], v[1]); w.y = pg8::cvt_pk_bf16(v[2], v[3]); w.z = pg8::cvt_pk_bf16(v[4], v[5]); w.w = pg8::cvt_pk_bf16(v[6], v[7]);
          *(uint4*)dp = w;
        }
      }
  }
};
template <class Epi>
DEVI void run8(unsigned char* lds, const bfraw* A, const bfraw* Bt, int M, int N, int K, const Epi& E, int G = -1, int c = -1, int ld = -1) {
  pg8::Gemm g{A, Bt, M, N, K, ld < 0 ? K : ld};
  pg8::StaticOrder S; S.init(M, N, G < 0 ? (int)gridDim.x : G, c < 0 ? (int)blockIdx.x : c);
  pg8::gemm_phase<Epi, pg8::StaticOrder, false>((PG8_LAS unsigned char*)lds, g, S, E, nullptr);
}

struct TrJob { const float* src; bfraw* dst; int ldw, K, kt, nt, drow0, mode; };
DEVI TrJob tr_decode(const P& p, int t) {
  TrJob j; int u = t;
  if (u < 1408) { j = TrJob{p.in[I_W1IN], (bfraw*)(p.ws + O_W1IN), 5632, 1024, u / 88, u % 88, 0, 1}; return j; }
  u -= 1408;
  if (u < 704) { j = TrJob{p.in[I_W1OUT], (bfraw*)(p.ws + O_W1OUT), 1024, 2816, u / 16, u % 16, 0, 0}; return j; }
  u -= 704;
  if (u < 2048) {
    const int pc = u >> 8; u &= 255;
    const int col0 = pc == 0 ? 0 : pc == 1 ? 1024 : pc == 2 ? 2048 : pc == 3 ? 5136 : pc == 4 ? 3088 : pc == 5 ? 4112 : pc == 6 ? 6160 : 7184;
    j = TrJob{p.in[I_WIN] + col0, (bfraw*)(p.ws + (pc < 4 ? O_WTA : O_WTB)), 8208, 1024, u >> 4, u & 15, (pc & 3) * 1024, 0}; return j;
  }
  u -= 2048;
  if (u < 768) { const int m = u >> 8; u &= 255; j = TrJob{p.in[m == 0 ? I_WA : m == 1 ? I_WB : I_WO], (bfraw*)(p.ws + (m == 0 ? O_WA : m == 1 ? O_WB : O_WO)), 1024, 1024, u >> 4, u & 15, 0, 0}; return j; }
  u -= 768;
  if (u < 1408) { j = TrJob{p.in[I_W2IN], (bfraw*)(p.ws + O_W2IN), 5632, 1024, u / 88, u % 88, 0, 1}; return j; }
  u -= 1408;
  j = TrJob{p.in[I_W2OUT], (bfraw*)(p.ws + O_W2OUT), 1024, 2816, u / 16, u % 16, 0, 0}; return j;
}

DEVI void phase_p0(const P& p, unsigned char* lds) {
  float* sf = (float*)lds;
  const int tid = ltid();
  for (int i = tid; i < 3072; i += NTHR) { float v = i < 2048 ? p.in[I_C][i] : p.in[I_CCTX][i - 2048]; sf[i] = v / (1.f + expf(-v)); }
  __syncthreads();
  {
    const float* w = p.in[I_WADA];
    float* mp = (float*)(p.ws + O_MODSP);
    for (int id = blockIdx.x * NTHR + tid; id < 16 * 9216; id += gridDim.x * NTHR) {
      int s = id / 9216, j = id - s * 9216;
      float a0 = 0, a1 = 0, a2 = 0;
#pragma unroll 16
      for (int k = s * 64; k < s * 64 + 64; ++k) { float wv = w[(size_t)k * 9216 + j]; a0 += sf[k] * wv; a1 += sf[1024 + k] * wv; a2 += sf[2048 + k] * wv; }
      mp[(s * 3 + 0) * 9216 + j] = a0; mp[(s * 3 + 1) * 9216 + j] = a1; mp[(s * 3 + 2) * 9216 + j] = a2;
    }
  }
  __syncthreads();
  {
    float4 rg0 = {0.f, 0.f, 0.f, 0.f}, rg1 = {0.f, 0.f, 0.f, 0.f};
    const int lk = tid >> 4, ln = (tid & 15) * 4;
    const int sn = tid >> 3, sk = (tid & 7) * 8;
    int t = blockIdx.x;
    TrJob jb = tr_decode(p, t < 7040 ? t : 0);
    if (t < 7040) {
      rg0 = ld4(jb.src + (size_t)(jb.kt * 64 + lk) * jb.ldw + jb.nt * 64 + ln);
      rg1 = ld4(jb.src + (size_t)(jb.kt * 64 + lk + 32) * jb.ldw + jb.nt * 64 + ln);
    }
    for (; t < 7040; t += gridDim.x) {
      sf[lk * 65 + ln] = rg0.x; sf[lk * 65 + ln + 1] = rg0.y; sf[lk * 65 + ln + 2] = rg0.z; sf[lk * 65 + ln + 3] = rg0.w;
      sf[(lk + 32) * 65 + ln] = rg1.x; sf[(lk + 32) * 65 + ln + 1] = rg1.y; sf[(lk + 32) * 65 + ln + 2] = rg1.z; sf[(lk + 32) * 65 + ln + 3] = rg1.w;
      __syncthreads();
      const TrJob cj = jb;
      const int tn = t + gridDim.x;
      if (tn < 7040) {
        jb = tr_decode(p, tn);
        rg0 = ld4(jb.src + (size_t)(jb.kt * 64 + lk) * jb.ldw + jb.nt * 64 + ln);
        rg1 = ld4(jb.src + (size_t)(jb.kt * 64 + lk + 32) * jb.ldw + jb.nt * 64 + ln);
      }
      {
        const int n = cj.nt * 64 + sn; int dr;
        if (cj.mode == 1) { int isb = n >= 2816; int f = n - isb * 2816; dr = (f >> 4) * 32 + isb * 16 + (f & 15); } else dr = cj.drow0 + n;
        unsigned w[4];
#pragma unroll
        for (int e = 0; e < 4; ++e) w[e] = (unsigned)f2bf(sf[(sk + 2 * e) * 65 + sn]) | ((unsigned)f2bf(sf[(sk + 2 * e + 1) * 65 + sn]) << 16);
        *(uint4*)(cj.dst + (size_t)dr * cj.K + cj.kt * 64 + sk) = uint4{w[0], w[1], w[2], w[3]};
      }
      __syncthreads();
    }
  }
  { bfraw* d = (bfraw*)(p.ws + O_WSB); for (int id = blockIdx.x * NTHR + tid; id < 65536; id += gridDim.x * NTHR) d[id] = f2bf(p.in[I_WS][id]); }
}

DEVI void phase_p0b(const P& p) {
  const float* mp = (const float*)(p.ws + O_MODSP);
  float* m = (float*)(p.ws + O_MODS);
  for (int id = blockIdx.x * NTHR + ltid(); id < 3 * 9216; id += gridDim.x * NTHR) {
    int j = id % 9216;
    float a = p.in[I_BADA][j];
    for (int s = 0; s < 16; ++s) a += mp[s * 3 * 9216 + id];
    m[id] = a;
  }
}

template <int MODE>
DEVI void phase_rows(const P& p, unsigned char* lds, int row_lo = 0, int row_hi = -1, int vb = -1, int nvb = -1) {
  const int tid = ltid(), lane = tid & 63, wid = tid >> 6;
  const float* mods = (const float*)(p.ws + O_MODS);
  float* hctx = (float*)(p.ws + O_HCTX);
  bfraw* hn = (bfraw*)(p.ws + O_HN);
  float* wg = (float*)lds;
  if (MODE == 2) {
    __syncthreads();
    for (int i = tid; i < 16384; i += NTHR) { int k = i >> 4, g = i & 15; wg[g * 1024 + k] = p.in[I_WIN][(size_t)k * 8208 + 3072 + g]; }
    __syncthreads();
  }
  const int nrows = row_hi >= 0 ? row_hi : ((MODE == 1 || MODE == 2) ? 16896 : 16384);
  if (vb < 0) { vb = (int)blockIdx.x; nvb = (int)gridDim.x; }
  const float* gvec = p.in[MODE == 1 ? I_GFFN1 : MODE == 2 ? I_GMIX : MODE == 3 ? I_GFFN2 : I_GFINAL];
  const int msh = MODE == 1 ? 0 : MODE == 2 ? 3 : 6;
  for (int row = row_lo + vb * 8 + wid; row < nrows; row += nvb * 8) {
    const bool lat = row < 16384;
    const int mrow = lat ? (row >> 13) : 2;
    float4 v[4];
    if (MODE == 1) {
      const float* src = lat ? p.in[I_X] + (size_t)row * 1024 : p.in[I_CTX] + (size_t)(row - 16384) * 1024;
#pragma unroll
      for (int i = 0; i < 4; ++i) { const nt_f4 t_ = __builtin_nontemporal_load((const nt_f4*)(src + i * 256 + lane * 4)); v[i] = float4{t_.x, t_.y, t_.z, t_.w}; }
      if (lat) {
        int ts = row & 8191; float rr = (float)(ts >> 6), cc = (float)(ts & 63);
        float fqv[4];
#pragma unroll
        for (int e = 0; e < 4; ++e) fqv[e] = expf((-9.210340371976184f * (float)(lane * 4 + e)) / 256.f);
        v[0].x += redsin(rr * fqv[0], false); v[0].y += redsin(rr * fqv[1], false); v[0].z += redsin(rr * fqv[2], false); v[0].w += redsin(rr * fqv[3], false);
        v[1].x += redsin(rr * fqv[0], true);  v[1].y += redsin(rr * fqv[1], true);  v[1].z += redsin(rr * fqv[2], true);  v[1].w += redsin(rr * fqv[3], true);
        v[2].x += redsin(cc * fqv[0], false); v[2].y += redsin(cc * fqv[1], false); v[2].z += redsin(cc * fqv[2], false); v[2].w += redsin(cc * fqv[3], false);
        v[3].x += redsin(cc * fqv[0], true);  v[3].y += redsin(cc * fqv[1], true);  v[3].z += redsin(cc * fqv[2], true);  v[3].w += redsin(cc * fqv[3], true);
      }
      float* dsth = lat ? p.out + (size_t)row * 1024 : hctx + (size_t)(row - 16384) * 1024;
#pragma unroll
      for (int i = 0; i < 4; ++i) *(float4*)(dsth + i * 256 + lane * 4) = v[i];
    } else {
      const float* src = lat ? p.out + (size_t)row * 1024 : hctx + (size_t)(row - 16384) * 1024;
#pragma unroll
      for (int i = 0; i < 4; ++i) v[i] = *(const float4*)(src + i * 256 + lane * 4);
    }
    float ss = 0;
#pragma unroll
    for (int i = 0; i < 4; ++i) ss += v[i].x * v[i].x + v[i].y * v[i].y + v[i].z * v[i].z + v[i].w * v[i].w;
    ss = wave_sum(ss);
    const float rs = rsqrtf(ss * (1.f / 1024.f) + EPS);
    if (MODE == 4) {
#pragma unroll
      for (int i = 0; i < 4; ++i) {
        float4 g = *(const float4*)(gvec + i * 256 + lane * 4);
        float4 o = {v[i].x * rs * g.x, v[i].y * rs * g.y, v[i].z * rs * g.z, v[i].w * rs * g.w};
        __builtin_nontemporal_store(nt_f4{o.x, o.y, o.z, o.w}, (nt_f4*)(p.out + (size_t)row * 1024 + i * 256 + lane * 4));
      }
    } else {
      const float* sh = mods + (size_t)(mrow * 9216 + msh * 1024);
      const float* scp = sh + 1024;
      float y[16];
#pragma unroll
      for (int i = 0; i < 4; ++i) {
        const int c = i * 256 + lane * 4;
        float4 g = *(const float4*)(gvec + c), s4 = *(const float4*)(sh + c), c4 = *(const float4*)(scp + c);
        y[i * 4 + 0] = v[i].x * rs * g.x * (1.f + c4.x) + s4.x; y[i * 4 + 1] = v[i].y * rs * g.y * (1.f + c4.y) + s4.y;
        y[i * 4 + 2] = v[i].z * rs * g.z * (1.f + c4.z) + s4.z; y[i * 4 + 3] = v[i].w * rs * g.w * (1.f + c4.w) + s4.w;
        uint2 pk; pk.x = (unsigned)f2bf(y[i * 4]) | ((unsigned)f2bf(y[i * 4 + 1]) << 16); pk.y = (unsigned)f2bf(y[i * 4 + 2]) | ((unsigned)f2bf(y[i * 4 + 3]) << 16);
        *(uint2*)(hn + (size_t)row * 1024 + c) = pk;
      }
      if (MODE == 2) {
        float ga[16];
#pragma unroll
        for (int g2 = 0; g2 < 16; ++g2) {
          float a = 0.f;
#pragma unroll
          for (int i = 0; i < 4; ++i) { float4 w4 = *(const float4*)(wg + g2 * 1024 + i * 256 + lane * 4); a += y[i * 4] * w4.x + y[i * 4 + 1] * w4.y + y[i * 4 + 2] * w4.z + y[i * 4 + 3] * w4.w; }
          ga[g2] = a;
          if ((g2 & 3) == 3) asm volatile("" ::: "memory");
        }
        const bool b5 = lane & 32, b4 = lane & 16, b3 = lane & 8, b2 = lane & 4;
        float r8[8], r4[4], r2[2];
#pragma unroll
        for (int g = 0; g < 8; ++g) { const float snd = b5 ? ga[g] : ga[g + 8], kp = b5 ? ga[g + 8] : ga[g]; r8[g] = kp + __shfl_xor(snd, 32, 64); }
#pragma unroll
        for (int g = 0; g < 4; ++g) { const float snd = b4 ? r8[g] : r8[g + 4], kp = b4 ? r8[g + 4] : r8[g]; r4[g] = kp + __shfl_xor(snd, 16, 64); }
#pragma unroll
        for (int g = 0; g < 2; ++g) { const float snd = b3 ? r4[g] : r4[g + 2], kp = b3 ? r4[g + 2] : r4[g]; r2[g] = kp + __shfl_xor(snd, 8, 64); }
        float r1 = (b2 ? r2[1] : r2[0]) + __shfl_xor(b2 ? r2[0] : r2[1], 4, 64);
        r1 += __shfl_xor(r1, 2, 64); r1 += __shfl_xor(r1, 1, 64);
        const int gi = (b5 ? 8 : 0) + (b4 ? 4 : 0) + (b3 ? 2 : 0) + (b2 ? 1 : 0);
        if ((lane & 3) == 0) ((float*)(p.ws + O_GATES))[(size_t)row * 16 + gi] = r1;
      }
    }
  }
}

DEVI void phase_ffn_in(const P& p, unsigned char* lds, size_t o_w, int nrows) {
  EpiFfnIn E{(bfraw*)(p.ws + O_ACT)};
  run8(lds, (const bfraw*)(p.ws + O_HN), (const bfraw*)(p.ws + o_w), nrows, 5632, 1024, E);
}

DEVI void phase_ffn_out(const P& p, unsigned char* lds, size_t o_w, int gidx, bool with_ctx) {
  EpiResid E{p.out, (const float*)(p.ws + O_MODS), 0, gidx, 0.5f, -1};
  run8(lds, (const bfraw*)(p.ws + O_ACT), (const bfraw*)(p.ws + o_w), 16384, 1024, 2816, E);
  (void)with_ctx;
}

DEVI void phase_r2_g2c(const P& p, unsigned char* lds) {
  const int G = (int)gridDim.x, nc = G >= 48 ? 24 : 0;
  if (nc == 0) {
    EpiResid E{(float*)(p.ws + O_HCTX), (const float*)(p.ws + O_MODS), 0, 2, 0.5f, 2};
    run8(lds, (const bfraw*)(p.ws + O_ACT) + (size_t)16384 * 2816, (const bfraw*)(p.ws + O_W1OUT), 512, 1024, 2816, E);
    __syncthreads();
  } else if ((int)blockIdx.x < nc) {
    const int sl = (int)blockIdx.x >> 3, k0 = sl * 1024, kl = sl == 2 ? 768 : 1024;
    EpiResidAtomic E{(float*)(p.ws + O_HCTX), (const float*)(p.ws + O_MODS), 0, 2, 0.5f, 2};
    run8(lds, (const bfraw*)(p.ws + O_ACT) + (size_t)16384 * 2816 + k0, (const bfraw*)(p.ws + O_W1OUT) + k0, 512, 1024, kl, E, 8, (int)blockIdx.x & 7, 2816);
    return;
  }
  phase_rows<2>(p, lds, 0, 16384, (int)blockIdx.x - nc, G - nc);
}

DEVI void phase_g3c(const P& p, unsigned char* lds) {
  EpiMix<0> E{(bfraw*)(p.ws + O_CTXRAW), nullptr, nullptr, nullptr};
  run8(lds, (const bfraw*)(p.ws + O_HN) + (size_t)16384 * 1024, (const bfraw*)(p.ws + O_WTA), 512, 3072, 1024, E);
}

DEVI void phase_g3a(const P& p, unsigned char* lds, int hb) {
  EpiMix<1> E{(bfraw*)(p.ws + O_QRAW), (bfraw*)(p.ws + O_KRAW), (bfraw*)(p.ws + O_V), (bfraw*)(p.ws + O_GVS)};
  run8(lds, (const bfraw*)(p.ws + O_HN) + (size_t)hb * 8192 * 1024, (const bfraw*)(p.ws + O_WTA), 8192, 4096, 1024, E);
}

DEVI void phase_g3b(const P& p, unsigned char* lds, int hb) {
  EpiMix<2> E{(bfraw*)(p.ws + O_V), (bfraw*)(p.ws + O_GVS), (bfraw*)(p.ws + O_QC), (bfraw*)(p.ws + O_KC)};
  run8(lds, (const bfraw*)(p.ws + O_HN) + (size_t)hb * 8192 * 1024, (const bfraw*)(p.ws + O_WTB), 8192, 4096, 1024, E);
}

DEVI void phase_g4(const P& p, unsigned char* lds) {
  const int Gh = (int)gridDim.x >> 1, grp = (int)blockIdx.x / Gh, c = (int)blockIdx.x % Gh;
  if (grp == 0) { EpiMix<3> E{(bfraw*)(p.ws + O_QC), nullptr, nullptr, nullptr}; run8(lds, (const bfraw*)(p.ws + O_V), (const bfraw*)(p.ws + O_WA), 8192, 1024, 1024, E, Gh, c); }
  else if (grp == 1) { EpiMix<3> E{(bfraw*)(p.ws + O_KC), nullptr, nullptr, nullptr}; run8(lds, (const bfraw*)(p.ws + O_GVS), (const bfraw*)(p.ws + O_WB), 8192, 1024, 1024, E, Gh, c); }
}

DEVI void phase_addmix(const P& p, int hb) {
  const uint4* t1 = (const uint4*)(p.ws + O_QC);
  const uint4* t2 = (const uint4*)(p.ws + O_KC);
  uint4* dst = (uint4*)(p.ws + (hb == 0 ? O_W1IN : O_QC));
  const int tid = ltid();
  for (int i = blockIdx.x * NTHR + tid; i < 8192 * 128; i += gridDim.x * NTHR) {
    const uint4 a = t1[i], b = t2[i];
    const unsigned aw[4] = {a.x, a.y, a.z, a.w}, bw[4] = {b.x, b.y, b.z, b.w}; unsigned o[4];
#pragma unroll
    for (int e = 0; e < 4; ++e) o[e] = (unsigned)f2bf(bf2f((bfraw)(aw[e] & 0xffff)) + bf2f((bfraw)(bw[e] & 0xffff))) | ((unsigned)f2bf(bf2f((bfraw)(aw[e] >> 16)) + bf2f((bfraw)(bw[e] >> 16))) << 16);
    dst[i] = uint4{o[0], o[1], o[2], o[3]};
  }
}

DEVI void phase_g5(const P& p, unsigned char* lds) {
  const int Gh = (int)gridDim.x >> 1, grp = (int)blockIdx.x / Gh, c = (int)blockIdx.x % Gh;
  EpiResid E{p.out, (const float*)(p.ws + O_MODS), grp * 8192, 5, 1.f, -1};
  if (grp < 2) run8(lds, (const bfraw*)(p.ws + (grp == 0 ? O_W1IN : O_QC)), (const bfraw*)(p.ws + O_WO), 8192, 1024, 1024, E, Gh, c);
}

DEVI void phase_cv(const P& p, int hb) {
  const int tid = ltid(), lane = tid & 63, wid = tid >> 6;
  const bfraw* qraw = (const bfraw*)(p.ws + O_QRAW);
  const bfraw* kraw = (const bfraw*)(p.ws + O_KRAW);
  const bfraw* craw = (const bfraw*)(p.ws + O_CTXRAW) + (size_t)hb * 256 * 3072;
  bfraw* qc = (bfraw*)(p.ws + O_QC);
  bfraw* kc = (bfraw*)(p.ws + O_KC);
  bfraw* vv = (bfraw*)(p.ws + O_V);
  const bfraw* gvs = (const bfraw*)(p.ws + O_GVS);
  float* rsb = (float*)(p.ws + O_RS);
  const float* cw = p.in[I_CONVW];
  const float* cb = p.in[I_CONVB];
  for (int task = blockIdx.x * 8 + wid; task < 1056 * 4; task += gridDim.x * 8) {
    const int sidx = task >> 2, part = task & 3, isk = part >> 1;
    const bool lat = sidx < 1024;
    const int lr0 = (lat ? sidx : sidx - 1024) * 8, len = lat ? 8192 : 256, orow0 = sidx * 8;
    const bfraw* src = lat ? (isk ? kraw : qraw) : (craw + isk * 1024);
    const size_t ld = lat ? 1024 : 3072;
    const int ch = (part & 1) * 512 + lane * 8, wch = isk * 1024 + ch;
    float w0[8], w1[8], w2[8], bb[8];
#pragma unroll
    for (int e = 0; e < 8; e += 4) {
      float4 a = ld4(cw + wch + e), b = ld4(cw + 2048 + wch + e), c4 = ld4(cw + 4096 + wch + e), d = ld4(cb + wch + e);
      w0[e] = a.x; w0[e + 1] = a.y; w0[e + 2] = a.z; w0[e + 3] = a.w; w1[e] = b.x; w1[e + 1] = b.y; w1[e + 2] = b.z; w1[e + 3] = b.w;
      w2[e] = c4.x; w2[e + 1] = c4.y; w2[e + 2] = c4.z; w2[e + 3] = c4.w; bb[e] = d.x; bb[e + 1] = d.y; bb[e + 2] = d.z; bb[e + 3] = d.w;
    }
    uint4 rw[10];
#pragma unroll
    for (int i = 0; i < 10; ++i) { const int lr = lr0 - 1 + i; uint4 t = {0u, 0u, 0u, 0u}; if (lr >= 0 && lr < len) t = *(const uint4*)(src + (size_t)lr * ld + ch); rw[i] = t; }
    const float osc = isk ? 1.f : 0.0625f;
    bfraw* dst = (isk ? kc : qc) + (size_t)orow0 * 1024 + ch;
#pragma unroll
    for (int i = 0; i < 8; ++i) {
      const unsigned av[4] = {rw[i].x, rw[i].y, rw[i].z, rw[i].w}, bv[4] = {rw[i + 1].x, rw[i + 1].y, rw[i + 1].z, rw[i + 1].w}, cv[4] = {rw[i + 2].x, rw[i + 2].y, rw[i + 2].z, rw[i + 2].w};
      unsigned ov[4];
#pragma unroll
      for (int e = 0; e < 4; ++e) {
        const float y0 = bf2f((bfraw)(av[e] & 0xffff)) * w0[2 * e] + bf2f((bfraw)(bv[e] & 0xffff)) * w1[2 * e] + bf2f((bfraw)(cv[e] & 0xffff)) * w2[2 * e] + bb[2 * e];
        const float y1 = bf2f((bfraw)(av[e] >> 16)) * w0[2 * e + 1] + bf2f((bfraw)(bv[e] >> 16)) * w1[2 * e + 1] + bf2f((bfraw)(cv[e] >> 16)) * w2[2 * e + 1] + bb[2 * e + 1];
        ov[e] = (unsigned)f2bf(siluf_(y0) * osc) | ((unsigned)f2bf(siluf_(y1) * osc) << 16);
      }
      *(uint4*)(dst + (size_t)i * 1024) = uint4{ov[0], ov[1], ov[2], ov[3]};
    }
  }
  for (int row = blockIdx.x * 8 + wid; row < 8448; row += gridDim.x * 8) {
    if (row < 8192) {
      float ss = 0;
#pragma unroll
      for (int hlf = 0; hlf < 2; ++hlf) {
        uint4 g = *(const uint4*)(gvs + (size_t)row * 1024 + hlf * 512 + lane * 8);
        unsigned gv[4] = {g.x, g.y, g.z, g.w};
#pragma unroll
        for (int e = 0; e < 4; ++e) { float a = bf2f((bfraw)(gv[e] & 0xffff)), b = bf2f((bfraw)(gv[e] >> 16)); ss += a * a + b * b; }
      }
      ss = wave_sum(ss);
      if (lane == 0) rsb[row] = rsqrtf(ss * (1.f / 1024.f) + EPS);
    } else {
#pragma unroll
      for (int hlf = 0; hlf < 2; ++hlf)
        *(uint4*)(vv + (size_t)row * 1024 + hlf * 512 + lane * 8) = *(const uint4*)(craw + 2048 + (size_t)(row - 8192) * 3072 + hlf * 512 + lane * 8);
    }
  }
}

DEVI void phase_ma(const P& p, unsigned char* lds, int hb) {
  const int tid = ltid();
  bfraw* st = (bfraw*)lds;
  float* sc = (float*)(lds + 131072);
  float* s_w = sc + 128, *s_ws = sc + 256, *s_red = sc + 384, *s_part = sc + 512;
  const float* bg = p.in[I_BGATES];
  for (int item = blockIdx.x; item < 528 + 256; item += gridDim.x) {
    unsigned char* wsb = lws(p.ws);
    const float* gates = (const float*)(wsb + O_GATES);
    const bfraw* kc = (const bfraw*)(wsb + O_KC);
    const bfraw* vv = (const bfraw*)(wsb + O_V);
    bfraw* states = (bfraw*)(wsb + O_ST);
    float* nloc = (float*)(wsb + O_NLOC);
    float* mg = (float*)(wsb + O_MG);
    if (item < 528) {
      const int seq = item / 66, j = item % 66, d = seq >> 2, h = seq & 3;
      int rbase, grow;
      if (j < 2) { int cc = d == 0 ? j : 1 - j; rbase = 8192 + cc * 128; grow = 16384 + hb * 256 + cc * 128; }
      else { int c = d == 0 ? j - 2 : 65 - j; rbase = c * 128; grow = hb * 8192 + c * 128; }
      __syncthreads();
      const int el = d == 0 ? (tid & 127) : 127 - (tid & 127);
      float li = 0.f, lf = 0.f;
      if (tid < 128) {
        li = gates[(size_t)(grow + el) * 16 + d * 8 + h] + bg[d * 8 + h];
        lf = logsigf_(gates[(size_t)(grow + el) * 16 + d * 8 + 4 + h] + bg[d * 8 + 4 + h]);
      }
      const float bcum = seg_scan_sum(lf, tid, s_red + 4);
      if (tid == 127) s_red[1] = bcum;
      __syncthreads();
      const float gtot = s_red[1];
      const float wv = gtot - bcum + li;
      if (tid < 128) s_w[el] = wv;
      __syncthreads();
      if (tid < 64) {
        float m = fmaxf(s_w[tid], s_w[tid + 64]);
#pragma unroll
        for (int o = 32; o > 0; o >>= 1) m = fmaxf(m, __shfl_xor(m, o, 64));
        if (tid == 0) s_red[0] = m;
      }
      __syncthreads();
      const float mloc = s_red[0];
      if (tid < 128) s_ws[el] = expf(wv - mloc);
      if (tid == 0) { mg[seq * 66 + j] = mloc; mg[528 + seq * 66 + j] = gtot; }
      __syncthreads();
      {
        const int k = tid & 255, part = tid >> 8;
        const bfraw* kp0 = kc + (size_t)(rbase + part * 64) * 1024 + h * 256 + k;
        float n = 0;
#pragma unroll 16
        for (int t = 0; t < 64; ++t) n += s_ws[part * 64 + t] * bf2f(kp0[(size_t)t * 1024]);
        s_part[tid] = n;
      }
      bfraw* dst = states + (size_t)(seq * 66 + j) * 65536;
      {
        f32x4 acc[8][4]; ZERO_ACC(acc, 8, 4);
        gemm_tile<256, 256, true, true, false>(vv + (size_t)rbase * 1024 + h * 256, 1024, kc + (size_t)rbase * 1024 + h * 256, 1024, 128, s_ws, acc, st, nullptr, 0);
        EPI_BEGIN(256, 256)
          dst[row * 256 + col] = f2bf(acc[i][j][r]);
        EPI_END
      }
      if (tid < 256) nloc[(size_t)(seq * 66 + j) * 256 + tid] = s_part[tid] + s_part[tid + 256];
    } else {
      const int it = item - 528, c = it >> 2, g = it & 3;
      bfraw* gvs = (bfraw*)(wsb + O_GVS);
      const float* rsb = (const float*)(wsb + O_RS);
      f32x4 acc[4][4]; ZERO_ACC(acc, 4, 4);
      gemm_tile<128, 256, false, true, false>((const bfraw*)(wsb + O_WSB) + g * 16384, 128, gvs + (size_t)c * 128 * 1024 + g * 256, 1024, 128, rsb + c * 128, acc, st, nullptr, 0);
      const float* gs = p.in[I_GSGU] + g * 256;
      const float* bs = p.in[I_BS] + g * 128;
      EPI_BEGIN(128, 256)
        gvs[(size_t)(c * 128 + row) * 1024 + g * 256 + col] = f2bf(gs[col] * acc[i][j][r] + bs[row]);
      EPI_END
    }
  }
}

DEVI void phase_mb(const P& p, unsigned char* lds) {
  bfraw* states = (bfraw*)(p.ws + O_ST);
  const float* mg = (const float*)(p.ws + O_MG);
  float* ment = (float*)(p.ws + O_MG) + 1056;
  const float* nloc = (const float*)(p.ws + O_NLOC);
  float* nent = (float*)(p.ws + O_NENT);
  const int gid = blockIdx.x * NTHR + ltid(), gsz = gridDim.x * NTHR;
  float* s_dec = (float*)lds, *s_scl = s_dec + 528;
  __syncthreads();
  if (ltid() < 8) {
    const int seq = ltid(); float m = 0;
    for (int j = 0; j < 66; ++j) {
      const float mloc = mg[seq * 66 + j], g = mg[528 + seq * 66 + j];
      const float mnew = fmaxf(g + m, mloc);
      s_dec[seq * 66 + j] = expf(g + m - mnew); s_scl[seq * 66 + j] = expf(mloc - mnew);
      if (blockIdx.x == 0) ment[seq * 66 + j] = m;
      m = mnew;
    }
  }
  __syncthreads();
  for (int id = gid; id < 8 * 16384; id += gsz) {
    const int seq = id >> 14, e = (id & 16383) * 4;
    float s0 = 0, s1 = 0, s2 = 0, s3 = 0;
    bfraw* base = states + (size_t)seq * 66 * 65536 + e;
#pragma unroll 1
    for (int cb = 0; cb < 66; cb += 22) {
      uint2 buf[22];
#pragma unroll
      for (int i = 0; i < 22; ++i) { const nt_u2 t_ = __builtin_nontemporal_load((const nt_u2*)(base + (size_t)(cb + i) * 65536)); buf[i] = uint2{t_.x, t_.y}; }
#pragma unroll
      for (int i = 0; i < 22; ++i) {
        const int j = cb + i; const uint2 cur = buf[i];
        const float dec = s_dec[seq * 66 + j], scl = s_scl[seq * 66 + j];
        if (j >= 2) { uint2 o; o.x = (unsigned)f2bf(s0) | ((unsigned)f2bf(s1) << 16); o.y = (unsigned)f2bf(s2) | ((unsigned)f2bf(s3) << 16);
          *(uint2*)(base + (size_t)j * 65536) = o; }
        s0 = dec * s0 + scl * bf2f((bfraw)(cur.x & 0xffff)); s1 = dec * s1 + scl * bf2f((bfraw)(cur.x >> 16));
        s2 = dec * s2 + scl * bf2f((bfraw)(cur.y & 0xffff)); s3 = dec * s3 + scl * bf2f((bfraw)(cur.y >> 16));
      }
    }
  }
  for (int id = gid; id < 8 * 256; id += gsz) {
    const int seq = id >> 8, k = id & 255;
    float n = 0;
    for (int j = 0; j < 66; ++j) {
      nent[(size_t)(seq * 66 + j) * 256 + k] = n;
      n = s_dec[seq * 66 + j] * n + s_scl[seq * 66 + j] * nloc[(size_t)(seq * 66 + j) * 256 + k];
    }
  }
}

DEVI void phase_mc(const P& p, unsigned char* lds, int hb) {
  const int tid = ltid(), lane = tid & 63, wid = tid >> 6, wm = wid >> 2, wn = wid & 3, fr = lane & 15, fq = lane >> 4;
  bfraw* st = (bfraw*)lds;
  bfraw* sS = (bfraw*)(lds + 61440);
  float* sc = (float*)(lds + 131072);
  float* s_b = sc, *s_u = sc + 256, *s_mt = sc + 512, *s_in = sc + 768, *s_den = sc + 1024, *s_dq = sc + 1280, *s_tmp = sc + 1536;
  float* s_sum = sc + 1792, *s_sq = sc + 1920;
  const float* bg = p.in[I_BGATES];
  for (int item = blockIdx.x; item < 256; item += gridDim.x) {
    unsigned char* wsb = lws(p.ws);
    const float* gates = (const float*)(wsb + O_GATES);
    const bfraw* qc = (const bfraw*)(wsb + O_QC);
    const bfraw* kc = (const bfraw*)(wsb + O_KC);
    bfraw* vv = (bfraw*)(wsb + O_V);
    const bfraw* states = (const bfraw*)(wsb + O_ST);
    const float* ment = (const float*)(wsb + O_MG) + 1056;
    const float* nent = (const float*)(wsb + O_NENT);
    const int c = item >> 2, h = item & 3, R0 = c * 128;
    const bfraw* qp = qc + (size_t)R0 * 1024 + h * 256;
    const bfraw* kp = kc + (size_t)R0 * 1024 + h * 256;
    __syncthreads();
    {
      const int d = (tid >> 7) & 1, t = tid & 127, el = d == 0 ? t : 127 - t, ix = d * 128 + el;
      float li = 0.f, lf = 0.f;
      if (tid < 256) {
        const size_t grow = (size_t)hb * 8192 + R0 + el;
        li = gates[grow * 16 + d * 8 + h] + bg[d * 8 + h];
        lf = logsigf_(gates[grow * 16 + d * 8 + 4 + h] + bg[d * 8 + 4 + h]);
        s_den[tid] = 0.f;
        if (tid < 128) { s_sum[tid] = 0.f; s_sq[tid] = 0.f; }
      }
      const float b = seg_scan_sum(lf, tid, s_tmp);
      const float uu = li - b;
      const float pm = seg_scan_max(tid < 256 ? uu : -INFINITY, tid, s_tmp);
      if (tid < 256) {
        const int seq = d * 4 + h, j = d == 0 ? c + 2 : 65 - c;
        const float mst = ment[seq * 66 + j];
        const float a = b + mst;
        const float mt = fmaxf(a, b + pm);
        s_b[ix] = b; s_u[ix] = uu; s_mt[ix] = mt; s_in[ix] = expf(a - mt);
      }
    }
    {
      const int row = tid >> 2, part = tid & 3;
      const uint4* q4 = (const uint4*)(qp + (size_t)row * 1024 + part * 64);
      const float4* nf4 = (const float4*)(nent + (size_t)((0 + h) * 66 + (c + 2)) * 256 + part * 64);
      const float4* nb4 = (const float4*)(nent + (size_t)((4 + h) * 66 + (65 - c)) * 256 + part * 64);
      uint4 qv[8];
#pragma unroll
      for (int i = 0; i < 8; ++i) qv[i] = q4[i];
      float af = 0, ab = 0;
#pragma unroll
      for (int i = 0; i < 8; ++i) {
        const float4 f0 = nf4[2 * i], f1 = nf4[2 * i + 1], b0 = nb4[2 * i], b1 = nb4[2 * i + 1];
        const float q0 = bf2f((bfraw)(qv[i].x & 0xffff)), q1 = bf2f((bfraw)(qv[i].x >> 16)), q2 = bf2f((bfraw)(qv[i].y & 0xffff)), q3 = bf2f((bfraw)(qv[i].y >> 16));
        const float q4_ = bf2f((bfraw)(qv[i].z & 0xffff)), q5 = bf2f((bfraw)(qv[i].z >> 16)), q6 = bf2f((bfraw)(qv[i].w & 0xffff)), q7 = bf2f((bfraw)(qv[i].w >> 16));
        af += q0 * f0.x + q1 * f0.y + q2 * f0.z + q3 * f0.w + q4_ * f1.x + q5 * f1.y + q6 * f1.z + q7 * f1.w;
        ab += q0 * b0.x + q1 * b0.y + q2 * b0.z + q3 * b0.w + q4_ * b1.x + q5 * b1.y + q6 * b1.z + q7 * b1.w;
      }
      af += __shfl_xor(af, 1, 64); af += __shfl_xor(af, 2, 64);
      ab += __shfl_xor(ab, 1, 64); ab += __shfl_xor(ab, 2, 64);
      if (part == 0) { s_dq[row] = af; s_dq[128 + row] = ab; }
    }
    __syncthreads();
    {
      f32x4 S[4][2]; ZERO_ACC(S, 4, 2);
      gemm_tile<128, 128, false, false, false>(qp, 1024, kp, 1024, 256, nullptr, S, st, nullptr, 0);
#pragma unroll 1
      for (int d = 0; d < 2; ++d)
#pragma unroll
        for (int i = 0; i < 4; ++i)
#pragma unroll
          for (int r = 0; r < 4; ++r) {
            const int row = wm * 64 + i * 16 + fq * 4 + r;
            const float bt = s_b[d * 128 + row] - s_mt[d * 128 + row];
            float rs = 0;
#pragma unroll
            for (int j = 0; j < 2; ++j) {
              const int col = wn * 32 + j * 16 + fr;
              const bool valid = d == 0 ? (col <= row) : (col >= row);
              const float val = valid ? S[i][j][r] * fexp(bt + s_u[d * 128 + col]) : 0.f;
              rs += val;
              sS[(d * 128 + row) * 136 + col] = f2bf(val);
            }
            rs = red16(rs);
            if (fr == 0) atomicAdd(&s_den[d * 128 + row], rs);
          }
    }
    __syncthreads();
    f32x4 hs[4][4];
    uint4* hpark = (uint4*)(wsb + O_HPARK) + ((size_t)item * NTHR + tid) * 8;
#pragma unroll 1
    for (int d = 0; d < 2; ++d) {
      f32x4 (&acc)[4][4] = hs; ZERO_ACC(acc, 4, 4);
      const int seq = d * 4 + h, j2 = d == 0 ? c + 2 : 65 - c;
      gemm_tile<128, 256, false, false, false>(qp, 1024, states + (size_t)(seq * 66 + j2) * 65536, 256, 256, nullptr, acc, st, nullptr, 0);
      EPIR_BEGIN(128, 256)
        const float sin_ = s_in[d * 128 + row];
        EPIR_COLS(256) acc[i][j][r] *= sin_; (void)col;
      EPIR_END
      gemm_tile<128, 256, false, true, true>(nullptr, 0, vv + (size_t)R0 * 1024 + h * 256, 1024, 128, nullptr, acc, st, sS + d * 128 * 136, 136);
      EPIR_BEGIN(128, 256)
        const float den = s_den[d * 128 + row] + s_in[d * 128 + row] * s_dq[d * 128 + row];
        const float inv = 1.f / fmaxf(fabsf(den), expf(-s_mt[d * 128 + row]));
        EPIR_COLS(256) acc[i][j][r] *= inv; (void)col;
      EPIR_END
      if (d == 0) {
#pragma unroll
        for (int i = 0; i < 4; ++i) {
          uint4 w0, w1;
          w0.x = (unsigned)f2bf(acc[i][0][0]) | ((unsigned)f2bf(acc[i][0][1]) << 16); w0.y = (unsigned)f2bf(acc[i][0][2]) | ((unsigned)f2bf(acc[i][0][3]) << 16);
          w0.z = (unsigned)f2bf(acc[i][1][0]) | ((unsigned)f2bf(acc[i][1][1]) << 16); w0.w = (unsigned)f2bf(acc[i][1][2]) | ((unsigned)f2bf(acc[i][1][3]) << 16);
          w1.x = (unsigned)f2bf(acc[i][2][0]) | ((unsigned)f2bf(acc[i][2][1]) << 16); w1.y = (unsigned)f2bf(acc[i][2][2]) | ((unsigned)f2bf(acc[i][2][3]) << 16);
          w1.z = (unsigned)f2bf(acc[i][3][0]) | ((unsigned)f2bf(acc[i][3][1]) << 16); w1.w = (unsigned)f2bf(acc[i][3][2]) | ((unsigned)f2bf(acc[i][3][3]) << 16);
          hpark[2 * i] = w0; hpark[2 * i + 1] = w1;
        }
      } else {
#pragma unroll
        for (int i = 0; i < 4; ++i) {
          const uint4 w0 = hpark[2 * i], w1 = hpark[2 * i + 1];
          const unsigned ww[8] = {w0.x, w0.y, w0.z, w0.w, w1.x, w1.y, w1.z, w1.w};
#pragma unroll
          for (int j = 0; j < 4; ++j) {
            hs[i][j][0] += bf2f((bfraw)(ww[2 * j] & 0xffff)); hs[i][j][1] += bf2f((bfraw)(ww[2 * j] >> 16));
            hs[i][j][2] += bf2f((bfraw)(ww[2 * j + 1] & 0xffff)); hs[i][j][3] += bf2f((bfraw)(ww[2 * j + 1] >> 16));
          }
        }
      }
    }
#pragma unroll
    for (int i = 0; i < 4; ++i)
#pragma unroll
      for (int r = 0; r < 4; ++r) {
        float ps = hs[i][0][r] + hs[i][1][r] + hs[i][2][r] + hs[i][3][r];
        ps = red16(ps);
        if (fr == 0) atomicAdd(&s_sum[wm * 64 + i * 16 + fq * 4 + r], ps);
      }
    __syncthreads();
#pragma unroll
    for (int i = 0; i < 4; ++i)
#pragma unroll
      for (int r = 0; r < 4; ++r) {
        const float mu = s_sum[wm * 64 + i * 16 + fq * 4 + r] * (1.f / 256.f);
        float ps = 0;
#pragma unroll
        for (int j = 0; j < 4; ++j) { float dlt = hs[i][j][r] - mu; ps += dlt * dlt; }
        ps = red16(ps);
        if (fr == 0) atomicAdd(&s_sq[wm * 64 + i * 16 + fq * 4 + r], ps);
      }
    __syncthreads();
    const float* gh = p.in[I_GHEAD] + h * 256;
    EPIR_BEGIN(128, 256)
      const float mu = s_sum[row] * (1.f / 256.f);
      const float rstd = rsqrtf(s_sq[row] * (1.f / 256.f) + EPS);
      EPIR_COLS(256)
        vv[(size_t)(R0 + row) * 1024 + h * 256 + col] = f2bf((hs[i][j][r] - mu) * rstd * gh[col]);
    EPIR_END
  }
}

constexpr int NPH = 28;
#define PHASE_PROGRAM \
  PHASE(0, phase_p0(p, lds)) \
  PHASE(1, phase_p0b(p)) \
  PHASE(2, phase_rows<1>(p, lds)) \
  PHASE(3, phase_ffn_in(p, lds, O_W1IN, 16896)) \
  PHASE(4, phase_ffn_out(p, lds, O_W1OUT, 2, true)) \
  PHASE(5, phase_r2_g2c(p, lds)) \
  PHASE(6, phase_rows<2>(p, lds, 16384, 16896)) \
  PHASE(7, phase_g3c(p, lds)) \
  PHASE(8, phase_g3a(p, lds, 0)) \
  PHASE(9, phase_cv(p, 0)) \
  PHASE(10, phase_ma(p, lds, 0)) \
  PHASE(11, phase_mb(p, lds)) \
  PHASE(12, phase_mc(p, lds, 0)) \
  PHASE(13, phase_g3b(p, lds, 0)) \
  PHASE(14, phase_g4(p, lds)) \
  PHASE(15, phase_addmix(p, 0); __syncthreads(); phase_g3a(p, lds, 1)) \
  PHASE(16, phase_cv(p, 1)) \
  PHASE(17, phase_ma(p, lds, 1)) \
  PHASE(18, phase_mb(p, lds)) \
  PHASE(19, phase_mc(p, lds, 1)) \
  PHASE(20, phase_g3b(p, lds, 1)) \
  PHASE(21, phase_g4(p, lds)) \
  PHASE(22, phase_addmix(p, 1)) \
  PHASE(23, phase_g5(p, lds)) \
  PHASE(24, phase_rows<3>(p, lds)) \
  PHASE(25, phase_ffn_in(p, lds, O_W2IN, 16384)) \
  PHASE(26, phase_ffn_out(p, lds, O_W2OUT, 8, false)) \
  PHASE(27, phase_rows<4>(p, lds))

#if !MULTI_LAUNCH
#ifndef USE_CG
#define USE_CG 0
#endif
#if USE_CG
#define PHASE(n, call) if (lo <= (n) && (n) < hi) { if ((n) > lo) { if ((n) == 1) grid.sync(); else xcd_barrier(xbar); } call; }
#else
#define PHASE(n, call) if (lo <= (n) && (n) < hi) { if ((n) > lo) xcd_barrier(xbar); call; }
#endif
__global__ void __launch_bounds__(512) mk(P p, int lo, int hi) {
  extern __shared__ __attribute__((aligned(16))) unsigned char lds[];
#if USE_CG
  cg::grid_group grid = cg::this_grid();
#endif
  volatile LAS unsigned* stw = (volatile LAS unsigned*)(lds + LDS_BYTES - 16);
  if (threadIdx.x == 0) { stw[0] = 0u; stw[1] = 0u; stw[2] = 0u; stw[3] = 0u; }
  __syncthreads();
  XcdBarrier xbar = xcd_barrier_post((unsigned*)(p.ws + O_BAR), stw);
  PHASE_PROGRAM
}
#undef PHASE
#else
#define PHASE(n, call) if constexpr (PH == (n)) { call; }
template <int PH>
__global__ void __launch_bounds__(512) mkp(P p) {
  extern __shared__ __attribute__((aligned(16))) unsigned char lds[];
  PHASE_PROGRAM
}
#undef PHASE
template <int PH> static void launch_all(const P& p, int grid, hipStream_t stream) {
  if constexpr (PH < NPH) {
    (void)hipFuncSetAttribute((const void*)mkp<PH>, hipFuncAttributeMaxDynamicSharedMemorySize, LDS_BYTES);
    hipLaunchKernelGGL(mkp<PH>, dim3(grid), dim3(NTHR), LDS_BYTES, stream, p);
    launch_all<PH + 1>(p, grid, stream);
  }
}
#endif

extern "C" void kernel_launch(void* const* d_in, const int* in_sizes, int n_in, void* d_out, int out_size, void* d_ws, size_t ws_size, hipStream_t stream) {
  static int grid_blocks = 0;
  if (!grid_blocks) {
    if (n_in != 25 || ws_size < O_END || ws_size < O_ACT + 16896ull * 2816 * 2) { fprintf(stderr, "kernel_launch: unexpected n_in %d / ws %zu\n", n_in, ws_size); grid_blocks = -1; return; }
    int dev = 0, cus = 0, per_cu = 0;
    (void)hipGetDevice(&dev);
    (void)hipDeviceGetAttribute(&cus, hipDeviceAttributeMultiprocessorCount, dev);
#if !MULTI_LAUNCH
    if (hipFuncSetAttribute((const void*)mk, hipFuncAttributeMaxDynamicSharedMemorySize, LDS_BYTES) != hipSuccess) { fprintf(stderr, "hipFuncSetAttribute failed\n"); grid_blocks = -1; return; }
    if (hipOccupancyMaxActiveBlocksPerMultiprocessor(&per_cu, (const void*)mk, NTHR, LDS_BYTES) != hipSuccess || per_cu < 1) { fprintf(stderr, "occupancy query failed (%d)\n", per_cu); grid_blocks = -1; return; }
#endif
    grid_blocks = cus * 1;
    fprintf(stderr, "kernel_launch: cus %d per_cu %d grid %d\n", cus, per_cu, grid_blocks);
  }
  if (grid_blocks < 0) return;
  P p{};
  for (int i = 0; i < 25; ++i) p.in[i] = (const float*)d_in[i];
  p.out = (float*)d_out; p.ws = (unsigned char*)d_ws;
#if MULTI_LAUNCH
  launch_all<0>(p, grid_blocks, stream);
#else
  int lo = 0, hi = NPH;
  if (hipMemsetAsync((unsigned char*)d_ws + O_BAR, 0, 16384, stream) != hipSuccess) { fprintf(stderr, "memset of barrier words failed\n"); return; }
  void* args[] = {&p, &lo, &hi};
#ifdef PROBE_K
  {
    hipLaunchKernelGGL(mk, dim3(grid_blocks), dim3(NTHR), LDS_BYTES, stream, p, 0, PROBE_K + 1);
    (void)hipMemsetAsync((unsigned char*)d_ws + O_BAR, 0, 16384, stream);
  }
#endif
#if USE_CG
  hipError_t e = hipLaunchCooperativeKernel((const void*)mk, dim3(grid_blocks), dim3(NTHR), args, LDS_BYTES, stream);
#else
  (void)args;
  hipLaunchKernelGGL(mk, dim3(grid_blocks), dim3(NTHR), LDS_BYTES, stream, p, lo, hi);
  hipError_t e = hipPeekAtLastError();
#endif
  if (e != hipSuccess) fprintf(stderr, "cooperative launch failed: %s (grid %d)\n", hipGetErrorString(e), grid_blocks);
#endif
}
```

```cpp
#include <hip/hip_runtime.h>
#include <hip/hip_cooperative_groups.h>
#include <cstdio>
#include <cstdint>
namespace cg = cooperative_groups;

#ifndef MULTI_LAUNCH
#define MULTI_LAUNCH 0
#endif

typedef unsigned short bfraw;
typedef __attribute__((ext_vector_type(8))) short bf16x8;
typedef __attribute__((ext_vector_type(4))) float f32x4;
#define DEVI __device__ __forceinline__

constexpr int NTHR = 512;
constexpr int GBM = 128;
constexpr int LROW = 40;
constexpr int LDS_BYTES = 143360;
constexpr float EPS = 1e-6f;

enum { I_X, I_C, I_CTX, I_CCTX, I_WADA, I_BADA, I_GFFN1, I_W1IN, I_W1OUT, I_GMIX, I_WIN, I_BGATES, I_CONVW, I_CONVB,
       I_GHEAD, I_GSGU, I_WS, I_BS, I_WA, I_WB, I_WO, I_GFFN2, I_W2IN, I_W2OUT, I_GFINAL };

struct P { const float* in[25]; float* out; unsigned char* ws; };

constexpr size_t O_W1IN  = 0;
constexpr size_t O_W1OUT = O_W1IN  + 5632ull * 1024 * 2;
constexpr size_t O_WTA   = O_W1OUT + 1024ull * 2816 * 2;
constexpr size_t O_WTB   = O_WTA   + 4096ull * 1024 * 2;
constexpr size_t O_WA    = O_WTB   + 4096ull * 1024 * 2;
constexpr size_t O_WB    = O_WA    + 1024ull * 1024 * 2;
constexpr size_t O_WO    = O_WB    + 1024ull * 1024 * 2;
constexpr size_t O_W2IN  = O_WO    + 1024ull * 1024 * 2;
constexpr size_t O_W2OUT = O_W2IN  + 5632ull * 1024 * 2;
constexpr size_t O_WSB   = O_W2OUT + 1024ull * 2816 * 2;
constexpr size_t O_MODSP = O_WSB   + 4ull * 128 * 128 * 2;
constexpr size_t O_MODS  = O_MODSP + 16ull * 3 * 9216 * 4;
constexpr size_t O_HCTX  = O_MODS  + 3ull * 9216 * 4;
constexpr size_t O_HN    = O_HCTX  + 512ull * 1024 * 4;
constexpr size_t O_GATES = O_HN    + 16896ull * 1024 * 2;
constexpr size_t O_CTXRAW= O_GATES + 16896ull * 16 * 4;
constexpr size_t O_BIG   = O_CTXRAW+ 2ull * 256 * 3072 * 2;
constexpr size_t O_ACT   = O_BIG;
constexpr size_t O_ST    = O_BIG;
constexpr size_t O_QRAW  = O_BIG;
constexpr size_t O_KRAW  = O_QRAW  + 8448ull * 1024 * 2;
constexpr size_t O_V     = O_ST    + 8ull * 66 * 131072;
constexpr size_t O_GVS   = O_V     + 8448ull * 1024 * 2;
constexpr size_t O_QC    = O_GVS   + 8192ull * 1024 * 2;
constexpr size_t O_KC    = O_QC    + 8448ull * 1024 * 2;
constexpr size_t O_NLOC  = O_KC    + 8448ull * 1024 * 2;
constexpr size_t O_NENT  = O_NLOC  + 8ull * 66 * 256 * 4;
constexpr size_t O_MG    = O_NENT  + 8ull * 66 * 256 * 4;
constexpr size_t O_RS    = O_MG    + 8192;
constexpr size_t O_HPARK = O_RS    + 8192ull * 4;
constexpr size_t O_BAR   = O_HPARK + 8192ull * 1024 * 2;
constexpr size_t O_END   = O_BAR + 16384;
static_assert(O_ACT + 16896ull * 2816 * 2 <= 268435456ull, "ws");
static_assert(O_END <= 268435456ull, "ws");
static_assert(O_KRAW + 8448ull * 1024 * 2 <= O_V, "overlay");

DEVI int ltid() { int t = __builtin_amdgcn_workitem_id_x(); asm volatile("" : "+v"(t)); return t; }
DEVI unsigned char* lws(unsigned char* w) { asm volatile("" : "+s"(w)); return w; }
DEVI float4 ld4(const float* p);
typedef float nt_f4 __attribute__((ext_vector_type(4)));
typedef unsigned nt_u2 __attribute__((ext_vector_type(2)));
typedef unsigned nt_u4 __attribute__((ext_vector_type(4)));
DEVI float4 ld4nt(const float* p) { const nt_f4 t = __builtin_nontemporal_load((const nt_f4*)p); return float4{t.x, t.y, t.z, t.w}; }
DEVI uint4 ldu4nt(const uint4* p) { const nt_u4 t = __builtin_nontemporal_load((const nt_u4*)p); return uint4{t.x, t.y, t.z, t.w}; }
DEVI bfraw f2bf(float f) { unsigned u = __float_as_uint(f); u += 0x7fffu + ((u >> 16) & 1u); return (bfraw)(u >> 16); }
DEVI float bf2f(bfraw h) { return __uint_as_float(((unsigned)h) << 16); }
DEVI float fexp(float x) { return __builtin_amdgcn_exp2f(x * 1.4426950408889634f); }
DEVI float sigmoidf_(float x) { return __builtin_amdgcn_rcpf(1.f + fexp(-x)); }
DEVI float siluf_(float x) { return x * sigmoidf_(x); }
DEVI float geluf_(float x) { return x * sigmoidf_(1.5957691216057308f * (x + 0.044715f * x * x * x)); }
DEVI float logsigf_(float x) { return fminf(x, 0.f) - log1pf(expf(-fabsf(x))); }
DEVI float wave_sum(float v) {
#pragma unroll
  for (int o = 32; o > 0; o >>= 1) v += __shfl_xor(v, o, 64);
  return v;
}
DEVI float red16(float v) {
  v += __shfl_xor(v, 1, 64); v += __shfl_xor(v, 2, 64); v += __shfl_xor(v, 4, 64); v += __shfl_xor(v, 8, 64);
  return v;
}
DEVI float redsin(float a, bool cosine) {
  float k = rintf(a * 0.15915494309189535f);
  float r = fmaf(-k, 6.2831854820251465f, a);
  r = fmaf(-k, -1.7484555e-7f, r);
  return cosine ? __cosf(r) : __sinf(r);
}


DEVI float seg_scan_sum(float v, int tid, float* s_x) {
  const int lane = tid & 63;
#pragma unroll
  for (int o = 1; o < 64; o <<= 1) { float t = __shfl_up(v, o, 64); if (lane >= o) v += t; }
  if (lane == 63 && tid < 256) s_x[tid >> 6] = v;
  __syncthreads();
  if (tid < 256 && ((tid >> 6) & 1)) v += s_x[(tid >> 6) - 1];
  __syncthreads();
  return v;
}
DEVI float seg_scan_max(float v, int tid, float* s_x) {
  const int lane = tid & 63;
#pragma unroll
  for (int o = 1; o < 64; o <<= 1) { float t = __shfl_up(v, o, 64); if (lane >= o) v = fmaxf(v, t); }
  if (lane == 63 && tid < 256) s_x[tid >> 6] = v;
  __syncthreads();
  if (tid < 256 && ((tid >> 6) & 1)) v = fmaxf(v, s_x[(tid >> 6) - 1]);
  __syncthreads();
  return v;
}

#define XB_TMO      128
#define XB_XCNT(j)  (256  + 64 * (j))
#define XB_XSUB(j)  (1280 + 64 * (j))
#define XB_XGEN(j)  (2304 + 64 * (j))
#define XB_TOP      3328
#define XB_TOPGEN   3392
#define XCD_BAR_WORDS 3456
#define XB_SPIN_CAP (1u << 18)
#define LAS __attribute__((address_space(3)))

__device__ __forceinline__ unsigned xb_ld(unsigned* p)              { return __hip_atomic_load(p, __ATOMIC_RELAXED, __HIP_MEMORY_SCOPE_AGENT); }
__device__ __forceinline__ unsigned xb_add(unsigned* p, unsigned v) { return __hip_atomic_fetch_add(p, v, __ATOMIC_RELAXED, __HIP_MEMORY_SCOPE_AGENT); }
__device__ __forceinline__ unsigned xb_xcc_id() { return (unsigned)__builtin_amdgcn_s_getreg((3 << 11) | 20) & 0xFu; }
#define XB_SPIN(cond, bar) do { unsigned _sp = 0; while (cond) { __builtin_amdgcn_s_sleep(1); \
    if ((++_sp & 255u) == 0u) { if (xb_ld(&(bar)[XB_TMO])) break; if (_sp > XB_SPIN_CAP) { atomicAdd(&(bar)[XB_TMO], 1u); break; } } } } while (0)

struct XcdBarrier {
    unsigned* bar; unsigned x;
    volatile LAS unsigned* st;
};

__device__ __forceinline__ XcdBarrier xcd_barrier_post(unsigned* bar, volatile LAS unsigned* st) {
    XcdBarrier b; b.bar = bar; b.x = xb_xcc_id(); b.st = st;
    if (threadIdx.x == 0) (void)xb_add(&bar[XB_XCNT(b.x)], 1u);
    return b;
}
__device__ __forceinline__ void xcd_barrier_complete(unsigned* bar, unsigned x, unsigned& nloc, unsigned& nx) {
    const unsigned G = gridDim.x * gridDim.y * gridDim.z;
    unsigned sum, cnt, mine, sp = 0u;
    for (;;) {
        sum = 0u; cnt = 0u; mine = 0u;
#pragma unroll
        for (unsigned j = 0; j < 16; ++j) { const unsigned c = xb_ld(&bar[XB_XCNT(j)]); sum += c; cnt += (c > 0u) ? 1u : 0u; mine = (j == x) ? c : mine; }
        if (sum == G) break;
        __builtin_amdgcn_s_sleep(1);
        if ((++sp & 255u) == 0u) { if (xb_ld(&bar[XB_TMO])) break; if (sp > XB_SPIN_CAP) { atomicAdd(&bar[XB_TMO], 1u); break; } }
    }
    nloc = mine > 0u ? mine : 1u; nx = cnt > 0u ? cnt : 1u;
}

__device__ __forceinline__ void xcd_barrier(const XcdBarrier& b) {
    asm volatile("s_waitcnt vmcnt(0)" ::: "memory");
    __syncthreads();
    if (threadIdx.x == 0) {
        unsigned* bar = b.bar;
        __builtin_amdgcn_s_waitcnt(0);
        unsigned nloc = b.st[0], nx = b.st[1];
        if (nloc == 0u) { xcd_barrier_complete(bar, b.x, nloc, nx); b.st[0] = nloc; b.st[1] = nx; }
        const unsigned old = xb_add(&bar[XB_XSUB(b.x)], 1u);
        const unsigned gen = old / nloc;
        if (old + 1u == (gen + 1u) * nloc) {
            __builtin_amdgcn_fence(__ATOMIC_RELEASE, "agent");
            asm volatile("s_waitcnt vmcnt(0)" ::: "memory");
            const unsigned og = xb_add(&bar[XB_TOP], 1u);
            const unsigned tg = og / nx;
            if (og + 1u == (tg + 1u) * nx) xb_add(&bar[XB_TOPGEN], 1u);
            else XB_SPIN(xb_ld(&bar[XB_TOPGEN]) == tg, bar);
            __builtin_amdgcn_fence(__ATOMIC_ACQUIRE, "agent");
            xb_add(&bar[XB_XGEN(b.x)], 1u);
            asm volatile("s_waitcnt vmcnt(0)" ::: "memory");
        } else {
            XB_SPIN(xb_ld(&bar[XB_XGEN(b.x)]) == gen, bar);
            __builtin_amdgcn_fence(__ATOMIC_ACQUIRE, "agent");
            asm volatile("s_waitcnt vmcnt(0)" ::: "memory");
        }
    }
    __syncthreads();
}

template <int BM, int BN, bool ATR, bool BTR, bool ALDS>
DEVI void gemm_tile(const bfraw* __restrict__ A, int lda, const bfraw* __restrict__ B, int ldb, int K,
                    const float* kscale, f32x4 (&acc)[BM / 32][BN / 64], bfraw* st, const bfraw* sAres, int ldres) {
  constexpr int MI = BM / 32, NJ = BN / 64, CA = BM / 128, CB = BN / 128, WM = BM / 2, WN = BN / 4;
  constexpr int STAGE = (ALDS ? BN : (BM + BN)) * LROW;
  int tid_ = ltid();
  const int tid = tid_, lane = tid & 63, wid = tid >> 6, wm = wid >> 2, wn = wid & 3;
  const int fr = lane & 15, fq = lane >> 4;
  uint4 ra0 = {0, 0, 0, 0}, ra1 = {0, 0, 0, 0}, rb0 = {0, 0, 0, 0}, rb1 = {0, 0, 0, 0};
  const int nk = K >> 5;

  auto gla = [&](int c, int k0) -> uint4 {
    if (!ATR) { int row = c >> 2, kc = (c & 3) * 8; return *(const uint4*)(A + (size_t)row * lda + k0 + kc); }
    else { int krow = c / (BM / 8), m0 = (c % (BM / 8)) * 8; return *(const uint4*)(A + (size_t)(k0 + krow) * lda + m0); }
  };
  auto glb = [&](int c, int k0) -> uint4 {
    if (!BTR) { int row = c >> 2, kc = (c & 3) * 8; return *(const uint4*)(B + (size_t)row * ldb + k0 + kc); }
    else { int krow = c / (BN / 8), n0 = (c % (BN / 8)) * 8; return *(const uint4*)(B + (size_t)(k0 + krow) * ldb + n0); }
  };
  auto gload = [&](int kt) {
    const int k0 = kt << 5;
    if (!ALDS) { ra0 = gla(tid, k0); if (CA > 1) ra1 = gla(tid + NTHR, k0); }
    rb0 = glb(tid, k0); if (CB > 1) rb1 = glb(tid + NTHR, k0);
  };
  constexpr int TSA = BM + 8, TSB = BN + 8;
  auto scale8 = [&](uint4 r, float sc) -> uint4 {
    unsigned w[4] = {r.x, r.y, r.z, r.w};
#pragma unroll
    for (int e = 0; e < 4; ++e) w[e] = (unsigned)f2bf(bf2f((bfraw)(w[e] & 0xffff)) * sc) | ((unsigned)f2bf(bf2f((bfraw)(w[e] >> 16)) * sc) << 16);
    return uint4{w[0], w[1], w[2], w[3]};
  };
  auto lstore = [&](int buf, int kt) {
    bfraw* sA = st + buf * STAGE;
    bfraw* sB = sA + (ALDS ? 0 : BM * LROW);
    auto sta = [&](int c, uint4 v) {
      if (!ATR) { int row = c >> 2, kc = (c & 3) * 8; *(uint4*)(sA + row * LROW + kc) = v; }
      else { int krow = c / (BM / 8), m0 = (c % (BM / 8)) * 8; *(uint4*)(sA + krow * TSA + m0) = v; }
    };
    auto stb = [&](int c, uint4 v) {
      if (!BTR) { int row = c >> 2, kc = (c & 3) * 8; *(uint4*)(sB + row * LROW + kc) = v; }
      else {
        int krow = c / (BN / 8), n0 = (c % (BN / 8)) * 8;
        if (kscale) v = scale8(v, kscale[(kt << 5) + krow]);
        *(uint4*)(sB + krow * TSB + n0) = v;
      }
    };
    if (!ALDS) { sta(tid, ra0); if (CA > 1) sta(tid + NTHR, ra1); }
    stb(tid, rb0); if (CB > 1) stb(tid + NTHR, rb1);
  };
  typedef short s16x4 __attribute__((ext_vector_type(4)));
  auto trfrag = [&](const bfraw* sT, int TS, int mt) -> bf16x8 {
    const bfraw* a1 = sT + (8 * fq + (fr >> 2)) * TS + mt + (fr & 3) * 4;
    s16x4 r1 = __builtin_amdgcn_ds_read_tr16_b64_v4i16((__attribute__((address_space(3))) s16x4*)a1);
    s16x4 r2 = __builtin_amdgcn_ds_read_tr16_b64_v4i16((__attribute__((address_space(3))) s16x4*)(a1 + 4 * TS));
    return bf16x8{r1[0], r1[1], r1[2], r1[3], r2[0], r2[1], r2[2], r2[3]};
  };
  auto compute = [&](int buf, int kt) {
    const bfraw* sA = st + buf * STAGE;
    const bfraw* sB = sA + (ALDS ? 0 : BM * LROW);
    bf16x8 af[MI], bfr[NJ];
#pragma unroll
    for (int i = 0; i < MI; ++i) {
      if (ALDS) af[i] = *(const bf16x8*)(sAres + (wm * WM + i * 16 + fr) * ldres + (kt << 5) + fq * 8);
      else if (ATR) af[i] = trfrag(sA, TSA, wm * WM + i * 16);
      else af[i] = *(const bf16x8*)(sA + (wm * WM + i * 16 + fr) * LROW + fq * 8);
    }
#pragma unroll
    for (int j = 0; j < NJ; ++j) {
      if (BTR) bfr[j] = trfrag(sB, TSB, wn * WN + j * 16);
      else bfr[j] = *(const bf16x8*)(sB + (wn * WN + j * 16 + fr) * LROW + fq * 8);
    }
#pragma unroll
    for (int i = 0; i < MI; ++i)
#pragma unroll
      for (int j = 0; j < NJ; ++j) acc[i][j] = __builtin_amdgcn_mfma_f32_16x16x32_bf16(af[i], bfr[j], acc[i][j], 0, 0, 0);
  };

  uint4 xa0 = {0, 0, 0, 0}, xa1 = {0, 0, 0, 0}, xb0 = {0, 0, 0, 0}, xb1 = {0, 0, 0, 0};
  auto swapsets = [&]() { uint4 t; t = ra0; ra0 = xa0; xa0 = t; t = ra1; ra1 = xa1; xa1 = t; t = rb0; rb0 = xb0; xb0 = t; t = rb1; rb1 = xb1; xb1 = t; };
  __syncthreads();
  gload(0); lstore(0, 0);
  if (nk > 1) gload(1);
  if (nk > 2) { swapsets(); gload(2); swapsets(); }
  __syncthreads();
  for (int kt = 0; kt < nk; kt += 2) {
    compute(0, kt);
    if (kt + 1 < nk) lstore(1, kt + 1);
    if (kt + 3 < nk) gload(kt + 3);
    __syncthreads();
    if (kt + 1 >= nk) break;
    compute(1, kt + 1);
    swapsets();
    if (kt + 2 < nk) lstore(0, kt + 2);
    if (kt + 4 < nk) gload(kt + 4);
    swapsets();
    __syncthreads();
  }
}

#define ZERO_ACC(acc, MI, NJ) _Pragma("unroll") for (int _i = 0; _i < (MI); ++_i) _Pragma("unroll") for (int _j = 0; _j < (NJ); ++_j) acc[_i][_j] = f32x4{0.f, 0.f, 0.f, 0.f};
#define EPI_BEGIN(BM, BN) { int _t = ltid(); const int _l = _t & 63, _w = _t >> 6; \
    const int _rb = (_w >> 2) * ((BM) / 2) + (_l >> 4) * 4, _cb = (_w & 3) * ((BN) / 4) + (_l & 15); \
    _Pragma("unroll") for (int i = 0; i < (BM) / 32; ++i) _Pragma("unroll") for (int j = 0; j < (BN) / 64; ++j) _Pragma("unroll") for (int r = 0; r < 4; ++r) { \
      const int row = _rb + i * 16 + r, col = _cb + j * 16;
#define EPI_END }}
#define EPIR_BEGIN(BM, BN) { int _t = ltid(); const int _l = _t & 63, _w = _t >> 6; \
    const int _rb = (_w >> 2) * ((BM) / 2) + (_l >> 4) * 4, _cb = (_w & 3) * ((BN) / 4) + (_l & 15); \
    _Pragma("unroll") for (int i = 0; i < (BM) / 32; ++i) _Pragma("unroll") for (int r = 0; r < 4; ++r) { \
      const int row = _rb + i * 16 + r;
#define EPIR_COLS(BN) _Pragma("unroll") for (int j = 0; j < (BN) / 64; ++j) { const int col = _cb + j * 16;
#define EPIR_END }}}


namespace pg8 {
#define PG8_LAS __attribute__((address_space(3)))
typedef unsigned short bf16_t;
typedef short bf16x8 __attribute__((ext_vector_type(8)));
typedef float f32x4 __attribute__((ext_vector_type(4)));
typedef unsigned u32x4 __attribute__((ext_vector_type(4)));
constexpr int BM = 256, BK = 64, HALF = 128, HTB = HALF * BK * 2  , STAGE_BYTES = 8 * HTB, NXCD = 8, WGM = 8;

__host__ __device__ __forceinline__ int lds_byte(int r, int c) { const int st = (r >> 4) * 2 + (c >> 5), rr = r & 15, cc = c & 31, ob = rr * 64 + cc * 2; return st * 1024 + (ob ^ (((ob >> 9) & 1) << 5)); }
__host__ __device__ __forceinline__ void stage_rc(int b, int& R, int& C) { const int st = b / 1024, sb = b % 1024, swz = sb ^ (((sb >> 9) & 1) << 5); R = (st >> 1) * 16 + swz / 64; C = (st & 1) * 32 + (swz % 64) / 2; }
__host__ __device__ __forceinline__ int perm32(int rho) { const int n = rho >> 4, i = rho & 15; return 8 * (i >> 2) + 4 * n + (i & 3); }

struct Unit { int pm, pn; };
struct Gemm { const bf16_t* A; const bf16_t* Bt; int M, N, K, ld; };
struct StaticOrder {
    int nM, nN, nwg, G, c;
    __host__ __device__ void init(int M, int N, int G_, int c_) { nM = M / BM; nN = N / BM; nwg = nM * nN; G = G_; c = c_; }
    __host__ __device__ bool next(int i, Unit& u) const {
        const long L = (long)i * G + c; if (L >= nwg) return false;
        int wgid = (int)L; { const int q = nwg / NXCD, r = nwg % NXCD, xcd = wgid % NXCD, off = wgid / NXCD; wgid = (xcd < r ? xcd * (q + 1) : r * (q + 1) + (xcd - r) * q) + off; }
        const int nig = WGM * nN, gid = wgid / nig, fm = gid * WGM, gsz = (nM - fm) < WGM ? (nM - fm) : WGM;
        u.pm = fm + ((wgid % nig) % gsz); u.pn = (wgid % nig) / gsz; return true;
    }
    __device__ __forceinline__ void a_ready(const Unit&) const {}
    __device__ __forceinline__ void done(const Unit&) const {}
};
__device__ __forceinline__ unsigned cvt_pk_bf16(float lo, float hi) { unsigned r; asm volatile("v_cvt_pk_bf16_f32 %0, %1, %2" : "=v"(r) : "v"(lo), "v"(hi)); return r; }
template <class Epi, class Sched, bool STAMP = false>
__device__ __forceinline__ void gemm_phase(PG8_LAS unsigned char* lds, const Gemm g, const Sched& S, const Epi& E, unsigned long long* stamps) {
    const int tid = threadIdx.x, wid = __builtin_amdgcn_readfirstlane(tid >> 6), lane = tid & 63, wr = wid >> 2, wc = wid & 3, fr = lane & 15, fq = lane >> 4;
    const int K = g.K, nt = K / BK;
    int ts_lo = 0, ts_hi = 0, nts = 0; const unsigned long long rt_entry = STAMP ? (unsigned long long)wall_clock64() : 0ull;
#define PG8_STAMP() do { if (STAMP && wid == 0 && nts < 64) { const unsigned long long _c = (unsigned long long)clock64(); \
        ts_lo = (lane == nts) ? (int)(unsigned)_c : ts_lo; ts_hi = (lane == nts) ? (int)(unsigned)(_c >> 32) : ts_hi; ++nts; } } while (0)
    PG8_STAMP();
    unsigned voffA[2], voffB[2];
#pragma unroll
    for (int i = 0; i < 2; ++i) { int R, C; stage_rc(tid * 16 + i * 8192, R, C); const int Rb = Epi::PERM ? ((R & ~31) + perm32(R & 31)) : R;
        voffA[i] = (unsigned)(R * g.ld + C) * 2u; voffB[i] = (unsigned)(Rb * g.ld + C) * 2u; }
    const size_t kstep = (size_t)(BK * 2);
    const size_t hstep = (size_t)HALF * g.ld * 2;
    const size_t tstep = 2 * hstep;
    const unsigned ldsw = (unsigned)wid * 1024u;
    const int aoff = lds_byte(wr * 64 + fr, fq * 8), boff = lds_byte(wc * 32 + fr, fq * 8);
#define PG8_SA(b, h) (((b) * 2 + (h)) * HTB)
#define PG8_SB(b, h) ((4 + (b) * 2 + (h)) * HTB)
#define PG8_STAGE(bufoff, gbase, voff) do { _Pragma("unroll") for (int _i = 0; _i < 2; ++_i) \
        __builtin_amdgcn_global_load_lds((const unsigned*)((const char*)(gbase) + (voff)[_i]), (PG8_LAS unsigned*)(lds + (bufoff) + ldsw + _i * 8192), 16, 0, 0); } while (0)
#define PG8_LDA(dst, b, h) do { _Pragma("unroll") for (int m = 0; m < 4; ++m) _Pragma("unroll") for (int k = 0; k < 2; ++k) dst[m][k] = *(const PG8_LAS bf16x8*)(lds + PG8_SA(b, h) + aoff + m * 2048 + k * 1024); } while (0)
#define PG8_LDB(dst, b, h) do { _Pragma("unroll") for (int n = 0; n < 2; ++n) _Pragma("unroll") for (int k = 0; k < 2; ++k) dst[n][k] = *(const PG8_LAS bf16x8*)(lds + PG8_SB(b, h) + boff + n * 2048 + k * 1024); } while (0)
#define PG8_MMA(ai, bj, At, Bt) do { __builtin_amdgcn_s_setprio(1); _Pragma("unroll") for (int m = 0; m < 4; ++m) _Pragma("unroll") for (int n = 0; n < 2; ++n) _Pragma("unroll") for (int k = 0; k < 2; ++k) \
        acc[ai][bj][m][n] = __builtin_amdgcn_mfma_f32_16x16x32_bf16(Bt[n][k], At[m][k], acc[ai][bj][m][n], 0, 0, 0); __builtin_amdgcn_s_setprio(0); } while (0)
#define PG8_WAIT_V(n) asm volatile("s_waitcnt vmcnt(" #n ")" ::: "memory")
#define PG8_WAIT_L(n) asm volatile("s_waitcnt lgkmcnt(" #n ")" ::: "memory")
#define PG8_BAR __builtin_amdgcn_s_barrier()
#define PG8_SCHED __builtin_amdgcn_sched_barrier(0)
    Unit cur, nxt; int ui = 0;
    if (!S.next(0, cur)) return;
    f32x4 acc[2][2][4][2];
#pragma unroll
    for (int a = 0; a < 2; ++a)
#pragma unroll
        for (int b = 0; b < 2; ++b)
#pragma unroll
            for (int m = 0; m < 4; ++m)
#pragma unroll
                for (int n = 0; n < 2; ++n) acc[a][b][m][n] = (f32x4){0.f, 0.f, 0.f, 0.f};
    bf16x8 At[4][2], B0[2][2], B1[2][2];
    const char* cA = (const char*)g.A + (size_t)cur.pm * tstep; const char* cB = (const char*)g.Bt + (size_t)cur.pn * tstep;
    S.a_ready(cur);
    PG8_STAGE(PG8_SB(0, 0), cB, voffB); PG8_STAGE(PG8_SA(0, 0), cA, voffA); PG8_STAGE(PG8_SB(0, 1), cB + hstep, voffB); PG8_STAGE(PG8_SA(0, 1), cA + hstep, voffA);
    if (wr == 1) PG8_BAR;
    PG8_WAIT_V(4); PG8_BAR;
    PG8_STAGE(PG8_SB(1, 0), cB + kstep, voffB); PG8_STAGE(PG8_SA(1, 0), cA + kstep, voffA); PG8_STAGE(PG8_SB(1, 1), cB + hstep + kstep, voffB);
    PG8_WAIT_V(6); PG8_BAR;
    PG8_STAMP();
    for (;;) {
        const bool has_next = S.next(ui + 1, nxt);
        const char* nA = has_next ? (const char*)g.A + (size_t)nxt.pm * tstep : cA; const char* nB = has_next ? (const char*)g.Bt + (size_t)nxt.pn * tstep : cB;
        for (int t = 0; t < nt; t += 2) {
            const bool last = (t == nt - 2);
            const char* a1 = cA + (size_t)(t + 1) * kstep;
            const char* a2 = last ? nA : cA + (size_t)(t + 2) * kstep; const char* b2 = last ? nB : cB + (size_t)(t + 2) * kstep;
            const char* a3 = a2 + kstep; const char* b3 = b2 + kstep;
            if (last && has_next) S.a_ready(nxt);
            PG8_LDB(B0, 0, 0); PG8_SCHED; PG8_LDA(At, 0, 0); PG8_STAGE(PG8_SA(1, 1), a1 + hstep, voffA);
            PG8_WAIT_L(8); PG8_BAR; PG8_WAIT_L(0); PG8_MMA(0, 0, At, B0); PG8_BAR; PG8_SCHED;
            PG8_LDB(B1, 0, 1); PG8_STAGE(PG8_SB(0, 0), b2, voffB);
            PG8_BAR; PG8_WAIT_L(0); PG8_MMA(0, 1, At, B1); PG8_BAR;
            PG8_LDA(At, 0, 1); PG8_STAGE(PG8_SA(0, 0), a2, voffA);
            PG8_BAR; PG8_WAIT_L(0); PG8_MMA(1, 0, At, B0); PG8_BAR; PG8_SCHED;
            PG8_STAGE(PG8_SB(0, 1), b2 + hstep, voffB);
            PG8_WAIT_V(6); PG8_BAR; PG8_MMA(1, 1, At, B1); PG8_BAR;
            PG8_LDB(B0, 1, 0); PG8_SCHED; PG8_LDA(At, 1, 0); PG8_STAGE(PG8_SA(0, 1), a2 + hstep, voffA);
            PG8_WAIT_L(8); PG8_BAR; PG8_WAIT_L(0); PG8_MMA(0, 0, At, B0); PG8_BAR; PG8_SCHED;
            PG8_LDB(B1, 1, 1); PG8_STAGE(PG8_SB(1, 0), b3, voffB);
            PG8_BAR; PG8_WAIT_L(0); PG8_MMA(0, 1, At, B1); PG8_BAR;
            PG8_LDA(At, 1, 1); PG8_STAGE(PG8_SA(1, 0), a3, voffA);
            PG8_BAR; PG8_WAIT_L(0); PG8_MMA(1, 0, At, B0); PG8_BAR; PG8_SCHED;
            PG8_STAGE(PG8_SB(1, 1), b3 + hstep, voffB);
            PG8_WAIT_V(6); PG8_BAR; PG8_MMA(1, 1, At, B1); PG8_BAR;
        }
        PG8_STAMP();
        if constexpr (!Epi::AFTER_DRAIN) { E(acc, cur, wr, wc, fr, fq); S.done(cur); }
        PG8_STAMP();
        if (!has_next) break;
#pragma unroll
        for (int a = 0; a < 2; ++a)
#pragma unroll
            for (int b = 0; b < 2; ++b)
#pragma unroll
                for (int m = 0; m < 4; ++m)
#pragma unroll
                    for (int n = 0; n < 2; ++n) acc[a][b][m][n] = (f32x4){0.f, 0.f, 0.f, 0.f};
        cur = nxt; cA = nA; cB = nB; ++ui;
    }
    PG8_WAIT_V(0);
    if (wr == 0) PG8_BAR;
    PG8_BAR;
    if constexpr (Epi::AFTER_DRAIN) { E.fused(acc, cur, wr, wc, fr, fq, lds, wid, lane); S.done(cur); }
    PG8_STAMP();
    if (STAMP && wid == 0) { stamps[lane] = lane < nts ? (((unsigned long long)(unsigned)ts_hi << 32) | (unsigned)ts_lo) : 0ull;
        if (lane == 62) stamps[62] = rt_entry; if (lane == 63) stamps[63] = (unsigned long long)wall_clock64(); }
#undef PG8_STAMP
#undef PG8_SA
#undef PG8_SB
#undef PG8_STAGE
#undef PG8_LDA
#undef PG8_LDB
#undef PG8_MMA
#undef PG8_WAIT_V
#undef PG8_WAIT_L
#undef PG8_BAR
#undef PG8_SCHED
}
}

typedef pg8::f32x4 pf4;
DEVI float4 ld4(const float* p) { return *(const float4*)p; }
struct EpiFfnIn {
  static constexpr bool PERM = false, AFTER_DRAIN = false;
  bfraw* act;
  DEVI void operator()(const pf4 (&acc)[2][2][4][2], const pg8::Unit& u, int wr, int wc, int fr, int fq) const {
    const int row0 = u.pm * 256 + wr * 64 + fr, f0 = (u.pn * 256 + wc * 32) / 2 + 4 * fq;
#pragma unroll
    for (int ai = 0; ai < 2; ++ai)
#pragma unroll
      for (int m = 0; m < 4; ++m) {
        bfraw* rowp = act + (size_t)(row0 + ai * 128 + m * 16) * 2816 + f0;
#pragma unroll
        for (int bj = 0; bj < 2; ++bj) {
          const pf4 a = acc[ai][bj][m][0], b = acc[ai][bj][m][1];
          uint2 w; w.x = pg8::cvt_pk_bf16(siluf_(a[0]) * b[0], siluf_(a[1]) * b[1]); w.y = pg8::cvt_pk_bf16(siluf_(a[2]) * b[2], siluf_(a[3]) * b[3]);
          *(uint2*)(rowp + bj * 64) = w;
        }
      }
  }
};
struct EpiResid {
  static constexpr bool PERM = false, AFTER_DRAIN = false;
  float* h; const float* mods; int rowoff, gidx; float scale; int mrow;
  DEVI void operator()(const pf4 (&acc)[2][2][4][2], const pg8::Unit& u, int wr, int wc, int fr, int fq) const {
    const int row0 = rowoff + u.pm * 256 + wr * 64 + fr, col0 = u.pn * 256 + wc * 32 + 4 * fq;
#pragma unroll
    for (int ai = 0; ai < 2; ++ai)
#pragma unroll
      for (int m = 0; m < 4; ++m) {
        const int r = row0 + ai * 128 + m * 16;
        float* rowp = h + (size_t)r * 1024 + col0;
        const float* gp = mods + (mrow >= 0 ? mrow : (r >> 13)) * 9216 + gidx * 1024 + col0;
#pragma unroll
        for (int bj = 0; bj < 2; ++bj)
#pragma unroll
          for (int n = 0; n < 2; ++n) {
            float4 hv = ld4(rowp + bj * 128 + n * 16); const float4 g = ld4(gp + bj * 128 + n * 16); const pf4 a = acc[ai][bj][m][n];
            hv.x += scale * g.x * a[0]; hv.y += scale * g.y * a[1]; hv.z += scale * g.z * a[2]; hv.w += scale * g.w * a[3];
            *(float4*)(rowp + bj * 128 + n * 16) = hv;
          }
      }
  }
};
struct EpiResidAtomic {
  static constexpr bool PERM = false, AFTER_DRAIN = false;
  float* h; const float* mods; int rowoff, gidx; float scale; int mrow;
  DEVI void operator()(const pf4 (&acc)[2][2][4][2], const pg8::Unit& u, int wr, int wc, int fr, int fq) const {
    const int row0 = rowoff + u.pm * 256 + wr * 64 + fr, col0 = u.pn * 256 + wc * 32 + 4 * fq;
#pragma unroll
    for (int ai = 0; ai < 2; ++ai)
#pragma unroll
      for (int m = 0; m < 4; ++m) {
        const int r = row0 + ai * 128 + m * 16;
        float* rowp = h + (size_t)r * 1024 + col0;
        const float* gp = mods + (mrow >= 0 ? mrow : (r >> 13)) * 9216 + gidx * 1024 + col0;
#pragma unroll
        for (int bj = 0; bj < 2; ++bj)
#pragma unroll
          for (int n = 0; n < 2; ++n) {
            const float4 g = ld4(gp + bj * 128 + n * 16); const pf4 a = acc[ai][bj][m][n];
            float* q = rowp + bj * 128 + n * 16;
            atomicAdd(q, scale * g.x * a[0]); atomicAdd(q + 1, scale * g.y * a[1]); atomicAdd(q + 2, scale * g.z * a[2]); atomicAdd(q + 3, scale * g.w * a[3]);
          }
      }
  }
};
template <int MODE> struct EpiMix {
  static constexpr bool PERM = true, AFTER_DRAIN = false;
  bfraw* d0; bfraw* d1; bfraw* d2; bfraw* d3;
  DEVI void operator()(const pf4 (&acc)[2][2][4][2], const pg8::Unit& u, int wr, int wc, int fr, int fq) const {
    const int row0 = u.pm * 256 + wr * 64 + fr;
    const int pc = u.pn >> 2;
    bfraw* dst = MODE == 0 ? d0 : (MODE == 1 || MODE == 2) ? (pc == 0 ? d0 : pc == 1 ? d1 : pc == 2 ? d2 : d3) : (MODE == 3 ? d0 : d1);
    const int ld = MODE == 0 ? 3072 : 1024;
    const int col0 = (MODE == 1 || MODE == 2 ? (u.pn & 3) : u.pn) * 256 + wc * 32 + 8 * fq;
#pragma unroll
    for (int ai = 0; ai < 2; ++ai)
#pragma unroll
      for (int m = 0; m < 4; ++m) {
        const size_t ro = (size_t)(row0 + ai * 128 + m * 16) * ld + col0;
#pragma unroll
        for (int bj = 0; bj < 2; ++bj) {
          float v[8];
#pragma unroll
          for (int e = 0; e < 4; ++e) { v[e] = acc[ai][bj][m][0][e]; v[4 + e] = acc[ai][bj][m][1][e]; }
          bfraw* dp = dst + ro + bj * 128;
          if (MODE == 1) { if (pc == 3) {
#pragma unroll
            for (int e = 0; e < 8; ++e) v[e] = geluf_(v[e]); } }
          if (MODE == 2 && pc >= 2) {
#pragma unroll
            for (int e = 0; e < 8; ++e) v[e] = sigmoidf_(v[e]);
          } else if (MODE == 2 || MODE == 3 || MODE == 4) {
            const uint4 o = *(const uint4*)dp; const unsigned ow[4] = {o.x, o.y, o.z, o.w};
            float p[8];
#pragma unroll
            for (int e = 0; e < 4; ++e) { p[2 * e] = bf2f((bfraw)(ow[e] & 0xffff)); p[2 * e + 1] = bf2f((bfraw)(ow[e] >> 16)); }
            if (MODE == 2) {
#pragma unroll
              for (int e = 0; e < 8; ++e) v[e] = (pc == 0 ? sigmoidf_(v[e]) : geluf_(v[e])) * p[e];
            } else if (MODE == 3) {
#pragma unroll
              for (int e = 0; e < 8; ++e) v[e] *= p[e];
            } else {
              const uint4 t = *(const uint4*)(d0 + ro + bj * 128); const unsigned tw[4] = {t.x, t.y, t.z, t.w};
#pragma unroll
              for (int e = 0; e < 4; ++e) { v[2 * e] = bf2f((bfraw)(tw[e] & 0xffff)) + p[2 * e] * v[2 * e]; v[2 * e + 1] = bf2f((bfraw)(tw[e] >> 16)) + p[2 * e + 1] * v[2 * e + 1]; }
            }
          }
          uint4 w; w.x = pg8::cvt_pk_bf16(v[0], v[1]); w.y = pg8::cvt_pk_bf16(v[2], v[3]); w.z = pg8::cvt_pk_bf16(v[4], v[5]); w.w = pg8::cvt_pk_bf16(v[6], v[7]);
          *(uint4*)dp = w;
        }
      }
  }
};
template <class Epi>
DEVI void run8(unsigned char* lds, const bfraw* A, const bfraw* Bt, int M, int N, int K, const Epi& E, int G = -1, int c = -1, int ld = -1) {
  pg8::Gemm g{A, Bt, M, N, K, ld < 0 ? K : ld};
  pg8::StaticOrder S; S.init(M, N, G < 0 ? (int)gridDim.x : G, c < 0 ? (int)blockIdx.x : c);
  pg8::gemm_phase<Epi, pg8::StaticOrder, false>((PG8_LAS unsigned char*)lds, g, S, E, nullptr);
}

struct TrJob { const float* src; bfraw* dst; int ldw, K, kt, nt, drow0, mode; };
DEVI TrJob tr_decode(const P& p, int t) {
  TrJob j; int u = t;
  if (u < 1408) { j = TrJob{p.in[I_W1IN], (bfraw*)(p.ws + O_W1IN), 5632, 1024, u / 88, u % 88, 0, 1}; return j; }
  u -= 1408;
  if (u < 704) { j = TrJob{p.in[I_W1OUT], (bfraw*)(p.ws + O_W1OUT), 1024, 2816, u / 16, u % 16, 0, 0}; return j; }
  u -= 704;
  if (u < 2048) {
    const int pc = u >> 8; u &= 255;
    const int col0 = pc == 0 ? 0 : pc == 1 ? 1024 : pc == 2 ? 2048 : pc == 3 ? 5136 : pc == 4 ? 3088 : pc == 5 ? 4112 : pc == 6 ? 6160 : 7184;
    j = TrJob{p.in[I_WIN] + col0, (bfraw*)(p.ws + (pc < 4 ? O_WTA : O_WTB)), 8208, 1024, u >> 4, u & 15, (pc & 3) * 1024, 0}; return j;
  }
  u -= 2048;
  if (u < 768) { const int m = u >> 8; u &= 255; j = TrJob{p.in[m == 0 ? I_WA : m == 1 ? I_WB : I_WO], (bfraw*)(p.ws + (m == 0 ? O_WA : m == 1 ? O_WB : O_WO)), 1024, 1024, u >> 4, u & 15, 0, 0}; return j; }
  u -= 768;
  if (u < 1408) { j = TrJob{p.in[I_W2IN], (bfraw*)(p.ws + O_W2IN), 5632, 1024, u / 88, u % 88, 0, 1}; return j; }
  u -= 1408;
  j = TrJob{p.in[I_W2OUT], (bfraw*)(p.ws + O_W2OUT), 1024, 2816, u / 16, u % 16, 0, 0}; return j;
}

DEVI void phase_p0(const P& p, unsigned char* lds) {
  float* sf = (float*)lds;
  const int tid = ltid();
  for (int i = tid; i < 3072; i += NTHR) { float v = i < 2048 ? p.in[I_C][i] : p.in[I_CCTX][i - 2048]; sf[i] = v / (1.f + expf(-v)); }
  __syncthreads();
  {
    const float* w = p.in[I_WADA];
    float* mp = (float*)(p.ws + O_MODSP);
    for (int id = blockIdx.x * NTHR + tid; id < 16 * 9216; id += gridDim.x * NTHR) {
      int s = id / 9216, j = id - s * 9216;
      float a0 = 0, a1 = 0, a2 = 0;
#pragma unroll 16
      for (int k = s * 64; k < s * 64 + 64; ++k) { float wv = __builtin_nontemporal_load(w + (size_t)k * 9216 + j); a0 += sf[k] * wv; a1 += sf[1024 + k] * wv; a2 += sf[2048 + k] * wv; }
      mp[(s * 3 + 0) * 9216 + j] = a0; mp[(s * 3 + 1) * 9216 + j] = a1; mp[(s * 3 + 2) * 9216 + j] = a2;
    }
  }
  __syncthreads();
  {
    float4 rg0 = {0.f, 0.f, 0.f, 0.f}, rg1 = {0.f, 0.f, 0.f, 0.f};
    const int lk = tid >> 4, ln = (tid & 15) * 4;
    const int sn = tid >> 3, sk = (tid & 7) * 8;
    int t = blockIdx.x;
    TrJob jb = tr_decode(p, t < 7040 ? t : 0);
    if (t < 7040) {
      rg0 = ld4nt(jb.src + (size_t)(jb.kt * 64 + lk) * jb.ldw + jb.nt * 64 + ln);
      rg1 = ld4nt(jb.src + (size_t)(jb.kt * 64 + lk + 32) * jb.ldw + jb.nt * 64 + ln);
    }
    for (; t < 7040; t += gridDim.x) {
      sf[lk * 65 + ln] = rg0.x; sf[lk * 65 + ln + 1] = rg0.y; sf[lk * 65 + ln + 2] = rg0.z; sf[lk * 65 + ln + 3] = rg0.w;
      sf[(lk + 32) * 65 + ln] = rg1.x; sf[(lk + 32) * 65 + ln + 1] = rg1.y; sf[(lk + 32) * 65 + ln + 2] = rg1.z; sf[(lk + 32) * 65 + ln + 3] = rg1.w;
      __syncthreads();
      const TrJob cj = jb;
      const int tn = t + gridDim.x;
      if (tn < 7040) {
        jb = tr_decode(p, tn);
        rg0 = ld4nt(jb.src + (size_t)(jb.kt * 64 + lk) * jb.ldw + jb.nt * 64 + ln);
        rg1 = ld4nt(jb.src + (size_t)(jb.kt * 64 + lk + 32) * jb.ldw + jb.nt * 64 + ln);
      }
      {
        const int n = cj.nt * 64 + sn; int dr;
        if (cj.mode == 1) { int isb = n >= 2816; int f = n - isb * 2816; dr = (f >> 4) * 32 + isb * 16 + (f & 15); } else dr = cj.drow0 + n;
        unsigned w[4];
#pragma unroll
        for (int e = 0; e < 4; ++e) w[e] = (unsigned)f2bf(sf[(sk + 2 * e) * 65 + sn]) | ((unsigned)f2bf(sf[(sk + 2 * e + 1) * 65 + sn]) << 16);
        *(uint4*)(cj.dst + (size_t)dr * cj.K + cj.kt * 64 + sk) = uint4{w[0], w[1], w[2], w[3]};
      }
      __syncthreads();
    }
  }
  { bfraw* d = (bfraw*)(p.ws + O_WSB); for (int id = blockIdx.x * NTHR + tid; id < 65536; id += gridDim.x * NTHR) d[id] = f2bf(p.in[I_WS][id]); }
}

DEVI void phase_p0b(const P& p) {
  const float* mp = (const float*)(p.ws + O_MODSP);
  float* m = (float*)(p.ws + O_MODS);
  for (int id = blockIdx.x * NTHR + ltid(); id < 3 * 9216; id += gridDim.x * NTHR) {
    int j = id % 9216;
    float a = p.in[I_BADA][j];
    for (int s = 0; s < 16; ++s) a += mp[s * 3 * 9216 + id];
    m[id] = a;
  }
}

template <int MODE>
DEVI void phase_rows(const P& p, unsigned char* lds, int row_lo = 0, int row_hi = -1, int vb = -1, int nvb = -1) {
  const int tid = ltid(), lane = tid & 63, wid = tid >> 6;
  const float* mods = (const float*)(p.ws + O_MODS);
  float* hctx = (float*)(p.ws + O_HCTX);
  bfraw* hn = (bfraw*)(p.ws + O_HN);
  float* wg = (float*)lds;
  if (MODE == 2) {
    __syncthreads();
    for (int i = tid; i < 16384; i += NTHR) { int k = i >> 4, g = i & 15; wg[g * 1024 + k] = p.in[I_WIN][(size_t)k * 8208 + 3072 + g]; }
    __syncthreads();
  }
  const int nrows = row_hi >= 0 ? row_hi : ((MODE == 1 || MODE == 2) ? 16896 : 16384);
  if (vb < 0) { vb = (int)blockIdx.x; nvb = (int)gridDim.x; }
  const float* gvec = p.in[MODE == 1 ? I_GFFN1 : MODE == 2 ? I_GMIX : MODE == 3 ? I_GFFN2 : I_GFINAL];
  const int msh = MODE == 1 ? 0 : MODE == 2 ? 3 : 6;
  for (int row = row_lo + vb * 8 + wid; row < nrows; row += nvb * 8) {
    const bool lat = row < 16384;
    const int mrow = lat ? (row >> 13) : 2;
    float4 v[4];
    if (MODE == 1) {
      const float* src = lat ? p.in[I_X] + (size_t)row * 1024 : p.in[I_CTX] + (size_t)(row - 16384) * 1024;
#pragma unroll
      for (int i = 0; i < 4; ++i) { const nt_f4 t_ = __builtin_nontemporal_load((const nt_f4*)(src + i * 256 + lane * 4)); v[i] = float4{t_.x, t_.y, t_.z, t_.w}; }
      if (lat) {
        int ts = row & 8191; float rr = (float)(ts >> 6), cc = (float)(ts & 63);
        float fqv[4];
#pragma unroll
        for (int e = 0; e < 4; ++e) fqv[e] = expf((-9.210340371976184f * (float)(lane * 4 + e)) / 256.f);
        v[0].x += redsin(rr * fqv[0], false); v[0].y += redsin(rr * fqv[1], false); v[0].z += redsin(rr * fqv[2], false); v[0].w += redsin(rr * fqv[3], false);
        v[1].x += redsin(rr * fqv[0], true);  v[1].y += redsin(rr * fqv[1], true);  v[1].z += redsin(rr * fqv[2], true);  v[1].w += redsin(rr * fqv[3], true);
        v[2].x += redsin(cc * fqv[0], false); v[2].y += redsin(cc * fqv[1], false); v[2].z += redsin(cc * fqv[2], false); v[2].w += redsin(cc * fqv[3], false);
        v[3].x += redsin(cc * fqv[0], true);  v[3].y += redsin(cc * fqv[1], true);  v[3].z += redsin(cc * fqv[2], true);  v[3].w += redsin(cc * fqv[3], true);
      }
      float* dsth = lat ? p.out + (size_t)row * 1024 : hctx + (size_t)(row - 16384) * 1024;
#pragma unroll
      for (int i = 0; i < 4; ++i) *(float4*)(dsth + i * 256 + lane * 4) = v[i];
    } else {
      const float* src = lat ? p.out + (size_t)row * 1024 : hctx + (size_t)(row - 16384) * 1024;
#pragma unroll
      for (int i = 0; i < 4; ++i) v[i] = *(const float4*)(src + i * 256 + lane * 4);
    }
    float ss = 0;
#pragma unroll
    for (int i = 0; i < 4; ++i) ss += v[i].x * v[i].x + v[i].y * v[i].y + v[i].z * v[i].z + v[i].w * v[i].w;
    ss = wave_sum(ss);
    const float rs = rsqrtf(ss * (1.f / 1024.f) + EPS);
    if (MODE == 4) {
#pragma unroll
      for (int i = 0; i < 4; ++i) {
        float4 g = *(const float4*)(gvec + i * 256 + lane * 4);
        float4 o = {v[i].x * rs * g.x, v[i].y * rs * g.y, v[i].z * rs * g.z, v[i].w * rs * g.w};
        __builtin_nontemporal_store(nt_f4{o.x, o.y, o.z, o.w}, (nt_f4*)(p.out + (size_t)row * 1024 + i * 256 + lane * 4));
      }
    } else {
      const float* sh = mods + (size_t)(mrow * 9216 + msh * 1024);
      const float* scp = sh + 1024;
      float y[16];
#pragma unroll
      for (int i = 0; i < 4; ++i) {
        const int c = i * 256 + lane * 4;
        float4 g = *(const float4*)(gvec + c), s4 = *(const float4*)(sh + c), c4 = *(const float4*)(scp + c);
        y[i * 4 + 0] = v[i].x * rs * g.x * (1.f + c4.x) + s4.x; y[i * 4 + 1] = v[i].y * rs * g.y * (1.f + c4.y) + s4.y;
        y[i * 4 + 2] = v[i].z * rs * g.z * (1.f + c4.z) + s4.z; y[i * 4 + 3] = v[i].w * rs * g.w * (1.f + c4.w) + s4.w;
        uint2 pk; pk.x = (unsigned)f2bf(y[i * 4]) | ((unsigned)f2bf(y[i * 4 + 1]) << 16); pk.y = (unsigned)f2bf(y[i * 4 + 2]) | ((unsigned)f2bf(y[i * 4 + 3]) << 16);
        *(uint2*)(hn + (size_t)row * 1024 + c) = pk;
      }
      if (MODE == 2) {
        float ga[16];
#pragma unroll
        for (int g2 = 0; g2 < 16; ++g2) {
          float a = 0.f;
#pragma unroll
          for (int i = 0; i < 4; ++i) { float4 w4 = *(const float4*)(wg + g2 * 1024 + i * 256 + lane * 4); a += y[i * 4] * w4.x + y[i * 4 + 1] * w4.y + y[i * 4 + 2] * w4.z + y[i * 4 + 3] * w4.w; }
          ga[g2] = a;
          if ((g2 & 3) == 3) asm volatile("" ::: "memory");
        }
        const bool b5 = lane & 32, b4 = lane & 16, b3 = lane & 8, b2 = lane & 4;
        float r8[8], r4[4], r2[2];
#pragma unroll
        for (int g = 0; g < 8; ++g) { const float snd = b5 ? ga[g] : ga[g + 8], kp = b5 ? ga[g + 8] : ga[g]; r8[g] = kp + __shfl_xor(snd, 32, 64); }
#pragma unroll
        for (int g = 0; g < 4; ++g) { const float snd = b4 ? r8[g] : r8[g + 4], kp = b4 ? r8[g + 4] : r8[g]; r4[g] = kp + __shfl_xor(snd, 16, 64); }
#pragma unroll
        for (int g = 0; g < 2; ++g) { const float snd = b3 ? r4[g] : r4[g + 2], kp = b3 ? r4[g + 2] : r4[g]; r2[g] = kp + __shfl_xor(snd, 8, 64); }
        float r1 = (b2 ? r2[1] : r2[0]) + __shfl_xor(b2 ? r2[0] : r2[1], 4, 64);
        r1 += __shfl_xor(r1, 2, 64); r1 += __shfl_xor(r1, 1, 64);
        const int gi = (b5 ? 8 : 0) + (b4 ? 4 : 0) + (b3 ? 2 : 0) + (b2 ? 1 : 0);
        if ((lane & 3) == 0) ((float*)(p.ws + O_GATES))[(size_t)row * 16 + gi] = r1;
      }
    }
  }
}

DEVI void phase_ffn_in(const P& p, unsigned char* lds, size_t o_w, int nrows) {
  EpiFfnIn E{(bfraw*)(p.ws + O_ACT)};
  run8(lds, (const bfraw*)(p.ws + O_HN), (const bfraw*)(p.ws + o_w), nrows, 5632, 1024, E);
}

DEVI void phase_ffn_out(const P& p, unsigned char* lds, size_t o_w, int gidx, bool with_ctx) {
  EpiResid E{p.out, (const float*)(p.ws + O_MODS), 0, gidx, 0.5f, -1};
  run8(lds, (const bfraw*)(p.ws + O_ACT), (const bfraw*)(p.ws + o_w), 16384, 1024, 2816, E);
  (void)with_ctx;
}

DEVI void phase_r2_g2c(const P& p, unsigned char* lds) {
  const int G = (int)gridDim.x, nc = G >= 48 ? 24 : 0;
  if (nc == 0) {
    EpiResid E{(float*)(p.ws + O_HCTX), (const float*)(p.ws + O_MODS), 0, 2, 0.5f, 2};
    run8(lds, (const bfraw*)(p.ws + O_ACT) + (size_t)16384 * 2816, (const bfraw*)(p.ws + O_W1OUT), 512, 1024, 2816, E);
    __syncthreads();
  } else if ((int)blockIdx.x < nc) {
    const int sl = (int)blockIdx.x >> 3, k0 = sl * 1024, kl = sl == 2 ? 768 : 1024;
    EpiResidAtomic E{(float*)(p.ws + O_HCTX), (const float*)(p.ws + O_MODS), 0, 2, 0.5f, 2};
    run8(lds, (const bfraw*)(p.ws + O_ACT) + (size_t)16384 * 2816 + k0, (const bfraw*)(p.ws + O_W1OUT) + k0, 512, 1024, kl, E, 8, (int)blockIdx.x & 7, 2816);
    return;
  }
  phase_rows<2>(p, lds, 0, 16384, (int)blockIdx.x - nc, G - nc);
}

DEVI void phase_g3c(const P& p, unsigned char* lds) {
  EpiMix<0> E{(bfraw*)(p.ws + O_CTXRAW), nullptr, nullptr, nullptr};
  run8(lds, (const bfraw*)(p.ws + O_HN) + (size_t)16384 * 1024, (const bfraw*)(p.ws + O_WTA), 512, 3072, 1024, E);
}

DEVI void phase_g3a(const P& p, unsigned char* lds, int hb) {
  EpiMix<1> E{(bfraw*)(p.ws + O_QRAW), (bfraw*)(p.ws + O_KRAW), (bfraw*)(p.ws + O_V), (bfraw*)(p.ws + O_GVS)};
  run8(lds, (const bfraw*)(p.ws + O_HN) + (size_t)hb * 8192 * 1024, (const bfraw*)(p.ws + O_WTA), 8192, 4096, 1024, E);
}

DEVI void phase_g3b(const P& p, unsigned char* lds, int hb) {
  EpiMix<2> E{(bfraw*)(p.ws + O_V), (bfraw*)(p.ws + O_GVS), (bfraw*)(p.ws + O_QC), (bfraw*)(p.ws + O_KC)};
  run8(lds, (const bfraw*)(p.ws + O_HN) + (size_t)hb * 8192 * 1024, (const bfraw*)(p.ws + O_WTB), 8192, 4096, 1024, E);
}

DEVI void phase_g4(const P& p, unsigned char* lds) {
  const int Gh = (int)gridDim.x >> 1, grp = (int)blockIdx.x / Gh, c = (int)blockIdx.x % Gh;
  if (grp == 0) { EpiMix<3> E{(bfraw*)(p.ws + O_QC), nullptr, nullptr, nullptr}; run8(lds, (const bfraw*)(p.ws + O_V), (const bfraw*)(p.ws + O_WA), 8192, 1024, 1024, E, Gh, c); }
  else if (grp == 1) { EpiMix<3> E{(bfraw*)(p.ws + O_KC), nullptr, nullptr, nullptr}; run8(lds, (const bfraw*)(p.ws + O_GVS), (const bfraw*)(p.ws + O_WB), 8192, 1024, 1024, E, Gh, c); }
}

DEVI void phase_addmix(const P& p, int hb) {
  const uint4* t1 = (const uint4*)(p.ws + O_QC);
  const uint4* t2 = (const uint4*)(p.ws + O_KC);
  uint4* dst = (uint4*)(p.ws + (hb == 0 ? O_W1IN : O_QC));
  const int tid = ltid();
  for (int i = blockIdx.x * NTHR + tid; i < 8192 * 128; i += gridDim.x * NTHR) {
    const uint4 a = ldu4nt(t1 + i), b = ldu4nt(t2 + i);
    const unsigned aw[4] = {a.x, a.y, a.z, a.w}, bw[4] = {b.x, b.y, b.z, b.w}; unsigned o[4];
#pragma unroll
    for (int e = 0; e < 4; ++e) o[e] = (unsigned)f2bf(bf2f((bfraw)(aw[e] & 0xffff)) + bf2f((bfraw)(bw[e] & 0xffff))) | ((unsigned)f2bf(bf2f((bfraw)(aw[e] >> 16)) + bf2f((bfraw)(bw[e] >> 16))) << 16);
    dst[i] = uint4{o[0], o[1], o[2], o[3]};
  }
}

DEVI void phase_g5(const P& p, unsigned char* lds) {
  const int Gh = (int)gridDim.x >> 1, grp = (int)blockIdx.x / Gh, c = (int)blockIdx.x % Gh;
  EpiResid E{p.out, (const float*)(p.ws + O_MODS), grp * 8192, 5, 1.f, -1};
  if (grp < 2) run8(lds, (const bfraw*)(p.ws + (grp == 0 ? O_W1IN : O_QC)), (const bfraw*)(p.ws + O_WO), 8192, 1024, 1024, E, Gh, c);
}

DEVI void phase_cv(const P& p, int hb) {
  const int tid = ltid(), lane = tid & 63, wid = tid >> 6;
  const bfraw* qraw = (const bfraw*)(p.ws + O_QRAW);
  const bfraw* kraw = (const bfraw*)(p.ws + O_KRAW);
  const bfraw* craw = (const bfraw*)(p.ws + O_CTXRAW) + (size_t)hb * 256 * 3072;
  bfraw* qc = (bfraw*)(p.ws + O_QC);
  bfraw* kc = (bfraw*)(p.ws + O_KC);
  bfraw* vv = (bfraw*)(p.ws + O_V);
  const bfraw* gvs = (const bfraw*)(p.ws + O_GVS);
  float* rsb = (float*)(p.ws + O_RS);
  const float* cw = p.in[I_CONVW];
  const float* cb = p.in[I_CONVB];
  for (int task = blockIdx.x * 8 + wid; task < 1056 * 4; task += gridDim.x * 8) {
    const int sidx = task >> 2, part = task & 3, isk = part >> 1;
    const bool lat = sidx < 1024;
    const int lr0 = (lat ? sidx : sidx - 1024) * 8, len = lat ? 8192 : 256, orow0 = sidx * 8;
    const bfraw* src = lat ? (isk ? kraw : qraw) : (craw + isk * 1024);
    const size_t ld = lat ? 1024 : 3072;
    const int ch = (part & 1) * 512 + lane * 8, wch = isk * 1024 + ch;
    float w0[8], w1[8], w2[8], bb[8];
#pragma unroll
    for (int e = 0; e < 8; e += 4) {
      float4 a = ld4(cw + wch + e), b = ld4(cw + 2048 + wch + e), c4 = ld4(cw + 4096 + wch + e), d = ld4(cb + wch + e);
      w0[e] = a.x; w0[e + 1] = a.y; w0[e + 2] = a.z; w0[e + 3] = a.w; w1[e] = b.x; w1[e + 1] = b.y; w1[e + 2] = b.z; w1[e + 3] = b.w;
      w2[e] = c4.x; w2[e + 1] = c4.y; w2[e + 2] = c4.z; w2[e + 3] = c4.w; bb[e] = d.x; bb[e + 1] = d.y; bb[e + 2] = d.z; bb[e + 3] = d.w;
    }
    uint4 rw[10];
#pragma unroll
    for (int i = 0; i < 10; ++i) { const int lr = lr0 - 1 + i; uint4 t = {0u, 0u, 0u, 0u}; if (lr >= 0 && lr < len) t = *(const uint4*)(src + (size_t)lr * ld + ch); rw[i] = t; }
    const float osc = isk ? 1.f : 0.0625f;
    bfraw* dst = (isk ? kc : qc) + (size_t)orow0 * 1024 + ch;
#pragma unroll
    for (int i = 0; i < 8; ++i) {
      const unsigned av[4] = {rw[i].x, rw[i].y, rw[i].z, rw[i].w}, bv[4] = {rw[i + 1].x, rw[i + 1].y, rw[i + 1].z, rw[i + 1].w}, cv[4] = {rw[i + 2].x, rw[i + 2].y, rw[i + 2].z, rw[i + 2].w};
      unsigned ov[4];
#pragma unroll
      for (int e = 0; e < 4; ++e) {
        const float y0 = bf2f((bfraw)(av[e] & 0xffff)) * w0[2 * e] + bf2f((bfraw)(bv[e] & 0xffff)) * w1[2 * e] + bf2f((bfraw)(cv[e] & 0xffff)) * w2[2 * e] + bb[2 * e];
        const float y1 = bf2f((bfraw)(av[e] >> 16)) * w0[2 * e + 1] + bf2f((bfraw)(bv[e] >> 16)) * w1[2 * e + 1] + bf2f((bfraw)(cv[e] >> 16)) * w2[2 * e + 1] + bb[2 * e + 1];
        ov[e] = (unsigned)f2bf(siluf_(y0) * osc) | ((unsigned)f2bf(siluf_(y1) * osc) << 16);
      }
      *(uint4*)(dst + (size_t)i * 1024) = uint4{ov[0], ov[1], ov[2], ov[3]};
    }
  }
  for (int row = blockIdx.x * 8 + wid; row < 8448; row += gridDim.x * 8) {
    if (row < 8192) {
      float ss = 0;
#pragma unroll
      for (int hlf = 0; hlf < 2; ++hlf) {
        uint4 g = *(const uint4*)(gvs + (size_t)row * 1024 + hlf * 512 + lane * 8);
        unsigned gv[4] = {g.x, g.y, g.z, g.w};
#pragma unroll
        for (int e = 0; e < 4; ++e) { float a = bf2f((bfraw)(gv[e] & 0xffff)), b = bf2f((bfraw)(gv[e] >> 16)); ss += a * a + b * b; }
      }
      ss = wave_sum(ss);
      if (lane == 0) rsb[row] = rsqrtf(ss * (1.f / 1024.f) + EPS);
    } else {
#pragma unroll
      for (int hlf = 0; hlf < 2; ++hlf)
        *(uint4*)(vv + (size_t)row * 1024 + hlf * 512 + lane * 8) = *(const uint4*)(craw + 2048 + (size_t)(row - 8192) * 3072 + hlf * 512 + lane * 8);
    }
  }
}

DEVI void phase_ma(const P& p, unsigned char* lds, int hb) {
  const int tid = ltid();
  bfraw* st = (bfraw*)lds;
  float* sc = (float*)(lds + 131072);
  float* s_w = sc + 128, *s_ws = sc + 256, *s_red = sc + 384, *s_part = sc + 512;
  const float* bg = p.in[I_BGATES];
  for (int item = blockIdx.x; item < 528 + 256; item += gridDim.x) {
    unsigned char* wsb = lws(p.ws);
    const float* gates = (const float*)(wsb + O_GATES);
    const bfraw* kc = (const bfraw*)(wsb + O_KC);
    const bfraw* vv = (const bfraw*)(wsb + O_V);
    bfraw* states = (bfraw*)(wsb + O_ST);
    float* nloc = (float*)(wsb + O_NLOC);
    float* mg = (float*)(wsb + O_MG);
    if (item < 528) {
      const int seq = item / 66, j = item % 66, d = seq >> 2, h = seq & 3;
      int rbase, grow;
      if (j < 2) { int cc = d == 0 ? j : 1 - j; rbase = 8192 + cc * 128; grow = 16384 + hb * 256 + cc * 128; }
      else { int c = d == 0 ? j - 2 : 65 - j; rbase = c * 128; grow = hb * 8192 + c * 128; }
      __syncthreads();
      const int el = d == 0 ? (tid & 127) : 127 - (tid & 127);
      float li = 0.f, lf = 0.f;
      if (tid < 128) {
        li = gates[(size_t)(grow + el) * 16 + d * 8 + h] + bg[d * 8 + h];
        lf = logsigf_(gates[(size_t)(grow + el) * 16 + d * 8 + 4 + h] + bg[d * 8 + 4 + h]);
      }
      const float bcum = seg_scan_sum(lf, tid, s_red + 4);
      if (tid == 127) s_red[1] = bcum;
      __syncthreads();
      const float gtot = s_red[1];
      const float wv = gtot - bcum + li;
      if (tid < 128) s_w[el] = wv;
      __syncthreads();
      if (tid < 64) {
        float m = fmaxf(s_w[tid], s_w[tid + 64]);
#pragma unroll
        for (int o = 32; o > 0; o >>= 1) m = fmaxf(m, __shfl_xor(m, o, 64));
        if (tid == 0) s_red[0] = m;
      }
      __syncthreads();
      const float mloc = s_red[0];
      if (tid < 128) s_ws[el] = expf(wv - mloc);
      if (tid == 0) { mg[seq * 66 + j] = mloc; mg[528 + seq * 66 + j] = gtot; }
      __syncthreads();
      {
        const int k = tid & 255, part = tid >> 8;
        const bfraw* kp0 = kc + (size_t)(rbase + part * 64) * 1024 + h * 256 + k;
        float n = 0;
#pragma unroll 16
        for (int t = 0; t < 64; ++t) n += s_ws[part * 64 + t] * bf2f(kp0[(size_t)t * 1024]);
        s_part[tid] = n;
      }
      bfraw* dst = states + (size_t)(seq * 66 + j) * 65536;
      {
        f32x4 acc[8][4]; ZERO_ACC(acc, 8, 4);
        gemm_tile<256, 256, true, true, false>(vv + (size_t)rbase * 1024 + h * 256, 1024, kc + (size_t)rbase * 1024 + h * 256, 1024, 128, s_ws, acc, st, nullptr, 0);
        EPI_BEGIN(256, 256)
          dst[row * 256 + col] = f2bf(acc[i][j][r]);
        EPI_END
      }
      if (tid < 256) nloc[(size_t)(seq * 66 + j) * 256 + tid] = s_part[tid] + s_part[tid + 256];
    } else {
      const int it = item - 528, c = it >> 2, g = it & 3;
      bfraw* gvs = (bfraw*)(wsb + O_GVS);
      const float* rsb = (const float*)(wsb + O_RS);
      f32x4 acc[4][4]; ZERO_ACC(acc, 4, 4);
      gemm_tile<128, 256, false, true, false>((const bfraw*)(wsb + O_WSB) + g * 16384, 128, gvs + (size_t)c * 128 * 1024 + g * 256, 1024, 128, rsb + c * 128, acc, st, nullptr, 0);
      const float* gs = p.in[I_GSGU] + g * 256;
      const float* bs = p.in[I_BS] + g * 128;
      EPI_BEGIN(128, 256)
        gvs[(size_t)(c * 128 + row) * 1024 + g * 256 + col] = f2bf(gs[col] * acc[i][j][r] + bs[row]);
      EPI_END
    }
  }
}

DEVI void phase_mb(const P& p, unsigned char* lds) {
  bfraw* states = (bfraw*)(p.ws + O_ST);
  const float* mg = (const float*)(p.ws + O_MG);
  float* ment = (float*)(p.ws + O_MG) + 1056;
  const float* nloc = (const float*)(p.ws + O_NLOC);
  float* nent = (float*)(p.ws + O_NENT);
  const int gid = blockIdx.x * NTHR + ltid(), gsz = gridDim.x * NTHR;
  float* s_dec = (float*)lds, *s_scl = s_dec + 528;
  __syncthreads();
  if (ltid() < 8) {
    const int seq = ltid(); float m = 0;
    for (int j = 0; j < 66; ++j) {
      const float mloc = mg[seq * 66 + j], g = mg[528 + seq * 66 + j];
      const float mnew = fmaxf(g + m, mloc);
      s_dec[seq * 66 + j] = expf(g + m - mnew); s_scl[seq * 66 + j] = expf(mloc - mnew);
      if (blockIdx.x == 0) ment[seq * 66 + j] = m;
      m = mnew;
    }
  }
  __syncthreads();
  for (int id = gid; id < 8 * 16384; id += gsz) {
    const int seq = id >> 14, e = (id & 16383) * 4;
    float s0 = 0, s1 = 0, s2 = 0, s3 = 0;
    bfraw* base = states + (size_t)seq * 66 * 65536 + e;
#pragma unroll 1
    for (int cb = 0; cb < 66; cb += 22) {
      uint2 buf[22];
#pragma unroll
      for (int i = 0; i < 22; ++i) { const nt_u2 t_ = __builtin_nontemporal_load((const nt_u2*)(base + (size_t)(cb + i) * 65536)); buf[i] = uint2{t_.x, t_.y}; }
#pragma unroll
      for (int i = 0; i < 22; ++i) {
        const int j = cb + i; const uint2 cur = buf[i];
        const float dec = s_dec[seq * 66 + j], scl = s_scl[seq * 66 + j];
        if (j >= 2) { uint2 o; o.x = (unsigned)f2bf(s0) | ((unsigned)f2bf(s1) << 16); o.y = (unsigned)f2bf(s2) | ((unsigned)f2bf(s3) << 16);
          __builtin_nontemporal_store(nt_u2{o.x, o.y}, (nt_u2*)(base + (size_t)j * 65536)); }
        s0 = dec * s0 + scl * bf2f((bfraw)(cur.x & 0xffff)); s1 = dec * s1 + scl * bf2f((bfraw)(cur.x >> 16));
        s2 = dec * s2 + scl * bf2f((bfraw)(cur.y & 0xffff)); s3 = dec * s3 + scl * bf2f((bfraw)(cur.y >> 16));
      }
    }
  }
  for (int id = gid; id < 8 * 256; id += gsz) {
    const int seq = id >> 8, k = id & 255;
    float n = 0;
    for (int j = 0; j < 66; ++j) {
      nent[(size_t)(seq * 66 + j) * 256 + k] = n;
      n = s_dec[seq * 66 + j] * n + s_scl[seq * 66 + j] * nloc[(size_t)(seq * 66 + j) * 256 + k];
    }
  }
}

DEVI void phase_mc(const P& p, unsigned char* lds, int hb) {
  const int tid = ltid(), lane = tid & 63, wid = tid >> 6, wm = wid >> 2, wn = wid & 3, fr = lane & 15, fq = lane >> 4;
  bfraw* st = (bfraw*)lds;
  bfraw* sS = (bfraw*)(lds + 61440);
  float* sc = (float*)(lds + 131072);
  float* s_b = sc, *s_u = sc + 256, *s_mt = sc + 512, *s_in = sc + 768, *s_den = sc + 1024, *s_dq = sc + 1280, *s_tmp = sc + 1536;
  float* s_sum = sc + 1792, *s_sq = sc + 1920;
  const float* bg = p.in[I_BGATES];
  for (int item = blockIdx.x; item < 256; item += gridDim.x) {
    unsigned char* wsb = lws(p.ws);
    const float* gates = (const float*)(wsb + O_GATES);
    const bfraw* qc = (const bfraw*)(wsb + O_QC);
    const bfraw* kc = (const bfraw*)(wsb + O_KC);
    bfraw* vv = (bfraw*)(wsb + O_V);
    const bfraw* states = (const bfraw*)(wsb + O_ST);
    const float* ment = (const float*)(wsb + O_MG) + 1056;
    const float* nent = (const float*)(wsb + O_NENT);
    const int c = item >> 2, h = item & 3, R0 = c * 128;
    const bfraw* qp = qc + (size_t)R0 * 1024 + h * 256;
    const bfraw* kp = kc + (size_t)R0 * 1024 + h * 256;
    __syncthreads();
    {
      const int d = (tid >> 7) & 1, t = tid & 127, el = d == 0 ? t : 127 - t, ix = d * 128 + el;
      float li = 0.f, lf = 0.f;
      if (tid < 256) {
        const size_t grow = (size_t)hb * 8192 + R0 + el;
        li = gates[grow * 16 + d * 8 + h] + bg[d * 8 + h];
        lf = logsigf_(gates[grow * 16 + d * 8 + 4 + h] + bg[d * 8 + 4 + h]);
        s_den[tid] = 0.f;
        if (tid < 128) { s_sum[tid] = 0.f; s_sq[tid] = 0.f; }
      }
      const float b = seg_scan_sum(lf, tid, s_tmp);
      const float uu = li - b;
      const float pm = seg_scan_max(tid < 256 ? uu : -INFINITY, tid, s_tmp);
      if (tid < 256) {
        const int seq = d * 4 + h, j = d == 0 ? c + 2 : 65 - c;
        const float mst = ment[seq * 66 + j];
        const float a = b + mst;
        const float mt = fmaxf(a, b + pm);
        s_b[ix] = b; s_u[ix] = uu; s_mt[ix] = mt; s_in[ix] = expf(a - mt);
      }
    }
    {
      const int row = tid >> 2, part = tid & 3;
      const uint4* q4 = (const uint4*)(qp + (size_t)row * 1024 + part * 64);
      const float4* nf4 = (const float4*)(nent + (size_t)((0 + h) * 66 + (c + 2)) * 256 + part * 64);
      const float4* nb4 = (const float4*)(nent + (size_t)((4 + h) * 66 + (65 - c)) * 256 + part * 64);
      uint4 qv[8];
#pragma unroll
      for (int i = 0; i < 8; ++i) qv[i] = q4[i];
      float af = 0, ab = 0;
#pragma unroll
      for (int i = 0; i < 8; ++i) {
        const float4 f0 = nf4[2 * i], f1 = nf4[2 * i + 1], b0 = nb4[2 * i], b1 = nb4[2 * i + 1];
        const float q0 = bf2f((bfraw)(qv[i].x & 0xffff)), q1 = bf2f((bfraw)(qv[i].x >> 16)), q2 = bf2f((bfraw)(qv[i].y & 0xffff)), q3 = bf2f((bfraw)(qv[i].y >> 16));
        const float q4_ = bf2f((bfraw)(qv[i].z & 0xffff)), q5 = bf2f((bfraw)(qv[i].z >> 16)), q6 = bf2f((bfraw)(qv[i].w & 0xffff)), q7 = bf2f((bfraw)(qv[i].w >> 16));
        af += q0 * f0.x + q1 * f0.y + q2 * f0.z + q3 * f0.w + q4_ * f1.x + q5 * f1.y + q6 * f1.z + q7 * f1.w;
        ab += q0 * b0.x + q1 * b0.y + q2 * b0.z + q3 * b0.w + q4_ * b1.x + q5 * b1.y + q6 * b1.z + q7 * b1.w;
      }
      af += __shfl_xor(af, 1, 64); af += __shfl_xor(af, 2, 64);
      ab += __shfl_xor(ab, 1, 64); ab += __shfl_xor(ab, 2, 64);
      if (part == 0) { s_dq[row] = af; s_dq[128 + row] = ab; }
    }
    __syncthreads();
    {
      f32x4 S[4][2]; ZERO_ACC(S, 4, 2);
      gemm_tile<128, 128, false, false, false>(qp, 1024, kp, 1024, 256, nullptr, S, st, nullptr, 0);
#pragma unroll 1
      for (int d = 0; d < 2; ++d)
#pragma unroll
        for (int i = 0; i < 4; ++i)
#pragma unroll
          for (int r = 0; r < 4; ++r) {
            const int row = wm * 64 + i * 16 + fq * 4 + r;
            const float bt = s_b[d * 128 + row] - s_mt[d * 128 + row];
            float rs = 0;
#pragma unroll
            for (int j = 0; j < 2; ++j) {
              const int col = wn * 32 + j * 16 + fr;
              const bool valid = d == 0 ? (col <= row) : (col >= row);
              const float val = valid ? S[i][j][r] * fexp(bt + s_u[d * 128 + col]) : 0.f;
              rs += val;
              sS[(d * 128 + row) * 136 + col] = f2bf(val);
            }
            rs = red16(rs);
            if (fr == 0) atomicAdd(&s_den[d * 128 + row], rs);
          }
    }
    __syncthreads();
    f32x4 hs[4][4];
    uint4* hpark = (uint4*)(wsb + O_HPARK) + ((size_t)item * NTHR + tid) * 8;
#pragma unroll 1
    for (int d = 0; d < 2; ++d) {
      f32x4 (&acc)[4][4] = hs; ZERO_ACC(acc, 4, 4);
      const int seq = d * 4 + h, j2 = d == 0 ? c + 2 : 65 - c;
      gemm_tile<128, 256, false, false, false>(qp, 1024, states + (size_t)(seq * 66 + j2) * 65536, 256, 256, nullptr, acc, st, nullptr, 0);
      EPIR_BEGIN(128, 256)
        const float sin_ = s_in[d * 128 + row];
        EPIR_COLS(256) acc[i][j][r] *= sin_; (void)col;
      EPIR_END
      gemm_tile<128, 256, false, true, true>(nullptr, 0, vv + (size_t)R0 * 1024 + h * 256, 1024, 128, nullptr, acc, st, sS + d * 128 * 136, 136);
      EPIR_BEGIN(128, 256)
        const float den = s_den[d * 128 + row] + s_in[d * 128 + row] * s_dq[d * 128 + row];
        const float inv = 1.f / fmaxf(fabsf(den), expf(-s_mt[d * 128 + row]));
        EPIR_COLS(256) acc[i][j][r] *= inv; (void)col;
      EPIR_END
      if (d == 0) {
#pragma unroll
        for (int i = 0; i < 4; ++i) {
          uint4 w0, w1;
          w0.x = (unsigned)f2bf(acc[i][0][0]) | ((unsigned)f2bf(acc[i][0][1]) << 16); w0.y = (unsigned)f2bf(acc[i][0][2]) | ((unsigned)f2bf(acc[i][0][3]) << 16);
          w0.z = (unsigned)f2bf(acc[i][1][0]) | ((unsigned)f2bf(acc[i][1][1]) << 16); w0.w = (unsigned)f2bf(acc[i][1][2]) | ((unsigned)f2bf(acc[i][1][3]) << 16);
          w1.x = (unsigned)f2bf(acc[i][2][0]) | ((unsigned)f2bf(acc[i][2][1]) << 16); w1.y = (unsigned)f2bf(acc[i][2][2]) | ((unsigned)f2bf(acc[i][2][3]) << 16);
          w1.z = (unsigned)f2bf(acc[i][3][0]) | ((unsigned)f2bf(acc[i][3][1]) << 16); w1.w = (unsigned)f2bf(acc[i][3][2]) | ((unsigned)f2bf(acc[i][3][3]) << 16);
          hpark[2 * i] = w0; hpark[2 * i + 1] = w1;
        }
      } else {
#pragma unroll
        for (int i = 0; i < 4; ++i) {
          const uint4 w0 = hpark[2 * i], w1 = hpark[2 * i + 1];
          const unsigned ww[8] = {w0.x, w0.y, w0.z, w0.w, w1.x, w1.y, w1.z, w1.w};
#pragma unroll
          for (int j = 0; j < 4; ++j) {
            hs[i][j][0] += bf2f((bfraw)(ww[2 * j] & 0xffff)); hs[i][j][1] += bf2f((bfraw)(ww[2 * j] >> 16));
            hs[i][j][2] += bf2f((bfraw)(ww[2 * j + 1] & 0xffff)); hs[i][j][3] += bf2f((bfraw)(ww[2 * j + 1] >> 16));
          }
        }
      }
    }
#pragma unroll
    for (int i = 0; i < 4; ++i)
#pragma unroll
      for (int r = 0; r < 4; ++r) {
        float ps = hs[i][0][r] + hs[i][1][r] + hs[i][2][r] + hs[i][3][r];
        ps = red16(ps);
        if (fr == 0) atomicAdd(&s_sum[wm * 64 + i * 16 + fq * 4 + r], ps);
      }
    __syncthreads();
#pragma unroll
    for (int i = 0; i < 4; ++i)
#pragma unroll
      for (int r = 0; r < 4; ++r) {
        const float mu = s_sum[wm * 64 + i * 16 + fq * 4 + r] * (1.f / 256.f);
        float ps = 0;
#pragma unroll
        for (int j = 0; j < 4; ++j) { float dlt = hs[i][j][r] - mu; ps += dlt * dlt; }
        ps = red16(ps);
        if (fr == 0) atomicAdd(&s_sq[wm * 64 + i * 16 + fq * 4 + r], ps);
      }
    __syncthreads();
    const float* gh = p.in[I_GHEAD] + h * 256;
    EPIR_BEGIN(128, 256)
      const float mu = s_sum[row] * (1.f / 256.f);
      const float rstd = rsqrtf(s_sq[row] * (1.f / 256.f) + EPS);
      EPIR_COLS(256)
        vv[(size_t)(R0 + row) * 1024 + h * 256 + col] = f2bf((hs[i][j][r] - mu) * rstd * gh[col]);
    EPIR_END
  }
}

constexpr int NPH = 28;
#define PHASE_PROGRAM \
  PHASE(0, phase_p0(p, lds)) \
  PHASE(1, phase_p0b(p)) \
  PHASE(2, phase_rows<1>(p, lds)) \
  PHASE(3, phase_ffn_in(p, lds, O_W1IN, 16896)) \
  PHASE(4, phase_ffn_out(p, lds, O_W1OUT, 2, true)) \
  PHASE(5, phase_r2_g2c(p, lds)) \
  PHASE(6, phase_rows<2>(p, lds, 16384, 16896)) \
  PHASE(7, phase_g3c(p, lds)) \
  PHASE(8, phase_g3a(p, lds, 0)) \
  PHASE(9, phase_cv(p, 0)) \
  PHASE(10, phase_ma(p, lds, 0)) \
  PHASE(11, phase_mb(p, lds)) \
  PHASE(12, phase_mc(p, lds, 0)) \
  PHASE(13, phase_g3b(p, lds, 0)) \
  PHASE(14, phase_g4(p, lds)) \
  PHASE(15, phase_addmix(p, 0); __syncthreads(); phase_g3a(p, lds, 1)) \
  PHASE(16, phase_cv(p, 1)) \
  PHASE(17, phase_ma(p, lds, 1)) \
  PHASE(18, phase_mb(p, lds)) \
  PHASE(19, phase_mc(p, lds, 1)) \
  PHASE(20, phase_g3b(p, lds, 1)) \
  PHASE(21, phase_g4(p, lds)) \
  PHASE(22, phase_addmix(p, 1)) \
  PHASE(23, phase_g5(p, lds)) \
  PHASE(24, phase_rows<3>(p, lds)) \
  PHASE(25, phase_ffn_in(p, lds, O_W2IN, 16384)) \
  PHASE(26, phase_ffn_out(p, lds, O_W2OUT, 8, false)) \
  PHASE(27, phase_rows<4>(p, lds))

#if !MULTI_LAUNCH
#ifndef USE_CG
#define USE_CG 0
#endif
#if USE_CG
#define PHASE(n, call) if (lo <= (n) && (n) < hi) { if ((n) > lo) { if ((n) == 1) grid.sync(); else xcd_barrier(xbar); } call; }
#else
#define PHASE(n, call) if (lo <= (n) && (n) < hi) { if ((n) > lo) xcd_barrier(xbar); call; }
#endif
__global__ void __launch_bounds__(512) mk(P p, int lo, int hi) {
  extern __shared__ __attribute__((aligned(16))) unsigned char lds[];
#if USE_CG
  cg::grid_group grid = cg::this_grid();
#endif
  volatile LAS unsigned* stw = (volatile LAS unsigned*)(lds + LDS_BYTES - 16);
  if (threadIdx.x == 0) { stw[0] = 0u; stw[1] = 0u; stw[2] = 0u; stw[3] = 0u; }
  __syncthreads();
  XcdBarrier xbar = xcd_barrier_post((unsigned*)(p.ws + O_BAR), stw);
  PHASE_PROGRAM
}
#undef PHASE
#else
#define PHASE(n, call) if constexpr (PH == (n)) { call; }
template <int PH>
__global__ void __launch_bounds__(512) mkp(P p) {
  extern __shared__ __attribute__((aligned(16))) unsigned char lds[];
  PHASE_PROGRAM
}
#undef PHASE
template <int PH> static void launch_all(const P& p, int grid, hipStream_t stream) {
  if constexpr (PH < NPH) {
    (void)hipFuncSetAttribute((const void*)mkp<PH>, hipFuncAttributeMaxDynamicSharedMemorySize, LDS_BYTES);
    hipLaunchKernelGGL(mkp<PH>, dim3(grid), dim3(NTHR), LDS_BYTES, stream, p);
    launch_all<PH + 1>(p, grid, stream);
  }
}
#endif

extern "C" void kernel_launch(void* const* d_in, const int* in_sizes, int n_in, void* d_out, int out_size, void* d_ws, size_t ws_size, hipStream_t stream) {
  static int grid_blocks = 0;
  if (!grid_blocks) {
    if (n_in != 25 || ws_size < O_END || ws_size < O_ACT + 16896ull * 2816 * 2) { fprintf(stderr, "kernel_launch: unexpected n_in %d / ws %zu\n", n_in, ws_size); grid_blocks = -1; return; }
    int dev = 0, cus = 0, per_cu = 0;
    (void)hipGetDevice(&dev);
    (void)hipDeviceGetAttribute(&cus, hipDeviceAttributeMultiprocessorCount, dev);
#if !MULTI_LAUNCH
    if (hipFuncSetAttribute((const void*)mk, hipFuncAttributeMaxDynamicSharedMemorySize, LDS_BYTES) != hipSuccess) { fprintf(stderr, "hipFuncSetAttribute failed\n"); grid_blocks = -1; return; }
    if (hipOccupancyMaxActiveBlocksPerMultiprocessor(&per_cu, (const void*)mk, NTHR, LDS_BYTES) != hipSuccess || per_cu < 1) { fprintf(stderr, "occupancy query failed (%d)\n", per_cu); grid_blocks = -1; return; }
#endif
    grid_blocks = cus * 1;
    fprintf(stderr, "kernel_launch: cus %d per_cu %d grid %d\n", cus, per_cu, grid_blocks);
  }
  if (grid_blocks < 0) return;
  P p{};
  for (int i = 0; i < 25; ++i) p.in[i] = (const float*)d_in[i];
  p.out = (float*)d_out; p.ws = (unsigned char*)d_ws;
#if MULTI_LAUNCH
  launch_all<0>(p, grid_blocks, stream);
#else
  int lo = 0, hi = NPH;
  if (hipMemsetAsync((unsigned char*)d_ws + O_BAR, 0, 16384, stream) != hipSuccess) { fprintf(stderr, "memset of barrier words failed\n"); return; }
  void* args[] = {&p, &lo, &hi};
#ifdef PROBE_K
  {
    hipLaunchKernelGGL(mk, dim3(grid_blocks), dim3(NTHR), LDS_BYTES, stream, p, 0, PROBE_K + 1);
    (void)hipMemsetAsync((unsigned char*)d_ws + O_BAR, 0, 16384, stream);
  }
#endif
#if USE_CG
  hipError_t e = hipLaunchCooperativeKernel((const void*)mk, dim3(grid_blocks), dim3(NTHR), args, LDS_BYTES, stream);
#else
  (void)args;
  hipLaunchKernelGGL(mk, dim3(grid_blocks), dim3(NTHR), LDS_BYTES, stream, p, lo, hi);
  hipError_t e = hipPeekAtLastError();
#endif
  if (e != hipSuccess) fprintf(stderr, "cooperative launch failed: %s (grid %d)\n", hipGetErrorString(e), grid_blocks);
#endif
}
```

```cpp
#include <hip/hip_runtime.h>
#include <hip/hip_cooperative_groups.h>
#include <cstdio>
#include <cstdint>
namespace cg = cooperative_groups;

#ifndef MULTI_LAUNCH
#define MULTI_LAUNCH 0
#endif

typedef unsigned short bfraw;
typedef __attribute__((ext_vector_type(8))) short bf16x8;
typedef __attribute__((ext_vector_type(4))) float f32x4;
#define DEVI __device__ __forceinline__

constexpr int NTHR = 512;
constexpr int GBM = 128;
constexpr int LROW = 40;
constexpr int LDS_BYTES = 143360;
constexpr float EPS = 1e-6f;

enum { I_X, I_C, I_CTX, I_CCTX, I_WADA, I_BADA, I_GFFN1, I_W1IN, I_W1OUT, I_GMIX, I_WIN, I_BGATES, I_CONVW, I_CONVB,
       I_GHEAD, I_GSGU, I_WS, I_BS, I_WA, I_WB, I_WO, I_GFFN2, I_W2IN, I_W2OUT, I_GFINAL };

struct P { const float* in[25]; float* out; unsigned char* ws; };

constexpr size_t O_W1IN  = 0;
constexpr size_t O_W1OUT = O_W1IN  + 5632ull * 1024 * 2;
constexpr size_t O_WTA   = O_W1OUT + 1024ull * 2816 * 2;
constexpr size_t O_WTB   = O_WTA   + 4096ull * 1024 * 2;
constexpr size_t O_WA    = O_WTB   + 4096ull * 1024 * 2;
constexpr size_t O_WB    = O_WA    + 1024ull * 1024 * 2;
constexpr size_t O_WO    = O_WB    + 1024ull * 1024 * 2;
constexpr size_t O_W2IN  = O_WO    + 1024ull * 1024 * 2;
constexpr size_t O_W2OUT = O_W2IN  + 5632ull * 1024 * 2;
constexpr size_t O_WSB   = O_W2OUT + 1024ull * 2816 * 2;
constexpr size_t O_MODSP = O_WSB   + 4ull * 128 * 128 * 2;
constexpr size_t O_MODS  = O_MODSP + 16ull * 3 * 9216 * 4;
constexpr size_t O_HCTX  = O_MODS  + 3ull * 9216 * 4;
constexpr size_t O_HN    = O_HCTX  + 512ull * 1024 * 4;
constexpr size_t O_GATES = O_HN    + 16896ull * 1024 * 2;
constexpr size_t O_CTXRAW= O_GATES + 16896ull * 16 * 4;
constexpr size_t O_BIG   = O_CTXRAW+ 2ull * 256 * 3072 * 2;
constexpr size_t O_ACT   = O_BIG;
constexpr size_t O_ST    = O_BIG;
constexpr size_t O_QRAW  = O_BIG;
constexpr size_t O_KRAW  = O_QRAW  + 8448ull * 1024 * 2;
constexpr size_t O_V     = O_ST    + 8ull * 66 * 131072;
constexpr size_t O_GVS   = O_V     + 8448ull * 1024 * 2;
constexpr size_t O_QC    = O_GVS   + 8192ull * 1024 * 2;
constexpr size_t O_KC    = O_QC    + 8448ull * 1024 * 2;
constexpr size_t O_NLOC  = O_KC    + 8448ull * 1024 * 2;
constexpr size_t O_NENT  = O_NLOC  + 8ull * 66 * 256 * 4;
constexpr size_t O_MG    = O_NENT  + 8ull * 66 * 256 * 4;
constexpr size_t O_RS    = O_MG    + 8192;
constexpr size_t O_HPARK = O_RS    + 8192ull * 4;
constexpr size_t O_BAR   = O_HPARK + 8192ull * 1024 * 2;
constexpr size_t O_END   = O_BAR + 16384;
static_assert(O_ACT + 16896ull * 2816 * 2 <= 268435456ull, "ws");
static_assert(O_END <= 268435456ull, "ws");
static_assert(O_KRAW + 8448ull * 1024 * 2 <= O_V, "overlay");

DEVI int ltid() { int t = __builtin_amdgcn_workitem_id_x(); asm volatile("" : "+v"(t)); return t; }
DEVI unsigned char* lws(unsigned char* w) { asm volatile("" : "+s"(w)); return w; }
DEVI float4 ld4(const float* p);
typedef float nt_f4 __attribute__((ext_vector_type(4)));
typedef unsigned nt_u2 __attribute__((ext_vector_type(2)));
typedef unsigned nt_u4 __attribute__((ext_vector_type(4)));
DEVI float4 ld4nt(const float* p) { const nt_f4 t = __builtin_nontemporal_load((const nt_f4*)p); return float4{t.x, t.y, t.z, t.w}; }
DEVI uint4 ldu4nt(const uint4* p) { const nt_u4 t = __builtin_nontemporal_load((const nt_u4*)p); return uint4{t.x, t.y, t.z, t.w}; }
DEVI bfraw f2bf(float f) { unsigned u = __float_as_uint(f); u += 0x7fffu + ((u >> 16) & 1u); return (bfraw)(u >> 16); }
DEVI float bf2f(bfraw h) { return __uint_as_float(((unsigned)h) << 16); }
DEVI float fexp(float x) { return __builtin_amdgcn_exp2f(x * 1.4426950408889634f); }
DEVI float sigmoidf_(float x) { return __builtin_amdgcn_rcpf(1.f + fexp(-x)); }
DEVI float siluf_(float x) { return x * sigmoidf_(x); }
DEVI float geluf_(float x) { return x * sigmoidf_(1.5957691216057308f * (x + 0.044715f * x * x * x)); }
DEVI float logsigf_(float x) { return fminf(x, 0.f) - log1pf(expf(-fabsf(x))); }
DEVI float wave_sum(float v) {
#pragma unroll
  for (int o = 32; o > 0; o >>= 1) v += __shfl_xor(v, o, 64);
  return v;
}
DEVI float red16(float v) {
  v += __shfl_xor(v, 1, 64); v += __shfl_xor(v, 2, 64); v += __shfl_xor(v, 4, 64); v += __shfl_xor(v, 8, 64);
  return v;
}
DEVI float redsin(float a, bool cosine) {
  float k = rintf(a * 0.15915494309189535f);
  float r = fmaf(-k, 6.2831854820251465f, a);
  r = fmaf(-k, -1.7484555e-7f, r);
  return cosine ? __cosf(r) : __sinf(r);
}


DEVI float seg_scan_sum(float v, int tid, float* s_x) {
  const int lane = tid & 63;
#pragma unroll
  for (int o = 1; o < 64; o <<= 1) { float t = __shfl_up(v, o, 64); if (lane >= o) v += t; }
  if (lane == 63 && tid < 256) s_x[tid >> 6] = v;
  __syncthreads();
  if (tid < 256 && ((tid >> 6) & 1)) v += s_x[(tid >> 6) - 1];
  __syncthreads();
  return v;
}
DEVI float seg_scan_max(float v, int tid, float* s_x) {
  const int lane = tid & 63;
#pragma unroll
  for (int o = 1; o < 64; o <<= 1) { float t = __shfl_up(v, o, 64); if (lane >= o) v = fmaxf(v, t); }
  if (lane == 63 && tid < 256) s_x[tid >> 6] = v;
  __syncthreads();
  if (tid < 256 && ((tid >> 6) & 1)) v = fmaxf(v, s_x[(tid >> 6) - 1]);
  __syncthreads();
  return v;
}

#define XB_TMO      128
#define XB_XCNT(j)  (256  + 64 * (j))
#define XB_XSUB(j)  (1280 + 64 * (j))
#define XB_XGEN(j)  (2304 + 64 * (j))
#define XB_TOP      3328
#define XB_TOPGEN   3392
#define XCD_BAR_WORDS 3456
#define XB_SPIN_CAP (1u << 18)
#define LAS __attribute__((address_space(3)))

__device__ __forceinline__ unsigned xb_ld(unsigned* p)              { return __hip_atomic_load(p, __ATOMIC_RELAXED, __HIP_MEMORY_SCOPE_AGENT); }
__device__ __forceinline__ unsigned xb_add(unsigned* p, unsigned v) { return __hip_atomic_fetch_add(p, v, __ATOMIC_RELAXED, __HIP_MEMORY_SCOPE_AGENT); }
__device__ __forceinline__ unsigned xb_xcc_id() { return (unsigned)__builtin_amdgcn_s_getreg((3 << 11) | 20) & 0xFu; }
#define XB_SPIN(cond, bar) do { unsigned _sp = 0; while (cond) { __builtin_amdgcn_s_sleep(1); \
    if ((++_sp & 255u) == 0u) { if (xb_ld(&(bar)[XB_TMO])) break; if (_sp > XB_SPIN_CAP) { atomicAdd(&(bar)[XB_TMO], 1u); break; } } } } while (0)

struct XcdBarrier {
    unsigned* bar; unsigned x;
    volatile LAS unsigned* st;
};

__device__ __forceinline__ XcdBarrier xcd_barrier_post(unsigned* bar, volatile LAS unsigned* st) {
    XcdBarrier b; b.bar = bar; b.x = xb_xcc_id(); b.st = st;
    if (threadIdx.x == 0) (void)xb_add(&bar[XB_XCNT(b.x)], 1u);
    return b;
}
__device__ __forceinline__ void xcd_barrier_complete(unsigned* bar, unsigned x, unsigned& nloc, unsigned& nx) {
    const unsigned G = gridDim.x * gridDim.y * gridDim.z;
    unsigned sum, cnt, mine, sp = 0u;
    for (;;) {
        sum = 0u; cnt = 0u; mine = 0u;
#pragma unroll
        for (unsigned j = 0; j < 16; ++j) { const unsigned c = xb_ld(&bar[XB_XCNT(j)]); sum += c; cnt += (c > 0u) ? 1u : 0u; mine = (j == x) ? c : mine; }
        if (sum == G) break;
        __builtin_amdgcn_s_sleep(1);
        if ((++sp & 255u) == 0u) { if (xb_ld(&bar[XB_TMO])) break; if (sp > XB_SPIN_CAP) { atomicAdd(&bar[XB_TMO], 1u); break; } }
    }
    nloc = mine > 0u ? mine : 1u; nx = cnt > 0u ? cnt : 1u;
}

__device__ __forceinline__ void xcd_barrier(const XcdBarrier& b) {
    asm volatile("s_waitcnt vmcnt(0)" ::: "memory");
    __syncthreads();
    if (threadIdx.x == 0) {
        unsigned* bar = b.bar;
        __builtin_amdgcn_s_waitcnt(0);
        unsigned nloc = b.st[0], nx = b.st[1];
        if (nloc == 0u) { xcd_barrier_complete(bar, b.x, nloc, nx); b.st[0] = nloc; b.st[1] = nx; }
        const unsigned old = xb_add(&bar[XB_XSUB(b.x)], 1u);
        const unsigned gen = old / nloc;
        if (old + 1u == (gen + 1u) * nloc) {
            __builtin_amdgcn_fence(__ATOMIC_RELEASE, "agent");
            asm volatile("s_waitcnt vmcnt(0)" ::: "memory");
            const unsigned og = xb_add(&bar[XB_TOP], 1u);
            const unsigned tg = og / nx;
            if (og + 1u == (tg + 1u) * nx) xb_add(&bar[XB_TOPGEN], 1u);
            else XB_SPIN(xb_ld(&bar[XB_TOPGEN]) == tg, bar);
            __builtin_amdgcn_fence(__ATOMIC_ACQUIRE, "agent");
            xb_add(&bar[XB_XGEN(b.x)], 1u);
            asm volatile("s_waitcnt vmcnt(0)" ::: "memory");
        } else {
            XB_SPIN(xb_ld(&bar[XB_XGEN(b.x)]) == gen, bar);
            __builtin_amdgcn_fence(__ATOMIC_ACQUIRE, "agent");
            asm volatile("s_waitcnt vmcnt(0)" ::: "memory");
        }
    }
    __syncthreads();
}

template <int BM, int BN, bool ATR, bool BTR, bool ALDS>
DEVI void gemm_tile(const bfraw* __restrict__ A, int lda, const bfraw* __restrict__ B, int ldb, int K,
                    const float* kscale, f32x4 (&acc)[BM / 32][BN / 64], bfraw* st, const bfraw* sAres, int ldres) {
  constexpr int MI = BM / 32, NJ = BN / 64, CA = BM / 128, CB = BN / 128, WM = BM / 2, WN = BN / 4;
  constexpr int STAGE = (ALDS ? BN : (BM + BN)) * LROW;
  int tid_ = ltid();
  const int tid = tid_, lane = tid & 63, wid = tid >> 6, wm = wid >> 2, wn = wid & 3;
  const int fr = lane & 15, fq = lane >> 4;
  uint4 ra0 = {0, 0, 0, 0}, ra1 = {0, 0, 0, 0}, rb0 = {0, 0, 0, 0}, rb1 = {0, 0, 0, 0};
  const int nk = K >> 5;

  auto gla = [&](int c, int k0) -> uint4 {
    if (!ATR) { int row = c >> 2, kc = (c & 3) * 8; return *(const uint4*)(A + (size_t)row * lda + k0 + kc); }
    else { int krow = c / (BM / 8), m0 = (c % (BM / 8)) * 8; return *(const uint4*)(A + (size_t)(k0 + krow) * lda + m0); }
  };
  auto glb = [&](int c, int k0) -> uint4 {
    if (!BTR) { int row = c >> 2, kc = (c & 3) * 8; return *(const uint4*)(B + (size_t)row * ldb + k0 + kc); }
    else { int krow = c / (BN / 8), n0 = (c % (BN / 8)) * 8; return *(const uint4*)(B + (size_t)(k0 + krow) * ldb + n0); }
  };
  auto gload = [&](int kt) {
    const int k0 = kt << 5;
    if (!ALDS) { ra0 = gla(tid, k0); if (CA > 1) ra1 = gla(tid + NTHR, k0); }
    rb0 = glb(tid, k0); if (CB > 1) rb1 = glb(tid + NTHR, k0);
  };
  constexpr int TSA = BM + 8, TSB = BN + 8;
  auto scale8 = [&](uint4 r, float sc) -> uint4 {
    unsigned w[4] = {r.x, r.y, r.z, r.w};
#pragma unroll
    for (int e = 0; e < 4; ++e) w[e] = (unsigned)f2bf(bf2f((bfraw)(w[e] & 0xffff)) * sc) | ((unsigned)f2bf(bf2f((bfraw)(w[e] >> 16)) * sc) << 16);
    return uint4{w[0], w[1], w[2], w[3]};
  };
  auto lstore = [&](int buf, int kt) {
    bfraw* sA = st + buf * STAGE;
    bfraw* sB = sA + (ALDS ? 0 : BM * LROW);
    auto sta = [&](int c, uint4 v) {
      if (!ATR) { int row = c >> 2, kc = (c & 3) * 8; *(uint4*)(sA + row * LROW + kc) = v; }
      else { int krow = c / (BM / 8), m0 = (c % (BM / 8)) * 8; *(uint4*)(sA + krow * TSA + m0) = v; }
    };
    auto stb = [&](int c, uint4 v) {
      if (!BTR) { int row = c >> 2, kc = (c & 3) * 8; *(uint4*)(sB + row * LROW + kc) = v; }
      else {
        int krow = c / (BN / 8), n0 = (c % (BN / 8)) * 8;
        if (kscale) v = scale8(v, kscale[(kt << 5) + krow]);
        *(uint4*)(sB + krow * TSB + n0) = v;
      }
    };
    if (!ALDS) { sta(tid, ra0); if (CA > 1) sta(tid + NTHR, ra1); }
    stb(tid, rb0); if (CB > 1) stb(tid + NTHR, rb1);
  };
  typedef short s16x4 __attribute__((ext_vector_type(4)));
  auto trfrag = [&](const bfraw* sT, int TS, int mt) -> bf16x8 {
    const bfraw* a1 = sT + (8 * fq + (fr >> 2)) * TS + mt + (fr & 3) * 4;
    s16x4 r1 = __builtin_amdgcn_ds_read_tr16_b64_v4i16((__attribute__((address_space(3))) s16x4*)a1);
    s16x4 r2 = __builtin_amdgcn_ds_read_tr16_b64_v4i16((__attribute__((address_space(3))) s16x4*)(a1 + 4 * TS));
    return bf16x8{r1[0], r1[1], r1[2], r1[3], r2[0], r2[1], r2[2], r2[3]};
  };
  auto compute = [&](int buf, int kt) {
    const bfraw* sA = st + buf * STAGE;
    const bfraw* sB = sA + (ALDS ? 0 : BM * LROW);
    bf16x8 af[MI], bfr[NJ];
#pragma unroll
    for (int i = 0; i < MI; ++i) {
      if (ALDS) af[i] = *(const bf16x8*)(sAres + (wm * WM + i * 16 + fr) * ldres + (kt << 5) + fq * 8);
      else if (ATR) af[i] = trfrag(sA, TSA, wm * WM + i * 16);
      else af[i] = *(const bf16x8*)(sA + (wm * WM + i * 16 + fr) * LROW + fq * 8);
    }
#pragma unroll
    for (int j = 0; j < NJ; ++j) {
      if (BTR) bfr[j] = trfrag(sB, TSB, wn * WN + j * 16);
      else bfr[j] = *(const bf16x8*)(sB + (wn * WN + j * 16 + fr) * LROW + fq * 8);
    }
#pragma unroll
    for (int i = 0; i < MI; ++i)
#pragma unroll
      for (int j = 0; j < NJ; ++j) acc[i][j] = __builtin_amdgcn_mfma_f32_16x16x32_bf16(af[i], bfr[j], acc[i][j], 0, 0, 0);
  };

  uint4 xa0 = {0, 0, 0, 0}, xa1 = {0, 0, 0, 0}, xb0 = {0, 0, 0, 0}, xb1 = {0, 0, 0, 0};
  auto swapsets = [&]() { uint4 t; t = ra0; ra0 = xa0; xa0 = t; t = ra1; ra1 = xa1; xa1 = t; t = rb0; rb0 = xb0; xb0 = t; t = rb1; rb1 = xb1; xb1 = t; };
  __syncthreads();
  gload(0); lstore(0, 0);
  if (nk > 1) gload(1);
  if (nk > 2) { swapsets(); gload(2); swapsets(); }
  __syncthreads();
  for (int kt = 0; kt < nk; kt += 2) {
    compute(0, kt);
    if (kt + 1 < nk) lstore(1, kt + 1);
    if (kt + 3 < nk) gload(kt + 3);
    __syncthreads();
    if (kt + 1 >= nk) break;
    compute(1, kt + 1);
    swapsets();
    if (kt + 2 < nk) lstore(0, kt + 2);
    if (kt + 4 < nk) gload(kt + 4);
    swapsets();
    __syncthreads();
  }
}

#define ZERO_ACC(acc, MI, NJ) _Pragma("unroll") for (int _i = 0; _i < (MI); ++_i) _Pragma("unroll") for (int _j = 0; _j < (NJ); ++_j) acc[_i][_j] = f32x4{0.f, 0.f, 0.f, 0.f};
#define EPI_BEGIN(BM, BN) { int _t = ltid(); const int _l = _t & 63, _w = _t >> 6; \
    const int _rb = (_w >> 2) * ((BM) / 2) + (_l >> 4) * 4, _cb = (_w & 3) * ((BN) / 4) + (_l & 15); \
    _Pragma("unroll") for (int i = 0; i < (BM) / 32; ++i) _Pragma("unroll") for (int j = 0; j < (BN) / 64; ++j) _Pragma("unroll") for (int r = 0; r < 4; ++r) { \
      const int row = _rb + i * 16 + r, col = _cb + j * 16;
#define EPI_END }}
#define EPIR_BEGIN(BM, BN) { int _t = ltid(); const int _l = _t & 63, _w = _t >> 6; \
    const int _rb = (_w >> 2) * ((BM) / 2) + (_l >> 4) * 4, _cb = (_w & 3) * ((BN) / 4) + (_l & 15); \
    _Pragma("unroll") for (int i = 0; i < (BM) / 32; ++i) _Pragma("unroll") for (int r = 0; r < 4; ++r) { \
      const int row = _rb + i * 16 + r;
#define EPIR_COLS(BN) _Pragma("unroll") for (int j = 0; j < (BN) / 64; ++j) { const int col = _cb + j * 16;
#define EPIR_END }}}


namespace pg8 {
#define PG8_LAS __attribute__((address_space(3)))
typedef unsigned short bf16_t;
typedef short bf16x8 __attribute__((ext_vector_type(8)));
typedef float f32x4 __attribute__((ext_vector_type(4)));
typedef unsigned u32x4 __attribute__((ext_vector_type(4)));
constexpr int BM = 256, BK = 64, HALF = 128, HTB = HALF * BK * 2  , STAGE_BYTES = 8 * HTB, NXCD = 8, WGM = 4;

__host__ __device__ __forceinline__ int lds_byte(int r, int c) { const int st = (r >> 4) * 2 + (c >> 5), rr = r & 15, cc = c & 31, ob = rr * 64 + cc * 2; return st * 1024 + (ob ^ (((ob >> 9) & 1) << 5)); }
__host__ __device__ __forceinline__ void stage_rc(int b, int& R, int& C) { const int st = b / 1024, sb = b % 1024, swz = sb ^ (((sb >> 9) & 1) << 5); R = (st >> 1) * 16 + swz / 64; C = (st & 1) * 32 + (swz % 64) / 2; }
__host__ __device__ __forceinline__ int perm32(int rho) { const int n = rho >> 4, i = rho & 15; return 8 * (i >> 2) + 4 * n + (i & 3); }

struct Unit { int pm, pn; };
struct Gemm { const bf16_t* A; const bf16_t* Bt; int M, N, K, ld; };
struct StaticOrder {
    int nM, nN, nwg, G, c;
    __host__ __device__ void init(int M, int N, int G_, int c_) { nM = M / BM; nN = N / BM; nwg = nM * nN; G = G_; c = c_; }
    __host__ __device__ bool next(int i, Unit& u) const {
        const long L = (long)i * G + c; if (L >= nwg) return false;
        int wgid = (int)L; { const int q = nwg / NXCD, r = nwg % NXCD, xcd = wgid % NXCD, off = wgid / NXCD; wgid = (xcd < r ? xcd * (q + 1) : r * (q + 1) + (xcd - r) * q) + off; }
        const int nig = WGM * nN, gid = wgid / nig, fm = gid * WGM, gsz = (nM - fm) < WGM ? (nM - fm) : WGM;
        u.pm = fm + ((wgid % nig) % gsz); u.pn = (wgid % nig) / gsz; return true;
    }
    __device__ __forceinline__ void a_ready(const Unit&) const {}
    __device__ __forceinline__ void done(const Unit&) const {}
};
__device__ __forceinline__ unsigned cvt_pk_bf16(float lo, float hi) { unsigned r; asm volatile("v_cvt_pk_bf16_f32 %0, %1, %2" : "=v"(r) : "v"(lo), "v"(hi)); return r; }
template <class Epi, class Sched, bool STAMP = false>
__device__ __forceinline__ void gemm_phase(PG8_LAS unsigned char* lds, const Gemm g, const Sched& S, const Epi& E, unsigned long long* stamps) {
    const int tid = threadIdx.x, wid = __builtin_amdgcn_readfirstlane(tid >> 6), lane = tid & 63, wr = wid >> 2, wc = wid & 3, fr = lane & 15, fq = lane >> 4;
    const int K = g.K, nt = K / BK;
    int ts_lo = 0, ts_hi = 0, nts = 0; const unsigned long long rt_entry = STAMP ? (unsigned long long)wall_clock64() : 0ull;
#define PG8_STAMP() do { if (STAMP && wid == 0 && nts < 64) { const unsigned long long _c = (unsigned long long)clock64(); \
        ts_lo = (lane == nts) ? (int)(unsigned)_c : ts_lo; ts_hi = (lane == nts) ? (int)(unsigned)(_c >> 32) : ts_hi; ++nts; } } while (0)
    PG8_STAMP();
    unsigned voffA[2], voffB[2];
#pragma unroll
    for (int i = 0; i < 2; ++i) { int R, C; stage_rc(tid * 16 + i * 8192, R, C); const int Rb = Epi::PERM ? ((R & ~31) + perm32(R & 31)) : R;
        voffA[i] = (unsigned)(R * g.ld + C) * 2u; voffB[i] = (unsigned)(Rb * g.ld + C) * 2u; }
    const size_t kstep = (size_t)(BK * 2);
    const size_t hstep = (size_t)HALF * g.ld * 2;
    const size_t tstep = 2 * hstep;
    const unsigned ldsw = (unsigned)wid * 1024u;
    const int aoff = lds_byte(wr * 64 + fr, fq * 8), boff = lds_byte(wc * 32 + fr, fq * 8);
#define PG8_SA(b, h) (((b) * 2 + (h)) * HTB)
#define PG8_SB(b, h) ((4 + (b) * 2 + (h)) * HTB)
#define PG8_STAGE(bufoff, gbase, voff) do { _Pragma("unroll") for (int _i = 0; _i < 2; ++_i) \
        __builtin_amdgcn_global_load_lds((const unsigned*)((const char*)(gbase) + (voff)[_i]), (PG8_LAS unsigned*)(lds + (bufoff) + ldsw + _i * 8192), 16, 0, 0); } while (0)
#define PG8_LDA(dst, b, h) do { _Pragma("unroll") for (int m = 0; m < 4; ++m) _Pragma("unroll") for (int k = 0; k < 2; ++k) dst[m][k] = *(const PG8_LAS bf16x8*)(lds + PG8_SA(b, h) + aoff + m * 2048 + k * 1024); } while (0)
#define PG8_LDB(dst, b, h) do { _Pragma("unroll") for (int n = 0; n < 2; ++n) _Pragma("unroll") for (int k = 0; k < 2; ++k) dst[n][k] = *(const PG8_LAS bf16x8*)(lds + PG8_SB(b, h) + boff + n * 2048 + k * 1024); } while (0)
#define PG8_MMA(ai, bj, At, Bt) do { __builtin_amdgcn_s_setprio(1); _Pragma("unroll") for (int m = 0; m < 4; ++m) _Pragma("unroll") for (int n = 0; n < 2; ++n) _Pragma("unroll") for (int k = 0; k < 2; ++k) \
        acc[ai][bj][m][n] = __builtin_amdgcn_mfma_f32_16x16x32_bf16(Bt[n][k], At[m][k], acc[ai][bj][m][n], 0, 0, 0); __builtin_amdgcn_s_setprio(0); } while (0)
#define PG8_WAIT_V(n) asm volatile("s_waitcnt vmcnt(" #n ")" ::: "memory")
#define PG8_WAIT_L(n) asm volatile("s_waitcnt lgkmcnt(" #n ")" ::: "memory")
#define PG8_BAR __builtin_amdgcn_s_barrier()
#define PG8_SCHED __builtin_amdgcn_sched_barrier(0)
    Unit cur, nxt; int ui = 0;
    if (!S.next(0, cur)) return;
    f32x4 acc[2][2][4][2];
#pragma unroll
    for (int a = 0; a < 2; ++a)
#pragma unroll
        for (int b = 0; b < 2; ++b)
#pragma unroll
            for (int m = 0; m < 4; ++m)
#pragma unroll
                for (int n = 0; n < 2; ++n) acc[a][b][m][n] = (f32x4){0.f, 0.f, 0.f, 0.f};
    bf16x8 At[4][2], B0[2][2], B1[2][2];
    const char* cA = (const char*)g.A + (size_t)cur.pm * tstep; const char* cB = (const char*)g.Bt + (size_t)cur.pn * tstep;
    S.a_ready(cur);
    PG8_STAGE(PG8_SB(0, 0), cB, voffB); PG8_STAGE(PG8_SA(0, 0), cA, voffA); PG8_STAGE(PG8_SB(0, 1), cB + hstep, voffB); PG8_STAGE(PG8_SA(0, 1), cA + hstep, voffA);
    if (wr == 1) PG8_BAR;
    PG8_WAIT_V(4); PG8_BAR;
    PG8_STAGE(PG8_SB(1, 0), cB + kstep, voffB); PG8_STAGE(PG8_SA(1, 0), cA + kstep, voffA); PG8_STAGE(PG8_SB(1, 1), cB + hstep + kstep, voffB);
    PG8_WAIT_V(6); PG8_BAR;
    PG8_STAMP();
    for (;;) {
        const bool has_next = S.next(ui + 1, nxt);
        const char* nA = has_next ? (const char*)g.A + (size_t)nxt.pm * tstep : cA; const char* nB = has_next ? (const char*)g.Bt + (size_t)nxt.pn * tstep : cB;
        for (int t = 0; t < nt; t += 2) {
            const bool last = (t == nt - 2);
            const char* a1 = cA + (size_t)(t + 1) * kstep;
            const char* a2 = last ? nA : cA + (size_t)(t + 2) * kstep; const char* b2 = last ? nB : cB + (size_t)(t + 2) * kstep;
            const char* a3 = a2 + kstep; const char* b3 = b2 + kstep;
            if (last && has_next) S.a_ready(nxt);
            PG8_LDB(B0, 0, 0); PG8_SCHED; PG8_LDA(At, 0, 0); PG8_STAGE(PG8_SA(1, 1), a1 + hstep, voffA);
            PG8_WAIT_L(8); PG8_BAR; PG8_WAIT_L(0); PG8_MMA(0, 0, At, B0); PG8_BAR; PG8_SCHED;
            PG8_LDB(B1, 0, 1); PG8_STAGE(PG8_SB(0, 0), b2, voffB);
            PG8_BAR; PG8_WAIT_L(0); PG8_MMA(0, 1, At, B1); PG8_BAR;
            PG8_LDA(At, 0, 1); PG8_STAGE(PG8_SA(0, 0), a2, voffA);
            PG8_BAR; PG8_WAIT_L(0); PG8_MMA(1, 0, At, B0); PG8_BAR; PG8_SCHED;
            PG8_STAGE(PG8_SB(0, 1), b2 + hstep, voffB);
            PG8_WAIT_V(6); PG8_BAR; PG8_MMA(1, 1, At, B1); PG8_BAR;
            PG8_LDB(B0, 1, 0); PG8_SCHED; PG8_LDA(At, 1, 0); PG8_STAGE(PG8_SA(0, 1), a2 + hstep, voffA);
            PG8_WAIT_L(8); PG8_BAR; PG8_WAIT_L(0); PG8_MMA(0, 0, At, B0); PG8_BAR; PG8_SCHED;
            PG8_LDB(B1, 1, 1); PG8_STAGE(PG8_SB(1, 0), b3, voffB);
            PG8_BAR; PG8_WAIT_L(0); PG8_MMA(0, 1, At, B1); PG8_BAR;
            PG8_LDA(At, 1, 1); PG8_STAGE(PG8_SA(1, 0), a3, voffA);
            PG8_BAR; PG8_WAIT_L(0); PG8_MMA(1, 0, At, B0); PG8_BAR; PG8_SCHED;
            PG8_STAGE(PG8_SB(1, 1), b3 + hstep, voffB);
            PG8_WAIT_V(6); PG8_BAR; PG8_MMA(1, 1, At, B1); PG8_BAR;
        }
        PG8_STAMP();
        if constexpr (!Epi::AFTER_DRAIN) { E(acc, cur, wr, wc, fr, fq); S.done(cur); }
        PG8_STAMP();
        if (!has_next) break;
#pragma unroll
        for (int a = 0; a < 2; ++a)
#pragma unroll
            for (int b = 0; b < 2; ++b)
#pragma unroll
                for (int m = 0; m < 4; ++m)
#pragma unroll
                    for (int n = 0; n < 2; ++n) acc[a][b][m][n] = (f32x4){0.f, 0.f, 0.f, 0.f};
        cur = nxt; cA = nA; cB = nB; ++ui;
    }
    PG8_WAIT_V(0);
    if (wr == 0) PG8_BAR;
    PG8_BAR;
    if constexpr (Epi::AFTER_DRAIN) { E.fused(acc, cur, wr, wc, fr, fq, lds, wid, lane); S.done(cur); }
    PG8_STAMP();
    if (STAMP && wid == 0) { stamps[lane] = lane < nts ? (((unsigned long long)(unsigned)ts_hi << 32) | (unsigned)ts_lo) : 0ull;
        if (lane == 62) stamps[62] = rt_entry; if (lane == 63) stamps[63] = (unsigned long long)wall_clock64(); }
#undef PG8_STAMP
#undef PG8_SA
#undef PG8_SB
#undef PG8_STAGE
#undef PG8_LDA
#undef PG8_LDB
#undef PG8_MMA
#undef PG8_WAIT_V
#undef PG8_WAIT_L
#undef PG8_BAR
#undef PG8_SCHED
}
}

typedef pg8::f32x4 pf4;
DEVI float4 ld4(const float* p) { return *(const float4*)p; }
struct EpiFfnIn {
  static constexpr bool PERM = false, AFTER_DRAIN = false;
  bfraw* act;
  DEVI void operator()(const pf4 (&acc)[2][2][4][2], const pg8::Unit& u, int wr, int wc, int fr, int fq) const {
    const int row0 = u.pm * 256 + wr * 64 + fr, f0 = (u.pn * 256 + wc * 32) / 2 + 4 * fq;
#pragma unroll
    for (int ai = 0; ai < 2; ++ai)
#pragma unroll
      for (int m = 0; m < 4; ++m) {
        bfraw* rowp = act + (size_t)(row0 + ai * 128 + m * 16) * 2816 + f0;
#pragma unroll
        for (int bj = 0; bj < 2; ++bj) {
          const pf4 a = acc[ai][bj][m][0], b = acc[ai][bj][m][1];
          uint2 w; w.x = pg8::cvt_pk_bf16(siluf_(a[0]) * b[0], siluf_(a[1]) * b[1]); w.y = pg8::cvt_pk_bf16(siluf_(a[2]) * b[2], siluf_(a[3]) * b[3]);
          *(uint2*)(rowp + bj * 64) = w;
        }
      }
  }
};
struct EpiResid {
  static constexpr bool PERM = false, AFTER_DRAIN = false;
  float* h; const float* mods; int rowoff, gidx; float scale; int mrow;
  DEVI void operator()(const pf4 (&acc)[2][2][4][2], const pg8::Unit& u, int wr, int wc, int fr, int fq) const {
    const int row0 = rowoff + u.pm * 256 + wr * 64 + fr, col0 = u.pn * 256 + wc * 32 + 4 * fq;
#pragma unroll
    for (int ai = 0; ai < 2; ++ai)
#pragma unroll
      for (int m = 0; m < 4; ++m) {
        const int r = row0 + ai * 128 + m * 16;
        float* rowp = h + (size_t)r * 1024 + col0;
        const float* gp = mods + (mrow >= 0 ? mrow : (r >> 13)) * 9216 + gidx * 1024 + col0;
#pragma unroll
        for (int bj = 0; bj < 2; ++bj)
#pragma unroll
          for (int n = 0; n < 2; ++n) {
            float4 hv = ld4(rowp + bj * 128 + n * 16); const float4 g = ld4(gp + bj * 128 + n * 16); const pf4 a = acc[ai][bj][m][n];
            hv.x += scale * g.x * a[0]; hv.y += scale * g.y * a[1]; hv.z += scale * g.z * a[2]; hv.w += scale * g.w * a[3];
            *(float4*)(rowp + bj * 128 + n * 16) = hv;
          }
      }
  }
};
struct EpiResidAtomic {
  static constexpr bool PERM = false, AFTER_DRAIN = false;
  float* h; const float* mods; int rowoff, gidx; float scale; int mrow;
  DEVI void operator()(const pf4 (&acc)[2][2][4][2], const pg8::Unit& u, int wr, int wc, int fr, int fq) const {
    const int row0 = rowoff + u.pm * 256 + wr * 64 + fr, col0 = u.pn * 256 + wc * 32 + 4 * fq;
#pragma unroll
    for (int ai = 0; ai < 2; ++ai)
#pragma unroll
      for (int m = 0; m < 4; ++m) {
        const int r = row0 + ai * 128 + m * 16;
        float* rowp = h + (size_t)r * 1024 + col0;
        const float* gp = mods + (mrow >= 0 ? mrow : (r >> 13)) * 9216 + gidx * 1024 + col0;
#pragma unroll
        for (int bj = 0; bj < 2; ++bj)
#pragma unroll
          for (int n = 0; n < 2; ++n) {
            const float4 g = ld4(gp + bj * 128 + n * 16); const pf4 a = acc[ai][bj][m][n];
            float* q = rowp + bj * 128 + n * 16;
            atomicAdd(q, scale * g.x * a[0]); atomicAdd(q + 1, scale * g.y * a[1]); atomicAdd(q + 2, scale * g.z * a[2]); atomicAdd(q + 3, scale * g.w * a[3]);
          }
      }
  }
};
template <int MODE> struct EpiMix {
  static constexpr bool PERM = true, AFTER_DRAIN = false;
  bfraw* d0; bfraw* d1; bfraw* d2; bfraw* d3;
  DEVI void operator()(const pf4 (&acc)[2][2][4][2], const pg8::Unit& u, int wr, int wc, int fr, int fq) const {
    const int row0 = u.pm * 256 + wr * 64 + fr;
    const int pc = u.pn >> 2;
    bfraw* dst = MODE == 0 ? d0 : (MODE == 1 || MODE == 2) ? (pc == 0 ? d0 : pc == 1 ? d1 : pc == 2 ? d2 : d3) : (MODE == 3 ? d0 : d1);
    const int ld = MODE == 0 ? 3072 : 1024;
    const int col0 = (MODE == 1 || MODE == 2 ? (u.pn & 3) : u.pn) * 256 + wc * 32 + 8 * fq;
#pragma unroll
    for (int ai = 0; ai < 2; ++ai)
#pragma unroll
      for (int m = 0; m < 4; ++m) {
        const size_t ro = (size_t)(row0 + ai * 128 + m * 16) * ld + col0;
#pragma unroll
        for (int bj = 0; bj < 2; ++bj) {
          float v[8];
#pragma unroll
          for (int e = 0; e < 4; ++e) { v[e] = acc[ai][bj][m][0][e]; v[4 + e] = acc[ai][bj][m][1][e]; }
          bfraw* dp = dst + ro + bj * 128;
          if (MODE == 1) { if (pc == 3) {
#pragma unroll
            for (int e = 0; e < 8; ++e) v[e] = geluf_(v[e]); } }
          if (MODE == 2 && pc >= 2) {
#pragma unroll
            for (int e = 0; e < 8; ++e) v[e] = sigmoidf_(v[e]);
          } else if (MODE == 2 || MODE == 3 || MODE == 4) {
            const uint4 o = *(const uint4*)dp; const unsigned ow[4] = {o.x, o.y, o.z, o.w};
            float p[8];
#pragma unroll
            for (int e = 0; e < 4; ++e) { p[2 * e] = bf2f((bfraw)(ow[e] & 0xffff)); p[2 * e + 1] = bf2f((bfraw)(ow[e] >> 16)); }
            if (MODE == 2) {
#pragma unroll
              for (int e = 0; e < 8; ++e) v[e] = (pc == 0 ? sigmoidf_(v[e]) : geluf_(v[e])) * p[e];
            } else if (MODE == 3) {
#pragma unroll
              for (int e = 0; e < 8; ++e) v[e] *= p[e];
            } else {
              const uint4 t = *(const uint4*)(d0 + ro + bj * 128); const unsigned tw[4] = {t.x, t.y, t.z, t.w};
#pragma unroll
              for (int e = 0; e < 4; ++e) { v[2 * e] = bf2f((bfraw)(tw[e] & 0xffff)) + p[2 * e] * v[2 * e]; v[2 * e + 1] = bf2f((bfraw)(tw[e] >> 16)) + p[2 * e + 1] * v[2 * e + 1]; }
            }
          }
          uint4 w; w.x = pg8::cvt_pk_bf16(v[0], v[1]); w.y = pg8::cvt_pk_bf16(v[2], v[3]); w.z = pg8::cvt_pk_bf16(v[4], v[5]); w.w = pg8::cvt_pk_bf16(v[6], v[7]);
          *(uint4*)dp = w;
        }
      }
  }
};
template <class Epi>
DEVI void run8(unsigned char* lds, const bfraw* A, const bfraw* Bt, int M, int N, int K, const Epi& E, int G = -1, int c = -1, int ld = -1) {
  pg8::Gemm g{A, Bt, M, N, K, ld < 0 ? K : ld};
  pg8::StaticOrder S; S.init(M, N, G < 0 ? (int)gridDim.x : G, c < 0 ? (int)blockIdx.x : c);
  pg8::gemm_phase<Epi, pg8::StaticOrder, false>((PG8_LAS unsigned char*)lds, g, S, E, nullptr);
}

struct TrJob { const float* src; bfraw* dst; int ldw, K, kt, nt, drow0, mode; };
DEVI TrJob tr_decode(const P& p, int t) {
  TrJob j; int u = t;
  if (u < 1408) { j = TrJob{p.in[I_W1IN], (bfraw*)(p.ws + O_W1IN), 5632, 1024, u / 88, u % 88, 0, 1}; return j; }
  u -= 1408;
  if (u < 704) { j = TrJob{p.in[I_W1OUT], (bfraw*)(p.ws + O_W1OUT), 1024, 2816, u / 16, u % 16, 0, 0}; return j; }
  u -= 704;
  if (u < 2048) {
    const int pc = u >> 8; u &= 255;
    const int col0 = pc == 0 ? 0 : pc == 1 ? 1024 : pc == 2 ? 2048 : pc == 3 ? 5136 : pc == 4 ? 3088 : pc == 5 ? 4112 : pc == 6 ? 6160 : 7184;
    j = TrJob{p.in[I_WIN] + col0, (bfraw*)(p.ws + (pc < 4 ? O_WTA : O_WTB)), 8208, 1024, u >> 4, u & 15, (pc & 3) * 1024, 0}; return j;
  }
  u -= 2048;
  if (u < 768) { const int m = u >> 8; u &= 255; j = TrJob{p.in[m == 0 ? I_WA : m == 1 ? I_WB : I_WO], (bfraw*)(p.ws + (m == 0 ? O_WA : m == 1 ? O_WB : O_WO)), 1024, 1024, u >> 4, u & 15, 0, 0}; return j; }
  u -= 768;
  if (u < 1408) { j = TrJob{p.in[I_W2IN], (bfraw*)(p.ws + O_W2IN), 5632, 1024, u / 88, u % 88, 0, 1}; return j; }
  u -= 1408;
  j = TrJob{p.in[I_W2OUT], (bfraw*)(p.ws + O_W2OUT), 1024, 2816, u / 16, u % 16, 0, 0}; return j;
}

DEVI void phase_p0(const P& p, unsigned char* lds) {
  float* sf = (float*)lds;
  const int tid = ltid();
  for (int i = tid; i < 3072; i += NTHR) { float v = i < 2048 ? p.in[I_C][i] : p.in[I_CCTX][i - 2048]; sf[i] = v / (1.f + expf(-v)); }
  __syncthreads();
  {
    const float* w = p.in[I_WADA];
    float* mp = (float*)(p.ws + O_MODSP);
    for (int id = blockIdx.x * NTHR + tid; id < 16 * 9216; id += gridDim.x * NTHR) {
      int s = id / 9216, j = id - s * 9216;
      float a0 = 0, a1 = 0, a2 = 0;
#pragma unroll 16
      for (int k = s * 64; k < s * 64 + 64; ++k) { float wv = __builtin_nontemporal_load(w + (size_t)k * 9216 + j); a0 += sf[k] * wv; a1 += sf[1024 + k] * wv; a2 += sf[2048 + k] * wv; }
      mp[(s * 3 + 0) * 9216 + j] = a0; mp[(s * 3 + 1) * 9216 + j] = a1; mp[(s * 3 + 2) * 9216 + j] = a2;
    }
  }
  __syncthreads();
  {
    float4 rg0 = {0.f, 0.f, 0.f, 0.f}, rg1 = {0.f, 0.f, 0.f, 0.f};
    const int lk = tid >> 4, ln = (tid & 15) * 4;
    const int sn = tid >> 3, sk = (tid & 7) * 8;
    int t = blockIdx.x;
    TrJob jb = tr_decode(p, t < 7040 ? t : 0);
    if (t < 7040) {
      rg0 = ld4nt(jb.src + (size_t)(jb.kt * 64 + lk) * jb.ldw + jb.nt * 64 + ln);
      rg1 = ld4nt(jb.src + (size_t)(jb.kt * 64 + lk + 32) * jb.ldw + jb.nt * 64 + ln);
    }
    for (; t < 7040; t += gridDim.x) {
      sf[lk * 65 + ln] = rg0.x; sf[lk * 65 + ln + 1] = rg0.y; sf[lk * 65 + ln + 2] = rg0.z; sf[lk * 65 + ln + 3] = rg0.w;
      sf[(lk + 32) * 65 + ln] = rg1.x; sf[(lk + 32) * 65 + ln + 1] = rg1.y; sf[(lk + 32) * 65 + ln + 2] = rg1.z; sf[(lk + 32) * 65 + ln + 3] = rg1.w;
      __syncthreads();
      const TrJob cj = jb;
      const int tn = t + gridDim.x;
      if (tn < 7040) {
        jb = tr_decode(p, tn);
        rg0 = ld4nt(jb.src + (size_t)(jb.kt * 64 + lk) * jb.ldw + jb.nt * 64 + ln);
        rg1 = ld4nt(jb.src + (size_t)(jb.kt * 64 + lk + 32) * jb.ldw + jb.nt * 64 + ln);
      }
      {
        const int n = cj.nt * 64 + sn; int dr;
        if (cj.mode == 1) { int isb = n >= 2816; int f = n - isb * 2816; dr = (f >> 4) * 32 + isb * 16 + (f & 15); } else dr = cj.drow0 + n;
        unsigned w[4];
#pragma unroll
        for (int e = 0; e < 4; ++e) w[e] = (unsigned)f2bf(sf[(sk + 2 * e) * 65 + sn]) | ((unsigned)f2bf(sf[(sk + 2 * e + 1) * 65 + sn]) << 16);
        *(uint4*)(cj.dst + (size_t)dr * cj.K + cj.kt * 64 + sk) = uint4{w[0], w[1], w[2], w[3]};
      }
      __syncthreads();
    }
  }
  { bfraw* d = (bfraw*)(p.ws + O_WSB); for (int id = blockIdx.x * NTHR + tid; id < 65536; id += gridDim.x * NTHR) d[id] = f2bf(p.in[I_WS][id]); }
}

DEVI void phase_p0b(const P& p) {
  const float* mp = (const float*)(p.ws + O_MODSP);
  float* m = (float*)(p.ws + O_MODS);
  for (int id = blockIdx.x * NTHR + ltid(); id < 3 * 9216; id += gridDim.x * NTHR) {
    int j = id % 9216;
    float a = p.in[I_BADA][j];
    for (int s = 0; s < 16; ++s) a += mp[s * 3 * 9216 + id];
    m[id] = a;
  }
}

template <int MODE>
DEVI void phase_rows(const P& p, unsigned char* lds, int row_lo = 0, int row_hi = -1, int vb = -1, int nvb = -1) {
  const int tid = ltid(), lane = tid & 63, wid = tid >> 6;
  const float* mods = (const float*)(p.ws + O_MODS);
  float* hctx = (float*)(p.ws + O_HCTX);
  bfraw* hn = (bfraw*)(p.ws + O_HN);
  float* wg = (float*)lds;
  if (MODE == 2) {
    __syncthreads();
    for (int i = tid; i < 16384; i += NTHR) { int k = i >> 4, g = i & 15; wg[g * 1024 + k] = p.in[I_WIN][(size_t)k * 8208 + 3072 + g]; }
    __syncthreads();
  }
  const int nrows = row_hi >= 0 ? row_hi : ((MODE == 1 || MODE == 2) ? 16896 : 16384);
  if (vb < 0) { vb = (int)blockIdx.x; nvb = (int)gridDim.x; }
  const float* gvec = p.in[MODE == 1 ? I_GFFN1 : MODE == 2 ? I_GMIX : MODE == 3 ? I_GFFN2 : I_GFINAL];
  const int msh = MODE == 1 ? 0 : MODE == 2 ? 3 : 6;
  for (int row = row_lo + vb * 8 + wid; row < nrows; row += nvb * 8) {
    const bool lat = row < 16384;
    const int mrow = lat ? (row >> 13) : 2;
    float4 v[4];
    if (MODE == 1) {
      const float* src = lat ? p.in[I_X] + (size_t)row * 1024 : p.in[I_CTX] + (size_t)(row - 16384) * 1024;
#pragma unroll
      for (int i = 0; i < 4; ++i) { const nt_f4 t_ = __builtin_nontemporal_load((const nt_f4*)(src + i * 256 + lane * 4)); v[i] = float4{t_.x, t_.y, t_.z, t_.w}; }
      if (lat) {
        int ts = row & 8191; float rr = (float)(ts >> 6), cc = (float)(ts & 63);
        float fqv[4];
#pragma unroll
        for (int e = 0; e < 4; ++e) fqv[e] = expf((-9.210340371976184f * (float)(lane * 4 + e)) / 256.f);
        v[0].x += redsin(rr * fqv[0], false); v[0].y += redsin(rr * fqv[1], false); v[0].z += redsin(rr * fqv[2], false); v[0].w += redsin(rr * fqv[3], false);
        v[1].x += redsin(rr * fqv[0], true);  v[1].y += redsin(rr * fqv[1], true);  v[1].z += redsin(rr * fqv[2], true);  v[1].w += redsin(rr * fqv[3], true);
        v[2].x += redsin(cc * fqv[0], false); v[2].y += redsin(cc * fqv[1], false); v[2].z += redsin(cc * fqv[2], false); v[2].w += redsin(cc * fqv[3], false);
        v[3].x += redsin(cc * fqv[0], true);  v[3].y += redsin(cc * fqv[1], true);  v[3].z += redsin(cc * fqv[2], true);  v[3].w += redsin(cc * fqv[3], true);
      }
      float* dsth = lat ? p.out + (size_t)row * 1024 : hctx + (size_t)(row - 16384) * 1024;
#pragma unroll
      for (int i = 0; i < 4; ++i) *(float4*)(dsth + i * 256 + lane * 4) = v[i];
    } else {
      const float* src = lat ? p.out + (size_t)row * 1024 : hctx + (size_t)(row - 16384) * 1024;
#pragma unroll
      for (int i = 0; i < 4; ++i) v[i] = *(const float4*)(src + i * 256 + lane * 4);
    }
    float ss = 0;
#pragma unroll
    for (int i = 0; i < 4; ++i) ss += v[i].x * v[i].x + v[i].y * v[i].y + v[i].z * v[i].z + v[i].w * v[i].w;
    ss = wave_sum(ss);
    const float rs = rsqrtf(ss * (1.f / 1024.f) + EPS);
    if (MODE == 4) {
#pragma unroll
      for (int i = 0; i < 4; ++i) {
        float4 g = *(const float4*)(gvec + i * 256 + lane * 4);
        float4 o = {v[i].x * rs * g.x, v[i].y * rs * g.y, v[i].z * rs * g.z, v[i].w * rs * g.w};
        __builtin_nontemporal_store(nt_f4{o.x, o.y, o.z, o.w}, (nt_f4*)(p.out + (size_t)row * 1024 + i * 256 + lane * 4));
      }
    } else {
      const float* sh = mods + (size_t)(mrow * 9216 + msh * 1024);
      const float* scp = sh + 1024;
      float y[16];
#pragma unroll
      for (int i = 0; i < 4; ++i) {
        const int c = i * 256 + lane * 4;
        float4 g = *(const float4*)(gvec + c), s4 = *(const float4*)(sh + c), c4 = *(const float4*)(scp + c);
        y[i * 4 + 0] = v[i].x * rs * g.x * (1.f + c4.x) + s4.x; y[i * 4 + 1] = v[i].y * rs * g.y * (1.f + c4.y) + s4.y;
        y[i * 4 + 2] = v[i].z * rs * g.z * (1.f + c4.z) + s4.z; y[i * 4 + 3] = v[i].w * rs * g.w * (1.f + c4.w) + s4.w;
        uint2 pk; pk.x = (unsigned)f2bf(y[i * 4]) | ((unsigned)f2bf(y[i * 4 + 1]) << 16); pk.y = (unsigned)f2bf(y[i * 4 + 2]) | ((unsigned)f2bf(y[i * 4 + 3]) << 16);
        *(uint2*)(hn + (size_t)row * 1024 + c) = pk;
      }
      if (MODE == 2) {
        float ga[16];
#pragma unroll
        for (int g2 = 0; g2 < 16; ++g2) {
          float a = 0.f;
#pragma unroll
          for (int i = 0; i < 4; ++i) { float4 w4 = *(const float4*)(wg + g2 * 1024 + i * 256 + lane * 4); a += y[i * 4] * w4.x + y[i * 4 + 1] * w4.y + y[i * 4 + 2] * w4.z + y[i * 4 + 3] * w4.w; }
          ga[g2] = a;
          if ((g2 & 3) == 3) asm volatile("" ::: "memory");
        }
        const bool b5 = lane & 32, b4 = lane & 16, b3 = lane & 8, b2 = lane & 4;
        float r8[8], r4[4], r2[2];
#pragma unroll
        for (int g = 0; g < 8; ++g) { const float snd = b5 ? ga[g] : ga[g + 8], kp = b5 ? ga[g + 8] : ga[g]; r8[g] = kp + __shfl_xor(snd, 32, 64); }
#pragma unroll
        for (int g = 0; g < 4; ++g) { const float snd = b4 ? r8[g] : r8[g + 4], kp = b4 ? r8[g + 4] : r8[g]; r4[g] = kp + __shfl_xor(snd, 16, 64); }
#pragma unroll
        for (int g = 0; g < 2; ++g) { const float snd = b3 ? r4[g] : r4[g + 2], kp = b3 ? r4[g + 2] : r4[g]; r2[g] = kp + __shfl_xor(snd, 8, 64); }
        float r1 = (b2 ? r2[1] : r2[0]) + __shfl_xor(b2 ? r2[0] : r2[1], 4, 64);
        r1 += __shfl_xor(r1, 2, 64); r1 += __shfl_xor(r1, 1, 64);
        const int gi = (b5 ? 8 : 0) + (b4 ? 4 : 0) + (b3 ? 2 : 0) + (b2 ? 1 : 0);
        if ((lane & 3) == 0) ((float*)(p.ws + O_GATES))[(size_t)row * 16 + gi] = r1;
      }
    }
  }
}

DEVI void phase_ffn_in(const P& p, unsigned char* lds, size_t o_w, int nrows) {
  EpiFfnIn E{(bfraw*)(p.ws + O_ACT)};
  run8(lds, (const bfraw*)(p.ws + O_HN), (const bfraw*)(p.ws + o_w), nrows, 5632, 1024, E);
}

DEVI void phase_ffn_out(const P& p, unsigned char* lds, size_t o_w, int gidx, bool with_ctx) {
  EpiResid E{p.out, (const float*)(p.ws + O_MODS), 0, gidx, 0.5f, -1};
  run8(lds, (const bfraw*)(p.ws + O_ACT), (const bfraw*)(p.ws + o_w), 16384, 1024, 2816, E);
  (void)with_ctx;
}

DEVI void phase_r2_g2c(const P& p, unsigned char* lds) {
  const int G = (int)gridDim.x, nc = G >= 48 ? 24 : 0;
  if (nc == 0) {
    EpiResid E{(float*)(p.ws + O_HCTX), (const float*)(p.ws + O_MODS), 0, 2, 0.5f, 2};
    run8(lds, (const bfraw*)(p.ws + O_ACT) + (size_t)16384 * 2816, (const bfraw*)(p.ws + O_W1OUT), 512, 1024, 2816, E);
    __syncthreads();
  } else if ((int)blockIdx.x < nc) {
    const int sl = (int)blockIdx.x >> 3, k0 = sl * 1024, kl = sl == 2 ? 768 : 1024;
    EpiResidAtomic E{(float*)(p.ws + O_HCTX), (const float*)(p.ws + O_MODS), 0, 2, 0.5f, 2};
    run8(lds, (const bfraw*)(p.ws + O_ACT) + (size_t)16384 * 2816 + k0, (const bfraw*)(p.ws + O_W1OUT) + k0, 512, 1024, kl, E, 8, (int)blockIdx.x & 7, 2816);
    return;
  }
  phase_rows<2>(p, lds, 0, 16384, (int)blockIdx.x - nc, G - nc);
}

DEVI void phase_g3c(const P& p, unsigned char* lds) {
  EpiMix<0> E{(bfraw*)(p.ws + O_CTXRAW), nullptr, nullptr, nullptr};
  run8(lds, (const bfraw*)(p.ws + O_HN) + (size_t)16384 * 1024, (const bfraw*)(p.ws + O_WTA), 512, 3072, 1024, E);
}

DEVI void phase_g3a(const P& p, unsigned char* lds, int hb) {
  EpiMix<1> E{(bfraw*)(p.ws + O_QRAW), (bfraw*)(p.ws + O_KRAW), (bfraw*)(p.ws + O_V), (bfraw*)(p.ws + O_GVS)};
  run8(lds, (const bfraw*)(p.ws + O_HN) + (size_t)hb * 8192 * 1024, (const bfraw*)(p.ws + O_WTA), 8192, 4096, 1024, E);
}

DEVI void phase_g3b(const P& p, unsigned char* lds, int hb) {
  EpiMix<2> E{(bfraw*)(p.ws + O_V), (bfraw*)(p.ws + O_GVS), (bfraw*)(p.ws + O_QC), (bfraw*)(p.ws + O_KC)};
  run8(lds, (const bfraw*)(p.ws + O_HN) + (size_t)hb * 8192 * 1024, (const bfraw*)(p.ws + O_WTB), 8192, 4096, 1024, E);
}

DEVI void phase_g4(const P& p, unsigned char* lds) {
  const int Gh = (int)gridDim.x >> 1, grp = (int)blockIdx.x / Gh, c = (int)blockIdx.x % Gh;
  if (grp == 0) { EpiMix<3> E{(bfraw*)(p.ws + O_QC), nullptr, nullptr, nullptr}; run8(lds, (const bfraw*)(p.ws + O_V), (const bfraw*)(p.ws + O_WA), 8192, 1024, 1024, E, Gh, c); }
  else if (grp == 1) { EpiMix<3> E{(bfraw*)(p.ws + O_KC), nullptr, nullptr, nullptr}; run8(lds, (const bfraw*)(p.ws + O_GVS), (const bfraw*)(p.ws + O_WB), 8192, 1024, 1024, E, Gh, c); }
}

DEVI void phase_addmix(const P& p, int hb) {
  const uint4* t1 = (const uint4*)(p.ws + O_QC);
  const uint4* t2 = (const uint4*)(p.ws + O_KC);
  uint4* dst = (uint4*)(p.ws + (hb == 0 ? O_W1IN : O_QC));
  const int tid = ltid();
  for (int i = blockIdx.x * NTHR + tid; i < 8192 * 128; i += gridDim.x * NTHR) {
    const uint4 a = ldu4nt(t1 + i), b = ldu4nt(t2 + i);
    const unsigned aw[4] = {a.x, a.y, a.z, a.w}, bw[4] = {b.x, b.y, b.z, b.w}; unsigned o[4];
#pragma unroll
    for (int e = 0; e < 4; ++e) o[e] = (unsigned)f2bf(bf2f((bfraw)(aw[e] & 0xffff)) + bf2f((bfraw)(bw[e] & 0xffff))) | ((unsigned)f2bf(bf2f((bfraw)(aw[e] >> 16)) + bf2f((bfraw)(bw[e] >> 16))) << 16);
    dst[i] = uint4{o[0], o[1], o[2], o[3]};
  }
}

DEVI void phase_g5(const P& p, unsigned char* lds) {
  const int Gh = (int)gridDim.x >> 1, grp = (int)blockIdx.x / Gh, c = (int)blockIdx.x % Gh;
  EpiResid E{p.out, (const float*)(p.ws + O_MODS), grp * 8192, 5, 1.f, -1};
  if (grp < 2) run8(lds, (const bfraw*)(p.ws + (grp == 0 ? O_W1IN : O_QC)), (const bfraw*)(p.ws + O_WO), 8192, 1024, 1024, E, Gh, c);
}

DEVI void phase_cv(const P& p, int hb) {
  const int tid = ltid(), lane = tid & 63, wid = tid >> 6;
  const bfraw* qraw = (const bfraw*)(p.ws + O_QRAW);
  const bfraw* kraw = (const bfraw*)(p.ws + O_KRAW);
  const bfraw* craw = (const bfraw*)(p.ws + O_CTXRAW) + (size_t)hb * 256 * 3072;
  bfraw* qc = (bfraw*)(p.ws + O_QC);
  bfraw* kc = (bfraw*)(p.ws + O_KC);
  bfraw* vv = (bfraw*)(p.ws + O_V);
  const bfraw* gvs = (const bfraw*)(p.ws + O_GVS);
  float* rsb = (float*)(p.ws + O_RS);
  const float* cw = p.in[I_CONVW];
  const float* cb = p.in[I_CONVB];
  for (int task = blockIdx.x * 8 + wid; task < 1056 * 4; task += gridDim.x * 8) {
    const int sidx = task >> 2, part = task & 3, isk = part >> 1;
    const bool lat = sidx < 1024;
    const int lr0 = (lat ? sidx : sidx - 1024) * 8, len = lat ? 8192 : 256, orow0 = sidx * 8;
    const bfraw* src = lat ? (isk ? kraw : qraw) : (craw + isk * 1024);
    const size_t ld = lat ? 1024 : 3072;
    const int ch = (part & 1) * 512 + lane * 8, wch = isk * 1024 + ch;
    float w0[8], w1[8], w2[8], bb[8];
#pragma unroll
    for (int e = 0; e < 8; e += 4) {
      float4 a = ld4(cw + wch + e), b = ld4(cw + 2048 + wch + e), c4 = ld4(cw + 4096 + wch + e), d = ld4(cb + wch + e);
      w0[e] = a.x; w0[e + 1] = a.y; w0[e + 2] = a.z; w0[e + 3] = a.w; w1[e] = b.x; w1[e + 1] = b.y; w1[e + 2] = b.z; w1[e + 3] = b.w;
      w2[e] = c4.x; w2[e + 1] = c4.y; w2[e + 2] = c4.z; w2[e + 3] = c4.w; bb[e] = d.x; bb[e + 1] = d.y; bb[e + 2] = d.z; bb[e + 3] = d.w;
    }
    uint4 rw[10];
#pragma unroll
    for (int i = 0; i < 10; ++i) { const int lr = lr0 - 1 + i; uint4 t = {0u, 0u, 0u, 0u}; if (lr >= 0 && lr < len) t = *(const uint4*)(src + (size_t)lr * ld + ch); rw[i] = t; }
    const float osc = isk ? 1.f : 0.0625f;
    bfraw* dst = (isk ? kc : qc) + (size_t)orow0 * 1024 + ch;
#pragma unroll
    for (int i = 0; i < 8; ++i) {
      const unsigned av[4] = {rw[i].x, rw[i].y, rw[i].z, rw[i].w}, bv[4] = {rw[i + 1].x, rw[i + 1].y, rw[i + 1].z, rw[i + 1].w}, cv[4] = {rw[i + 2].x, rw[i + 2].y, rw[i + 2].z, rw[i + 2].w};
      unsigned ov[4];
#pragma unroll
      for (int e = 0; e < 4; ++e) {
        const float y0 = bf2f((bfraw)(av[e] & 0xffff)) * w0[2 * e] + bf2f((bfraw)(bv[e] & 0xffff)) * w1[2 * e] + bf2f((bfraw)(cv[e] & 0xffff)) * w2[2 * e] + bb[2 * e];
        const float y1 = bf2f((bfraw)(av[e] >> 16)) * w0[2 * e + 1] + bf2f((bfraw)(bv[e] >> 16)) * w1[2 * e + 1] + bf2f((bfraw)(cv[e] >> 16)) * w2[2 * e + 1] + bb[2 * e + 1];
        ov[e] = (unsigned)f2bf(siluf_(y0) * osc) | ((unsigned)f2bf(siluf_(y1) * osc) << 16);
      }
      *(uint4*)(dst + (size_t)i * 1024) = uint4{ov[0], ov[1], ov[2], ov[3]};
    }
  }
  for (int row = blockIdx.x * 8 + wid; row < 8448; row += gridDim.x * 8) {
    if (row < 8192) {
      float ss = 0;
#pragma unroll
      for (int hlf = 0; hlf < 2; ++hlf) {
        uint4 g = *(const uint4*)(gvs + (size_t)row * 1024 + hlf * 512 + lane * 8);
        unsigned gv[4] = {g.x, g.y, g.z, g.w};
#pragma unroll
        for (int e = 0; e < 4; ++e) { float a = bf2f((bfraw)(gv[e] & 0xffff)), b = bf2f((bfraw)(gv[e] >> 16)); ss += a * a + b * b; }
      }
      ss = wave_sum(ss);
      if (lane == 0) rsb[row] = rsqrtf(ss * (1.f / 1024.f) + EPS);
    } else {
#pragma unroll
      for (int hlf = 0; hlf < 2; ++hlf)
        *(uint4*)(vv + (size_t)row * 1024 + hlf * 512 + lane * 8) = *(const uint4*)(craw + 2048 + (size_t)(row - 8192) * 3072 + hlf * 512 + lane * 8);
    }
  }
}

DEVI void phase_ma(const P& p, unsigned char* lds, int hb) {
  const int tid = ltid();
  bfraw* st = (bfraw*)lds;
  float* sc = (float*)(lds + 131072);
  float* s_w = sc + 128, *s_ws = sc + 256, *s_red = sc + 384, *s_part = sc + 512;
  const float* bg = p.in[I_BGATES];
  for (int item = blockIdx.x; item < 528 + 256; item += gridDim.x) {
    unsigned char* wsb = lws(p.ws);
    const float* gates = (const float*)(wsb + O_GATES);
    const bfraw* kc = (const bfraw*)(wsb + O_KC);
    const bfraw* vv = (const bfraw*)(wsb + O_V);
    bfraw* states = (bfraw*)(wsb + O_ST);
    float* nloc = (float*)(wsb + O_NLOC);
    float* mg = (float*)(wsb + O_MG);
    if (item < 528) {
      const int seq = item / 66, j = item % 66, d = seq >> 2, h = seq & 3;
      int rbase, grow;
      if (j < 2) { int cc = d == 0 ? j : 1 - j; rbase = 8192 + cc * 128; grow = 16384 + hb * 256 + cc * 128; }
      else { int c = d == 0 ? j - 2 : 65 - j; rbase = c * 128; grow = hb * 8192 + c * 128; }
      __syncthreads();
      const int el = d == 0 ? (tid & 127) : 127 - (tid & 127);
      float li = 0.f, lf = 0.f;
      if (tid < 128) {
        li = gates[(size_t)(grow + el) * 16 + d * 8 + h] + bg[d * 8 + h];
        lf = logsigf_(gates[(size_t)(grow + el) * 16 + d * 8 + 4 + h] + bg[d * 8 + 4 + h]);
      }
      const float bcum = seg_scan_sum(lf, tid, s_red + 4);
      if (tid == 127) s_red[1] = bcum;
      __syncthreads();
      const float gtot = s_red[1];
      const float wv = gtot - bcum + li;
      if (tid < 128) s_w[el] = wv;
      __syncthreads();
      if (tid < 64) {
        float m = fmaxf(s_w[tid], s_w[tid + 64]);
#pragma unroll
        for (int o = 32; o > 0; o >>= 1) m = fmaxf(m, __shfl_xor(m, o, 64));
        if (tid == 0) s_red[0] = m;
      }
      __syncthreads();
      const float mloc = s_red[0];
      if (tid < 128) s_ws[el] = expf(wv - mloc);
      if (tid == 0) { mg[seq * 66 + j] = mloc; mg[528 + seq * 66 + j] = gtot; }
      __syncthreads();
      {
        const int k = tid & 255, part = tid >> 8;
        const bfraw* kp0 = kc + (size_t)(rbase + part * 64) * 1024 + h * 256 + k;
        float n = 0;
#pragma unroll 16
        for (int t = 0; t < 64; ++t) n += s_ws[part * 64 + t] * bf2f(kp0[(size_t)t * 1024]);
        s_part[tid] = n;
      }
      bfraw* dst = states + (size_t)(seq * 66 + j) * 65536;
      {
        f32x4 acc[8][4]; ZERO_ACC(acc, 8, 4);
        gemm_tile<256, 256, true, true, false>(vv + (size_t)rbase * 1024 + h * 256, 1024, kc + (size_t)rbase * 1024 + h * 256, 1024, 128, s_ws, acc, st, nullptr, 0);
        EPI_BEGIN(256, 256)
          dst[row * 256 + col] = f2bf(acc[i][j][r]);
        EPI_END
      }
      if (tid < 256) nloc[(size_t)(seq * 66 + j) * 256 + tid] = s_part[tid] + s_part[tid + 256];
    } else {
      const int it = item - 528, c = it >> 2, g = it & 3;
      bfraw* gvs = (bfraw*)(wsb + O_GVS);
      const float* rsb = (const float*)(wsb + O_RS);
      f32x4 acc[4][4]; ZERO_ACC(acc, 4, 4);
      gemm_tile<128, 256, false, true, false>((const bfraw*)(wsb + O_WSB) + g * 16384, 128, gvs + (size_t)c * 128 * 1024 + g * 256, 1024, 128, rsb + c * 128, acc, st, nullptr, 0);
      const float* gs = p.in[I_GSGU] + g * 256;
      const float* bs = p.in[I_BS] + g * 128;
      EPI_BEGIN(128, 256)
        gvs[(size_t)(c * 128 + row) * 1024 + g * 256 + col] = f2bf(gs[col] * acc[i][j][r] + bs[row]);
      EPI_END
    }
  }
}

DEVI void phase_mb(const P& p, unsigned char* lds) {
  bfraw* states = (bfraw*)(p.ws + O_ST);
  const float* mg = (const float*)(p.ws + O_MG);
  float* ment = (float*)(p.ws + O_MG) + 1056;
  const float* nloc = (const float*)(p.ws + O_NLOC);
  float* nent = (float*)(p.ws + O_NENT);
  const int gid = blockIdx.x * NTHR + ltid(), gsz = gridDim.x * NTHR;
  float* s_dec = (float*)lds, *s_scl = s_dec + 528;
  __syncthreads();
  if (ltid() < 8) {
    const int seq = ltid(); float m = 0;
    for (int j = 0; j < 66; ++j) {
      const float mloc = mg[seq * 66 + j], g = mg[528 + seq * 66 + j];
      const float mnew = fmaxf(g + m, mloc);
      s_dec[seq * 66 + j] = expf(g + m - mnew); s_scl[seq * 66 + j] = expf(mloc - mnew);
      if (blockIdx.x == 0) ment[seq * 66 + j] = m;
      m = mnew;
    }
  }
  __syncthreads();
  for (int id = gid; id < 8 * 16384; id += gsz) {
    const int seq = id >> 14, e = (id & 16383) * 4;
    float s0 = 0, s1 = 0, s2 = 0, s3 = 0;
    bfraw* base = states + (size_t)seq * 66 * 65536 + e;
#pragma unroll 1
    for (int cb = 0; cb < 66; cb += 22) {
      uint2 buf[22];
#pragma unroll
      for (int i = 0; i < 22; ++i) { const nt_u2 t_ = __builtin_nontemporal_load((const nt_u2*)(base + (size_t)(cb + i) * 65536)); buf[i] = uint2{t_.x, t_.y}; }
#pragma unroll
      for (int i = 0; i < 22; ++i) {
        const int j = cb + i; const uint2 cur = buf[i];
        const float dec = s_dec[seq * 66 + j], scl = s_scl[seq * 66 + j];
        if (j >= 2) { uint2 o; o.x = (unsigned)f2bf(s0) | ((unsigned)f2bf(s1) << 16); o.y = (unsigned)f2bf(s2) | ((unsigned)f2bf(s3) << 16);
          __builtin_nontemporal_store(nt_u2{o.x, o.y}, (nt_u2*)(base + (size_t)j * 65536)); }
        s0 = dec * s0 + scl * bf2f((bfraw)(cur.x & 0xffff)); s1 = dec * s1 + scl * bf2f((bfraw)(cur.x >> 16));
        s2 = dec * s2 + scl * bf2f((bfraw)(cur.y & 0xffff)); s3 = dec * s3 + scl * bf2f((bfraw)(cur.y >> 16));
      }
    }
  }
  for (int id = gid; id < 8 * 256; id += gsz) {
    const int seq = id >> 8, k = id & 255;
    float n = 0;
    for (int j = 0; j < 66; ++j) {
      nent[(size_t)(seq * 66 + j) * 256 + k] = n;
      n = s_dec[seq * 66 + j] * n + s_scl[seq * 66 + j] * nloc[(size_t)(seq * 66 + j) * 256 + k];
    }
  }
}

DEVI void phase_mc(const P& p, unsigned char* lds, int hb) {
  const int tid = ltid(), lane = tid & 63, wid = tid >> 6, wm = wid >> 2, wn = wid & 3, fr = lane & 15, fq = lane >> 4;
  bfraw* st = (bfraw*)lds;
  bfraw* sS = (bfraw*)(lds + 61440);
  float* sc = (float*)(lds + 131072);
  float* s_b = sc, *s_u = sc + 256, *s_mt = sc + 512, *s_in = sc + 768, *s_den = sc + 1024, *s_dq = sc + 1280, *s_tmp = sc + 1536;
  float* s_sum = sc + 1792, *s_sq = sc + 1920;
  const float* bg = p.in[I_BGATES];
  for (int item = blockIdx.x; item < 256; item += gridDim.x) {
    unsigned char* wsb = lws(p.ws);
    const float* gates = (const float*)(wsb + O_GATES);
    const bfraw* qc = (const bfraw*)(wsb + O_QC);
    const bfraw* kc = (const bfraw*)(wsb + O_KC);
    bfraw* vv = (bfraw*)(wsb + O_V);
    const bfraw* states = (const bfraw*)(wsb + O_ST);
    const float* ment = (const float*)(wsb + O_MG) + 1056;
    const float* nent = (const float*)(wsb + O_NENT);
    const int c = item >> 2, h = item & 3, R0 = c * 128;
    const bfraw* qp = qc + (size_t)R0 * 1024 + h * 256;
    const bfraw* kp = kc + (size_t)R0 * 1024 + h * 256;
    __syncthreads();
    {
      const int d = (tid >> 7) & 1, t = tid & 127, el = d == 0 ? t : 127 - t, ix = d * 128 + el;
      float li = 0.f, lf = 0.f;
      if (tid < 256) {
        const size_t grow = (size_t)hb * 8192 + R0 + el;
        li = gates[grow * 16 + d * 8 + h] + bg[d * 8 + h];
        lf = logsigf_(gates[grow * 16 + d * 8 + 4 + h] + bg[d * 8 + 4 + h]);
        s_den[tid] = 0.f;
        if (tid < 128) { s_sum[tid] = 0.f; s_sq[tid] = 0.f; }
      }
      const float b = seg_scan_sum(lf, tid, s_tmp);
      const float uu = li - b;
      const float pm = seg_scan_max(tid < 256 ? uu : -INFINITY, tid, s_tmp);
      if (tid < 256) {
        const int seq = d * 4 + h, j = d == 0 ? c + 2 : 65 - c;
        const float mst = ment[seq * 66 + j];
        const float a = b + mst;
        const float mt = fmaxf(a, b + pm);
        s_b[ix] = b; s_u[ix] = uu; s_mt[ix] = mt; s_in[ix] = expf(a - mt);
      }
    }
    {
      const int row = tid >> 2, part = tid & 3;
      const uint4* q4 = (const uint4*)(qp + (size_t)row * 1024 + part * 64);
      const float4* nf4 = (const float4*)(nent + (size_t)((0 + h) * 66 + (c + 2)) * 256 + part * 64);
      const float4* nb4 = (const float4*)(nent + (size_t)((4 + h) * 66 + (65 - c)) * 256 + part * 64);
      uint4 qv[8];
#pragma unroll
      for (int i = 0; i < 8; ++i) qv[i] = q4[i];
      float af = 0, ab = 0;
#pragma unroll
      for (int i = 0; i < 8; ++i) {
        const float4 f0 = nf4[2 * i], f1 = nf4[2 * i + 1], b0 = nb4[2 * i], b1 = nb4[2 * i + 1];
        const float q0 = bf2f((bfraw)(qv[i].x & 0xffff)), q1 = bf2f((bfraw)(qv[i].x >> 16)), q2 = bf2f((bfraw)(qv[i].y & 0xffff)), q3 = bf2f((bfraw)(qv[i].y >> 16));
        const float q4_ = bf2f((bfraw)(qv[i].z & 0xffff)), q5 = bf2f((bfraw)(qv[i].z >> 16)), q6 = bf2f((bfraw)(qv[i].w & 0xffff)), q7 = bf2f((bfraw)(qv[i].w >> 16));
        af += q0 * f0.x + q1 * f0.y + q2 * f0.z + q3 * f0.w + q4_ * f1.x + q5 * f1.y + q6 * f1.z + q7 * f1.w;
        ab += q0 * b0.x + q1 * b0.y + q2 * b0.z + q3 * b0.w + q4_ * b1.x + q5 * b1.y + q6 * b1.z + q7 * b1.w;
      }
      af += __shfl_xor(af, 1, 64); af += __shfl_xor(af, 2, 64);
      ab += __shfl_xor(ab, 1, 64); ab += __shfl_xor(ab, 2, 64);
      if (part == 0) { s_dq[row] = af; s_dq[128 + row] = ab; }
    }
    __syncthreads();
    {
      f32x4 S[4][2]; ZERO_ACC(S, 4, 2);
      gemm_tile<128, 128, false, false, false>(qp, 1024, kp, 1024, 256, nullptr, S, st, nullptr, 0);
#pragma unroll 1
      for (int d = 0; d < 2; ++d)
#pragma unroll
        for (int i = 0; i < 4; ++i)
#pragma unroll
          for (int r = 0; r < 4; ++r) {
            const int row = wm * 64 + i * 16 + fq * 4 + r;
            const float bt = s_b[d * 128 + row] - s_mt[d * 128 + row];
            float rs = 0;
#pragma unroll
            for (int j = 0; j < 2; ++j) {
              const int col = wn * 32 + j * 16 + fr;
              const bool valid = d == 0 ? (col <= row) : (col >= row);
              const float val = valid ? S[i][j][r] * fexp(bt + s_u[d * 128 + col]) : 0.f;
              rs += val;
              sS[(d * 128 + row) * 136 + col] = f2bf(val);
            }
            rs = red16(rs);
            if (fr == 0) atomicAdd(&s_den[d * 128 + row], rs);
          }
    }
    __syncthreads();
    f32x4 hs[4][4];
    uint4* hpark = (uint4*)(wsb + O_HPARK) + ((size_t)item * NTHR + tid) * 8;
#pragma unroll 1
    for (int d = 0; d < 2; ++d) {
      f32x4 (&acc)[4][4] = hs; ZERO_ACC(acc, 4, 4);
      const int seq = d * 4 + h, j2 = d == 0 ? c + 2 : 65 - c;
      gemm_tile<128, 256, false, false, false>(qp, 1024, states + (size_t)(seq * 66 + j2) * 65536, 256, 256, nullptr, acc, st, nullptr, 0);
      EPIR_BEGIN(128, 256)
        const float sin_ = s_in[d * 128 + row];
        EPIR_COLS(256) acc[i][j][r] *= sin_; (void)col;
      EPIR_END
      gemm_tile<128, 256, false, true, true>(nullptr, 0, vv + (size_t)R0 * 1024 + h * 256, 1024, 128, nullptr, acc, st, sS + d * 128 * 136, 136);
      EPIR_BEGIN(128, 256)
        const float den = s_den[d * 128 + row] + s_in[d * 128 + row] * s_dq[d * 128 + row];
        const float inv = 1.f / fmaxf(fabsf(den), expf(-s_mt[d * 128 + row]));
        EPIR_COLS(256) acc[i][j][r] *= inv; (void)col;
      EPIR_END
      if (d == 0) {
#pragma unroll
        for (int i = 0; i < 4; ++i) {
          uint4 w0, w1;
          w0.x = (unsigned)f2bf(acc[i][0][0]) | ((unsigned)f2bf(acc[i][0][1]) << 16); w0.y = (unsigned)f2bf(acc[i][0][2]) | ((unsigned)f2bf(acc[i][0][3]) << 16);
          w0.z = (unsigned)f2bf(acc[i][1][0]) | ((unsigned)f2bf(acc[i][1][1]) << 16); w0.w = (unsigned)f2bf(acc[i][1][2]) | ((unsigned)f2bf(acc[i][1][3]) << 16);
          w1.x = (unsigned)f2bf(acc[i][2][0]) | ((unsigned)f2bf(acc[i][2][1]) << 16); w1.y = (unsigned)f2bf(acc[i][2][2]) | ((unsigned)f2bf(acc[i][2][3]) << 16);
          w1.z = (unsigned)f2bf(acc[i][3][0]) | ((unsigned)f2bf(acc[i][3][1]) << 16); w1.w = (unsigned)f2bf(acc[i][3][2]) | ((unsigned)f2bf(acc[i][3][3]) << 16);
          hpark[2 * i] = w0; hpark[2 * i + 1] = w1;
        }
      } else {
#pragma unroll
        for (int i = 0; i < 4; ++i) {
          const uint4 w0 = hpark[2 * i], w1 = hpark[2 * i + 1];
          const unsigned ww[8] = {w0.x, w0.y, w0.z, w0.w, w1.x, w1.y, w1.z, w1.w};
#pragma unroll
          for (int j = 0; j < 4; ++j) {
            hs[i][j][0] += bf2f((bfraw)(ww[2 * j] & 0xffff)); hs[i][j][1] += bf2f((bfraw)(ww[2 * j] >> 16));
            hs[i][j][2] += bf2f((bfraw)(ww[2 * j + 1] & 0xffff)); hs[i][j][3] += bf2f((bfraw)(ww[2 * j + 1] >> 16));
          }
        }
      }
    }
#pragma unroll
    for (int i = 0; i < 4; ++i)
#pragma unroll
      for (int r = 0; r < 4; ++r) {
        float ps = hs[i][0][r] + hs[i][1][r] + hs[i][2][r] + hs[i][3][r];
        ps = red16(ps);
        if (fr == 0) atomicAdd(&s_sum[wm * 64 + i * 16 + fq * 4 + r], ps);
      }
    __syncthreads();
#pragma unroll
    for (int i = 0; i < 4; ++i)
#pragma unroll
      for (int r = 0; r < 4; ++r) {
        const float mu = s_sum[wm * 64 + i * 16 + fq * 4 + r] * (1.f / 256.f);
        float ps = 0;
#pragma unroll
        for (int j = 0; j < 4; ++j) { float dlt = hs[i][j][r] - mu; ps += dlt * dlt; }
        ps = red16(ps);
        if (fr == 0) atomicAdd(&s_sq[wm * 64 + i * 16 + fq * 4 + r], ps);
      }
    __syncthreads();
    const float* gh = p.in[I_GHEAD] + h * 256;
    EPIR_BEGIN(128, 256)
      const float mu = s_sum[row] * (1.f / 256.f);
      const float rstd = rsqrtf(s_sq[row] * (1.f / 256.f) + EPS);
      EPIR_COLS(256)
        vv[(size_t)(R0 + row) * 1024 + h * 256 + col] = f2bf((hs[i][j][r] - mu) * rstd * gh[col]);
    EPIR_END
  }
}

constexpr int NPH = 28;
#define PHASE_PROGRAM \
  PHASE(0, phase_p0(p, lds)) \
  PHASE(1, phase_p0b(p)) \
  PHASE(2, phase_rows<1>(p, lds)) \
  PHASE(3, phase_ffn_in(p, lds, O_W1IN, 16896)) \
  PHASE(4, phase_ffn_out(p, lds, O_W1OUT, 2, true)) \
  PHASE(5, phase_r2_g2c(p, lds)) \
  PHASE(6, phase_rows<2>(p, lds, 16384, 16896)) \
  PHASE(7, phase_g3c(p, lds)) \
  PHASE(8, phase_g3a(p, lds, 0)) \
  PHASE(9, phase_cv(p, 0)) \
  PHASE(10, phase_ma(p, lds, 0)) \
  PHASE(11, phase_mb(p, lds)) \
  PHASE(12, phase_mc(p, lds, 0)) \
  PHASE(13, phase_g3b(p, lds, 0)) \
  PHASE(14, phase_g4(p, lds)) \
  PHASE(15, phase_addmix(p, 0); __syncthreads(); phase_g3a(p, lds, 1)) \
  PHASE(16, phase_cv(p, 1)) \
  PHASE(17, phase_ma(p, lds, 1)) \
  PHASE(18, phase_mb(p, lds)) \
  PHASE(19, phase_mc(p, lds, 1)) \
  PHASE(20, phase_g3b(p, lds, 1)) \
  PHASE(21, phase_g4(p, lds)) \
  PHASE(22, phase_addmix(p, 1)) \
  PHASE(23, phase_g5(p, lds)) \
  PHASE(24, phase_rows<3>(p, lds)) \
  PHASE(25, phase_ffn_in(p, lds, O_W2IN, 16384)) \
  PHASE(26, phase_ffn_out(p, lds, O_W2OUT, 8, false)) \
  PHASE(27, phase_rows<4>(p, lds))

#if !MULTI_LAUNCH
#ifndef USE_CG
#define USE_CG 0
#endif
#if USE_CG
#define PHASE(n, call) if (lo <= (n) && (n) < hi) { if ((n) > lo) { if ((n) == 1) grid.sync(); else xcd_barrier(xbar); } call; }
#else
#define PHASE(n, call) if (lo <= (n) && (n) < hi) { if ((n) > lo) xcd_barrier(xbar); call; }
#endif
__global__ void __launch_bounds__(512) mk(P p, int lo, int hi) {
  extern __shared__ __attribute__((aligned(16))) unsigned char lds[];
#if USE_CG
  cg::grid_group grid = cg::this_grid();
#endif
  volatile LAS unsigned* stw = (volatile LAS unsigned*)(lds + LDS_BYTES - 16);
  if (threadIdx.x == 0) { stw[0] = 0u; stw[1] = 0u; stw[2] = 0u; stw[3] = 0u; }
  __syncthreads();
  XcdBarrier xbar = xcd_barrier_post((unsigned*)(p.ws + O_BAR), stw);
  PHASE_PROGRAM
}
#undef PHASE
#else
#define PHASE(n, call) if constexpr (PH == (n)) { call; }
template <int PH>
__global__ void __launch_bounds__(512) mkp(P p) {
  extern __shared__ __attribute__((aligned(16))) unsigned char lds[];
  PHASE_PROGRAM
}
#undef PHASE
template <int PH> static void launch_all(const P& p, int grid, hipStream_t stream) {
  if constexpr (PH < NPH) {
    (void)hipFuncSetAttribute((const void*)mkp<PH>, hipFuncAttributeMaxDynamicSharedMemorySize, LDS_BYTES);
    hipLaunchKernelGGL(mkp<PH>, dim3(grid), dim3(NTHR), LDS_BYTES, stream, p);
    launch_all<PH + 1>(p, grid, stream);
  }
}
#endif

extern "C" void kernel_launch(void* const* d_in, const int* in_sizes, int n_in, void* d_out, int out_size, void* d_ws, size_t ws_size, hipStream_t stream) {
  static int grid_blocks = 0;
  if (!grid_blocks) {
    if (n_in != 25 || ws_size < O_END || ws_size < O_ACT + 16896ull * 2816 * 2) { fprintf(stderr, "kernel_launch: unexpected n_in %d / ws %zu\n", n_in, ws_size); grid_blocks = -1; return; }
    int dev = 0, cus = 0, per_cu = 0;
    (void)hipGetDevice(&dev);
    (void)hipDeviceGetAttribute(&cus, hipDeviceAttributeMultiprocessorCount, dev);
#if !MULTI_LAUNCH
    if (hipFuncSetAttribute((const void*)mk, hipFuncAttributeMaxDynamicSharedMemorySize, LDS_BYTES) != hipSuccess) { fprintf(stderr, "hipFuncSetAttribute failed\n"); grid_blocks = -1; return; }
    if (hipOccupancyMaxActiveBlocksPerMultiprocessor(&per_cu, (const void*)mk, NTHR, LDS_BYTES) != hipSuccess || per_cu < 1) { fprintf(stderr, "occupancy query failed (%d)\n", per_cu); grid_blocks = -1; return; }
#endif
    grid_blocks = cus * 1;
    fprintf(stderr, "kernel_launch: cus %d per_cu %d grid %d\n", cus, per_cu, grid_blocks);
  }
  if (grid_blocks < 0) return;
  P p{};
  for (int i = 0; i < 25; ++i) p.in[i] = (const float*)d_in[i];
  p.out = (float*)d_out; p.ws = (unsigned char*)d_ws;
#if MULTI_LAUNCH
  launch_all<0>(p, grid_blocks, stream);
#else
  int lo = 0, hi = NPH;
  if (hipMemsetAsync((unsigned char*)d_ws + O_BAR, 0, 16384, stream) != hipSuccess) { fprintf(stderr, "memset of barrier words failed\n"); return; }
  void* args[] = {&p, &lo, &hi};
#ifdef PROBE_K
  {
    hipLaunchKernelGGL(mk, dim3(grid_blocks), dim3(NTHR), LDS_BYTES, stream, p, 0, PROBE_K + 1);
    (void)hipMemsetAsync((unsigned char*)d_ws + O_BAR, 0, 16384, stream);
  }
#endif
#if USE_CG
  hipError_t e = hipLaunchCooperativeKernel((const void*)mk, dim3(grid_blocks), dim3(NTHR), args, LDS_BYTES, stream);
#else
  (void)args;
  hipLaunchKernelGGL(mk, dim3(grid_blocks), dim3(NTHR), LDS_BYTES, stream, p, lo, hi);
  hipError_t e = hipPeekAtLastError();
#endif
  if (e != hipSuccess) fprintf(stderr, "cooperative launch failed: %s (grid %d)\n", hipGetErrorString(e), grid_blocks);
#endif
}
```
